# Optimizing an MI355X kernel written in HIP

```python
import math
import jax
import jax.numpy as jnp
from jax import lax
import numpy as np

D_MODEL = 1024
BATCH = 8
SEQ = 4096
DEPTH = 2

N_MIXERS = 2
N_A_LAYERS = (DEPTH + 1) // 2
N_B_LAYERS = DEPTH // 2
A_HEADS = 16
A_HEAD_DIM = 64
A_V_DIM = 64
A_Q_RANK = 256
A_KV_RANK = 128
IDX_HEADS = 8
IDX_DIM = 64
IDX_TOPK_MAX = 256
IDX_TOPK_FRAC = 4
A_IN_WIDTH = A_Q_RANK + A_KV_RANK + IDX_DIM + IDX_HEADS
B_HEADS = 16
B_HEAD_DIM = 64
B_IN_WIDTH = 3 * B_HEADS * B_HEAD_DIM + B_HEADS
REL_BUCKETS = 32
REL_MAX_DIST = 128
N_EXPERTS = 32
TOP_K = 4
D_EXPERT = 1024
SWIGLU_ALPHA = 1.702
SWIGLU_LIMIT = 7.0
EXPERT_BLOCK = 512
Q_BLOCK = 128
LN_EPS = 1e-5
RMS_EPS = 1e-6
DEEPNORM_ALPHA = (2.0 * DEPTH) ** 0.25
DEEPNORM_BETA = (8.0 * DEPTH) ** -0.25

kernel_name = 'hybrid_dsa_fox_moe_deepnorm'


def layer_norm(x, g, b):
    xf = x.astype(jnp.float32)
    mu = jnp.mean(xf, -1, keepdims=True)
    var = jnp.mean(jnp.square(xf - mu), -1, keepdims=True)
    return ((xf - mu) * lax.rsqrt(var + LN_EPS) * g + b).astype(x.dtype)


def rms_norm(x, g):
    xf = x.astype(jnp.float32)
    y = xf * lax.rsqrt(jnp.mean(xf * xf, -1, keepdims=True) + RMS_EPS)
    return (y * g).astype(x.dtype)


def t5_bucket(dist):
    max_exact = REL_BUCKETS // 2
    n = jnp.maximum(dist, 0)
    large = max_exact + (jnp.log(jnp.maximum(n, 1).astype(jnp.float32) / max_exact)
                         / math.log(REL_MAX_DIST / max_exact)
                         * (REL_BUCKETS - max_exact)).astype(jnp.int32)
    large = jnp.minimum(large, REL_BUCKETS - 1)
    return jnp.where(n < max_exact, n, large)


def dsa_mixer(x, w_in, g_q, g_kv, g_kidx, b_kidx, w_uq, w_uk, w_uv, w_qidx, w_o, rel_table):
    bsz, seq, _ = x.shape
    topk = min(IDX_TOPK_MAX, seq // IDX_TOPK_FRAC)
    scale = A_HEAD_DIM ** -0.5
    proj = x @ w_in
    c_q, c_kv, k_idx, w_idx = jnp.split(
        proj, [A_Q_RANK, A_Q_RANK + A_KV_RANK, A_Q_RANK + A_KV_RANK + IDX_DIM], axis=-1)
    c_q = rms_norm(c_q, g_q)
    c_kv = rms_norm(c_kv, g_kv)
    k_idx = layer_norm(k_idx, g_kidx, b_kidx)
    q = jnp.einsum('bsr,rhd->bshd', c_q, w_uq)
    q_lat = jnp.einsum('bshd,rhd->bshr', q, w_uk) * scale
    q_idx = jnp.einsum('bsr,rhd->bshd', c_q, w_qidx)
    w_idx = w_idx * (IDX_HEADS ** -0.5 * IDX_DIM ** -0.5)
    key_pos = jnp.arange(seq)

    def block(i):
        t0 = i * Q_BLOCK
        qi = lax.dynamic_slice_in_dim(q_idx, t0, Q_BLOCK, axis=1)
        wi = lax.dynamic_slice_in_dim(w_idx, t0, Q_BLOCK, axis=1)
        ql = lax.dynamic_slice_in_dim(q_lat, t0, Q_BLOCK, axis=1)
        q_pos = t0 + jnp.arange(Q_BLOCK)
        causal = key_pos[None, :] <= q_pos[:, None]
        rel = jax.nn.relu(jnp.einsum('bthd,bsd->bths', qi, k_idx,
                                     preferred_element_type=jnp.float32))
        score = jnp.einsum('bths,bth->bts', rel, wi.astype(jnp.float32))
        score = jnp.where(causal[None], score, -jnp.inf)
        _, sel = lax.top_k(score, topk)
        c_sel = jax.vmap(lambda c, ix: c[ix])(c_kv, sel)
        valid = sel <= q_pos[None, :, None]
        bias = rel_table[t5_bucket(q_pos[None, :, None] - sel)]
        logits = jnp.einsum('bthr,btkr->bthk', ql, c_sel, preferred_element_type=jnp.float32)
        logits = logits + jnp.moveaxis(bias, -1, 2).astype(jnp.float32)
        logits = jnp.where(valid[:, :, None, :], logits, -jnp.inf)
        p = jax.nn.softmax(logits, axis=-1).astype(x.dtype)
        o_lat = jnp.einsum('bthk,btkr->bthr', p, c_sel)
        return jnp.einsum('bthr,rhd->bthd', o_lat, w_uv)

    out = lax.map(block, jnp.arange(seq // Q_BLOCK))
    out = out.transpose(1, 0, 2, 3, 4).reshape(bsz, seq, A_HEADS * A_V_DIM)
    return out @ w_o


def fox_mixer(x, w_in, b_f, w_o):
    bsz, seq, _ = x.shape
    hd = B_HEADS * B_HEAD_DIM
    scale = B_HEAD_DIM ** -0.5
    proj = x @ w_in
    q = proj[..., :hd].reshape(bsz, seq, B_HEADS, B_HEAD_DIM)
    k = proj[..., hd:2 * hd].reshape(bsz, seq, B_HEADS, B_HEAD_DIM)
    v = proj[..., 2 * hd:3 * hd].reshape(bsz, seq, B_HEADS, B_HEAD_DIM)
    log_f = jax.nn.log_sigmoid(proj[..., 3 * hd:].astype(jnp.float32) + b_f.astype(jnp.float32))
    cum = jnp.cumsum(log_f, axis=1).transpose(0, 2, 1)
    key_pos = jnp.arange(seq)

    def block(i):
        t0 = i * Q_BLOCK
        qi = lax.dynamic_slice_in_dim(q, t0, Q_BLOCK, axis=1)
        ci = lax.dynamic_slice_in_dim(cum, t0, Q_BLOCK, axis=2)
        q_pos = t0 + jnp.arange(Q_BLOCK)
        logits = jnp.einsum('bthd,bshd->bhts', qi, k, preferred_element_type=jnp.float32) * scale
        logits = logits + ci[:, :, :, None] - cum[:, :, None, :]
        logits = jnp.where((key_pos[None, :] <= q_pos[:, None])[None, None], logits, -jnp.inf)
        p = jax.nn.softmax(logits, axis=-1).astype(x.dtype)
        return jnp.einsum('bhts,bshd->bthd', p, v)

    out = lax.map(block, jnp.arange(seq // Q_BLOCK))
    out = out.transpose(1, 0, 2, 3, 4).reshape(bsz, seq, hd)
    return out @ w_o


def moe(x, w_router, b_router, w_gu, b_gu, w_down, b_down):
    bsz, seq, dm = x.shape
    xt = x.reshape(-1, dm)
    n_tok = xt.shape[0]
    n_pairs = n_tok * TOP_K
    logits = (xt @ w_router + b_router).astype(jnp.float32)
    top_v, top_e = lax.top_k(logits, TOP_K)
    gates = jax.nn.softmax(top_v, axis=-1)
    flat_e = top_e.reshape(-1)
    flat_tok = (jnp.arange(n_pairs, dtype=jnp.int32) // TOP_K)
    flat_g = gates.reshape(-1)
    order = jnp.argsort(flat_e)
    e_sorted = flat_e[order]
    counts = jnp.bincount(flat_e, length=N_EXPERTS)
    starts = jnp.cumsum(counts) - counts
    padded = (counts + EXPERT_BLOCK - 1) // EXPERT_BLOCK * EXPERT_BLOCK
    pad_ends = jnp.cumsum(padded)
    pad_starts = pad_ends - padded
    dest = pad_starts[e_sorted] + (jnp.arange(n_pairs) - starts[e_sorted])
    n_slots = -(-n_pairs // EXPERT_BLOCK) * EXPERT_BLOCK + N_EXPERTS * EXPERT_BLOCK
    slot_tok = jnp.full((n_slots,), n_tok, jnp.int32).at[dest].set(flat_tok[order])
    slot_gate = jnp.zeros((n_slots,), x.dtype).at[dest].set(flat_g[order].astype(x.dtype))
    n_chunks = n_slots // EXPERT_BLOCK
    chunk_start = jnp.arange(n_chunks) * EXPERT_BLOCK
    chunk_e = jnp.minimum(jnp.searchsorted(pad_ends, chunk_start, side='right'), N_EXPERTS - 1)
    xt_pad = jnp.concatenate([xt, jnp.zeros((1, dm), xt.dtype)], axis=0)

    def expert_block(args):
        tok, e = args
        h = xt_pad[tok] @ w_gu[e] + b_gu[e]
        gate, up = h[:, :D_EXPERT], h[:, D_EXPERT:]
        gate = jnp.minimum(gate, SWIGLU_LIMIT)
        up = jnp.clip(up, -SWIGLU_LIMIT, SWIGLU_LIMIT)
        h = (up + 1.0) * (gate * jax.nn.sigmoid(SWIGLU_ALPHA * gate))
        return h @ w_down[e] + b_down[e]

    y = lax.map(expert_block, (slot_tok.reshape(n_chunks, EXPERT_BLOCK), chunk_e))
    y = y.reshape(n_slots, dm) * slot_gate[:, None]
    out = jax.ops.segment_sum(y, slot_tok, num_segments=n_tok + 1)[:n_tok]
    return out.reshape(bsz, seq, dm)


def _normal(k, shape, scale):
    return jax.random.normal(k, shape, jnp.float32) * scale


def setup_inputs(seed: int = 0) -> dict:
    key = jax.random.key(seed)
    ks = jax.random.split(key, 32)
    D = D_MODEL
    hd = B_HEADS * B_HEAD_DIM
    b_qkv = _normal(ks[12], (N_B_LAYERS, D, 3 * hd), D ** -0.5)
    b_f_cols = _normal(ks[13], (N_B_LAYERS, D, B_HEADS), 0.1 * D ** -0.5)
    return {
        'x': _normal(ks[0], (BATCH, SEQ, D), 1.0),
        'rel_table': _normal(ks[1], (REL_BUCKETS, A_HEADS), 0.5),
        'a_w_in': _normal(ks[2], (N_A_LAYERS, D, A_IN_WIDTH), D ** -0.5),
        'a_g_q': 1.0 + _normal(ks[3], (N_A_LAYERS, A_Q_RANK), 0.02),
        'a_g_kv': 1.0 + _normal(ks[4], (N_A_LAYERS, A_KV_RANK), 0.02),
        'a_g_kidx': 1.0 + _normal(ks[5], (N_A_LAYERS, IDX_DIM), 0.02),
        'a_b_kidx': _normal(ks[6], (N_A_LAYERS, IDX_DIM), 0.02),
        'a_w_uq': _normal(ks[7], (N_A_LAYERS, A_Q_RANK, A_HEADS, A_HEAD_DIM), A_Q_RANK ** -0.5),
        'a_w_uk': _normal(ks[8], (N_A_LAYERS, A_KV_RANK, A_HEADS, A_HEAD_DIM), A_KV_RANK ** -0.5),
        'a_w_uv': _normal(ks[9], (N_A_LAYERS, A_KV_RANK, A_HEADS, A_V_DIM), A_KV_RANK ** -0.5),
        'a_w_qidx': _normal(ks[10], (N_A_LAYERS, A_Q_RANK, IDX_HEADS, IDX_DIM), A_Q_RANK ** -0.5),
        'a_w_o': _normal(ks[11], (N_A_LAYERS, A_HEADS * A_V_DIM, D), DEEPNORM_BETA * (A_HEADS * A_V_DIM) ** -0.5),
        'b_w_in': jnp.concatenate([b_qkv, b_f_cols], axis=-1),
        'b_b_f': jax.random.uniform(ks[14], (N_B_LAYERS, B_HEADS), jnp.float32, 1.0, 4.0),
        'b_w_o': _normal(ks[15], (N_B_LAYERS, hd, D), DEEPNORM_BETA * hd ** -0.5),
        'ln_mix_g': 1.0 + _normal(ks[16], (DEPTH, D), 0.02),
        'ln_mix_b': _normal(ks[17], (DEPTH, D), 0.02),
        'ln_ffn_g': 1.0 + _normal(ks[18], (DEPTH, D), 0.02),
        'ln_ffn_b': _normal(ks[19], (DEPTH, D), 0.02),
        'w_router': _normal(ks[20], (DEPTH, D, N_EXPERTS), D ** -0.5),
        'b_router': _normal(ks[21], (DEPTH, N_EXPERTS), 0.01),
        'w_gu': _normal(ks[22], (DEPTH, N_EXPERTS, D, 2 * D_EXPERT), D ** -0.5),
        'b_gu': _normal(ks[23], (DEPTH, N_EXPERTS, 2 * D_EXPERT), 0.02),
        'w_down': _normal(ks[24], (DEPTH, N_EXPERTS, D_EXPERT, D), DEEPNORM_BETA * D_EXPERT ** -0.5),
        'b_down': _normal(ks[25], (DEPTH, N_EXPERTS, D), 0.02),
    }


def reference(x, rel_table, a_w_in, a_g_q, a_g_kv, a_g_kidx, a_b_kidx, a_w_uq, a_w_uk, a_w_uv,
              a_w_qidx, a_w_o, b_w_in, b_b_f, b_w_o, ln_mix_g, ln_mix_b, ln_ffn_g, ln_ffn_b,
              w_router, b_router, w_gu, b_gu, w_down, b_down):
    for i in range(DEPTH):
        j = i // N_MIXERS
        if i % N_MIXERS == 0:
            h = dsa_mixer(x, a_w_in[j], a_g_q[j], a_g_kv[j], a_g_kidx[j], a_b_kidx[j],
                          a_w_uq[j], a_w_uk[j], a_w_uv[j], a_w_qidx[j], a_w_o[j], rel_table)
        else:
            h = fox_mixer(x, b_w_in[j], b_b_f[j], b_w_o[j])
        x = layer_norm(DEEPNORM_ALPHA * x + h, ln_mix_g[i], ln_mix_b[i])
        f = moe(x, w_router[i], b_router[i], w_gu[i], b_gu[i], w_down[i], b_down[i])
        x = layer_norm(DEEPNORM_ALPHA * x + f, ln_ffn_g[i], ln_ffn_b[i])
    return x
```

```cpp
#define MK_N_LAUNCHES 21
#include <hip/hip_runtime.h>
#include <cstdio>
#include <cstdint>
namespace pg8 {
#define PG8_LAS __attribute__((address_space(3)))
typedef unsigned short bf16_t;
typedef short bf16x8 __attribute__((ext_vector_type(8)));
typedef float f32x4 __attribute__((ext_vector_type(4)));
typedef unsigned u32x4 __attribute__((ext_vector_type(4)));
constexpr int BM = 256, BK = 64, HALF = 128, HTB = HALF * BK * 2  , STAGE_BYTES = 8 * HTB, NXCD = 8, WGM = 8;

__host__ __device__ __forceinline__ int lds_byte(int r, int c) { const int st = (r >> 4) * 2 + (c >> 5), rr = r & 15, cc = c & 31, ob = rr * 64 + cc * 2; return st * 1024 + (ob ^ (((ob >> 9) & 1) << 5)); }
__host__ __device__ __forceinline__ void stage_rc(int b, int& R, int& C) { const int st = b / 1024, sb = b % 1024, swz = sb ^ (((sb >> 9) & 1) << 5); R = (st >> 1) * 16 + swz / 64; C = (st & 1) * 32 + (swz % 64) / 2; }
__host__ __device__ __forceinline__ int perm32(int rho) { const int n = rho >> 4, i = rho & 15; return 8 * (i >> 2) + 4 * n + (i & 3); }

struct Unit { int pm, pn; };
struct Gemm { const bf16_t* A; const bf16_t* Bt; int M, N, K; };

struct StaticOrder {
    int nM, nN, nwg, G, c;
    __host__ __device__ void init(int M, int N, int G_, int c_) { nM = M / BM; nN = N / BM; nwg = nM * nN; G = G_; c = c_; }
    __host__ __device__ bool next(int i, Unit& u) const {
        const long L = (long)i * G + c; if (L >= nwg) return false;
        int wgid = (int)L; { const int q = nwg / NXCD, r = nwg % NXCD, xcd = wgid % NXCD, off = wgid / NXCD; wgid = (xcd < r ? xcd * (q + 1) : r * (q + 1) + (xcd - r) * q) + off; }
        const int nig = WGM * nN, gid = wgid / nig, fm = gid * WGM, gsz = (nM - fm) < WGM ? (nM - fm) : WGM;
        u.pm = fm + ((wgid % nig) % gsz); u.pn = (wgid % nig) / gsz; return true;
    }
    __device__ __forceinline__ void a_ready(const Unit&) const {}
    __device__ __forceinline__ void done(const Unit&) const {}
};

__device__ __forceinline__ unsigned cvt_pk_bf16(float lo, float hi) { unsigned r; asm volatile("v_cvt_pk_bf16_f32 %0, %1, %2" : "=v"(r) : "v"(lo), "v"(hi)); return r; }
typedef float f32x2 __attribute__((ext_vector_type(2)));
__device__ __forceinline__ f32x2 gelu_pk(f32x2 v) {
    const f32x2 av = __builtin_elementwise_abs(v), d = av * 0.2316418882f + 1.0f;
    f32x2 t; t.x = __builtin_amdgcn_rcpf(d.x); t.y = __builtin_amdgcn_rcpf(d.y);
    f32x2 q = t * 0.5307027145f + (-0.7265760135f); q = q * t + 0.7107068705f; q = q * t + (-0.142248368f); q = q * t + 0.127414796f; q = q * t;
    const f32x2 s = (v * v) * (-0.72134752044f);
    f32x2 e; e.x = __builtin_amdgcn_exp2f(s.x); e.y = __builtin_amdgcn_exp2f(s.y);
    const f32x2 m = v * (q * e), r = v - m;
    f32x2 o; o.x = v.x < 0.f ? m.x : r.x; o.y = v.y < 0.f ? m.y : r.y; return o;
}

template <int ACT  > struct EpiBf16 {
    static constexpr bool PERM = true, AFTER_DRAIN = false; static_assert(ACT == 0 || ACT == 1, "EpiBf16: ACT is 0 (none) or 1 (gelu_pk)");
    bf16_t* O; int ldc; const float* bias; int split_cols; size_t split_stride; float scale0;
    __device__ __forceinline__ void operator()(const f32x4 (&acc)[2][2][4][2], const Unit& u, int wr, int wc, int fr, int fq) const {
        const int row0 = u.pm * BM + wr * 64 + fr; int colt = u.pn * BM; bf16_t* base = O;
        float sc = 1.f; if (split_cols) { const int t = colt / split_cols; base += (size_t)t * split_stride; colt -= t * split_cols; if (t == 0) sc = scale0; }
        const int col0 = colt + wc * 32 + 8 * fq, bcol0 = u.pn * BM + wc * 32 + 8 * fq;
        f32x4 bv[2][2];
#pragma unroll
        for (int bj = 0; bj < 2; ++bj)
#pragma unroll
            for (int n = 0; n < 2; ++n) bv[bj][n] = bias ? *(const f32x4*)(bias + bcol0 + bj * HALF + 4 * n) : (f32x4){0.f, 0.f, 0.f, 0.f};
#pragma unroll
        for (int ai = 0; ai < 2; ++ai)
#pragma unroll
            for (int m = 0; m < 4; ++m) { bf16_t* rowp = base + (size_t)(row0 + ai * HALF + m * 16) * ldc + col0;
#pragma unroll
                for (int bj = 0; bj < 2; ++bj) { f32x4 v0 = acc[ai][bj][m][0] + bv[bj][0], v1 = acc[ai][bj][m][1] + bv[bj][1];
                    if (ACT == 1) { f32x2 a = gelu_pk((f32x2){v0[0], v0[1]}), b = gelu_pk((f32x2){v0[2], v0[3]}), c = gelu_pk((f32x2){v1[0], v1[1]}), d = gelu_pk((f32x2){v1[2], v1[3]});
                        v0 = (f32x4){a.x, a.y, b.x, b.y}; v1 = (f32x4){c.x, c.y, d.x, d.y}; }
                    v0 = v0 * sc; v1 = v1 * sc; u32x4 w; w.x = cvt_pk_bf16(v0[0], v0[1]); w.y = cvt_pk_bf16(v0[2], v0[3]); w.z = cvt_pk_bf16(v1[0], v1[1]); w.w = cvt_pk_bf16(v1[2], v1[3]);
                    *(u32x4*)(rowp + bj * HALF) = w; } }
    }
};

struct PanelStats {
    unsigned* xbuf;
    unsigned* cnt;
    unsigned* tmo;
    int ntn; float eps;
    unsigned code;
    __device__ __forceinline__ bool run(const f32x4 (&v)[2][2][4][2], const Unit& u, int wr, int wc, int fr, int fq, PG8_LAS unsigned char* lds, int wid, int lane) const {
        typedef float f32x2v __attribute__((ext_vector_type(2)));
        PG8_LAS f32x2v* P = (PG8_LAS f32x2v*)lds;
        PG8_LAS f32x2v* S = (PG8_LAS f32x2v*)(lds + 8192);
        PG8_LAS unsigned* flag = (PG8_LAS unsigned*)(lds + 8192 + 2048);
#pragma unroll
        for (int ai = 0; ai < 2; ++ai)
#pragma unroll
            for (int m = 0; m < 4; ++m) {
                float s = 0.f;
#pragma unroll
                for (int bj = 0; bj < 2; ++bj)
#pragma unroll
                    for (int n = 0; n < 2; ++n) { const f32x4 x = v[ai][bj][m][n]; s += (x[0] + x[1]) + (x[2] + x[3]); }
                s += __shfl_xor(s, 16); s += __shfl_xor(s, 32);
                const float mw = s * (1.0f / 64.0f); float q = 0.f;
#pragma unroll
                for (int bj = 0; bj < 2; ++bj)
#pragma unroll
                    for (int n = 0; n < 2; ++n) { const f32x4 d = v[ai][bj][m][n] - mw; q += (d[0] * d[0] + d[1] * d[1]) + (d[2] * d[2] + d[3] * d[3]); }
                q += __shfl_xor(q, 16); q += __shfl_xor(q, 32);
                if (fq == 0) P[(ai * HALF + wr * 64 + m * 16 + fr) * 4 + wc] = (f32x2v){mw, q};
            }
        asm volatile("s_waitcnt lgkmcnt(0)" ::: "memory"); __builtin_amdgcn_s_barrier(); asm volatile("" ::: "memory");
#if defined(BROKEN_EXCHANGE_NO_WAIT)
#warning BROKEN CONTROL BUILD: the row-statistics exchange does not wait; results are wrong by design
        if (blockIdx.x >= 64) { const long long t0_ = clock64(); while (clock64() - t0_ < 60000) __builtin_amdgcn_s_sleep(8); }
#endif
        const int row = wid * 32 + (lane & 31);
        if (lane < 32) {
            const f32x2v a = P[row * 4 + 0], b = P[row * 4 + 1], c = P[row * 4 + 2], d = P[row * 4 + 3];
            const float mt = (a.x + b.x + c.x + d.x) * 0.25f;
            const float da = a.x - mt, db = b.x - mt, dc = c.x - mt, dd = d.x - mt;
            const float m2 = (a.y + b.y) + (c.y + d.y) + 64.0f * ((da * da + db * db) + (dc * dc + dd * dd));
            unsigned long long* slot = (unsigned long long*)xbuf + ((size_t)(u.pm * BM + row) * 4 + u.pn);
            __hip_atomic_store(slot, ((unsigned long long)__float_as_uint(m2) << 32) | __float_as_uint(mt), __ATOMIC_RELAXED, __HIP_MEMORY_SCOPE_AGENT);
        }
        asm volatile("s_waitcnt vmcnt(0)" ::: "memory");
        if (lane == 0) __hip_atomic_fetch_add(cnt + 64 * u.pm, 1u, __ATOMIC_RELAXED, __HIP_MEMORY_SCOPE_AGENT);
        if (wid == 0) {
            bool dead = false; const unsigned long long t0 = __builtin_amdgcn_s_memrealtime(); const unsigned want = 8u * (unsigned)ntn;
            for (;;) {
#if defined(BROKEN_EXCHANGE_NO_WAIT)
                break;
#endif
                if ((unsigned)__builtin_amdgcn_readfirstlane(__hip_atomic_load(cnt + 64 * u.pm, __ATOMIC_RELAXED, __HIP_MEMORY_SCOPE_AGENT)) >= want) break;
                if (__builtin_amdgcn_s_memrealtime() - t0 > 2000000ull) {
                    if (lane == 0) { unsigned expect = 0u; __hip_atomic_compare_exchange_strong(tmo + 1, &expect, code | (unsigned)(u.pm & 0xff), __ATOMIC_RELAXED, __ATOMIC_RELAXED, __HIP_MEMORY_SCOPE_AGENT);
                                     __hip_atomic_store(tmo, 1u, __ATOMIC_RELAXED, __HIP_MEMORY_SCOPE_AGENT); }
                    dead = true; break; }
                __builtin_amdgcn_s_sleep(2);
            }
            __builtin_amdgcn_fence(__ATOMIC_ACQUIRE, "agent");
            if (lane == 0) flag[0] = dead ? 1u : 0u;
        }
        asm volatile("s_waitcnt vmcnt(0) lgkmcnt(0)" ::: "memory"); __builtin_amdgcn_s_barrier(); asm volatile("" ::: "memory");
        const bool bad = flag[0] != 0u;
        if (lane < 32) {
            const unsigned long long* slot = (const unsigned long long*)xbuf + (size_t)(u.pm * BM + row) * 4; float mt[4], m2[4]; float ms = 0.f;
#pragma unroll
            for (int t = 0; t < 4; ++t) { if (t < ntn) { const unsigned long long w = __hip_atomic_load(slot + t, __ATOMIC_RELAXED, __HIP_MEMORY_SCOPE_AGENT); mt[t] = __uint_as_float((unsigned)w); m2[t] = __uint_as_float((unsigned)(w >> 32)); } else { mt[t] = 0.f; m2[t] = 0.f; } ms += mt[t]; }
            const float mean = ms / (float)ntn; float q = 0.f;
#pragma unroll
            for (int t = 0; t < 4; ++t) if (t < ntn) { const float dm = mt[t] - mean; q += m2[t] + 256.0f * dm * dm; }
            S[row] = (f32x2v){mean, 1.0f / sqrtf(q / (256.0f * (float)ntn) + eps)};
        }
        asm volatile("s_waitcnt lgkmcnt(0)" ::: "memory"); __builtin_amdgcn_s_barrier(); asm volatile("" ::: "memory");
        return bad;
    }
};
struct EpiLnRes {
    static constexpr bool PERM = false, AFTER_DRAIN = true;
    const float* base; float* out; int ldc; const float* bias; PanelStats st; unsigned poison;
    __device__ __forceinline__ void fused(f32x4 (&acc)[2][2][4][2], const Unit& u, int wr, int wc, int fr, int fq, PG8_LAS unsigned char* lds, int wid, int lane) const {
        typedef float f32x2v __attribute__((ext_vector_type(2)));
        const PG8_LAS f32x2v* S = (const PG8_LAS f32x2v*)(lds + 8192);
        const int col0 = u.pn * BM + wc * 32 + 4 * fq;
#pragma unroll
        for (int bj = 0; bj < 2; ++bj)
#pragma unroll
            for (int n = 0; n < 2; ++n) { const f32x4 bv = bias ? *(const f32x4*)(bias + col0 + bj * HALF + n * 16) : (f32x4){0.f, 0.f, 0.f, 0.f};
#pragma unroll
                for (int ai = 0; ai < 2; ++ai)
#pragma unroll
                    for (int m = 0; m < 4; ++m) acc[ai][bj][m][n] += bv; }
        f32x4 pre[4][2][2];
#pragma unroll
        for (int m = 0; m < 4; ++m) { const size_t off = (size_t)(u.pm * BM + wr * 64 + m * 16 + fr) * ldc + col0;
#pragma unroll
            for (int bj = 0; bj < 2; ++bj)
#pragma unroll
                for (int n = 0; n < 2; ++n) pre[m][bj][n] = *(const f32x4*)(base + off + bj * HALF + n * 16); }
        const bool bad = st.run(acc, u, wr, wc, fr, fq, lds, wid, lane) || poison != 0u;
        const float qnan = __builtin_nanf("");
#pragma unroll
        for (int ai = 0; ai < 2; ++ai)
#pragma unroll
            for (int m = 0; m < 4; ++m) { const int r = ai * HALF + wr * 64 + m * 16 + fr; const f32x2v sr = S[r]; const size_t off = (size_t)(u.pm * BM + r) * ldc + col0;
#pragma unroll
                for (int bj = 0; bj < 2; ++bj)
#pragma unroll
                    for (int n = 0; n < 2; ++n) { const f32x4 bs = ai == 0 ? pre[m][bj][n] : *(const f32x4*)(base + off + bj * HALF + n * 16); f32x4 o = bs + (acc[ai][bj][m][n] - sr.x) * sr.y;
                        if (bad) o = (f32x4){qnan, qnan, qnan, qnan}; *(f32x4*)(out + off + bj * HALF + n * 16) = o; }
                if (m & 1) asm volatile("" ::: "memory"); }
    }
};
struct EpiLnResLn {
    static constexpr bool PERM = false, AFTER_DRAIN = true;
    const float* base; float* out; bf16_t* xn; int ldc; const float* bias; PanelStats st1, st2; unsigned poison;
    __device__ __forceinline__ void fused(f32x4 (&acc)[2][2][4][2], const Unit& u, int wr, int wc, int fr, int fq, PG8_LAS unsigned char* lds, int wid, int lane) const {
        typedef float f32x2v __attribute__((ext_vector_type(2))); typedef unsigned u32x2v __attribute__((ext_vector_type(2)));
        const PG8_LAS f32x2v* S = (const PG8_LAS f32x2v*)(lds + 8192);
        const int col0 = u.pn * BM + wc * 32 + 4 * fq;
#pragma unroll
        for (int bj = 0; bj < 2; ++bj)
#pragma unroll
            for (int n = 0; n < 2; ++n) { const f32x4 bv = bias ? *(const f32x4*)(bias + col0 + bj * HALF + n * 16) : (f32x4){0.f, 0.f, 0.f, 0.f};
#pragma unroll
                for (int ai = 0; ai < 2; ++ai)
#pragma unroll
                    for (int m = 0; m < 4; ++m) acc[ai][bj][m][n] += bv; }
        bool bad = st1.run(acc, u, wr, wc, fr, fq, lds, wid, lane) || poison != 0u;
        const float qnan = __builtin_nanf("");
#pragma unroll
        for (int ai = 0; ai < 2; ++ai)
#pragma unroll
            for (int m = 0; m < 4; ++m) { const int r = ai * HALF + wr * 64 + m * 16 + fr; const f32x2v sr = S[r]; const size_t off = (size_t)(u.pm * BM + r) * ldc + col0;
#pragma unroll
                for (int bj = 0; bj < 2; ++bj)
#pragma unroll
                    for (int n = 0; n < 2; ++n) { const f32x4 bs = *(const f32x4*)(base + off + bj * HALF + n * 16); acc[ai][bj][m][n] = bs + (acc[ai][bj][m][n] - sr.x) * sr.y; }
                asm volatile("" : "+v"(acc[ai][0][m][0]), "+v"(acc[ai][0][m][1]), "+v"(acc[ai][1][m][0]), "+v"(acc[ai][1][m][1]));
                if (m & 1) asm volatile("" ::: "memory"); }
        const bool bad1 = bad;
        bad = st2.run(acc, u, wr, wc, fr, fq, lds, wid, lane) || bad;
#pragma unroll
        for (int ai = 0; ai < 2; ++ai)
#pragma unroll
            for (int m = 0; m < 4; ++m) { const int r = ai * HALF + wr * 64 + m * 16 + fr; const f32x2v sr = S[r]; const size_t off = (size_t)(u.pm * BM + r) * ldc + col0;
#pragma unroll
                for (int bj = 0; bj < 2; ++bj)
#pragma unroll
                    for (int n = 0; n < 2; ++n) { const f32x4 x1 = acc[ai][bj][m][n]; *(f32x4*)(out + off + bj * HALF + n * 16) = bad1 ? (f32x4){qnan, qnan, qnan, qnan} : x1;
                        const f32x4 o = (x1 - sr.x) * sr.y; u32x2v w; w.x = cvt_pk_bf16(o[0], o[1]); w.y = cvt_pk_bf16(o[2], o[3]);
                        if (bad) { w.x = 0x7fc07fc0u; w.y = 0x7fc07fc0u; } *(u32x2v*)(xn + off + bj * HALF + n * 16) = w; }
                asm volatile("" ::: "memory"); }
    }
};

template <class Epi, class Sched, bool ALIGN_EPI = false, bool SP2 = false>
__device__ __forceinline__ void gemm_phase(PG8_LAS unsigned char* lds, const Gemm g, const Sched& S, const Epi& E) {
    int tid_ = threadIdx.x; asm volatile("" : "+v"(tid_));
    const int tid = tid_, wid = __builtin_amdgcn_readfirstlane(tid >> 6), lane = tid & 63, wr = wid >> 2, wc = wid & 3, fr = lane & 15, fq = lane >> 4;
    const int K = g.K, nt = K / BK;
    unsigned voffA[2], voffB[2];
#pragma unroll
    for (int i = 0; i < 2; ++i) { int R, C; stage_rc(tid * 16 + i * 8192, R, C); const int Rb = Epi::PERM ? ((R & ~31) + perm32(R & 31)) : R;
        voffA[i] = (unsigned)(R * K + C) * 2u; voffB[i] = (unsigned)(Rb * K + C) * 2u; }
    const size_t kstep = (size_t)(BK * 2);
    const size_t hstep = (size_t)HALF * K * 2;
    const size_t tstep = 2 * hstep;
    const unsigned ldsw = (unsigned)wid * 1024u;
    const int aoff = lds_byte(wr * 64 + fr, fq * 8), boff = lds_byte(wc * 32 + fr, fq * 8);
#define PG8_SA(b, h) (((b) * 2 + (h)) * HTB)
#define PG8_SB(b, h) ((4 + (b) * 2 + (h)) * HTB)
#define PG8_STAGE(bufoff, gbase, voff) do { _Pragma("unroll") for (int _i = 0; _i < 2; ++_i) \
        __builtin_amdgcn_global_load_lds((const unsigned*)((const char*)(gbase) + (voff)[_i]), (PG8_LAS unsigned*)(lds + (bufoff) + ldsw + _i * 8192), 16, 0, 0); } while (0)
#define PG8_LDA(dst, b, h) do { _Pragma("unroll") for (int m = 0; m < 4; ++m) _Pragma("unroll") for (int k = 0; k < 2; ++k) dst[m][k] = *(const PG8_LAS bf16x8*)(lds + PG8_SA(b, h) + aoff + m * 2048 + k * 1024); } while (0)
#define PG8_LDB(dst, b, h) do { _Pragma("unroll") for (int n = 0; n < 2; ++n) _Pragma("unroll") for (int k = 0; k < 2; ++k) dst[n][k] = *(const PG8_LAS bf16x8*)(lds + PG8_SB(b, h) + boff + n * 2048 + k * 1024); } while (0)
#define PG8_MMA(ai, bj, At, Bt) do { __builtin_amdgcn_s_setprio(1); _Pragma("unroll") for (int m = 0; m < 4; ++m) _Pragma("unroll") for (int n = 0; n < 2; ++n) _Pragma("unroll") for (int k = 0; k < 2; ++k) \
        acc[ai][bj][m][n] = __builtin_amdgcn_mfma_f32_16x16x32_bf16(Bt[n][k], At[m][k], acc[ai][bj][m][n], 0, 0, 0); __builtin_amdgcn_s_setprio(0); } while (0)
#define PG8_WAIT_V(n) asm volatile("s_waitcnt vmcnt(" #n ")" ::: "memory")
#define PG8_WAIT_L(n) asm volatile("s_waitcnt lgkmcnt(" #n ")" ::: "memory")
#define PG8_BAR __builtin_amdgcn_s_barrier()
#define PG8_SCHED __builtin_amdgcn_sched_barrier(0)
    Unit cur, nxt; int ui = 0;
    if (!S.next(0, cur)) return;
    f32x4 acc[2][2][4][2];
#pragma unroll
    for (int a = 0; a < 2; ++a)
#pragma unroll
        for (int b = 0; b < 2; ++b)
#pragma unroll
            for (int m = 0; m < 4; ++m)
#pragma unroll
                for (int n = 0; n < 2; ++n) acc[a][b][m][n] = (f32x4){0.f, 0.f, 0.f, 0.f};
    bf16x8 At[4][2], B0[2][2], B1[2][2];
    const char* cA = (const char*)g.A + (size_t)cur.pm * tstep; const char* cB = (const char*)g.Bt + (size_t)cur.pn * tstep;
    S.a_ready(cur);
    if constexpr (SP2) {
        PG8_STAGE(PG8_SB(0, 0), cB, voffB); PG8_STAGE(PG8_SB(0, 1), cB + hstep, voffB); PG8_STAGE(PG8_SA(0, 0), cA, voffA); PG8_STAGE(PG8_SA(0, 1), cA + hstep, voffA);
        if (wr == 1) PG8_BAR;
        PG8_WAIT_V(2); PG8_BAR;
        PG8_STAGE(PG8_SB(1, 0), cB + kstep, voffB); PG8_STAGE(PG8_SA(1, 0), cA + kstep, voffA); PG8_STAGE(PG8_SB(1, 1), cB + hstep + kstep, voffB);
        PG8_WAIT_V(6); PG8_BAR;
    } else {
        PG8_STAGE(PG8_SB(0, 0), cB, voffB); PG8_STAGE(PG8_SA(0, 0), cA, voffA); PG8_STAGE(PG8_SB(0, 1), cB + hstep, voffB); PG8_STAGE(PG8_SA(0, 1), cA + hstep, voffA);
        if (wr == 1) PG8_BAR;
        PG8_WAIT_V(4); PG8_BAR;
        PG8_STAGE(PG8_SB(1, 0), cB + kstep, voffB); PG8_STAGE(PG8_SA(1, 0), cA + kstep, voffA); PG8_STAGE(PG8_SB(1, 1), cB + hstep + kstep, voffB);
        PG8_WAIT_V(6); PG8_BAR;
    }
    for (;;) {
        const bool has_next = S.next(ui + 1, nxt);
        const char* nA = has_next ? (const char*)g.A + (size_t)nxt.pm * tstep : cA; const char* nB = has_next ? (const char*)g.Bt + (size_t)nxt.pn * tstep : cB;
        for (int t = 0; t < nt; t += 2) {
            const bool last = (t == nt - 2);
            const char* a1 = cA + (size_t)(t + 1) * kstep;
            const char* a2 = last ? nA : cA + (size_t)(t + 2) * kstep; const char* b2 = last ? nB : cB + (size_t)(t + 2) * kstep;
            const char* a3 = a2 + kstep; const char* b3 = b2 + kstep;
            if (last && has_next) S.a_ready(nxt);
            if constexpr (SP2) {
            PG8_LDB(B0, 0, 0); PG8_LDB(B1, 0, 1); PG8_SCHED; PG8_LDA(At, 0, 0); PG8_STAGE(PG8_SA(1, 1), a1 + hstep, voffA);
            PG8_WAIT_V(8); PG8_WAIT_L(0); PG8_BAR; PG8_MMA(0, 0, At, B0); PG8_MMA(0, 1, At, B1); PG8_BAR; PG8_SCHED;
            PG8_LDA(At, 0, 1); PG8_STAGE(PG8_SB(0, 0), b2, voffB); PG8_STAGE(PG8_SB(0, 1), b2 + hstep, voffB); PG8_STAGE(PG8_SA(0, 0), a2, voffA);
            PG8_WAIT_V(8); PG8_WAIT_L(0); PG8_BAR; PG8_MMA(1, 0, At, B0); PG8_MMA(1, 1, At, B1); PG8_BAR; PG8_SCHED;
            PG8_LDB(B0, 1, 0); PG8_LDB(B1, 1, 1); PG8_SCHED; PG8_LDA(At, 1, 0); PG8_STAGE(PG8_SA(0, 1), a2 + hstep, voffA);
            PG8_WAIT_V(8); PG8_WAIT_L(0); PG8_BAR; PG8_MMA(0, 0, At, B0); PG8_MMA(0, 1, At, B1); PG8_BAR; PG8_SCHED;
            PG8_LDA(At, 1, 1); PG8_STAGE(PG8_SB(1, 0), b3, voffB); PG8_STAGE(PG8_SB(1, 1), b3 + hstep, voffB); PG8_STAGE(PG8_SA(1, 0), a3, voffA);
            PG8_WAIT_V(8); PG8_WAIT_L(0); PG8_BAR; PG8_MMA(1, 0, At, B0); PG8_MMA(1, 1, At, B1); PG8_BAR; PG8_SCHED;
            } else {
            PG8_LDB(B0, 0, 0); PG8_SCHED; PG8_LDA(At, 0, 0); PG8_STAGE(PG8_SA(1, 1), a1 + hstep, voffA);
            PG8_WAIT_L(8); PG8_BAR; PG8_WAIT_L(0); PG8_MMA(0, 0, At, B0); PG8_BAR; PG8_SCHED;
            PG8_LDB(B1, 0, 1); PG8_STAGE(PG8_SB(0, 0), b2, voffB);
            PG8_BAR; PG8_WAIT_L(0); PG8_MMA(0, 1, At, B1); PG8_BAR;
            PG8_LDA(At, 0, 1); PG8_STAGE(PG8_SA(0, 0), a2, voffA);
            PG8_BAR; PG8_WAIT_L(0); PG8_MMA(1, 0, At, B0); PG8_BAR; PG8_SCHED;
            PG8_STAGE(PG8_SB(0, 1), b2 + hstep, voffB);
            PG8_WAIT_V(6); PG8_BAR; PG8_MMA(1, 1, At, B1); PG8_BAR;
            PG8_LDB(B0, 1, 0); PG8_SCHED; PG8_LDA(At, 1, 0); PG8_STAGE(PG8_SA(0, 1), a2 + hstep, voffA);
            PG8_WAIT_L(8); PG8_BAR; PG8_WAIT_L(0); PG8_MMA(0, 0, At, B0); PG8_BAR; PG8_SCHED;
            PG8_LDB(B1, 1, 1); PG8_STAGE(PG8_SB(1, 0), b3, voffB);
            PG8_BAR; PG8_WAIT_L(0); PG8_MMA(0, 1, At, B1); PG8_BAR;
            PG8_LDA(At, 1, 1); PG8_STAGE(PG8_SA(1, 0), a3, voffA);
            PG8_BAR; PG8_WAIT_L(0); PG8_MMA(1, 0, At, B0); PG8_BAR; PG8_SCHED;
            PG8_STAGE(PG8_SB(1, 1), b3 + hstep, voffB);
            PG8_WAIT_V(6); PG8_BAR; PG8_MMA(1, 1, At, B1); PG8_BAR;
            }
        }
        if constexpr (ALIGN_EPI) { if (wr == 0) PG8_BAR; }
        if constexpr (!Epi::AFTER_DRAIN) { E(acc, cur, wr, wc, fr, fq); S.done(cur); }
        if (!has_next) break;
#pragma unroll
        for (int a = 0; a < 2; ++a)
#pragma unroll
            for (int b = 0; b < 2; ++b)
#pragma unroll
                for (int m = 0; m < 4; ++m)
#pragma unroll
                    for (int n = 0; n < 2; ++n) acc[a][b][m][n] = (f32x4){0.f, 0.f, 0.f, 0.f};
        cur = nxt; cA = nA; cB = nB; ++ui;
        if constexpr (ALIGN_EPI) { if (wr == 1) PG8_BAR; }
    }
    PG8_WAIT_V(0);
    if constexpr (!ALIGN_EPI) { if (wr == 0) PG8_BAR; }
    PG8_BAR;
    if constexpr (Epi::AFTER_DRAIN) { E.fused(acc, cur, wr, wc, fr, fq, lds, wid, lane); S.done(cur); }
#undef PG8_SA
#undef PG8_SB
#undef PG8_STAGE
#undef PG8_LDA
#undef PG8_LDB
#undef PG8_MMA
#undef PG8_WAIT_V
#undef PG8_WAIT_L
#undef PG8_BAR
#undef PG8_SCHED
}
}
namespace pg8 {
struct EpiF32 {
    static constexpr bool PERM = false, AFTER_DRAIN = false;
    float* O; int ldc;
    __device__ __forceinline__ void operator()(const f32x4 (&acc)[2][2][4][2], const Unit& u, int wr, int wc, int fr_, int fq_) const {
        int t_ = threadIdx.x; asm volatile("" : "+v"(t_)); const int fr = t_ & 15, fq = (t_ & 63) >> 4; (void)fr_; (void)fq_;
        const int row0 = u.pm * BM + wr * 64 + fr, col0 = u.pn * BM + wc * 32 + 4 * fq;
#pragma unroll
        for (int ai = 0; ai < 2; ++ai)
#pragma unroll
            for (int m = 0; m < 4; ++m) { float* rowp = O + (size_t)(row0 + ai * HALF + m * 16) * ldc + col0;
#pragma unroll
                for (int bj = 0; bj < 2; ++bj)
#pragma unroll
                    for (int n = 0; n < 2; ++n) *(f32x4*)(rowp + bj * HALF + n * 16) = acc[ai][bj][m][n]; }
    }
};
struct EpiResF32 {
    static constexpr bool PERM = false, AFTER_DRAIN = false;
    const float* base; float* out; int ldc; float alpha;
    __device__ __forceinline__ void operator()(const f32x4 (&acc)[2][2][4][2], const Unit& u, int wr, int wc, int fr_, int fq_) const {
        int t_ = threadIdx.x; asm volatile("" : "+v"(t_)); const int fr = t_ & 15, fq = (t_ & 63) >> 4; (void)fr_; (void)fq_;
        const int row0 = u.pm * BM + wr * 64 + fr, col0 = u.pn * BM + wc * 32 + 4 * fq;
#pragma unroll
        for (int ai = 0; ai < 2; ++ai)
#pragma unroll
            for (int m = 0; m < 4; ++m) { const size_t off = (size_t)(row0 + ai * HALF + m * 16) * ldc + col0;
                f32x4 bs[2][2];
#pragma unroll
                for (int bj = 0; bj < 2; ++bj)
#pragma unroll
                    for (int n = 0; n < 2; ++n) bs[bj][n] = *(const f32x4*)(base + off + bj * HALF + n * 16);
#pragma unroll
                for (int bj = 0; bj < 2; ++bj)
#pragma unroll
                    for (int n = 0; n < 2; ++n) *(f32x4*)(out + off + bj * HALF + n * 16) = bs[bj][n] * alpha + acc[ai][bj][m][n]; }
    }
};
struct EpiCq {
    static constexpr bool PERM = true, AFTER_DRAIN = false;
    bf16_t* qlat; bf16_t* qidx;
    __device__ __forceinline__ void operator()(const f32x4 (&acc)[2][2][4][2], const Unit& u, int wr, int wc, int fr_, int fq_) const {
        int t_ = threadIdx.x; asm volatile("" : "+v"(t_)); const int fr = t_ & 15, fq = (t_ & 63) >> 4; (void)fr_; (void)fq_;
        const int row0 = u.pm * BM + wr * 64 + fr; int colt = u.pn * BM; bf16_t* base = qlat; int ldc = 2048;
        if (colt >= 2048) { base = qidx; ldc = 512; colt -= 2048; }
        const int col0 = colt + wc * 32 + 8 * fq;
#pragma unroll
        for (int ai = 0; ai < 2; ++ai)
#pragma unroll
            for (int m = 0; m < 4; ++m) { bf16_t* rowp = base + (size_t)(row0 + ai * HALF + m * 16) * ldc + col0;
#pragma unroll
                for (int bj = 0; bj < 2; ++bj) { const f32x4 v0 = acc[ai][bj][m][0], v1 = acc[ai][bj][m][1];
                    u32x4 w; w.x = cvt_pk_bf16(v0[0], v0[1]); w.y = cvt_pk_bf16(v0[2], v0[3]); w.z = cvt_pk_bf16(v1[0], v1[1]); w.w = cvt_pk_bf16(v1[2], v1[3]);
                    *(u32x4*)(rowp + bj * HALF) = w; } }
    }
};
struct EpiSwiglu {
    static constexpr bool PERM = true, AFTER_DRAIN = false;
    bf16_t* H; const float* bgu;
    __device__ __forceinline__ void operator()(const f32x4 (&acc)[2][2][4][2], const Unit& u, int wr, int wc, int fr_, int fq_) const {
        int t_ = threadIdx.x; asm volatile("" : "+v"(t_)); const int fr = t_ & 15, fq = (t_ & 63) >> 4; (void)fr_; (void)fq_;
        const int e = u.pn >> 3, pnl = u.pn & 7;
        const int row0 = u.pm * BM + wr * 64 + fr, col0 = pnl * 128 + wc * 32 + 8 * fq;
        const float* bg = bgu + (size_t)e * 2048 + col0; const float* bu = bg + 1024;
        f32x4 bgv[2], buv[2];
#pragma unroll
        for (int n = 0; n < 2; ++n) { bgv[n] = *(const f32x4*)(bg + 4 * n); buv[n] = *(const f32x4*)(bu + 4 * n); }
#pragma unroll
        for (int ai = 0; ai < 2; ++ai)
#pragma unroll
            for (int m = 0; m < 4; ++m) { bf16_t* rowp = H + (size_t)(row0 + ai * HALF + m * 16) * 1024 + col0;
                float h[8];
#pragma unroll
                for (int n = 0; n < 2; ++n) { const f32x4 g4 = acc[ai][0][m][n] + bgv[n], u4 = acc[ai][1][m][n] + buv[n];
#pragma unroll
                    for (int i = 0; i < 4; ++i) { const float g = fminf(g4[i], 7.0f); const float up = fminf(fmaxf(u4[i], -7.0f), 7.0f);
                        const float sg = __builtin_amdgcn_rcpf(1.0f + __builtin_amdgcn_exp2f(g * (-1.702f * 1.4426950408889634f)));
                        h[4 * n + i] = (up + 1.0f) * (g * sg); } }
                u32x4 w; w.x = cvt_pk_bf16(h[0], h[1]); w.y = cvt_pk_bf16(h[2], h[3]); w.z = cvt_pk_bf16(h[4], h[5]); w.w = cvt_pk_bf16(h[6], h[7]);
                *(u32x4*)rowp = w; }
    }
};
struct MoeOrder {
    int nT, nNl, G, c; const PG8_LAS int* tile_e;
    __device__ __forceinline__ bool next(int i, Unit& u) const {
        const int nwg = nT * nNl; const long L = (long)i * G + c; if (L >= nwg) return false;
        const int q = nwg / NXCD, r = nwg % NXCD, xcd = (int)(L % NXCD), off = (int)(L / NXCD);
        const int wgid = (xcd < r ? xcd * (q + 1) : r * (q + 1) + (xcd - r) * q) + off;
        const int pm = wgid / nNl, j = wgid % nNl;
        u.pm = pm; u.pn = tile_e[pm] * nNl + j; return true;
    }
    __device__ __forceinline__ void a_ready(const Unit&) const {}
    __device__ __forceinline__ void done(const Unit&) const {}
};
}
#ifndef PG8_SP2
#define PG8_SP2 true
#endif
#ifndef PG8_ALIGN
#define PG8_ALIGN true
#endif
#include <hip/hip_bf16.h>
#include <cmath>
namespace attn_body {
using bf16=__hip_bfloat16;
using bf16x8=__attribute__((ext_vector_type(8)))short;
using s16x4=__attribute__((ext_vector_type(4)))short;
using f32x16=__attribute__((ext_vector_type(16)))float;
using u32x4=__attribute__((ext_vector_type(4)))unsigned;
constexpr int BATCH=8,NHEAD=16,SEQ=4096,D=64,DM=NHEAD*D,XD=16;
constexpr int NW=8,QBLK=32,QB=QBLK*NW,KVBLK=64,NQB=SEQ/QB;
constexpr int ATTN_PITCH=DM, ATTN_UNIT_ROWS=QB;
__device__ __forceinline__ int crow(int r,int hi){return (r&3)+8*(r>>2)+4*hi;}
#define SBAR() __builtin_amdgcn_sched_barrier(0)
__device__ __forceinline__ void cmask(f32x16&p0,f32x16&p1,int jb,int qrel,int hi){
  const float NEG=-INFINITY; int kb=64*jb+4*hi;
  #pragma unroll
  for(int r=0;r<16;++r){int kv=kb+(r&3)+8*(r>>2); if(kv>qrel)p0[r]=NEG; if(kv+32>qrel)p1[r]=NEG;}
}

constexpr int NSLOT=3, SLOTB=10240;
constexpr int LDS_K=0, LDS_V=NSLOT*SLOTB, LDS_WS=2*NSLOT*SLOTB, LDS_OST=LDS_WS+NW*64*4, LDS_BYTES=LDS_OST+NW*4096;
constexpr float C2=0.125f*1.4426950408889634f;
__device__ __forceinline__ void glds16(const void*gsrc,unsigned lds_dst){unsigned keep;
  asm volatile("s_mov_b32 %0, m0\n\ts_mov_b32 m0, %2\n\ts_nop 0\n\tglobal_load_lds_dwordx4 %1, off\n\ts_mov_b32 m0, %0":"=&s"(keep):"v"(gsrc),"s"(lds_dst):"memory");}
__device__ __forceinline__ float max3f(float a,float b,float c){float r;asm("v_max3_f32 %0, %1, %2, %3":"=v"(r):"v"(a),"v"(b),"v"(c));return r;}
__device__ __forceinline__ float max2f(float a,float b){float r;asm("v_max_f32_e32 %0, %1, %2":"=v"(r):"v"(a),"v"(b));return r;}
__device__ __forceinline__ float fadd_s(float a,float b){float r;asm("v_add_f32_e32 %0, %1, %2":"=v"(r):"v"(a),"v"(b));return r;}
__device__ __forceinline__ float fsub_s(float a,float b){float r;asm("v_sub_f32_e32 %0, %1, %2":"=v"(r):"v"(a),"v"(b));return r;}
typedef float f32x2_t __attribute__((ext_vector_type(2))); typedef __bf16 bf16x2_t __attribute__((ext_vector_type(2)));
__device__ __forceinline__ unsigned cvtpk_s(float lo,float hi){f32x2_t v={lo,hi};bf16x2_t b=__builtin_convertvector(v,bf16x2_t);return __builtin_bit_cast(unsigned,b);}
#define WAIT_BAR(N) asm volatile("s_waitcnt vmcnt(" #N ") lgkmcnt(0)\n\ts_barrier":::"memory")

__device__ __forceinline__ void qkt(f32x16&p0,f32x16&p1,const char*Kslot,const bf16x8*qr,int r32,int hi){
  const f32x16 zz=f32x16{};
  const char*kb=Kslot+hi*1024+r32*16;
  #pragma unroll
  for(int d0=0;d0<5;++d0){
    const bf16x8 b0=*reinterpret_cast<const bf16x8*>(kb+d0*2048);
    const bf16x8 b1=*reinterpret_cast<const bf16x8*>(kb+d0*2048+512);
    if(d0==0){p0=__builtin_amdgcn_mfma_f32_32x32x16_bf16(b0,qr[0],zz,0,0,0);p1=__builtin_amdgcn_mfma_f32_32x32x16_bf16(b1,qr[0],zz,0,0,0);}
    else{p0=__builtin_amdgcn_mfma_f32_32x32x16_bf16(b0,qr[d0],p0,0,0,0);p1=__builtin_amdgcn_mfma_f32_32x32x16_bf16(b1,qr[d0],p1,0,0,0);}}
}
typedef __attribute__((address_space(3))) const char* lds_cptr;
typedef short v4i16_t __attribute__((ext_vector_type(4)));
__device__ __forceinline__ void kload8(bf16x8*kf,lds_cptr kp){
  kf[0]=*(const __attribute__((address_space(3))) bf16x8*)(kp);      kf[1]=*(const __attribute__((address_space(3))) bf16x8*)(kp+512);
  kf[2]=*(const __attribute__((address_space(3))) bf16x8*)(kp+2048); kf[3]=*(const __attribute__((address_space(3))) bf16x8*)(kp+2560);
  kf[4]=*(const __attribute__((address_space(3))) bf16x8*)(kp+4096); kf[5]=*(const __attribute__((address_space(3))) bf16x8*)(kp+4608);
  kf[6]=*(const __attribute__((address_space(3))) bf16x8*)(kp+6144); kf[7]=*(const __attribute__((address_space(3))) bf16x8*)(kp+6656);
  kf[8]=*(const __attribute__((address_space(3))) bf16x8*)(kp+8192); kf[9]=*(const __attribute__((address_space(3))) bf16x8*)(kp+8704);
}
__device__ __forceinline__ void kload2(bf16x8*kf,lds_cptr kp,int j){ kf[2*j]=*(const __attribute__((address_space(3))) bf16x8*)(kp+j*2048); kf[2*j+1]=*(const __attribute__((address_space(3))) bf16x8*)(kp+j*2048+512); }
__device__ __forceinline__ s16x4 vtr(lds_cptr p){ return __builtin_bit_cast(s16x4,__builtin_amdgcn_ds_read_tr16_b64_v4i16((__attribute__((address_space(3))) v4i16_t*)p)); }
__device__ __forceinline__ float rowmax(const f32x16&p0,const f32x16&p1){
  float a=max3f(p0[0],p0[1],p1[0]),b=max3f(p0[2],p0[3],p1[1]);a=max3f(a,p1[2],p1[3]);
  #pragma unroll
  for(int r=4;r<16;r+=4){a=max3f(a,p0[r],p0[r+1]);b=max3f(b,p0[r+2],p0[r+3]);a=max3f(a,p1[r],p1[r+1]);b=max3f(b,p1[r+2],p1[r+3]);}
  const float m=max2f(a,b);
  auto rr=__builtin_amdgcn_permlane32_swap(__float_as_uint(m),__float_as_uint(m),false,false);
  return max2f(__uint_as_float(rr[0]),__uint_as_float(rr[1]));
}
__device__ __forceinline__ void pv(f32x16*o,int vb,bf16x8 pa0,bf16x8 pa1,bf16x8 pa2,bf16x8 pa3){
  #pragma unroll
  for(int d0=0;d0<2;++d0){s16x4 lo[4],hi[4];
    #pragma unroll
    for(int ks=0;ks<4;++ks){
      asm volatile("ds_read_b64_tr_b16 %0,%1 offset:%c2":"=&v"(lo[ks]):"v"(vb),"i"(d0*4096+ks*1024):"memory");
      asm volatile("ds_read_b64_tr_b16 %0,%1 offset:%c2":"=&v"(hi[ks]):"v"(vb),"i"(d0*4096+ks*1024+512):"memory");}
    asm volatile("s_waitcnt lgkmcnt(0)":::"memory");SBAR();
    #define PK(k) (bf16x8){lo[k][0],lo[k][1],lo[k][2],lo[k][3],hi[k][0],hi[k][1],hi[k][2],hi[k][3]}
    o[d0]=__builtin_amdgcn_mfma_f32_32x32x16_bf16(pa0,PK(0),o[d0],0,0,0);
    o[d0]=__builtin_amdgcn_mfma_f32_32x32x16_bf16(pa1,PK(1),o[d0],0,0,0);
    o[d0]=__builtin_amdgcn_mfma_f32_32x32x16_bf16(pa2,PK(2),o[d0],0,0,0);
    o[d0]=__builtin_amdgcn_mfma_f32_32x32x16_bf16(pa3,PK(3),o[d0],0,0,0);
    #undef PK
  }
}

#ifndef ATTN_STORE16
#define ATTN_STORE16(p,v) (*(u32x4*)(p)=(v))
#endif
__device__ __forceinline__ void set_m(bf16x8&q4,float mneg,int hi){
  const unsigned p1=cvtpk_s(mneg,0.f)&0xffffu; const float f1=__uint_as_float(p1<<16); const float r1=mneg-f1;
  const unsigned p2=cvtpk_s(r1,0.f)&0xffffu;   const float f2=__uint_as_float(p2<<16); const float r2=r1-f2;
  const unsigned p3=cvtpk_s(r2,0.f)&0xffffu;
  u32x4 w=__builtin_bit_cast(u32x4,q4); w[3]=hi?w[3]:(p1|(p2<<16)); w[0]=hi?p3:w[0]; q4=__builtin_bit_cast(bf16x8,w);
}
template<int THRL> __device__ __forceinline__ void attn_unit(int b,int h,int qb,const bf16*Q,const bf16*__restrict__ K,const bf16*__restrict__ V,bf16*O,const bf16*__restrict__ QX,const bf16*__restrict__ KX,char*shm){
  int tid_o=threadIdx.x; asm volatile("":"+v"(tid_o)); const int tid=tid_o,lane=tid&63,r32=lane&31,hi=lane>>5; const int wid=__builtin_amdgcn_readfirstlane(tid>>6);
  const long rowbase=(long)b*SEQ; const int q0=qb*QB;
  const bf16*Qw=Q+(rowbase+q0+wid*QBLK)*DM+h*D;
  const bf16*Kh=K+rowbase*DM+h*D,*Vh=V+rowbase*DM+h*D;
  const unsigned lds0=(unsigned)(uintptr_t)shm;
  float*wsf=(float*)(shm+LDS_WS)+wid*64;
  const bf16*ksrc=Kh+(long)lane*DM+wid*8;
  const bf16*vsrc=Vh+(long)(16*(wid&3)+(lane>>2))*DM+(wid>>2)*32+(lane&3)*8;
  const bf16*kxsrc=KX+((rowbase+lane)*NHEAD+h)*XD+(wid&1)*8;
  const unsigned kdst=lds0+LDS_K+wid*1024, vdst=lds0+LDS_V+wid*1024, kxdst=lds0+LDS_K+8192+(wid&1)*1024;
  #define DMA_K(t,slot) do{ glds16(ksrc+(long)(t)*KVBLK*DM,(unsigned)__builtin_amdgcn_readfirstlane(kdst+(slot))); glds16(kxsrc+(long)(t)*KVBLK*NHEAD*XD,(unsigned)__builtin_amdgcn_readfirstlane(kxdst+(slot))); }while(0)
  #define DMA_V(t,slot) glds16(vsrc+(long)(t)*KVBLK*DM,(unsigned)__builtin_amdgcn_readfirstlane(vdst+(slot)))
  const int vb0=(int)(lds0+LDS_V)+((lane>>4)&1)*32+(lane&3)*8+(4*hi+((lane&15)>>2))*64;
  const char*Kbase=shm+LDS_K; bf16x8 kf[10];
  const lds_cptr shm3=(lds_cptr)shm; const lds_cptr kp0=shm3+LDS_K+hi*1024+r32*16; const lds_cptr vp0=shm3+LDS_V+((lane>>4)&1)*32+(lane&3)*8+(4*hi+((lane&15)>>2))*64;
  const int NT=(q0+QB)/KVBLK;
  DMA_K(0,0);DMA_V(0,0);DMA_K(1,SLOTB);
  bf16x8 qr[5];
  #pragma unroll
  for(int d0=0;d0<4;++d0)qr[d0]=*reinterpret_cast<const bf16x8*>(&Qw[(long)r32*DM+d0*16+hi*8]);
  qr[4]=*reinterpret_cast<const bf16x8*>(&QX[((rowbase+q0+wid*QBLK+r32)*NHEAD+h)*XD+hi*8]);
  float mhat=0.f,l_reg=0.f;f32x16 o[2];o[0]=f32x16{};o[1]=f32x16{};const f32x16 zero16=f32x16{};
  const int qrel=wid*QBLK+r32;
  #define CMASK(P0,P1,t) do{int jb_=(t)-(NT-4); if(jb_>=0)cmask(P0,P1,jb_,qrel,hi);}while(0)
  bool resc=false;
  #define START(P0,P1) do{ const float rm=rowmax(P0,P1); resc=false; \
    { const float dl=rm; mhat=fadd_s(mhat,dl); \
      _Pragma("unroll") for(int r=0;r<16;++r){P0[r]=fsub_s(P0[r],dl);P1[r]=fsub_s(P1[r],dl);} \
      set_m(qr[4],-mhat,hi); asm volatile("":"+v"(qr[4])); } \
    _Pragma("unroll") for(int r=0;r<16;++r)P0[r]=__builtin_amdgcn_exp2f(P0[r]); }while(0)
  #define RESC() do{ if(resc){ asm volatile("s_waitcnt lgkmcnt(0)":::"memory"); \
      _Pragma("unroll") for(int d_=0;d_<2;++d_) _Pragma("unroll") for(int r=0;r<16;++r)o[d_][r]*=wsf[crow(r,hi)]; } }while(0)
  f32x16 pA0,pA1,pB0,pB1;
  int sl_prev=0,sl_cur=0,sl_next=SLOTB;
  #define ROT() do{sl_prev=sl_cur;sl_cur=sl_next;sl_next=(sl_next==(NSLOT-1)*SLOTB)?0:sl_next+SLOTB;}while(0)
  DMA_K(2,2*SLOTB);
  WAIT_BAR(3);
  qkt(pA0,pA1,Kbase,qr,r32,hi);asm volatile("s_nop 15\n\ts_nop 7":"+v"(pA0),"+v"(pA1));CMASK(pA0,pA1,0);
  START(pA0,pA1);
  _Pragma("unroll") for(int r=0;r<16;++r)pA1[r]=__builtin_amdgcn_exp2f(pA1[r]);
  WAIT_BAR(0);
  DMA_K(3,0);DMA_V(1,SLOTB);
  ROT();
  kload8(kf,kp0+sl_cur);
  WAIT_BAR(3);
  s16x4 vlo[8],vhi[8]; u32x4 pw0,pw1,pw2,pw3;
  #define PKW(P,B) cvtpk_s(P[B],P[B+1])
  #define PAF(k) __builtin_bit_cast(bf16x8,pw##k)
  #define VFR(i) (bf16x8){vlo[i][0],vlo[i][1],vlo[i][2],vlo[i][3],vhi[i][0],vhi[i][1],vhi[i][2],vhi[i][3]}
  #define PIN(x) asm volatile("":"+v"(x))
  #define MX3(a,b,c) __builtin_fmaxf(__builtin_fmaxf((a),(b)),(c))
  #define GAPA(MF,A0,A1,A2,A3,W0,W1,PW) do{ MF; sacc+=A0; sacc+=A1; sacc+=A2; sacc+=A3; PIN(sacc); W0; W1; PIN(PW); SBAR(); }while(0)
  #define EX(v) __builtin_amdgcn_exp2f(v)
  #define GAPB(MF,X,B) do{ MF; X[B]=EX(X[B]); X[B+1]=EX(X[B+1]); X[B+2]=EX(X[B+2]); X[B+3]=EX(X[B+3]); PIN(X); SBAR(); }while(0)
  #define VRD(i) do{ vlo[i]=vtr(vp_+(((i)>>2)*4096+((i)&3)*1024)); vhi[i]=vtr(vp_+(((i)>>2)*4096+((i)&3)*1024+512)); }while(0)
  #define KRD(G,j) do{ if(G){ kload2(kf,kp0+sl_next,j); SBAR(); } }while(0)
  #define STEP(C0,C1,P0,P1,t,GK,GV,GL) do{ SBAR(); \
    const lds_cptr vp_=vp0+sl_prev; \
    VRD(0); SBAR(); float sacc=(P0[0]+P0[1]); \
    GAPA(C0=__builtin_amdgcn_mfma_f32_32x32x16_bf16(kf[0],qr[0],zero16,0,0,0), P0[2],P0[3],P0[4],P0[5],     pw0[0]=PKW(P0,0), pw0[1]=PKW(P0,2), pw0); \
    VRD(4); SBAR(); GAPA(C1=__builtin_amdgcn_mfma_f32_32x32x16_bf16(kf[1],qr[0],zero16,0,0,0), P0[6],P0[7],P0[8],P0[9],     pw0[2]=PKW(P0,4), pw0[3]=PKW(P0,6), pw0); \
    VRD(1); SBAR(); GAPA(C0=__builtin_amdgcn_mfma_f32_32x32x16_bf16(kf[2],qr[1],C0,0,0,0),   P0[10],P0[11],P0[12],P0[13], pw1[0]=PKW(P0,8), pw1[1]=PKW(P0,10), pw1); \
    VRD(5); SBAR(); GAPA(C1=__builtin_amdgcn_mfma_f32_32x32x16_bf16(kf[3],qr[1],C1,0,0,0),   P0[14],P0[15],P1[0],P1[1],   pw1[2]=PKW(P0,12),pw1[3]=PKW(P0,14), pw1); \
    VRD(2); SBAR(); GAPA(C0=__builtin_amdgcn_mfma_f32_32x32x16_bf16(kf[4],qr[2],C0,0,0,0),   P1[2],P1[3],P1[4],P1[5],     pw2[0]=PKW(P1,0), pw2[1]=PKW(P1,2), pw2); \
    VRD(6); SBAR(); GAPA(C1=__builtin_amdgcn_mfma_f32_32x32x16_bf16(kf[5],qr[2],C1,0,0,0),   P1[6],P1[7],P1[8],P1[9],     pw2[2]=PKW(P1,4), pw2[3]=PKW(P1,6), pw2); \
    VRD(3); SBAR(); GAPA(C0=__builtin_amdgcn_mfma_f32_32x32x16_bf16(kf[6],qr[3],C0,0,0,0),   P1[10],P1[11],P1[12],P1[13], pw3[0]=PKW(P1,8), pw3[1]=PKW(P1,10), pw3); \
    VRD(7); SBAR(); GAPA(C1=__builtin_amdgcn_mfma_f32_32x32x16_bf16(kf[7],qr[3],C1,0,0,0),   P1[14],P1[15],0.f,0.f,       pw3[2]=PKW(P1,12),pw3[3]=PKW(P1,14), pw3); \
    C0=__builtin_amdgcn_mfma_f32_32x32x16_bf16(kf[8],qr[4],C0,0,0,0); C1=__builtin_amdgcn_mfma_f32_32x32x16_bf16(kf[9],qr[4],C1,0,0,0); SBAR(); \
    l_reg+=sacc; \
    if(GK){DMA_K((t)+3,sl_cur);} if(GV){DMA_V((t)+1,sl_next);} \
    CMASK(C0,C1,t); \
    { float a=MX3(C0[0],C0[1],C1[0]),b=MX3(C0[2],C0[3],C1[1]); a=MX3(a,C1[2],C1[3]); \
      _Pragma("unroll") for(int r=4;r<16;r+=4){a=MX3(a,C0[r],C0[r+1]);b=MX3(b,C0[r+2],C0[r+3]);a=MX3(a,C1[r],C1[r+1]);b=MX3(b,C1[r+2],C1[r+3]);} \
      float rm=__builtin_fmaxf(a,b); { auto rr=__builtin_amdgcn_permlane32_swap(__float_as_uint(rm),__float_as_uint(rm),false,false); rm=__builtin_fmaxf(__uint_as_float(rr[0]),__uint_as_float(rr[1])); } \
      resc=false; \
      if(__builtin_expect(__any(rm>(float)THRL),0)){ const float dl=__builtin_fmaxf(rm,0.f); mhat+=dl; \
        _Pragma("unroll") for(int r=0;r<16;++r){C0[r]-=dl;C1[r]-=dl;} \
        set_m(qr[4],-mhat,hi); asm volatile("":"+v"(qr[4])); \
        const float f=__builtin_amdgcn_exp2f(-dl); l_reg*=f; if(hi==0)wsf[r32]=f; resc=true; } } \
    SBAR(); \
    GAPB(o[0]=__builtin_amdgcn_mfma_f32_32x32x16_bf16(PAF(0),VFR(0),o[0],0,0,0), C0,0); \
    GAPB(o[1]=__builtin_amdgcn_mfma_f32_32x32x16_bf16(PAF(0),VFR(4),o[1],0,0,0), C0,4); \
    KRD(GL,0); GAPB(o[0]=__builtin_amdgcn_mfma_f32_32x32x16_bf16(PAF(1),VFR(1),o[0],0,0,0), C0,8); \
    KRD(GL,1); GAPB(o[1]=__builtin_amdgcn_mfma_f32_32x32x16_bf16(PAF(1),VFR(5),o[1],0,0,0), C0,12); \
    KRD(GL,2); GAPB(o[0]=__builtin_amdgcn_mfma_f32_32x32x16_bf16(PAF(2),VFR(2),o[0],0,0,0), C1,0); \
    KRD(GL,3); GAPB(o[1]=__builtin_amdgcn_mfma_f32_32x32x16_bf16(PAF(2),VFR(6),o[1],0,0,0), C1,4); \
    KRD(GL,4); GAPB(o[0]=__builtin_amdgcn_mfma_f32_32x32x16_bf16(PAF(3),VFR(3),o[0],0,0,0), C1,8); \
    GAPB(o[1]=__builtin_amdgcn_mfma_f32_32x32x16_bf16(PAF(3),VFR(7),o[1],0,0,0), C1,12); \
    }while(0)
  int t=1;
  #undef CMASK
  #define CMASK(P0,P1,t) do{}while(0)
  for(;t+5<NT;t+=2){
    STEP(pB0,pB1,pA0,pA1,t,true,true,true);     WAIT_BAR(3); RESC(); ROT();
    STEP(pA0,pA1,pB0,pB1,t+1,true,true,true);   WAIT_BAR(3); RESC(); ROT();
  }
  #undef CMASK
  #define CMASK(P0,P1,t) do{int jb_=(t)-(NT-4); if(jb_>=0)cmask(P0,P1,jb_,qrel,hi);}while(0)
  #define ENDW(tt) do{ if((tt)+3<NT){WAIT_BAR(3);} else if((tt)+2<NT){WAIT_BAR(1);} else {WAIT_BAR(0);} }while(0)
  for(;t+1<NT;t+=2){
    STEP(pB0,pB1,pA0,pA1,t,(t+3<NT),(t+1<NT),(t+1<NT));       ENDW(t);   RESC(); ROT();
    STEP(pA0,pA1,pB0,pB1,t+1,(t+4<NT),(t+2<NT),(t+2<NT));     ENDW(t+1); RESC(); ROT();
  }
  STEP(pB0,pB1,pA0,pA1,NT-1,false,false,false); RESC();
  { float sacc=pB0[0]+pB0[1]; _Pragma("unroll") for(int r=2;r<16;++r)sacc+=pB0[r]; _Pragma("unroll") for(int r=0;r<16;++r)sacc+=pB1[r]; l_reg+=sacc;
    pw0=(u32x4){PKW(pB0,0),PKW(pB0,2),PKW(pB0,4),PKW(pB0,6)};pw1=(u32x4){PKW(pB0,8),PKW(pB0,10),PKW(pB0,12),PKW(pB0,14)};pw2=(u32x4){PKW(pB1,0),PKW(pB1,2),PKW(pB1,4),PKW(pB1,6)};pw3=(u32x4){PKW(pB1,8),PKW(pB1,10),PKW(pB1,12),PKW(pB1,14)};
    SBAR(); pv(o,vb0+sl_cur,PAF(0),PAF(1),PAF(2),PAF(3)); }
  #undef PKW
  #undef PAF
  #undef VFR
  #undef PIN
  #undef MX3
  #undef GAPA
  #undef GAPB
  #undef EX
  #undef VRD
  #undef KRD
  #undef STEP
  #undef ENDW
  {auto rr=__builtin_amdgcn_permlane32_swap(__float_as_uint(l_reg),__float_as_uint(l_reg),false,false);l_reg=__uint_as_float(rr[0])+__uint_as_float(rr[1]);}
  if(hi==0)wsf[32+r32]=l_reg;asm volatile("s_waitcnt lgkmcnt(0)":::"memory");
  float rli[16];
  #pragma unroll
  for(int r=0;r<16;++r)rli[r]=__builtin_amdgcn_rcpf(wsf[32+crow(r,hi)]);
  bf16*Ow=O+(rowbase+q0+wid*QBLK)*DM+h*D;
  { bf16*stg=(bf16*)(shm+LDS_OST)+wid*2048;
    #pragma unroll
    for(int r=0;r<16;++r){const int orow=crow(r,hi);
      #pragma unroll
      for(int d0=0;d0<2;++d0)stg[orow*64+d0*32+r32]=__float2bfloat16(o[d0][r]*rli[r]);}
    asm volatile("s_waitcnt lgkmcnt(0)":::"memory");
    #pragma unroll
    for(int i=0;i<4;++i){const int row=i*8+(lane>>3),ch=lane&7; const u32x4 v=*(const u32x4*)(stg+row*64+ch*8); ATTN_STORE16(Ow+(long)row*DM+ch*8,v);} }
  asm volatile("s_waitcnt lgkmcnt(0)\n\ts_barrier":::"memory");
  #undef DMA_K
  #undef DMA_V
  #undef CMASK
  #undef START
  #undef RESC
  #undef ROT
}
constexpr int ATTN_LDS_BYTES=LDS_BYTES;
struct AttnTensors { const bf16* Q; const bf16* K; const bf16* V; bf16* O; const bf16* QX; const bf16* KX; };
struct AttnUnit { int bh; int qb; };
struct StaticOrder {
  int vcu, G;
  __device__ __forceinline__ explicit StaticOrder(int grid,int block):vcu((grid%8==0)?(block%8)*(grid/8)+block/8:block),G(grid){}
  __device__ __forceinline__ bool next(int i,AttnUnit&u)const{
    if(G==256){ if(i>=8)return false; const int s=vcu&1,p=i>>1,j=i&1; u.bh=vcu>>1; u.qb=4*p+(j?3-s:s); return true; }
    const int L=i*G+vcu; if(L>=BATCH*NHEAD*NQB)return false; u.bh=L%(BATCH*NHEAD); u.qb=NQB-1-L/(BATCH*NHEAD); return true; }
  __device__ __forceinline__ void a_ready(const AttnUnit&)const{}
  __device__ __forceinline__ void done(const AttnUnit&)const{}
};
template<class Sched,int THRL=8> __device__ __forceinline__ void attn_phase(char*lds,const AttnTensors&T,const Sched&S){
  AttnUnit u;
  for(int i=0;S.next(i,u);++i){ S.a_ready(u); attn_unit<THRL>(u.bh/NHEAD,u.bh%NHEAD,u.qb,T.Q,T.K,T.V,T.O,T.QX,T.KX,lds); S.done(u); }
}
#undef SBAR
#undef WAIT_BAR
}

constexpr int NWAVES = 8;
#ifndef MK_N_LAUNCHES
#define MK_N_LAUNCHES 1
#endif
constexpr int BATCH = 8, T = 4096, D = 1024, M = BATCH * T;
constexpr int A_H = 16, A_RQ = 256, A_RKV = 128, IDX_H = 8, IDX_D = 64, A_INW = 456, TOPK = 256;
constexpr int B_INW = 3088;
constexpr int NEXP = 32, MOE_K = 4, DEXP = 1024;
constexpr int NPAIR = M * MOE_K;
constexpr int MAXSLOT = NPAIR + NEXP * 256;
constexpr float LN_EPS = 1e-5f, RMS_EPS = 1e-6f;
constexpr float DN_ALPHA = 1.41421356237309515f;
constexpr float LOG2E = 1.4426950408889634f;
constexpr int N_PHASES = 22;

constexpr size_t MiB = 1u << 20;
constexpr size_t WS_CTL = 0, CTL_ZERO_BYTES = 1 * MiB;
constexpr size_t WS_SMALL = 1 * MiB;
constexpr size_t WS_WAIN = 2 * MiB, WS_WACQ = 3 * MiB, WS_WAO = 5 * MiB, WS_WBIN = 9 * MiB, WS_WBO = 15 * MiB;
constexpr size_t WS_PAR = 18 * MiB;
constexpr int PAR_REL = 0, PAR_AGQ = 512, PAR_AGKV = 768, PAR_AGKI = 896, PAR_ABKI = 960, PAR_BF = 1024, PAR_BROUT = 1088, PAR_LN = 2048  ,
              PAR_WROUT = 16384  , PAR_WF = 81920  , PAR_BGU = 98304  , PAR_BDOWN = 229376  , PAR_END = 294912;
static_assert((size_t)PAR_END * 4 <= 2 * MiB, "parameter copies");
constexpr size_t WS_WGU = 32 * MiB, WS_WD = 288 * MiB;
constexpr size_t WS_XF = 416 * MiB, WS_XB = 544 * MiB;
constexpr size_t WS_PROJ = 608 * MiB, WS_CQN = 672 * MiB, WS_CKV = 688 * MiB, WS_KIDX = 696 * MiB, WS_WIDX = 700 * MiB, WS_BKT = 701 * MiB  , WS_SEL = 712 * MiB  ,
                 WS_QIDX = 736 * MiB, WS_QLAT = 768 * MiB, WS_OLAT = 896 * MiB;
constexpr size_t WS_Q = 608 * MiB, WS_K = 672 * MiB, WS_V = 736 * MiB, WS_LOGF = 800 * MiB, WS_QX = 802 * MiB, WS_KX = 818 * MiB;
constexpr size_t WS_TOPE = 1024 * MiB, WS_TOPG = 1025 * MiB, WS_POS = 1026 * MiB, WS_SLOT = 1027 * MiB;
constexpr size_t WS_XG = 1028 * MiB, WS_H = 1300 * MiB, WS_Y = 1572 * MiB, WS_END = 1700 * MiB;
static_assert((size_t)MAXSLOT * 1024 * 2 <= 272 * MiB, "slot buffers");
constexpr int CW_TMO = 0, CW_CODE = 1;
constexpr int CW_BAR = 4096;
constexpr int CW_CNT = 16384;
constexpr int SM_NT = 0, SM_TILE_E = 64;
constexpr int RING_OFF = 0, RING_BYTES = 131072;
constexpr int LDS_BYTES = 147456;
constexpr int MISC_OFF = LDS_BYTES - 256;
#define GAS __attribute__((address_space(1)))
#define LAS __attribute__((address_space(3)))
typedef unsigned short bf16;
typedef unsigned v4u __attribute__((ext_vector_type(4)));
typedef float f32x4 __attribute__((ext_vector_type(4)));
typedef short bf16x8 __attribute__((ext_vector_type(8)));
typedef GAS unsigned gu32;
typedef GAS unsigned long long gu64;
#define RLX_AGENT __ATOMIC_RELAXED, __HIP_MEMORY_SCOPE_AGENT
#define LDS_WAIT() asm volatile("s_waitcnt lgkmcnt(0)" ::: "memory")
#define VM_WAIT() asm volatile("s_waitcnt vmcnt(0)" ::: "memory")
__device__ __forceinline__ unsigned long long rt() { return __builtin_amdgcn_s_memrealtime(); }
__device__ __forceinline__ unsigned f2bf(float f) { unsigned u = __builtin_bit_cast(unsigned, f); return (u + 0x7fffu + ((u >> 16) & 1u)) >> 16; }
__device__ __forceinline__ unsigned pk2(float lo, float hi) { return f2bf(lo) | (f2bf(hi) << 16); }

#define XB_TMO      128
#define XB_XCNT(j)  (256  + 64 * (j))
#define XB_XSUB(j)  (1280 + 64 * (j))
#define XB_XGEN(j)  (2304 + 64 * (j))
#define XB_TOP      3328
#define XB_TOPGEN   3392
#define XCD_BAR_WORDS 3456
#define XB_SPIN_CAP (1u << 18)

__device__ __forceinline__ unsigned xb_ld(unsigned* p)              { return __hip_atomic_load(p, __ATOMIC_RELAXED, __HIP_MEMORY_SCOPE_AGENT); }
__device__ __forceinline__ unsigned xb_add(unsigned* p, unsigned v) { return __hip_atomic_fetch_add(p, v, __ATOMIC_RELAXED, __HIP_MEMORY_SCOPE_AGENT); }
__device__ __forceinline__ unsigned xb_xcc_id() { return (unsigned)__builtin_amdgcn_s_getreg((3 << 11) | 20) & 0xFu; }
#define XB_SPIN(cond, bar) do { unsigned _sp = 0; while (cond) { __builtin_amdgcn_s_sleep(1); \
    if ((++_sp & 255u) == 0u) { if (xb_ld(&(bar)[XB_TMO])) break; if (_sp > XB_SPIN_CAP) { atomicAdd(&(bar)[XB_TMO], 1u); break; } } } } while (0)

struct XcdBarrier {
    unsigned* bar; unsigned x;
    volatile LAS unsigned* st;
};

__device__ __forceinline__ XcdBarrier xcd_barrier_post(unsigned* bar, volatile LAS unsigned* st) {
    XcdBarrier b; b.bar = bar; b.x = xb_xcc_id(); b.st = st;
    if (threadIdx.x == 0) (void)xb_add(&bar[XB_XCNT(b.x)], 1u);
    return b;
}
__device__ __forceinline__ void xcd_barrier_complete(unsigned* bar, unsigned x, unsigned& nloc, unsigned& nx) {
    const unsigned G = gridDim.x * gridDim.y * gridDim.z;
    unsigned sum, cnt, mine, sp = 0u;
    for (;;) {
        sum = 0u; cnt = 0u; mine = 0u;
#pragma unroll
        for (unsigned j = 0; j < 16; ++j) { const unsigned c = xb_ld(&bar[XB_XCNT(j)]); sum += c; cnt += (c > 0u) ? 1u : 0u; mine = (j == x) ? c : mine; }
        if (sum == G) break;
        __builtin_amdgcn_s_sleep(1);
        if ((++sp & 255u) == 0u) { if (xb_ld(&bar[XB_TMO])) break; if (sp > XB_SPIN_CAP) { atomicAdd(&bar[XB_TMO], 1u); break; } }
    }
    nloc = mine > 0u ? mine : 1u; nx = cnt > 0u ? cnt : 1u;
}

__device__ __forceinline__ void xcd_barrier(const XcdBarrier& b) {
    asm volatile("s_waitcnt vmcnt(0)" ::: "memory");
    __syncthreads();
    if (threadIdx.x == 0) {
        unsigned* bar = b.bar;
        __builtin_amdgcn_s_waitcnt(0);
        unsigned nloc = b.st[0], nx = b.st[1];
        if (nloc == 0u) { xcd_barrier_complete(bar, b.x, nloc, nx); b.st[0] = nloc; b.st[1] = nx; }
        const unsigned old = xb_add(&bar[XB_XSUB(b.x)], 1u);
        const unsigned gen = old / nloc;
        if (old + 1u == (gen + 1u) * nloc) {
            __builtin_amdgcn_fence(__ATOMIC_RELEASE, "agent");
            asm volatile("s_waitcnt vmcnt(0)" ::: "memory");
            const unsigned og = xb_add(&bar[XB_TOP], 1u);
            const unsigned tg = og / nx;
            if (og + 1u == (tg + 1u) * nx) xb_add(&bar[XB_TOPGEN], 1u);
            else XB_SPIN(xb_ld(&bar[XB_TOPGEN]) == tg, bar);
            __builtin_amdgcn_fence(__ATOMIC_ACQUIRE, "agent");
            xb_add(&bar[XB_XGEN(b.x)], 1u);
            asm volatile("s_waitcnt vmcnt(0)" ::: "memory");
        } else {
            XB_SPIN(xb_ld(&bar[XB_XGEN(b.x)]) == gen, bar);
            __builtin_amdgcn_fence(__ATOMIC_ACQUIRE, "agent");
            asm volatile("s_waitcnt vmcnt(0)" ::: "memory");
        }
    }
    __syncthreads();
}

struct Frame {
    LAS unsigned char* lds;
    volatile LAS unsigned* MISC;
    gu32* ctl;
    int vcu, G;
    unsigned char* ws;
};
__device__ __forceinline__ int opaque_tid() { int t = threadIdx.x; asm volatile("" : "+v"(t)); return t; }
#define PHASE_IDS() const int tid = opaque_tid(), lane = tid & 63, wave = __builtin_amdgcn_readfirstlane(tid >> 6); (void)lane; (void)wave
typedef float f32x2 __attribute__((ext_vector_type(2)));
typedef unsigned u32x4 __attribute__((ext_vector_type(4)));
typedef unsigned u32x2 __attribute__((ext_vector_type(2)));
__device__ __forceinline__ float wave_sum(float v) {
#pragma unroll
    for (int o = 1; o < 64; o <<= 1) v += __shfl_xor(v, o);
    return v;
}
__device__ __forceinline__ unsigned cvtpk(float lo, float hi) { typedef __bf16 bf2 __attribute__((ext_vector_type(2))); f32x2 v = {lo, hi}; bf2 b = __builtin_convertvector(v, bf2); return __builtin_bit_cast(unsigned, b); }
__device__ __forceinline__ float bf2f(unsigned short h) { return __uint_as_float((unsigned)h << 16); }

template <int MODE>
__device__ __forceinline__ void p0_transpose_item(const float* W, int ldw, int nvalid, int K, bf16* WT, int row_off, LAS float* scr, int kb, int nb, int lane) {
    const int k0 = 64 * kb, n0 = 32 * nb;
    const int nn = n0 + (lane & 31); const bool ok = nn < nvalid;
#pragma unroll 8
    for (int i = 0; i < 32; ++i) { const int kk = 2 * i + (lane >> 5); scr[kk * 33 + (lane & 31)] = ok ? W[(size_t)(k0 + kk) * ldw + nn] : 0.f; }
    LDS_WAIT(); asm volatile("" ::: "memory");
    const int c = lane & 7;
#pragma unroll
    for (int j = 0; j < 4; ++j) { const int n = (lane >> 3) + 8 * j; const LAS float* s = scr + (8 * c) * 33 + n;
        v4u o; o.x = pk2(s[0 * 33], s[1 * 33]); o.y = pk2(s[2 * 33], s[3 * 33]); o.z = pk2(s[4 * 33], s[5 * 33]); o.w = pk2(s[6 * 33], s[7 * 33]);
        const int ng = n0 + n; int row;
        if (MODE == 0) row = row_off + ng; else { const int np = ng & 1023; row = (np >> 7) * 256 + ((ng >> 10) << 7) + (np & 127); }
        *(GAS v4u*)(WT + (size_t)row * K + k0 + 8 * c) = o; }
    LDS_WAIT(); asm volatile("" ::: "memory");
}
struct P0In { const float *x, *a_w_in, *a_w_uq, *a_w_uk, *a_w_uv, *a_w_qidx, *a_w_o, *b_w_in, *b_w_o, *w_gu, *w_down;
              const float *rel, *a_g_q, *a_g_kv, *a_g_kidx, *a_b_kidx, *b_b_f, *ln_mix_g, *ln_mix_b, *ln_ffn_g, *ln_ffn_b, *w_router, *b_router, *b_gu, *b_down; };
__device__ __forceinline__ void p0_copy(float* dst, const float* src, int n, int g0, int gs) { for (int i = g0; i < n; i += gs) dst[i] = src[i]; }
__device__ __forceinline__ void p0_prologue(Frame& F, const P0In& I) {
    PHASE_IDS();
    bf16* WAIN = (bf16*)(F.ws + WS_WAIN); bf16* WACQ = (bf16*)(F.ws + WS_WACQ); bf16* WAO = (bf16*)(F.ws + WS_WAO); bf16* WBIN = (bf16*)(F.ws + WS_WBIN); bf16* WBO = (bf16*)(F.ws + WS_WBO);
    bf16* WGU = (bf16*)(F.ws + WS_WGU); bf16* WD = (bf16*)(F.ws + WS_WD); bf16* XB = (bf16*)(F.ws + WS_XB);
    for (int it = F.vcu; it < 128 + 256; it += F.G) {
        if (it < 128) {
            const int h = it >> 3, rb = it & 7; const int rq = tid & 255, rs = wave >> 2;
            float q[64];
            const GAS f32x4* qp = (const GAS f32x4*)(I.a_w_uq + ((size_t)rq * A_H + h) * 64);
#pragma unroll
            for (int i = 0; i < 16; ++i) { const f32x4 v = qp[i]; q[4 * i] = v.x; q[4 * i + 1] = v.y; q[4 * i + 2] = v.z; q[4 * i + 3] = v.w; }
            for (int j = 0; j < 8; ++j) { const int r = rb * 16 + rs * 8 + j; const float* kp = I.a_w_uk + ((size_t)r * A_H + h) * 64; float s = 0.f;
#pragma unroll
                for (int d = 0; d < 64; ++d) s += q[d] * kp[d];
                WACQ[(size_t)(h * 128 + r) * 256 + rq] = (bf16)f2bf(s * (0.125f * LOG2E)); }
        } else {
            const int i2 = it - 128, h = i2 >> 4, nc = i2 & 15; LAS float* wo = (LAS float*)F.lds;
#pragma unroll
            for (int i = 0; i < 8; ++i) { const int idx = tid + 512 * i, d = idx >> 6, n = idx & 63; wo[idx] = I.a_w_o[(size_t)(h * 64 + d) * D + nc * 64 + n]; }
            LDS_WAIT(); __syncthreads();
            const int nl = tid & 63, rg = wave; float acc[16];
#pragma unroll
            for (int i = 0; i < 16; ++i) acc[i] = 0.f;
            for (int d = 0; d < 64; ++d) { const float w = wo[d * 64 + nl];
#pragma unroll
                for (int i = 0; i < 16; ++i) acc[i] += I.a_w_uv[((size_t)(rg * 16 + i) * A_H + h) * 64 + d] * w; }
            v4u o0, o1; o0.x = pk2(acc[0], acc[1]); o0.y = pk2(acc[2], acc[3]); o0.z = pk2(acc[4], acc[5]); o0.w = pk2(acc[6], acc[7]);
            o1.x = pk2(acc[8], acc[9]); o1.y = pk2(acc[10], acc[11]); o1.z = pk2(acc[12], acc[13]); o1.w = pk2(acc[14], acc[15]);
            GAS v4u* op = (GAS v4u*)(WAO + (size_t)(nc * 64 + nl) * 2048 + h * 128 + rg * 16); op[0] = o0; op[1] = o1;
            __syncthreads();
        }
    }
    __syncthreads();
    LAS float* scr = (LAS float*)(F.lds + RING_OFF + wave * 16384);
    const int gw = F.vcu * NWAVES + wave, NGW = F.G * NWAVES;
    constexpr int I_AIN = 16 * 16, I_QIDX = 4 * 16, I_BIN = 16 * 96, I_BO = 16 * 32, I_GU1 = 16 * 64, I_D1 = 16 * 32;
    constexpr int I_GU = 64 * I_GU1, I_DN = 64 * I_D1;
    constexpr int NITEMS = I_AIN + I_QIDX + I_BIN + I_BO + I_GU + I_DN;
    for (int it = gw; it < NITEMS; it += NGW) {
        int r = it;
        if (r < I_AIN) { p0_transpose_item<0>(I.a_w_in, A_INW, A_INW, 1024, WAIN, 0, scr, r / 16, r % 16, lane); continue; } r -= I_AIN;
        if (r < I_QIDX) { p0_transpose_item<0>(I.a_w_qidx, 512, 512, 256, WACQ, 2048, scr, r / 16, r % 16, lane); continue; } r -= I_QIDX;
        if (r < I_BIN) { p0_transpose_item<0>(I.b_w_in, B_INW, 3072, 1024, WBIN, 0, scr, r / 96, r % 96, lane); continue; } r -= I_BIN;
        if (r < I_BO) { p0_transpose_item<0>(I.b_w_o, 1024, 1024, 1024, WBO, 0, scr, r / 32, r % 32, lane); continue; } r -= I_BO;
        if (r < I_GU) { const int mi = r / I_GU1, rr = r % I_GU1; p0_transpose_item<1>(I.w_gu + (size_t)mi * 1024 * 2048, 2048, 2048, 1024, WGU + (size_t)mi * 2048 * 1024, 0, scr, rr / 64, rr % 64, lane); continue; } r -= I_GU;
        { const int mi = r / I_D1, rr = r % I_D1; p0_transpose_item<0>(I.w_down + (size_t)mi * 1024 * 1024, 1024, 1024, 1024, WD + (size_t)mi * 1024 * 1024, 0, scr, rr / 32, rr % 32, lane); }
    }
    { float* PAR = (float*)(F.ws + WS_PAR); const int g0 = F.vcu * 512 + tid, gs = F.G * 512;
      p0_copy(PAR + PAR_REL, I.rel, 512, g0, gs); p0_copy(PAR + PAR_AGQ, I.a_g_q, 256, g0, gs); p0_copy(PAR + PAR_AGKV, I.a_g_kv, 128, g0, gs); p0_copy(PAR + PAR_AGKI, I.a_g_kidx, 64, g0, gs);
      p0_copy(PAR + PAR_ABKI, I.a_b_kidx, 64, g0, gs); p0_copy(PAR + PAR_BF, I.b_b_f, 16, g0, gs); p0_copy(PAR + PAR_BROUT, I.b_router, 64, g0, gs);
      p0_copy(PAR + PAR_LN, I.ln_mix_g, 2048, g0, gs); p0_copy(PAR + PAR_LN + 2048, I.ln_mix_b, 2048, g0, gs); p0_copy(PAR + PAR_LN + 4096, I.ln_ffn_g, 2048, g0, gs); p0_copy(PAR + PAR_LN + 6144, I.ln_ffn_b, 2048, g0, gs);
      p0_copy(PAR + PAR_WROUT, I.w_router, 65536, g0, gs); p0_copy(PAR + PAR_BGU, I.b_gu, 131072, g0, gs); p0_copy(PAR + PAR_BDOWN, I.b_down, 65536, g0, gs);
      for (int i = g0; i < 16384; i += gs) PAR[PAR_WF + i] = I.b_w_in[(size_t)(i >> 4) * B_INW + 3072 + (i & 15)]; }
    { const size_t n8 = (size_t)M * D / 8; const size_t g0 = (size_t)F.vcu * 512 + tid, gs = (size_t)F.G * 512;
      for (size_t i = g0; i < n8; i += gs) { const GAS f32x4* p = (const GAS f32x4*)(I.x + i * 8); const f32x4 a = p[0], b = p[1];
          v4u o; o.x = pk2(a.x, a.y); o.y = pk2(a.z, a.w); o.z = pk2(b.x, b.y); o.w = pk2(b.z, b.w); *(GAS v4u*)(XB + i * 8) = o; } }
}

__device__ __forceinline__ void p_dsa_norms(Frame& F, const float* g_q, const float* g_kv, const float* g_kidx, const float* b_kidx) {
    PHASE_IDS();
    const float* PROJ = (const float*)(F.ws + WS_PROJ); bf16* CQN = (bf16*)(F.ws + WS_CQN); bf16* CKV = (bf16*)(F.ws + WS_CKV); bf16* KIDX = (bf16*)(F.ws + WS_KIDX); float* WIDX = (float*)(F.ws + WS_WIDX);
    const int l = lane; const int gw = F.vcu * NWAVES + wave, NGW = F.G * NWAVES;
    const f32x4 gq = *(const f32x4*)(g_q + 4 * l); const f32x2 gkv = *(const f32x2*)(g_kv + 2 * l); const float gki = g_kidx[l], bki = b_kidx[l];
    for (int row = gw; row < M; row += NGW) {
        const float* p = PROJ + (size_t)row * 512;
        const f32x4 cq = *(const f32x4*)(p + 4 * l); const f32x2 ckv = *(const f32x2*)(p + 256 + 2 * l); const float ki = p[384 + l]; const float wi = (l < 8) ? p[448 + l] : 0.f;
        const float rq = 1.0f / sqrtf(wave_sum(cq.x * cq.x + cq.y * cq.y + cq.z * cq.z + cq.w * cq.w) * (1.0f / 256.0f) + RMS_EPS);
        const float rkv = 1.0f / sqrtf(wave_sum(ckv.x * ckv.x + ckv.y * ckv.y) * (1.0f / 128.0f) + RMS_EPS);
        const float mean = wave_sum(ki) * (1.0f / 64.0f); const float dk = ki - mean; const float rki = 1.0f / sqrtf(wave_sum(dk * dk) * (1.0f / 64.0f) + LN_EPS);
        u32x2 oq; oq.x = cvtpk(cq.x * rq * gq.x, cq.y * rq * gq.y); oq.y = cvtpk(cq.z * rq * gq.z, cq.w * rq * gq.w);
        *(GAS u32x2*)(CQN + (size_t)row * 256 + 4 * l) = oq;
        *(GAS unsigned*)(CKV + (size_t)row * 128 + 2 * l) = cvtpk(ckv.x * rkv * gkv.x, ckv.y * rkv * gkv.y);
        KIDX[(size_t)row * 64 + l] = (bf16)f2bf(dk * rki * gki + bki);
        if (l < 8) WIDX[(size_t)row * 8 + l] = wi * 0.04419417382415922f;
    }
}

__device__ __forceinline__ int t5_bucket(int n) {
    if (n < 16) return n; if (n >= 128) return 31;
    const int v = 16 + (int)(__builtin_amdgcn_logf((float)n * 0.0625f) * (16.0f / 3.0f));
    return v < 31 ? v : 31;
}
__device__ __forceinline__ unsigned fkey(float f) { const unsigned u = __float_as_uint(f); return (u & 0x80000000u) ? ~u : (u | 0x80000000u); }
__device__ __forceinline__ int popc64(unsigned long long m) { return __builtin_popcountll(m); }
__device__ __forceinline__ int mbcnt(unsigned long long m) { return (int)__builtin_amdgcn_mbcnt_hi((unsigned)(m >> 32), __builtin_amdgcn_mbcnt_lo((unsigned)m, 0u)); }
typedef float f32x16 __attribute__((ext_vector_type(16)));
__device__ __forceinline__ void p_indexer(Frame& F) {
    PHASE_IDS();
    const bf16* QIDX = (const bf16*)(F.ws + WS_QIDX); const bf16* KIDX = (const bf16*)(F.ws + WS_KIDX); const float* WIDX = (const float*)(F.ws + WS_WIDX);
    unsigned short* SEL = (unsigned short*)(F.ws + WS_SEL); unsigned char* BKT = (unsigned char*)(F.ws + WS_BKT);
    LAS float* S = (LAS float*)F.lds;
    LAS unsigned short* selst = (LAS unsigned short*)(F.lds + 131072) + wave * 256;
    const int l = lane, l31 = l & 31, hi = l >> 5;
    { const int gw = F.vcu * NWAVES + wave, NGW = F.G * NWAVES;
      for (int rr = gw; rr < BATCH * 256; rr += NGW) { const int b = rr >> 8, t = rr & 255; const size_t row = (size_t)b * T + t;
          unsigned short s4[4]; unsigned bk = 0;
#pragma unroll
          for (int i = 0; i < 4; ++i) { const int k = 4 * l + i; const bool v = k <= t; s4[i] = v ? (unsigned short)k : (unsigned short)0xFFFF; bk |= (unsigned)(v ? t5_bucket(t - k) : 32) << (8 * i); }
          u32x2 o; o.x = (unsigned)s4[0] | ((unsigned)s4[1] << 16); o.y = (unsigned)s4[2] | ((unsigned)s4[3] << 16);
          *(GAS u32x2*)(SEL + row * 256 + 4 * l) = o; *(GAS unsigned*)(BKT + row * 256 + 4 * l) = bk; } }
    for (int i = 0; ; ++i) {
        const int L = i * F.G + F.vcu; const int rnd = L >> 8, pos = L & 255;
        if (rnd >= 15) break;
        const int b = pos & 7, gs = pos >> 3; const int g = 479 - 32 * rnd - ((rnd & 1) ? (31 - gs) : gs);
        const int t0 = 256 + 8 * g, nk = t0 + 8, nkt = (nk + 31) >> 5; const size_t rowb = (size_t)b * T;
        bf16x8 af[2][4]; float wA[2][8], wB[2][8];
        { const int tl = 2 * ((l31 >> 2) & 1) + (l31 >> 4), hd = (l31 & 3) + 4 * ((l31 >> 3) & 1);
#pragma unroll
          for (int mt = 0; mt < 2; ++mt) { const bf16* qp = QIDX + (rowb + t0 + mt * 4 + tl) * 512 + hd * 64 + hi * 8;
#pragma unroll
              for (int ks = 0; ks < 4; ++ks) af[mt][ks] = *(const GAS bf16x8*)(qp + ks * 16);
              const float* wp = WIDX + (rowb + t0 + mt * 4 + 2 * hi) * 8;
              const f32x4 a0 = *(const GAS f32x4*)(wp), a1 = *(const GAS f32x4*)(wp + 4), b0 = *(const GAS f32x4*)(wp + 8), b1 = *(const GAS f32x4*)(wp + 12);
              wA[mt][0] = a0.x; wA[mt][1] = a0.y; wA[mt][2] = a0.z; wA[mt][3] = a0.w; wA[mt][4] = a1.x; wA[mt][5] = a1.y; wA[mt][6] = a1.z; wA[mt][7] = a1.w;
              wB[mt][0] = b0.x; wB[mt][1] = b0.y; wB[mt][2] = b0.z; wB[mt][3] = b0.w; wB[mt][4] = b1.x; wB[mt][5] = b1.y; wB[mt][6] = b1.z; wB[mt][7] = b1.w; } }
        for (int kt = wave; kt < nkt; kt += NWAVES) {
            const int key = kt * 32 + l31; const bf16* kp = KIDX + (rowb + key) * 64 + hi * 8;
            bf16x8 bfr[4];
#pragma unroll
            for (int ks = 0; ks < 4; ++ks) bfr[ks] = *(const GAS bf16x8*)(kp + ks * 16);
#pragma unroll
            for (int mt = 0; mt < 2; ++mt) { f32x16 acc = f32x16{};
#pragma unroll
                for (int ks = 0; ks < 4; ++ks) acc = __builtin_amdgcn_mfma_f32_32x32x16_bf16(af[mt][ks], bfr[ks], acc, 0, 0, 0);
                float sA = 0.f, sB = 0.f;
#pragma unroll
                for (int r = 0; r < 8; ++r) { sA += wA[mt][r] * fmaxf(acc[r], 0.f); sB += wB[mt][r] * fmaxf(acc[8 + r], 0.f); }
                const int tokA = mt * 4 + 2 * hi; const int tA = t0 + tokA;
                S[tokA * 4096 + key] = (key <= tA) ? sA : -INFINITY; S[(tokA + 1) * 4096 + key] = (key <= tA + 1) ? sB : -INFINITY; }
        }
        LDS_WAIT(); __syncthreads();
        { const int t = t0 + wave; const int nvalid = nkt * 32; const int nj = (nvalid + 63) >> 6;
          unsigned u[64];
#pragma unroll
          for (int j = 0; j < 64; ++j) { const int idx = j * 64 + l; u[j] = (idx < nvalid) ? fkey(S[wave * 4096 + idx]) : 0u; }
          unsigned Tk = 0u;
          for (int bit = 31; bit >= 0; --bit) { const unsigned cand = Tk | (1u << bit); int cnt = 0;
#pragma unroll
              for (int jb = 0; jb < 8; ++jb) { if (jb * 8 < nj) {
#pragma unroll
                  for (int jj = 0; jj < 8; ++jj) cnt += popc64(__ballot(u[jb * 8 + jj] >= cand)); } }
              if (cnt >= TOPK) Tk = cand; }
          int cgt = 0;
#pragma unroll
          for (int j = 0; j < 64; ++j) cgt += popc64(__ballot(u[j] > Tk));
          const int need = TOPK - cgt; int off = 0, toff = 0;
#pragma unroll
          for (int j = 0; j < 64; ++j) { const unsigned long long m1 = __ballot(u[j] > Tk), m2 = __ballot(u[j] == Tk);
              if (u[j] > Tk) selst[off + mbcnt(m1)] = (unsigned short)(j * 64 + l);
              if (u[j] == Tk) { const int rk = toff + mbcnt(m2); if (rk < need) selst[cgt + rk] = (unsigned short)(j * 64 + l); }
              off += popc64(m1); toff += popc64(m2); }
          LDS_WAIT(); asm volatile("" ::: "memory");
          const size_t row = rowb + t; unsigned short s4[4]; unsigned bk = 0;
#pragma unroll
          for (int i2 = 0; i2 < 4; ++i2) { s4[i2] = selst[4 * l + i2]; bk |= (unsigned)t5_bucket(t - (int)s4[i2]) << (8 * i2); }
          u32x2 o; o.x = (unsigned)s4[0] | ((unsigned)s4[1] << 16); o.y = (unsigned)s4[2] | ((unsigned)s4[3] << 16);
          *(GAS u32x2*)(SEL + row * 256 + 4 * l) = o; *(GAS unsigned*)(BKT + row * 256 + 4 * l) = bk; }
        LDS_WAIT(); __syncthreads();
    }
}

typedef short v4i16_t __attribute__((ext_vector_type(4)));
__device__ __forceinline__ void p_sparse_attn(Frame& F, const float* rel_table) {
    PHASE_IDS();
    const bf16* QLAT = (const bf16*)(F.ws + WS_QLAT); const bf16* CKV = (const bf16*)(F.ws + WS_CKV); bf16* OLAT = (bf16*)(F.ws + WS_OLAT);
    const unsigned short* SEL = (const unsigned short*)(F.ws + WS_SEL); const unsigned char* BKT = (const unsigned char*)(F.ws + WS_BKT);
    LAS unsigned char* cb = F.lds + wave * 16384;
    LAS unsigned short* selw = (LAS unsigned short*)(F.lds + 131072 + wave * 768);
    LAS unsigned char* bktw = (LAS unsigned char*)(F.lds + 131072 + wave * 768 + 512);
    LAS float* relt = (LAS float*)(F.lds + 131072 + 8 * 768);
    for (int i = tid; i < 33 * 16; i += NWAVES * 64) relt[i] = (i < 512) ? rel_table[i] * LOG2E : -INFINITY;
    LDS_WAIT(); __syncthreads();
    const int l = lane, l15 = l & 15, g = l >> 4;
    const int gw = F.vcu * NWAVES + wave, NGW = F.G * NWAVES;
    for (int it = gw; it < M; it += NGW) {
        size_t row; if (NGW == 2048) row = (size_t)(gw >> 8) * T + (size_t)((gw & 255) + 256 * (it >> 11)); else row = (size_t)it;
        const size_t rowb = row & ~(size_t)(T - 1);
        { const u32x2 sv = *(const GAS u32x2*)(SEL + row * 256 + 4 * l); const unsigned bv = *(const GAS unsigned*)(BKT + row * 256 + 4 * l);
          *(LAS u32x2*)(selw + 4 * l) = sv; *(LAS unsigned*)(bktw + 4 * l) = bv; }
        bf16x8 bq[4];
#pragma unroll
        for (int ks = 0; ks < 4; ++ks) bq[ks] = *(const GAS bf16x8*)(QLAT + row * 2048 + l15 * 128 + ks * 32 + g * 8);
        float m_run = -INFINITY, l_run = 0.f; f32x4 o[8];
#pragma unroll
        for (int mt = 0; mt < 8; ++mt) o[mt] = (f32x4){0.f, 0.f, 0.f, 0.f};
        LDS_WAIT();
        for (int c = 0; c < 4; ++c) {
#pragma unroll
            for (int q = 0; q < 16; ++q) { const int rin = 4 * q + g; unsigned idx = selw[c * 64 + rin]; idx = (idx == 0xFFFFu) ? 0u : idx;
                const bf16* src = CKV + (rowb + idx) * 128 + ((l15 ^ (rin & 15)) * 8);
                __builtin_amdgcn_global_load_lds((const GAS unsigned*)src, (LAS unsigned*)(cb + q * 1024), 16, 0, 0); }
            asm volatile("s_waitcnt vmcnt(0)" ::: "memory");
            f32x4 s[4]; float mx = -INFINITY;
#pragma unroll
            for (int tt = 0; tt < 4; ++tt) { f32x4 acc = (f32x4){0.f, 0.f, 0.f, 0.f};
#pragma unroll
                for (int ks = 0; ks < 4; ++ks) { const bf16x8 a = *(const LAS bf16x8*)(cb + (16 * tt + l15) * 256 + (((4 * ks + g) ^ l15) * 16));
                    acc = __builtin_amdgcn_mfma_f32_16x16x32_bf16(a, bq[ks], acc, 0, 0, 0); }
                const unsigned bk4 = *(const LAS unsigned*)(bktw + c * 64 + 16 * tt + 4 * g);
#pragma unroll
                for (int r = 0; r < 4; ++r) { acc[r] += relt[((bk4 >> (8 * r)) & 0xffu) * 16 + l15]; mx = fmaxf(mx, acc[r]); }
                s[tt] = acc; }
            mx = fmaxf(mx, __shfl_xor(mx, 16)); mx = fmaxf(mx, __shfl_xor(mx, 32));
            const float m_new = fmaxf(m_run, mx); const float alpha = __builtin_amdgcn_exp2f(m_run - m_new); m_run = m_new;
            float ls = 0.f;
#pragma unroll
            for (int tt = 0; tt < 4; ++tt)
#pragma unroll
                for (int r = 0; r < 4; ++r) { const float p = __builtin_amdgcn_exp2f(s[tt][r] - m_new); s[tt][r] = p; ls += p; }
            l_run = l_run * alpha + ls;
#pragma unroll
            for (int mt = 0; mt < 8; ++mt) o[mt] *= alpha;
#pragma unroll
            for (int s2 = 0; s2 < 2; ++s2) {
                u32x4 pw; pw.x = cvtpk(s[2 * s2][0], s[2 * s2][1]); pw.y = cvtpk(s[2 * s2][2], s[2 * s2][3]); pw.z = cvtpk(s[2 * s2 + 1][0], s[2 * s2 + 1][1]); pw.w = cvtpk(s[2 * s2 + 1][2], s[2 * s2 + 1][3]);
                const bf16x8 pb = __builtin_bit_cast(bf16x8, pw);
                const int q4 = l15 >> 2, p4 = l15 & 3; const int rloc = 4 * g + q4;
#pragma unroll
                for (int mt = 0; mt < 8; ++mt) {
                    const int choff = (((2 * mt + (p4 >> 1)) ^ rloc) * 16) + (p4 & 1) * 8;
                    const v4i16_t lo = __builtin_amdgcn_ds_read_tr16_b64_v4i16((LAS v4i16_t*)(cb + (32 * s2 + rloc) * 256 + choff));
                    const v4i16_t hi4 = __builtin_amdgcn_ds_read_tr16_b64_v4i16((LAS v4i16_t*)(cb + (32 * s2 + 16 + rloc) * 256 + choff));
                    const bf16x8 a = (bf16x8){lo[0], lo[1], lo[2], lo[3], hi4[0], hi4[1], hi4[2], hi4[3]};
                    o[mt] = __builtin_amdgcn_mfma_f32_16x16x32_bf16(a, pb, o[mt], 0, 0, 0); }
            }
            LDS_WAIT();
        }
        l_run += __shfl_xor(l_run, 16); l_run += __shfl_xor(l_run, 32);
        const float inv = 1.0f / l_run;
#pragma unroll
        for (int mt = 0; mt < 8; ++mt) { u32x2 w; w.x = cvtpk(o[mt][0] * inv, o[mt][1] * inv); w.y = cvtpk(o[mt][2] * inv, o[mt][3] * inv);
            *(GAS u32x2*)(OLAT + row * 2048 + l15 * 128 + 16 * mt + 4 * g) = w; }
    }
    LDS_WAIT(); __syncthreads();
}

typedef float f32x4v __attribute__((ext_vector_type(4)));
__device__ __forceinline__ void p_ln_router(Frame& F, const float* lg, const float* lb, const float* w_router, const float* b_router, int layer) {
    PHASE_IDS();
    const float* Y = (const float*)(F.ws + WS_Y); float* XF = (float*)(F.ws + WS_XF); bf16* XB = (bf16*)(F.ws + WS_XB);
    int* TOPE = (int*)(F.ws + WS_TOPE); float* TOPG = (float*)(F.ws + WS_TOPG); int* POS = (int*)(F.ws + WS_POS);
    gu32* gcnt = F.ctl + CW_CNT + 64 * layer;
    LAS float* lgt = (LAS float*)F.lds;
    LAS int* hist = (LAS int*)(F.lds + 128 * 33 * 4);
    LAS int* base = hist + 32;
    const int l = lane, l15 = l & 15, g = l >> 4;
    f32x4 gv[4], bv[4];
#pragma unroll
    for (int j = 0; j < 4; ++j) { gv[j] = *(const f32x4*)(lg + 4 * l + 256 * j); bv[j] = *(const f32x4*)(lb + 4 * l + 256 * j); }
    for (int unit = F.vcu; unit < M / 128; unit += F.G) {
        const int r0 = unit * 128 + wave * 16;
        if (tid < 32) hist[tid] = 0;
        for (int i = 0; i < 16; ++i) { const size_t row = (size_t)(r0 + i);
            const GAS f32x4* yp = (const GAS f32x4*)(Y + row * D) + l; f32x4 v[4]; float s = 0.f;
#pragma unroll
            for (int j = 0; j < 4; ++j) { v[j] = yp[64 * j]; s += (v[j].x + v[j].y) + (v[j].z + v[j].w); }
            const float mean = wave_sum(s) * (1.f / D); float s2 = 0.f;
#pragma unroll
            for (int j = 0; j < 4; ++j) { v[j] = v[j] - mean; s2 += (v[j].x * v[j].x + v[j].y * v[j].y) + (v[j].z * v[j].z + v[j].w * v[j].w); }
            const float rstd = 1.f / sqrtf(wave_sum(s2) * (1.f / D) + LN_EPS);
            GAS f32x4* xo = (GAS f32x4*)(XF + row * D) + l; GAS u32x2* bo = (GAS u32x2*)(XB + row * D) + l;
#pragma unroll
            for (int j = 0; j < 4; ++j) { const f32x4 o = v[j] * rstd * gv[j] + bv[j]; xo[64 * j] = o; u32x2 w; w.x = cvtpk(o.x, o.y); w.y = cvtpk(o.z, o.w); bo[64 * j] = w; } }
        asm volatile("s_waitcnt vmcnt(0)" ::: "memory");
        f32x4 acc0 = (f32x4){0.f, 0.f, 0.f, 0.f}, acc1 = acc0;
        { const float* xr = XF + (size_t)(r0 + l15) * D + 4 * g;
          for (int k0 = 0; k0 < D; k0 += 16) { const f32x4 a = __builtin_nontemporal_load((const f32x4*)(xr + k0));
              const float* wp = w_router + (size_t)(k0 + 4 * g) * NEXP + l15;
#pragma unroll
              for (int j = 0; j < 4; ++j) { acc0 = __builtin_amdgcn_mfma_f32_16x16x4f32(a[j], wp[j * NEXP], acc0, 0, 0, 0); acc1 = __builtin_amdgcn_mfma_f32_16x16x4f32(a[j], wp[j * NEXP + 16], acc1, 0, 0, 0); } } }
        { const float b0 = b_router[l15], b1 = b_router[l15 + 16];
#pragma unroll
          for (int r = 0; r < 4; ++r) { lgt[(wave * 16 + 4 * g + r) * 33 + l15] = acc0[r] + b0; lgt[(wave * 16 + 4 * g + r) * 33 + l15 + 16] = acc1[r] + b1; } }
        LDS_WAIT(); __syncthreads();
        int te[4] = {0, 0, 0, 0}, lp[4] = {0, 0, 0, 0}; float tg[4] = {0.f, 0.f, 0.f, 0.f};
        if (l < 16) { const LAS float* rp = lgt + (wave * 16 + l) * 33; float tv[4] = {-INFINITY, -INFINITY, -INFINITY, -INFINITY};
            for (int e = 0; e < NEXP; ++e) { const float v = rp[e];
                if (v > tv[3]) { if (v > tv[0]) { tv[3] = tv[2]; te[3] = te[2]; tv[2] = tv[1]; te[2] = te[1]; tv[1] = tv[0]; te[1] = te[0]; tv[0] = v; te[0] = e; }
                    else if (v > tv[1]) { tv[3] = tv[2]; te[3] = te[2]; tv[2] = tv[1]; te[2] = te[1]; tv[1] = v; te[1] = e; }
                    else if (v > tv[2]) { tv[3] = tv[2]; te[3] = te[2]; tv[2] = v; te[2] = e; }
                    else { tv[3] = v; te[3] = e; } } }
            const float e1 = __expf(tv[1] - tv[0]), e2 = __expf(tv[2] - tv[0]), e3 = __expf(tv[3] - tv[0]); const float inv = 1.0f / (1.0f + e1 + e2 + e3);
            tg[0] = inv; tg[1] = e1 * inv; tg[2] = e2 * inv; tg[3] = e3 * inv;
#pragma unroll
            for (int k = 0; k < 4; ++k) lp[k] = atomicAdd((int*)(hist + te[k]), 1); }
        LDS_WAIT(); __syncthreads();
        if (tid < 32) base[tid] = (int)__hip_atomic_fetch_add(gcnt + tid, (unsigned)hist[tid], __ATOMIC_RELAXED, __HIP_MEMORY_SCOPE_AGENT);
        LDS_WAIT(); __syncthreads();
        if (l < 16) { const size_t row = (size_t)(r0 + l);
            typedef int i32x4 __attribute__((ext_vector_type(4)));
            *(GAS i32x4*)(TOPE + row * 4) = (i32x4){te[0], te[1], te[2], te[3]};
            *(GAS f32x4*)(TOPG + row * 4) = (f32x4){tg[0], tg[1], tg[2], tg[3]};
            *(GAS i32x4*)(POS + row * 4) = (i32x4){base[te[0]] + lp[0], base[te[1]] + lp[1], base[te[2]] + lp[2], base[te[3]] + lp[3]}; }
        LDS_WAIT(); __syncthreads();
    }
}

__device__ __forceinline__ void p_moe_gather(Frame& F, int layer) {
    PHASE_IDS();
    const int* TOPE = (const int*)(F.ws + WS_TOPE); const int* POS = (const int*)(F.ws + WS_POS); int* SLOT = (int*)(F.ws + WS_SLOT);
    const bf16* XB = (const bf16*)(F.ws + WS_XB); bf16* XG = (bf16*)(F.ws + WS_XG);
    int* SMALL = (int*)(F.ws + WS_SMALL) + 1024 * layer; gu32* gcnt = F.ctl + CW_CNT + 64 * layer;
    LAS int* start = (LAS int*)F.lds;
    if (tid == 0) { int acc = 0; for (int e = 0; e < NEXP; ++e) { start[e] = acc; const int c = (int)__hip_atomic_load(gcnt + e, __ATOMIC_RELAXED, __HIP_MEMORY_SCOPE_AGENT); acc += (c + 255) & ~255; } start[NEXP] = acc; }
    LDS_WAIT(); __syncthreads();
    if (blockIdx.x == 0) { const int nT = start[NEXP] >> 8; if (tid == 0) SMALL[SM_NT] = nT;
        for (int pm = tid; pm < nT; pm += NWAVES * 64) { int e = 0; for (int k = 1; k < NEXP; ++k) e += (start[k] <= pm * 256) ? 1 : 0;
            SMALL[SM_TILE_E + pm] = e; } }
    const int gw = F.vcu * NWAVES + wave, NGW = F.G * NWAVES;
    for (int p = gw; p < NPAIR; p += NGW) { const int e = TOPE[p], slot = start[e] + POS[p]; const int tok = p >> 2;
        const GAS v4u* src = (const GAS v4u*)(XB + (size_t)tok * D) + lane; GAS v4u* dst = (GAS v4u*)(XG + (size_t)slot * D) + lane;
        const v4u a = src[0], b = src[64]; dst[0] = a; dst[64] = b; if (lane == 0) SLOT[p] = slot; }
    LDS_WAIT(); __syncthreads();
}

__device__ __forceinline__ void p_moe_combine_ln(Frame& F, const float* lg, const float* lb, float* out_final) {
    PHASE_IDS();
    float* XF = (float*)(F.ws + WS_XF); bf16* XB = (bf16*)(F.ws + WS_XB); const bf16* Y2 = (const bf16*)(F.ws + WS_XG);
    const int* SLOT = (const int*)(F.ws + WS_SLOT); const float* TOPG = (const float*)(F.ws + WS_TOPG);
    const int l = lane; const int gw = F.vcu * NWAVES + wave, NGW = F.G * NWAVES;
    f32x4 gv[4], bv[4];
#pragma unroll
    for (int j = 0; j < 4; ++j) { gv[j] = *(const f32x4*)(lg + 4 * l + 256 * j); bv[j] = *(const f32x4*)(lb + 4 * l + 256 * j); }
    for (int row = gw; row < M; row += NGW) {
        typedef int i32x4 __attribute__((ext_vector_type(4)));
        const i32x4 sl = *(const GAS i32x4*)(SLOT + (size_t)row * 4); const f32x4 gt = *(const GAS f32x4*)(TOPG + (size_t)row * 4);
        GAS f32x4* xp = (GAS f32x4*)(XF + (size_t)row * D) + l; f32x4 v[4];
#pragma unroll
        for (int j = 0; j < 4; ++j) v[j] = xp[64 * j] * DN_ALPHA;
#pragma unroll
        for (int k = 0; k < 4; ++k) { const GAS u32x2* yp = (const GAS u32x2*)(Y2 + (size_t)sl[k] * D) + l; const float gk = gt[k];
#pragma unroll
            for (int j = 0; j < 4; ++j) { const u32x2 w = yp[64 * j];
                v[j].x += gk * __uint_as_float(w.x << 16); v[j].y += gk * __uint_as_float(w.x & 0xffff0000u); v[j].z += gk * __uint_as_float(w.y << 16); v[j].w += gk * __uint_as_float(w.y & 0xffff0000u); } }
        float s = 0.f;
#pragma unroll
        for (int j = 0; j < 4; ++j) s += (v[j].x + v[j].y) + (v[j].z + v[j].w);
        const float mean = wave_sum(s) * (1.f / D); float s2 = 0.f;
#pragma unroll
        for (int j = 0; j < 4; ++j) { v[j] = v[j] - mean; s2 += (v[j].x * v[j].x + v[j].y * v[j].y) + (v[j].z * v[j].z + v[j].w * v[j].w); }
        const float rstd = 1.f / sqrtf(wave_sum(s2) * (1.f / D) + LN_EPS);
        if (out_final) { GAS f32x4* op = (GAS f32x4*)(out_final + (size_t)row * D) + l;
#pragma unroll
            for (int j = 0; j < 4; ++j) op[64 * j] = v[j] * rstd * gv[j] + bv[j]; }
        else { GAS u32x2* bo = (GAS u32x2*)(XB + (size_t)row * D) + l;
#pragma unroll
            for (int j = 0; j < 4; ++j) { const f32x4 o = v[j] * rstd * gv[j] + bv[j]; xp[64 * j] = o; u32x2 w; w.x = cvtpk(o.x, o.y); w.y = cvtpk(o.z, o.w); bo[64 * j] = w; } }
    }
}

__device__ __forceinline__ void p_fox_gate(Frame& F, const float* w_f, const float* b_f) {
    PHASE_IDS();
    const float* XF = (const float*)(F.ws + WS_XF); float* LOGF = (float*)(F.ws + WS_LOGF);
    const int l = lane, l15 = l & 15, g = l >> 4; const int gw = F.vcu * NWAVES + wave, NGW = F.G * NWAVES;
    const float bf = b_f[l15];
    for (int tile = gw; tile < M / 16; tile += NGW) {
        f32x4 acc = (f32x4){0.f, 0.f, 0.f, 0.f}; const float* xr = XF + (size_t)(tile * 16 + l15) * D + 4 * g;
        for (int k0 = 0; k0 < D; k0 += 16) { const f32x4 a = *(const GAS f32x4*)(xr + k0); const float* wp = w_f + (size_t)(k0 + 4 * g) * 16 + l15;
#pragma unroll
            for (int j = 0; j < 4; ++j) acc = __builtin_amdgcn_mfma_f32_16x16x4f32(a[j], wp[j * 16], acc, 0, 0, 0); }
#pragma unroll
        for (int r = 0; r < 4; ++r) { const float z = acc[r] + bf; const float ls = fminf(z, 0.f) - log1pf(__expf(-fabsf(z)));
            LOGF[(size_t)(tile * 16 + 4 * g + r) * 16 + l15] = ls; }
    }
}
__device__ __forceinline__ void split3(float f, unsigned short& h, unsigned short& m, unsigned short& lo) {
    const unsigned p1 = f2bf(f); const float f1 = __uint_as_float(p1 << 16); const float r1 = f - f1;
    const unsigned p2 = f2bf(r1); const float f2 = __uint_as_float(p2 << 16); const float r2 = r1 - f2;
    h = (unsigned short)p1; m = (unsigned short)p2; lo = (unsigned short)f2bf(r2);
}
__device__ __forceinline__ void p_fox_cum(Frame& F) {
    PHASE_IDS();
    const float* LOGF = (const float*)(F.ws + WS_LOGF); bf16* QX = (bf16*)(F.ws + WS_QX); bf16* KX = (bf16*)(F.ws + WS_KX);
    LAS double* red = (LAS double*)F.lds;
    LAS double* pre = red + 512;
    LAS double* tot = pre + 16;
    const int h = tid & 15, sub = tid >> 4;
    for (int unit = F.vcu; unit < BATCH * 32; unit += F.G) {
        const int b = unit >> 5, seg = unit & 31; const size_t rowb = (size_t)b * T;
        double s = 0.0; for (int t = sub; t < seg * 128; t += 32) s += (double)LOGF[(rowb + t) * 16 + h];
        red[sub * 16 + h] = s;
        const int t0 = seg * 128 + sub * 4; float lf[4];
#pragma unroll
        for (int i = 0; i < 4; ++i) lf[i] = LOGF[(rowb + t0 + i) * 16 + h];
        tot[sub * 16 + h] = (double)lf[0] + (double)lf[1] + (double)lf[2] + (double)lf[3];
        LDS_WAIT(); __syncthreads();
        if (tid < 16) { double a = 0.0; for (int j = 0; j < 32; ++j) a += red[j * 16 + tid]; pre[tid] = a; }
        LDS_WAIT(); __syncthreads();
        double c = pre[h]; for (int j = 0; j < sub; ++j) c += tot[j * 16 + h];
#pragma unroll
        for (int i = 0; i < 4; ++i) { c += (double)lf[i]; const float cf = (float)(c * 1.4426950408889634);
            unsigned short ch, cm, cl; split3(cf, ch, cm, cl); unsigned short nh, nm, nl; split3(-cf, nh, nm, nl);
            const size_t o = ((rowb + t0 + i) * 16 + h) * 16;
            const unsigned one2 = 0x3F803F80u;
            v4u q0; q0.x = one2; q0.y = 0x3F80u | ((unsigned)ch << 16); q0.z = (unsigned)cm | ((unsigned)cl << 16); q0.w = 0u;
            v4u q1; q1.x = 0u; q1.y = 0u; q1.z = 0u; q1.w = 0u;
            v4u k0; k0.x = (unsigned)nh | ((unsigned)nm << 16); k0.y = (unsigned)nl | (0x3F80u << 16); k0.z = one2; k0.w = one2;
            v4u k1; k1.x = 0x3F80u; k1.y = 0u; k1.z = 0u; k1.w = 0u;
            *(GAS v4u*)(QX + o) = q0; *(GAS v4u*)(QX + o + 8) = q1; *(GAS v4u*)(KX + o) = k0; *(GAS v4u*)(KX + o + 8) = k1; }
        LDS_WAIT(); __syncthreads();
    }
}

struct Args { const float* in[25]; float* out; unsigned char* ws; int ph_lo, ph_hi, li, pad; };

#define IN(k) (lo <= (k) && (k) < hi)
#define BOTH(k) (IN(k) && IN((k) + 1))
#define GRID_BAR(k) do { if (BOTH(k)) xcd_barrier(bar); } while (0)

__device__ __forceinline__ int moe_tile_table(Frame& F, const int* SMALL) {
    const int nT = SMALL[SM_NT]; LAS int* te = (LAS int*)(F.lds + RING_BYTES);
    for (int i = threadIdx.x; i < nT; i += NWAVES * 64) te[i] = SMALL[SM_TILE_E + i];
    LDS_WAIT(); __syncthreads();
    return nT;
}
__device__ __forceinline__ void moe_phases(Frame& F, const XcdBarrier& bar, int lo, int hi, const int layer, const int pb, float* out_final) {
    const float* PAR = (const float*)(F.ws + WS_PAR);
    const float* lnm_g = PAR + PAR_LN + layer * D; const float* lnm_b = PAR + PAR_LN + 2048 + layer * D; const float* lnf_g = PAR + PAR_LN + 4096 + layer * D; const float* lnf_b = PAR + PAR_LN + 6144 + layer * D;
    const int* SMALL = (const int*)(F.ws + WS_SMALL) + 1024 * layer;
    if (IN(pb)) { p_ln_router(F, lnm_g, lnm_b, PAR + PAR_WROUT + (size_t)layer * D * NEXP, PAR + PAR_BROUT + layer * NEXP, layer); GRID_BAR(pb); }
    if (IN(pb + 1)) { p_moe_gather(F, layer); GRID_BAR(pb + 1); }
    if (IN(pb + 2)) {
        const int nT = moe_tile_table(F, SMALL);
        pg8::Gemm g{(const pg8::bf16_t*)(F.ws + WS_XG), (const pg8::bf16_t*)(F.ws + WS_WGU) + (size_t)layer * NEXP * 2048 * 1024, nT * 256, NEXP * 2048, 1024};
        pg8::MoeOrder S{nT, 8, F.G, (int)blockIdx.x, (const LAS int*)(F.lds + RING_BYTES)};
        pg8::EpiSwiglu E{(pg8::bf16_t*)(F.ws + WS_H), PAR + PAR_BGU + (size_t)layer * NEXP * 2048};
        pg8::gemm_phase<pg8::EpiSwiglu, pg8::MoeOrder, PG8_ALIGN, PG8_SP2>(F.lds + RING_OFF, g, S, E);
        GRID_BAR(pb + 2);
    }
    if (IN(pb + 3)) {
        const int nT = moe_tile_table(F, SMALL);
        pg8::Gemm g{(const pg8::bf16_t*)(F.ws + WS_H), (const pg8::bf16_t*)(F.ws + WS_WD) + (size_t)layer * NEXP * 1024 * 1024, nT * 256, NEXP * 1024, 1024};
        pg8::MoeOrder S{nT, 4, F.G, (int)blockIdx.x, (const LAS int*)(F.lds + RING_BYTES)};
        pg8::EpiBf16<0> E{(pg8::bf16_t*)(F.ws + WS_XG), 1024, PAR + PAR_BDOWN + (size_t)layer * NEXP * 1024, 1024, 0, 1.f};
        pg8::gemm_phase<pg8::EpiBf16<0>, pg8::MoeOrder, PG8_ALIGN, PG8_SP2>(F.lds + RING_OFF, g, S, E);
        GRID_BAR(pb + 3);
    }
    if (IN(pb + 4)) { p_moe_combine_ln(F, lnf_g, lnf_b, out_final); if (!out_final) GRID_BAR(pb + 4); }
}

__global__ void __launch_bounds__(NWAVES * 64, 2) mk_fwd(Args args) {
    extern __shared__ __attribute__((aligned(16))) unsigned char lds[];
    Frame F;
    F.lds = (LAS unsigned char*)lds;
    F.MISC = (volatile LAS unsigned*)(F.lds + MISC_OFF);
    F.G = gridDim.x; { const int bx = blockIdx.x; F.vcu = (F.G % 8 == 0) ? (bx % 8) * (F.G / 8) + bx / 8 : bx; }
    F.ws = args.ws; F.ctl = (gu32*)(args.ws + WS_CTL);
    if (threadIdx.x < 64) ((LAS unsigned*)(F.lds + MISC_OFF))[threadIdx.x] = 0u;
    __syncthreads();
    XcdBarrier bar; bar.bar = (unsigned*)(F.ctl + CW_BAR); bar.x = 0; bar.st = nullptr;
    if (MK_N_LAUNCHES == 1) bar = xcd_barrier_post((unsigned*)(F.ctl + CW_BAR), F.MISC + 8);
    const int lo = args.ph_lo, hi = args.ph_hi;

    if (IN(0)) {
        P0In I{args.in[0], args.in[2], args.in[7], args.in[8], args.in[9], args.in[10], args.in[11], args.in[12], args.in[14], args.in[21], args.in[23],
               args.in[1], args.in[3], args.in[4], args.in[5], args.in[6], args.in[13], args.in[15], args.in[16], args.in[17], args.in[18], args.in[19], args.in[20], args.in[22], args.in[24]};
        p0_prologue(F, I); GRID_BAR(0);
    }
    if (IN(1)) {
        pg8::Gemm g{(const pg8::bf16_t*)(F.ws + WS_XB), (const pg8::bf16_t*)(F.ws + WS_WAIN), M, 512, 1024}; pg8::StaticOrder S; S.init(M, 512, F.G, (int)blockIdx.x);
        pg8::EpiF32 E{(float*)(F.ws + WS_PROJ), 512};
        pg8::gemm_phase<pg8::EpiF32, pg8::StaticOrder, PG8_ALIGN, PG8_SP2>(F.lds + RING_OFF, g, S, E);
        GRID_BAR(1);
    }
    if (IN(2)) { const float* PAR = (const float*)(F.ws + WS_PAR); p_dsa_norms(F, PAR + PAR_AGQ, PAR + PAR_AGKV, PAR + PAR_AGKI, PAR + PAR_ABKI); GRID_BAR(2); }
    if (IN(3)) {
        pg8::Gemm g{(const pg8::bf16_t*)(F.ws + WS_CQN), (const pg8::bf16_t*)(F.ws + WS_WACQ), M, 2560, 256}; pg8::StaticOrder S; S.init(M, 2560, F.G, (int)blockIdx.x);
        pg8::EpiCq E{(pg8::bf16_t*)(F.ws + WS_QLAT), (pg8::bf16_t*)(F.ws + WS_QIDX)};
        pg8::gemm_phase<pg8::EpiCq, pg8::StaticOrder, PG8_ALIGN, PG8_SP2>(F.lds + RING_OFF, g, S, E);
        GRID_BAR(3);
    }
    if (IN(4)) { p_indexer(F); GRID_BAR(4); }
    if (IN(5)) { p_sparse_attn(F, (const float*)(F.ws + WS_PAR) + PAR_REL); GRID_BAR(5); }
    if (IN(6)) {
        pg8::Gemm g{(const pg8::bf16_t*)(F.ws + WS_OLAT), (const pg8::bf16_t*)(F.ws + WS_WAO), M, 1024, 2048}; pg8::StaticOrder S; S.init(M, 1024, F.G, (int)blockIdx.x);
        pg8::EpiResF32 E{args.in[0], (float*)(F.ws + WS_Y), D, DN_ALPHA};
        pg8::gemm_phase<pg8::EpiResF32, pg8::StaticOrder, PG8_ALIGN, PG8_SP2>(F.lds + RING_OFF, g, S, E);
        GRID_BAR(6);
    }
    moe_phases(F, bar, lo, hi, 0, 7, nullptr);
    if (IN(12)) {
        p_fox_gate(F, (const float*)(F.ws + WS_PAR) + PAR_WF, (const float*)(F.ws + WS_PAR) + PAR_BF);
        pg8::Gemm g{(const pg8::bf16_t*)(F.ws + WS_XB), (const pg8::bf16_t*)(F.ws + WS_WBIN), M, 3072, 1024}; pg8::StaticOrder S; S.init(M, 3072, F.G, (int)blockIdx.x);
        pg8::EpiBf16<0> E{(pg8::bf16_t*)(F.ws + WS_Q), D, nullptr, D, (size_t)(WS_K - WS_Q) / 2, attn_body::C2};
        pg8::gemm_phase<pg8::EpiBf16<0>, pg8::StaticOrder, PG8_ALIGN, PG8_SP2>(F.lds + RING_OFF, g, S, E);
        GRID_BAR(12);
    }
    if (IN(13)) { p_fox_cum(F); GRID_BAR(13); }
    if (IN(14)) {
        const attn_body::AttnTensors AT{(const attn_body::bf16*)(F.ws + WS_Q), (const attn_body::bf16*)(F.ws + WS_K), (const attn_body::bf16*)(F.ws + WS_V), (attn_body::bf16*)(F.ws + WS_Q),
                                        (const attn_body::bf16*)(F.ws + WS_QX), (const attn_body::bf16*)(F.ws + WS_KX)};
        const attn_body::StaticOrder S((int)F.G, (int)blockIdx.x);
        attn_body::attn_phase<attn_body::StaticOrder>((char*)lds + RING_OFF, AT, S);
        GRID_BAR(14);
    }
    if (IN(15)) {
        pg8::Gemm g{(const pg8::bf16_t*)(F.ws + WS_Q), (const pg8::bf16_t*)(F.ws + WS_WBO), M, 1024, 1024}; pg8::StaticOrder S; S.init(M, 1024, F.G, (int)blockIdx.x);
        pg8::EpiResF32 E{(const float*)(F.ws + WS_XF), (float*)(F.ws + WS_Y), D, DN_ALPHA};
        pg8::gemm_phase<pg8::EpiResF32, pg8::StaticOrder, PG8_ALIGN, PG8_SP2>(F.lds + RING_OFF, g, S, E);
        GRID_BAR(15);
    }
    moe_phases(F, bar, lo, hi, 1, 16, args.out);
}
#undef IN
#undef BOTH
#undef GRID_BAR

extern "C" void kernel_launch(void* const* d_in, const int* in_sizes, int n_in, void* d_out, int out_size, void* d_ws, size_t ws_size, hipStream_t stream) {
    static int grid = 0;
    if (grid == 0) {
        if (n_in != 25 || in_sizes[0] != M * D || out_size != M * D || ws_size < WS_END) { fprintf(stderr, "kernel_launch: unexpected shapes (n_in %d, in0 %d, out %d, ws %zu); nothing launched\n", n_in, n_in > 0 ? in_sizes[0] : -1, out_size, ws_size); grid = -1; return; }
        int dev = 0, cus = 0, per_cu = 0;
        if (hipGetDevice(&dev) != hipSuccess || hipDeviceGetAttribute(&cus, hipDeviceAttributeMultiprocessorCount, dev) != hipSuccess) { grid = -1; return; }
        if (hipFuncSetAttribute((const void*)mk_fwd, hipFuncAttributeMaxDynamicSharedMemorySize, LDS_BYTES) != hipSuccess) { fprintf(stderr, "kernel_launch: hipFuncSetAttribute failed\n"); grid = -1; return; }
        if (hipOccupancyMaxActiveBlocksPerMultiprocessor(&per_cu, (const void*)mk_fwd, NWAVES * 64, LDS_BYTES) != hipSuccess || per_cu < 1) fprintf(stderr, "kernel_launch: occupancy query reports %d workgroups per CU\n", per_cu);
        (void)hipGetLastError();
        grid = cus;
    }
    if (grid < 0) return;
    if (hipMemsetAsync((char*)d_ws + WS_CTL, 0, CTL_ZERO_BYTES, stream) != hipSuccess) return;
    Args a{};
    for (int i = 0; i < 25; ++i) a.in[i] = (const float*)d_in[i];
    a.out = (float*)d_out; a.ws = (unsigned char*)d_ws;
    constexpr int NPH = 21;
    for (int li = 0; li < MK_N_LAUNCHES; ++li) {
        if (MK_N_LAUNCHES == 1) { a.ph_lo = 0; a.ph_hi = NPH; } else { a.ph_lo = li; a.ph_hi = li + 1; }
        a.li = li;
        hipLaunchKernelGGL(mk_fwd, dim3(grid), dim3(NWAVES * 64), LDS_BYTES, stream, a);
        if (MK_N_LAUNCHES != 1 && li + 1 == NPH) break;
    }
}
```

```cpp
#define MK_N_LAUNCHES 1
#define MK_REP_MASK 0u
#define MK_P0_REP 0
#define MK_CHECK_SEL 0
#define MK_IDX_REP 0
#define MK_EPI_REP 0
#define MK_XBAR 0
#define MK_SA_EXP 0
#include <hip/hip_runtime.h>
#include <cstdio>
#include <cstdint>
namespace pg8 {
#define PG8_LAS __attribute__((address_space(3)))
typedef unsigned short bf16_t;
typedef short bf16x8 __attribute__((ext_vector_type(8)));
typedef float f32x4 __attribute__((ext_vector_type(4)));
typedef unsigned u32x4 __attribute__((ext_vector_type(4)));
typedef short bf16x16 __attribute__((ext_vector_type(16)));
typedef int i32x8 __attribute__((ext_vector_type(8)));
constexpr int BM = 256, BK = 64, HALF = 128, HTB = HALF * BK * 2  , STAGE_BYTES = 8 * HTB, NXCD = 8, WGM = 8;

__host__ __device__ __forceinline__ int lds_byte(int r, int c) { const int st = (r >> 4) * 2 + (c >> 5), rr = r & 15, cc = c & 31, ob = rr * 64 + cc * 2; return st * 1024 + (ob ^ (((ob >> 9) & 1) << 5)); }
__host__ __device__ __forceinline__ void stage_rc(int b, int& R, int& C) { const int st = b / 1024, sb = b % 1024, swz = sb ^ (((sb >> 9) & 1) << 5); R = (st >> 1) * 16 + swz / 64; C = (st & 1) * 32 + (swz % 64) / 2; }
__host__ __device__ __forceinline__ int perm32(int rho) { const int n = rho >> 4, i = rho & 15; return 8 * (i >> 2) + 4 * n + (i & 3); }

struct Unit { int pm, pn; };
struct Gemm { const bf16_t* A; const bf16_t* Bt; int M, N, K; };

struct StaticOrder {
    int nM, nN, nwg, G, c;
    __host__ __device__ void init(int M, int N, int G_, int c_) { nM = M / BM; nN = N / BM; nwg = nM * nN; G = G_; c = c_; }
    __host__ __device__ bool next(int i, Unit& u) const {
        const long L = (long)i * G + c; if (L >= nwg) return false;
        int wgid = (int)L; { const int q = nwg / NXCD, r = nwg % NXCD, xcd = wgid % NXCD, off = wgid / NXCD; wgid = (xcd < r ? xcd * (q + 1) : r * (q + 1) + (xcd - r) * q) + off; }
        const int nig = WGM * nN, gid = wgid / nig, fm = gid * WGM, gsz = (nM - fm) < WGM ? (nM - fm) : WGM;
        u.pm = fm + ((wgid % nig) % gsz); u.pn = (wgid % nig) / gsz; return true;
    }
    __device__ __forceinline__ void a_ready(const Unit&) const {}
    __device__ __forceinline__ void done(const Unit&) const {}
};

__device__ __forceinline__ unsigned cvt_pk_bf16(float lo, float hi) { unsigned r; asm volatile("v_cvt_pk_bf16_f32 %0, %1, %2" : "=v"(r) : "v"(lo), "v"(hi)); return r; }
typedef float f32x2 __attribute__((ext_vector_type(2)));
__device__ __forceinline__ f32x2 gelu_pk(f32x2 v) {
    const f32x2 av = __builtin_elementwise_abs(v), d = av * 0.2316418882f + 1.0f;
    f32x2 t; t.x = __builtin_amdgcn_rcpf(d.x); t.y = __builtin_amdgcn_rcpf(d.y);
    f32x2 q = t * 0.5307027145f + (-0.7265760135f); q = q * t + 0.7107068705f; q = q * t + (-0.142248368f); q = q * t + 0.127414796f; q = q * t;
    const f32x2 s = (v * v) * (-0.72134752044f);
    f32x2 e; e.x = __builtin_amdgcn_exp2f(s.x); e.y = __builtin_amdgcn_exp2f(s.y);
    const f32x2 m = v * (q * e), r = v - m;
    f32x2 o; o.x = v.x < 0.f ? m.x : r.x; o.y = v.y < 0.f ? m.y : r.y; return o;
}

template <int ACT  > struct EpiBf16 {
    static constexpr bool PERM = true, AFTER_DRAIN = false; static_assert(ACT == 0 || ACT == 1, "EpiBf16: ACT is 0 (none) or 1 (gelu_pk)");
    bf16_t* O; int ldc; const float* bias; int split_cols; size_t split_stride; float scale0;
    __device__ __forceinline__ void operator()(const f32x4 (&acc)[2][2][4][2], const Unit& u, int wr, int wc, int fr, int fq) const {
        const int row0 = u.pm * BM + wr * 64 + fr; int colt = u.pn * BM; bf16_t* base = O;
        float sc = 1.f; if (split_cols) { const int t = colt / split_cols; base += (size_t)t * split_stride; colt -= t * split_cols; if (t == 0) sc = scale0; }
        const int col0 = colt + wc * 32 + 8 * fq, bcol0 = u.pn * BM + wc * 32 + 8 * fq;
        f32x4 bv[2][2];
#pragma unroll
        for (int bj = 0; bj < 2; ++bj)
#pragma unroll
            for (int n = 0; n < 2; ++n) bv[bj][n] = bias ? *(const f32x4*)(bias + bcol0 + bj * HALF + 4 * n) : (f32x4){0.f, 0.f, 0.f, 0.f};
#pragma unroll
        for (int ai = 0; ai < 2; ++ai)
#pragma unroll
            for (int m = 0; m < 4; ++m) { bf16_t* rowp = base + (size_t)(row0 + ai * HALF + m * 16) * ldc + col0;
#pragma unroll
                for (int bj = 0; bj < 2; ++bj) { f32x4 v0 = acc[ai][bj][m][0] + bv[bj][0], v1 = acc[ai][bj][m][1] + bv[bj][1];
                    if (ACT == 1) { f32x2 a = gelu_pk((f32x2){v0[0], v0[1]}), b = gelu_pk((f32x2){v0[2], v0[3]}), c = gelu_pk((f32x2){v1[0], v1[1]}), d = gelu_pk((f32x2){v1[2], v1[3]});
                        v0 = (f32x4){a.x, a.y, b.x, b.y}; v1 = (f32x4){c.x, c.y, d.x, d.y}; }
                    v0 = v0 * sc; v1 = v1 * sc; u32x4 w; w.x = cvt_pk_bf16(v0[0], v0[1]); w.y = cvt_pk_bf16(v0[2], v0[3]); w.z = cvt_pk_bf16(v1[0], v1[1]); w.w = cvt_pk_bf16(v1[2], v1[3]);
                    *(u32x4*)(rowp + bj * HALF) = w; } }
    }
};

struct PanelStats {
    unsigned* xbuf;
    unsigned* cnt;
    unsigned* tmo;
    int ntn; float eps;
    unsigned code;
    __device__ __forceinline__ bool run(const f32x4 (&v)[2][2][4][2], const Unit& u, int wr, int wc, int fr, int fq, PG8_LAS unsigned char* lds, int wid, int lane) const {
        typedef float f32x2v __attribute__((ext_vector_type(2)));
        PG8_LAS f32x2v* P = (PG8_LAS f32x2v*)lds;
        PG8_LAS f32x2v* S = (PG8_LAS f32x2v*)(lds + 8192);
        PG8_LAS unsigned* flag = (PG8_LAS unsigned*)(lds + 8192 + 2048);
#pragma unroll
        for (int ai = 0; ai < 2; ++ai)
#pragma unroll
            for (int m = 0; m < 4; ++m) {
                float s = 0.f;
#pragma unroll
                for (int bj = 0; bj < 2; ++bj)
#pragma unroll
                    for (int n = 0; n < 2; ++n) { const f32x4 x = v[ai][bj][m][n]; s += (x[0] + x[1]) + (x[2] + x[3]); }
                s += __shfl_xor(s, 16); s += __shfl_xor(s, 32);
                const float mw = s * (1.0f / 64.0f); float q = 0.f;
#pragma unroll
                for (int bj = 0; bj < 2; ++bj)
#pragma unroll
                    for (int n = 0; n < 2; ++n) { const f32x4 d = v[ai][bj][m][n] - mw; q += (d[0] * d[0] + d[1] * d[1]) + (d[2] * d[2] + d[3] * d[3]); }
                q += __shfl_xor(q, 16); q += __shfl_xor(q, 32);
                if (fq == 0) P[(ai * HALF + wr * 64 + m * 16 + fr) * 4 + wc] = (f32x2v){mw, q};
            }
        asm volatile("s_waitcnt lgkmcnt(0)" ::: "memory"); __builtin_amdgcn_s_barrier(); asm volatile("" ::: "memory");
#if defined(BROKEN_EXCHANGE_NO_WAIT)
#warning BROKEN CONTROL BUILD: the row-statistics exchange does not wait; results are wrong by design
        if (blockIdx.x >= 64) { const long long t0_ = clock64(); while (clock64() - t0_ < 60000) __builtin_amdgcn_s_sleep(8); }
#endif
        const int row = wid * 32 + (lane & 31);
        if (lane < 32) {
            const f32x2v a = P[row * 4 + 0], b = P[row * 4 + 1], c = P[row * 4 + 2], d = P[row * 4 + 3];
            const float mt = (a.x + b.x + c.x + d.x) * 0.25f;
            const float da = a.x - mt, db = b.x - mt, dc = c.x - mt, dd = d.x - mt;
            const float m2 = (a.y + b.y) + (c.y + d.y) + 64.0f * ((da * da + db * db) + (dc * dc + dd * dd));
            unsigned long long* slot = (unsigned long long*)xbuf + ((size_t)(u.pm * BM + row) * 4 + u.pn);
            __hip_atomic_store(slot, ((unsigned long long)__float_as_uint(m2) << 32) | __float_as_uint(mt), __ATOMIC_RELAXED, __HIP_MEMORY_SCOPE_AGENT);
        }
        asm volatile("s_waitcnt vmcnt(0)" ::: "memory");
        if (lane == 0) __hip_atomic_fetch_add(cnt + 64 * u.pm, 1u, __ATOMIC_RELAXED, __HIP_MEMORY_SCOPE_AGENT);
        if (wid == 0) {
            bool dead = false; const unsigned long long t0 = __builtin_amdgcn_s_memrealtime(); const unsigned want = 8u * (unsigned)ntn;
            for (;;) {
#if defined(BROKEN_EXCHANGE_NO_WAIT)
                break;
#endif
                if ((unsigned)__builtin_amdgcn_readfirstlane(__hip_atomic_load(cnt + 64 * u.pm, __ATOMIC_RELAXED, __HIP_MEMORY_SCOPE_AGENT)) >= want) break;
                if (__builtin_amdgcn_s_memrealtime() - t0 > 2000000ull) {
                    if (lane == 0) { unsigned expect = 0u; __hip_atomic_compare_exchange_strong(tmo + 1, &expect, code | (unsigned)(u.pm & 0xff), __ATOMIC_RELAXED, __ATOMIC_RELAXED, __HIP_MEMORY_SCOPE_AGENT);
                                     __hip_atomic_store(tmo, 1u, __ATOMIC_RELAXED, __HIP_MEMORY_SCOPE_AGENT); }
                    dead = true; break; }
                __builtin_amdgcn_s_sleep(2);
            }
            __builtin_amdgcn_fence(__ATOMIC_ACQUIRE, "agent");
            if (lane == 0) flag[0] = dead ? 1u : 0u;
        }
        asm volatile("s_waitcnt vmcnt(0) lgkmcnt(0)" ::: "memory"); __builtin_amdgcn_s_barrier(); asm volatile("" ::: "memory");
        const bool bad = flag[0] != 0u;
        if (lane < 32) {
            const unsigned long long* slot = (const unsigned long long*)xbuf + (size_t)(u.pm * BM + row) * 4; float mt[4], m2[4]; float ms = 0.f;
#pragma unroll
            for (int t = 0; t < 4; ++t) { if (t < ntn) { const unsigned long long w = __hip_atomic_load(slot + t, __ATOMIC_RELAXED, __HIP_MEMORY_SCOPE_AGENT); mt[t] = __uint_as_float((unsigned)w); m2[t] = __uint_as_float((unsigned)(w >> 32)); } else { mt[t] = 0.f; m2[t] = 0.f; } ms += mt[t]; }
            const float mean = ms / (float)ntn; float q = 0.f;
#pragma unroll
            for (int t = 0; t < 4; ++t) if (t < ntn) { const float dm = mt[t] - mean; q += m2[t] + 256.0f * dm * dm; }
            S[row] = (f32x2v){mean, 1.0f / sqrtf(q / (256.0f * (float)ntn) + eps)};
        }
        asm volatile("s_waitcnt lgkmcnt(0)" ::: "memory"); __builtin_amdgcn_s_barrier(); asm volatile("" ::: "memory");
        return bad;
    }
};
struct EpiLnRes {
    static constexpr bool PERM = false, AFTER_DRAIN = true;
    const float* base; float* out; int ldc; const float* bias; PanelStats st; unsigned poison;
    __device__ __forceinline__ void fused(f32x4 (&acc)[2][2][4][2], const Unit& u, int wr, int wc, int fr, int fq, PG8_LAS unsigned char* lds, int wid, int lane) const {
        typedef float f32x2v __attribute__((ext_vector_type(2)));
        const PG8_LAS f32x2v* S = (const PG8_LAS f32x2v*)(lds + 8192);
        const int col0 = u.pn * BM + wc * 32 + 4 * fq;
#pragma unroll
        for (int bj = 0; bj < 2; ++bj)
#pragma unroll
            for (int n = 0; n < 2; ++n) { const f32x4 bv = bias ? *(const f32x4*)(bias + col0 + bj * HALF + n * 16) : (f32x4){0.f, 0.f, 0.f, 0.f};
#pragma unroll
                for (int ai = 0; ai < 2; ++ai)
#pragma unroll
                    for (int m = 0; m < 4; ++m) acc[ai][bj][m][n] += bv; }
        f32x4 pre[4][2][2];
#pragma unroll
        for (int m = 0; m < 4; ++m) { const size_t off = (size_t)(u.pm * BM + wr * 64 + m * 16 + fr) * ldc + col0;
#pragma unroll
            for (int bj = 0; bj < 2; ++bj)
#pragma unroll
                for (int n = 0; n < 2; ++n) pre[m][bj][n] = *(const f32x4*)(base + off + bj * HALF + n * 16); }
        const bool bad = st.run(acc, u, wr, wc, fr, fq, lds, wid, lane) || poison != 0u;
        const float qnan = __builtin_nanf("");
#pragma unroll
        for (int ai = 0; ai < 2; ++ai)
#pragma unroll
            for (int m = 0; m < 4; ++m) { const int r = ai * HALF + wr * 64 + m * 16 + fr; const f32x2v sr = S[r]; const size_t off = (size_t)(u.pm * BM + r) * ldc + col0;
#pragma unroll
                for (int bj = 0; bj < 2; ++bj)
#pragma unroll
                    for (int n = 0; n < 2; ++n) { const f32x4 bs = ai == 0 ? pre[m][bj][n] : *(const f32x4*)(base + off + bj * HALF + n * 16); f32x4 o = bs + (acc[ai][bj][m][n] - sr.x) * sr.y;
                        if (bad) o = (f32x4){qnan, qnan, qnan, qnan}; *(f32x4*)(out + off + bj * HALF + n * 16) = o; }
                if (m & 1) asm volatile("" ::: "memory"); }
    }
};
struct EpiLnResLn {
    static constexpr bool PERM = false, AFTER_DRAIN = true;
    const float* base; float* out; bf16_t* xn; int ldc; const float* bias; PanelStats st1, st2; unsigned poison;
    __device__ __forceinline__ void fused(f32x4 (&acc)[2][2][4][2], const Unit& u, int wr, int wc, int fr, int fq, PG8_LAS unsigned char* lds, int wid, int lane) const {
        typedef float f32x2v __attribute__((ext_vector_type(2))); typedef unsigned u32x2v __attribute__((ext_vector_type(2)));
        const PG8_LAS f32x2v* S = (const PG8_LAS f32x2v*)(lds + 8192);
        const int col0 = u.pn * BM + wc * 32 + 4 * fq;
#pragma unroll
        for (int bj = 0; bj < 2; ++bj)
#pragma unroll
            for (int n = 0; n < 2; ++n) { const f32x4 bv = bias ? *(const f32x4*)(bias + col0 + bj * HALF + n * 16) : (f32x4){0.f, 0.f, 0.f, 0.f};
#pragma unroll
                for (int ai = 0; ai < 2; ++ai)
#pragma unroll
                    for (int m = 0; m < 4; ++m) acc[ai][bj][m][n] += bv; }
        bool bad = st1.run(acc, u, wr, wc, fr, fq, lds, wid, lane) || poison != 0u;
        const float qnan = __builtin_nanf("");
#pragma unroll
        for (int ai = 0; ai < 2; ++ai)
#pragma unroll
            for (int m = 0; m < 4; ++m) { const int r = ai * HALF + wr * 64 + m * 16 + fr; const f32x2v sr = S[r]; const size_t off = (size_t)(u.pm * BM + r) * ldc + col0;
#pragma unroll
                for (int bj = 0; bj < 2; ++bj)
#pragma unroll
                    for (int n = 0; n < 2; ++n) { const f32x4 bs = *(const f32x4*)(base + off + bj * HALF + n * 16); acc[ai][bj][m][n] = bs + (acc[ai][bj][m][n] - sr.x) * sr.y; }
                asm volatile("" : "+v"(acc[ai][0][m][0]), "+v"(acc[ai][0][m][1]), "+v"(acc[ai][1][m][0]), "+v"(acc[ai][1][m][1]));
                if (m & 1) asm volatile("" ::: "memory"); }
        const bool bad1 = bad;
        bad = st2.run(acc, u, wr, wc, fr, fq, lds, wid, lane) || bad;
#pragma unroll
        for (int ai = 0; ai < 2; ++ai)
#pragma unroll
            for (int m = 0; m < 4; ++m) { const int r = ai * HALF + wr * 64 + m * 16 + fr; const f32x2v sr = S[r]; const size_t off = (size_t)(u.pm * BM + r) * ldc + col0;
#pragma unroll
                for (int bj = 0; bj < 2; ++bj)
#pragma unroll
                    for (int n = 0; n < 2; ++n) { const f32x4 x1 = acc[ai][bj][m][n]; *(f32x4*)(out + off + bj * HALF + n * 16) = bad1 ? (f32x4){qnan, qnan, qnan, qnan} : x1;
                        const f32x4 o = (x1 - sr.x) * sr.y; u32x2v w; w.x = cvt_pk_bf16(o[0], o[1]); w.y = cvt_pk_bf16(o[2], o[3]);
                        if (bad) { w.x = 0x7fc07fc0u; w.y = 0x7fc07fc0u; } *(u32x2v*)(xn + off + bj * HALF + n * 16) = w; }
                asm volatile("" ::: "memory"); }
    }
};

template <class Epi, class Sched, bool ALIGN_EPI = false, bool SP2 = false, bool GATHER = false, bool F8 = false>
__device__ __forceinline__ void gemm_phase(PG8_LAS unsigned char* lds, const Gemm g, const Sched& S, const Epi& E, const PG8_LAS unsigned short* tokl = nullptr) {
    int tid_ = threadIdx.x; asm volatile("" : "+v"(tid_));
    const int tid = tid_, wid = __builtin_amdgcn_readfirstlane(tid >> 6), lane = tid & 63, wr = wid >> 2, wc = wid & 3, fr = lane & 15, fq = lane >> 4;
    const int K = g.K, nt = K / BK;
    unsigned voffA[2], voffB[2];
#pragma unroll
    for (int i = 0; i < 2; ++i) { int R, C; stage_rc(tid * 16 + i * 8192, R, C); const int Rb = Epi::PERM ? ((R & ~31) + perm32(R & 31)) : R;
        voffA[i] = GATHER ? (unsigned)C * 2u : (unsigned)(R * K + C) * 2u; voffB[i] = (unsigned)(Rb * K + C) * 2u; }
    const size_t rowbytes = (size_t)K * 2; unsigned tkc[2] = {0u, 0u}; (void)rowbytes;
#define PG8_LOADTK(dst, unit_i) do { int R0_, C0_, R1_, C1_; stage_rc(tid * 16, R0_, C0_); stage_rc(tid * 16 + 8192, R1_, C1_); (void)C0_; (void)C1_; \
        _Pragma("unroll") for (int h_ = 0; h_ < 2; ++h_) dst[h_] = (unsigned)tokl[(unit_i) * 256 + h_ * HALF + R0_] | ((unsigned)tokl[(unit_i) * 256 + h_ * HALF + R1_] << 16); } while (0)
#define PG8_STAGE_A(bufoff, gbase, half, TK) do { if constexpr (GATHER) { _Pragma("unroll") for (int _i = 0; _i < 2; ++_i) { const unsigned _tok = ((TK)[half] >> (16 * _i)) & 0xffffu; \
        __builtin_amdgcn_global_load_lds((const unsigned*)((const char*)(gbase) + (size_t)_tok * rowbytes + voffA[_i]), (PG8_LAS unsigned*)(lds + (bufoff) + ldsw + _i * 8192), 16, 0, 0); } } \
    else { PG8_STAGE(bufoff, (gbase) + (half) * hstep, voffA); } } while (0)
    const size_t kstep = (size_t)(BK * 2);
    const size_t hstep = (size_t)HALF * K * 2;
    const size_t tstep = 2 * hstep;
    const unsigned ldsw = (unsigned)wid * 1024u;
    const int aoff = lds_byte(wr * 64 + fr, fq * 8), boff = lds_byte(wc * 32 + fr, fq * 8);
    unsigned f8scl = 0x7f7f7f7fu; asm volatile("" : "+v"(f8scl)); (void)f8scl;
    constexpr int KFS = 1024;
#define PG8_SA(b, h) (((b) * 2 + (h)) * HTB)
#define PG8_SB(b, h) ((4 + (b) * 2 + (h)) * HTB)
#define PG8_STAGE(bufoff, gbase, voff) do { _Pragma("unroll") for (int _i = 0; _i < 2; ++_i) \
        __builtin_amdgcn_global_load_lds((const unsigned*)((const char*)(gbase) + (voff)[_i]), (PG8_LAS unsigned*)(lds + (bufoff) + ldsw + _i * 8192), 16, 0, 0); } while (0)
#define PG8_LDA(dst, b, h) do { _Pragma("unroll") for (int m = 0; m < 4; ++m) _Pragma("unroll") for (int k = 0; k < 2; ++k) dst[m][k] = *(const PG8_LAS bf16x8*)(lds + PG8_SA(b, h) + aoff + m * 2048 + k * KFS); } while (0)
#define PG8_LDB(dst, b, h) do { _Pragma("unroll") for (int n = 0; n < 2; ++n) _Pragma("unroll") for (int k = 0; k < 2; ++k) dst[n][k] = *(const PG8_LAS bf16x8*)(lds + PG8_SB(b, h) + boff + n * 2048 + k * KFS); } while (0)
#define PG8_F8FRAG(X) __builtin_bit_cast(i32x8, __builtin_shufflevector(X[0], X[1], 0, 1, 2, 3, 4, 5, 6, 7, 8, 9, 10, 11, 12, 13, 14, 15))
#define PG8_MMA(ai, bj, At, Bt) do { __builtin_amdgcn_s_setprio(1); if constexpr (F8) { const i32x8 b80_ = PG8_F8FRAG(Bt[0]), b81_ = PG8_F8FRAG(Bt[1]); _Pragma("unroll") for (int m = 0; m < 4; ++m) { const i32x8 a8_ = PG8_F8FRAG(At[m]); \
        asm volatile("v_mfma_scale_f32_16x16x128_f8f6f4 %0, %1, %2, %0, %3, %3 op_sel_hi:[0,0,0]" : "+v"(acc[ai][bj][m][0]) : "v"(b80_), "v"(a8_), "v"(f8scl)); \
        asm volatile("v_mfma_scale_f32_16x16x128_f8f6f4 %0, %1, %2, %0, %3, %3 op_sel_hi:[0,0,0]" : "+v"(acc[ai][bj][m][1]) : "v"(b81_), "v"(a8_), "v"(f8scl)); } } else { \
        _Pragma("unroll") for (int m = 0; m < 4; ++m) _Pragma("unroll") for (int n = 0; n < 2; ++n) _Pragma("unroll") for (int k = 0; k < 2; ++k) \
        acc[ai][bj][m][n] = __builtin_amdgcn_mfma_f32_16x16x32_bf16(Bt[n][k], At[m][k], acc[ai][bj][m][n], 0, 0, 0); } __builtin_amdgcn_s_setprio(0); } while (0)
#define PG8_WAIT_V(n) asm volatile("s_waitcnt vmcnt(" #n ")" ::: "memory")
#define PG8_WAIT_L(n) asm volatile("s_waitcnt lgkmcnt(" #n ")" ::: "memory")
#define PG8_BAR __builtin_amdgcn_s_barrier()
#define PG8_SCHED __builtin_amdgcn_sched_barrier(0)
    Unit cur, nxt; int ui = 0;
    if (!S.next(0, cur)) return;
    f32x4 acc[2][2][4][2];
#pragma unroll
    for (int a = 0; a < 2; ++a)
#pragma unroll
        for (int b = 0; b < 2; ++b)
#pragma unroll
            for (int m = 0; m < 4; ++m)
#pragma unroll
                for (int n = 0; n < 2; ++n) acc[a][b][m][n] = (f32x4){0.f, 0.f, 0.f, 0.f};
    bf16x8 At[4][2], B0[2][2], B1[2][2];
    const char* cA = (const char*)g.A + (GATHER ? (size_t)0 : (size_t)cur.pm * tstep); const char* cB = (const char*)g.Bt + (size_t)cur.pn * tstep;
    if constexpr (GATHER) { PG8_LOADTK(tkc, 0); }
    S.a_ready(cur);
    if constexpr (SP2) {
        PG8_STAGE(PG8_SB(0, 0), cB, voffB); PG8_STAGE(PG8_SB(0, 1), cB + hstep, voffB); PG8_STAGE_A(PG8_SA(0, 0), cA, 0, tkc); PG8_STAGE_A(PG8_SA(0, 1), cA, 1, tkc);
        if (wr == 1) PG8_BAR;
        PG8_WAIT_V(2); PG8_BAR;
        PG8_STAGE(PG8_SB(1, 0), cB + kstep, voffB); PG8_STAGE_A(PG8_SA(1, 0), cA + kstep, 0, tkc); PG8_STAGE(PG8_SB(1, 1), cB + hstep + kstep, voffB);
        PG8_WAIT_V(6); PG8_BAR;
    } else {
        PG8_STAGE(PG8_SB(0, 0), cB, voffB); PG8_STAGE_A(PG8_SA(0, 0), cA, 0, tkc); PG8_STAGE(PG8_SB(0, 1), cB + hstep, voffB); PG8_STAGE_A(PG8_SA(0, 1), cA, 1, tkc);
        if (wr == 1) PG8_BAR;
        PG8_WAIT_V(4); PG8_BAR;
        PG8_STAGE(PG8_SB(1, 0), cB + kstep, voffB); PG8_STAGE_A(PG8_SA(1, 0), cA + kstep, 0, tkc); PG8_STAGE(PG8_SB(1, 1), cB + hstep + kstep, voffB);
        PG8_WAIT_V(6); PG8_BAR;
    }
    for (;;) {
        const bool has_next = S.next(ui + 1, nxt);
        const char* nA = has_next ? (const char*)g.A + (GATHER ? (size_t)0 : (size_t)nxt.pm * tstep) : cA;
 const char* nB = has_next ? (const char*)g.Bt + (size_t)nxt.pn * tstep : cB;
        for (int t = 0; t < nt; t += 2) {
            const bool last = (t == nt - 2);
            const char* a1 = cA + (size_t)(t + 1) * kstep;
            const char* a2 = last ? nA : cA + (size_t)(t + 2) * kstep; const char* b2 = last ? nB : cB + (size_t)(t + 2) * kstep;
            const char* a3 = a2 + kstep; const char* b3 = b2 + kstep;
            unsigned tk2[2]; tk2[0] = tkc[0]; tk2[1] = tkc[1]; (void)tk2;
            if constexpr (GATHER) { if (last && has_next) { PG8_LOADTK(tk2, ui + 1); } }
            if (last && has_next) S.a_ready(nxt);
            if constexpr (SP2) {
            PG8_LDB(B0, 0, 0); PG8_LDB(B1, 0, 1); PG8_SCHED; PG8_LDA(At, 0, 0); PG8_STAGE_A(PG8_SA(1, 1), a1, 1, tkc);
            PG8_WAIT_V(8); PG8_WAIT_L(0); PG8_BAR; PG8_MMA(0, 0, At, B0); PG8_MMA(0, 1, At, B1); PG8_BAR; PG8_SCHED;
            PG8_LDA(At, 0, 1); PG8_STAGE(PG8_SB(0, 0), b2, voffB); PG8_STAGE(PG8_SB(0, 1), b2 + hstep, voffB); PG8_STAGE_A(PG8_SA(0, 0), a2, 0, tk2);
            PG8_WAIT_V(8); PG8_WAIT_L(0); PG8_BAR; PG8_MMA(1, 0, At, B0); PG8_MMA(1, 1, At, B1); PG8_BAR; PG8_SCHED;
            PG8_LDB(B0, 1, 0); PG8_LDB(B1, 1, 1); PG8_SCHED; PG8_LDA(At, 1, 0); PG8_STAGE_A(PG8_SA(0, 1), a2, 1, tk2);
            PG8_WAIT_V(8); PG8_WAIT_L(0); PG8_BAR; PG8_MMA(0, 0, At, B0); PG8_MMA(0, 1, At, B1); PG8_BAR; PG8_SCHED;
            PG8_LDA(At, 1, 1); PG8_STAGE(PG8_SB(1, 0), b3, voffB); PG8_STAGE(PG8_SB(1, 1), b3 + hstep, voffB); PG8_STAGE_A(PG8_SA(1, 0), a3, 0, tk2);
            PG8_WAIT_V(8); PG8_WAIT_L(0); PG8_BAR; PG8_MMA(1, 0, At, B0); PG8_MMA(1, 1, At, B1); PG8_BAR; PG8_SCHED;
            } else {
            PG8_LDB(B0, 0, 0); PG8_SCHED; PG8_LDA(At, 0, 0); PG8_STAGE_A(PG8_SA(1, 1), a1, 1, tkc);
            PG8_WAIT_L(8); PG8_BAR; PG8_WAIT_L(0); PG8_MMA(0, 0, At, B0); PG8_BAR; PG8_SCHED;
            PG8_LDB(B1, 0, 1); PG8_STAGE(PG8_SB(0, 0), b2, voffB);
            PG8_BAR; PG8_WAIT_L(0); PG8_MMA(0, 1, At, B1); PG8_BAR;
            PG8_LDA(At, 0, 1); PG8_STAGE_A(PG8_SA(0, 0), a2, 0, tk2);
            PG8_BAR; PG8_WAIT_L(0); PG8_MMA(1, 0, At, B0); PG8_BAR; PG8_SCHED;
            PG8_STAGE(PG8_SB(0, 1), b2 + hstep, voffB);
            PG8_WAIT_V(6); PG8_BAR; PG8_MMA(1, 1, At, B1); PG8_BAR;
            PG8_LDB(B0, 1, 0); PG8_SCHED; PG8_LDA(At, 1, 0); PG8_STAGE_A(PG8_SA(0, 1), a2, 1, tk2);
            PG8_WAIT_L(8); PG8_BAR; PG8_WAIT_L(0); PG8_MMA(0, 0, At, B0); PG8_BAR; PG8_SCHED;
            PG8_LDB(B1, 1, 1); PG8_STAGE(PG8_SB(1, 0), b3, voffB);
            PG8_BAR; PG8_WAIT_L(0); PG8_MMA(0, 1, At, B1); PG8_BAR;
            PG8_LDA(At, 1, 1); PG8_STAGE_A(PG8_SA(1, 0), a3, 0, tk2);
            PG8_BAR; PG8_WAIT_L(0); PG8_MMA(1, 0, At, B0); PG8_BAR; PG8_SCHED;
            PG8_STAGE(PG8_SB(1, 1), b3 + hstep, voffB);
            PG8_WAIT_V(6); PG8_BAR; PG8_MMA(1, 1, At, B1); PG8_BAR;
            }
        }
        if constexpr (ALIGN_EPI) { if (wr == 0) PG8_BAR; }
        if constexpr (F8) asm volatile("s_nop 15\n\ts_nop 15" ::: "memory");
        if constexpr (!Epi::AFTER_DRAIN) { E(acc, cur, wr, wc, fr, fq);
#if defined(MK_EPI_REP) && MK_EPI_REP
            E(acc, cur, wr, wc, fr, fq);
#endif
            S.done(cur); }
        if (!has_next) break;
#pragma unroll
        for (int a = 0; a < 2; ++a)
#pragma unroll
            for (int b = 0; b < 2; ++b)
#pragma unroll
                for (int m = 0; m < 4; ++m)
#pragma unroll
                    for (int n = 0; n < 2; ++n) acc[a][b][m][n] = (f32x4){0.f, 0.f, 0.f, 0.f};
        cur = nxt; cA = nA; cB = nB; ++ui; if constexpr (GATHER) { PG8_LOADTK(tkc, ui); }
        if constexpr (ALIGN_EPI) { if (wr == 1) PG8_BAR; }
    }
    PG8_WAIT_V(0);
    if constexpr (!ALIGN_EPI) { if (wr == 0) PG8_BAR; }
    PG8_BAR;
    if constexpr (Epi::AFTER_DRAIN) { E.fused(acc, cur, wr, wc, fr, fq, lds, wid, lane); S.done(cur); }
#undef PG8_SA
#undef PG8_SB
#undef PG8_STAGE
#undef PG8_STAGE_A
#undef PG8_LOADTK
#undef PG8_LDA
#undef PG8_LDB
#undef PG8_MMA
#undef PG8_F8FRAG
#undef PG8_WAIT_V
#undef PG8_WAIT_L
#undef PG8_BAR
#undef PG8_SCHED
}
}
namespace pg8 {
struct EpiF32 {
    static constexpr bool PERM = false, AFTER_DRAIN = false;
    float* O; int ldc;
    __device__ __forceinline__ void operator()(const f32x4 (&acc)[2][2][4][2], const Unit& u, int wr, int wc, int fr_, int fq_) const {
        int t_ = threadIdx.x; asm volatile("" : "+v"(t_)); const int fr = t_ & 15, fq = (t_ & 63) >> 4; (void)fr_; (void)fq_;
        const int row0 = u.pm * BM + wr * 64 + fr, col0 = u.pn * BM + wc * 32 + 4 * fq;
#pragma unroll
        for (int ai = 0; ai < 2; ++ai)
#pragma unroll
            for (int m = 0; m < 4; ++m) { float* rowp = O + (size_t)(row0 + ai * HALF + m * 16) * ldc + col0;
#pragma unroll
                for (int bj = 0; bj < 2; ++bj)
#pragma unroll
                    for (int n = 0; n < 2; ++n) *(f32x4*)(rowp + bj * HALF + n * 16) = acc[ai][bj][m][n]; }
    }
};
struct EpiResF32 {
    static constexpr bool PERM = false, AFTER_DRAIN = false;
    const float* base; float* out; int ldc; float alpha;
    __device__ __forceinline__ void operator()(const f32x4 (&acc)[2][2][4][2], const Unit& u, int wr, int wc, int fr_, int fq_) const {
        int t_ = threadIdx.x; asm volatile("" : "+v"(t_)); const int fr = t_ & 15, fq = (t_ & 63) >> 4; (void)fr_; (void)fq_;
        const int row0 = u.pm * BM + wr * 64 + fr, col0 = u.pn * BM + wc * 32 + 4 * fq;
#pragma unroll
        for (int ai = 0; ai < 2; ++ai)
#pragma unroll
            for (int m = 0; m < 4; ++m) { const size_t off = (size_t)(row0 + ai * HALF + m * 16) * ldc + col0;
                f32x4 bs[2][2];
#pragma unroll
                for (int bj = 0; bj < 2; ++bj)
#pragma unroll
                    for (int n = 0; n < 2; ++n) bs[bj][n] = *(const f32x4*)(base + off + bj * HALF + n * 16);
#pragma unroll
                for (int bj = 0; bj < 2; ++bj)
#pragma unroll
                    for (int n = 0; n < 2; ++n) *(f32x4*)(out + off + bj * HALF + n * 16) = bs[bj][n] * alpha + acc[ai][bj][m][n]; }
    }
};
struct EpiDsaNorm {
    static constexpr bool PERM = false, AFTER_DRAIN = false;
    bf16_t* cqn; bf16_t* ckv; bf16_t* kidx; float* widx; const float* gq; const float* gkv; const float* gki; const float* bki; unsigned* cmaxw; PG8_LAS float* scr; float rms_eps, ln_eps;
    __device__ __forceinline__ void operator()(const f32x4 (&acc)[2][2][4][2], const Unit& u, int wr, int wc, int fr_, int fq_) const {
        int t_ = threadIdx.x; asm volatile("" : "+v"(t_)); const int fr = t_ & 15, fq = (t_ & 63) >> 4; (void)fr_; (void)fq_;
#define EDN_RED4(v_) do { v_ += __shfl_xor(v_, 16); v_ += __shfl_xor(v_, 32); } while (0)
#define EDN_BAR() asm volatile("s_waitcnt lgkmcnt(0)\n\ts_barrier" ::: "memory")
#define EDN_PK(v_) ({ u32x2e w_; w_.x = cvt_pk_bf16((v_)[0], (v_)[1]); w_.y = cvt_pk_bf16((v_)[2], (v_)[3]); w_; })
        typedef unsigned u32x2e __attribute__((ext_vector_type(2)));
        if (u.pn == 0) {
#pragma unroll
            for (int ai = 0; ai < 2; ++ai)
#pragma unroll
                for (int m = 0; m < 4; ++m) { float s = 0.f;
#pragma unroll
                    for (int bj = 0; bj < 2; ++bj)
#pragma unroll
                        for (int n = 0; n < 2; ++n) { const f32x4 x = acc[ai][bj][m][n]; s += (x[0] * x[0] + x[1] * x[1]) + (x[2] * x[2] + x[3] * x[3]); }
                    EDN_RED4(s); if (fq == 0) scr[(ai * HALF + wr * 64 + m * 16 + fr) * 4 + wc] = s; }
            EDN_BAR();
#pragma unroll
            for (int ai = 0; ai < 2; ++ai)
#pragma unroll
                for (int m = 0; m < 4; ++m) { const int rl = ai * HALF + wr * 64 + m * 16 + fr; const f32x4 p4 = *(const PG8_LAS f32x4*)(scr + rl * 4);
                    const float rq = 1.0f / sqrtf(((p4[0] + p4[1]) + (p4[2] + p4[3])) * (1.0f / 256.0f) + rms_eps); bf16_t* rowp = cqn + (size_t)(u.pm * BM + rl) * 256;
#pragma unroll
                    for (int bj = 0; bj < 2; ++bj)
#pragma unroll
                        for (int n = 0; n < 2; ++n) { const int col = bj * HALF + wc * 32 + n * 16 + 4 * fq; const f32x4 v = acc[ai][bj][m][n] * rq * *(const f32x4*)(gq + col); *(u32x2e*)(rowp + col) = EDN_PK(v); } }
        } else {
            float cmx = 0.f;
#pragma unroll
            for (int ai = 0; ai < 2; ++ai)
#pragma unroll
                for (int m = 0; m < 4; ++m) { const int rl = ai * HALF + wr * 64 + m * 16 + fr; float s1 = 0.f, s4 = 0.f, s2 = 0.f, s3 = 0.f;
#pragma unroll
                    for (int n = 0; n < 2; ++n) { const f32x4 x = acc[ai][0][m][n]; const f32x4 xg = x * *(const f32x4*)(gkv + wc * 32 + n * 16 + 4 * fq);
                        s1 += (x[0] * x[0] + x[1] * x[1]) + (x[2] * x[2] + x[3] * x[3]); s4 += (xg[0] * xg[0] + xg[1] * xg[1]) + (xg[2] * xg[2] + xg[3] * xg[3]);
                        const f32x4 y = acc[ai][1][m][n]; s2 += (y[0] + y[1]) + (y[2] + y[3]); s3 += (y[0] * y[0] + y[1] * y[1]) + (y[2] * y[2] + y[3] * y[3]); }
                    EDN_RED4(s1); EDN_RED4(s4); EDN_RED4(s2); EDN_RED4(s3);
                    if (fq == 0) { scr[rl * 4 + wc] = s1; scr[1024 + rl * 4 + wc] = s4; if (wc < 2) { scr[2048 + rl * 2 + wc] = s2; scr[2560 + rl * 2 + wc] = s3; } } }
            EDN_BAR();
#pragma unroll
            for (int ai = 0; ai < 2; ++ai)
#pragma unroll
                for (int m = 0; m < 4; ++m) { const int rl = ai * HALF + wr * 64 + m * 16 + fr; const size_t grow = (size_t)(u.pm * BM + rl);
                    const f32x4 p1 = *(const PG8_LAS f32x4*)(scr + rl * 4), p4 = *(const PG8_LAS f32x4*)(scr + 1024 + rl * 4);
                    const float rkv = 1.0f / sqrtf(((p1[0] + p1[1]) + (p1[2] + p1[3])) * (1.0f / 128.0f) + rms_eps);
                    cmx = fmaxf(cmx, ((p4[0] + p4[1]) + (p4[2] + p4[3])) * rkv * rkv);
#pragma unroll
                    for (int n = 0; n < 2; ++n) { const int col = wc * 32 + n * 16 + 4 * fq; const f32x4 v = acc[ai][0][m][n] * rkv * *(const f32x4*)(gkv + col); { int w8 = __builtin_amdgcn_cvt_pk_fp8_f32(v[0], v[1], 0, false); w8 = __builtin_amdgcn_cvt_pk_fp8_f32(v[2], v[3], w8, true); *(unsigned*)((unsigned char*)ckv + grow * 128 + col) = (unsigned)w8; } }
                    if (wc < 2) { const float sm = scr[2048 + rl * 2] + scr[2048 + rl * 2 + 1], sq = scr[2560 + rl * 2] + scr[2560 + rl * 2 + 1];
                        const float mean = sm * (1.0f / 64.0f); const float var = fmaxf(sq * (1.0f / 64.0f) - mean * mean, 0.f); const float rstd = 1.0f / sqrtf(var + ln_eps);
#pragma unroll
                        for (int n = 0; n < 2; ++n) { const int col = wc * 32 + n * 16 + 4 * fq; const f32x4 v = (acc[ai][1][m][n] - mean) * rstd * *(const f32x4*)(gki + col) + *(const f32x4*)(bki + col); *(u32x2e*)(kidx + grow * 64 + col) = EDN_PK(v); } }
                    if (wc == 2 && fq < 2) *(f32x4*)(widx + grow * 8 + 4 * fq) = acc[ai][1][m][0] * 0.04419417382415922f; }
            if (wc == 0 && fq == 0) __hip_atomic_fetch_max(cmaxw, __builtin_bit_cast(unsigned, sqrtf(cmx)), __ATOMIC_RELAXED, __HIP_MEMORY_SCOPE_AGENT);
        }
        EDN_BAR();
#undef EDN_RED4
#undef EDN_BAR
#undef EDN_PK
    }
};
struct EpiCq {
    static constexpr bool PERM = true, AFTER_DRAIN = false;
    bf16_t* qlat; bf16_t* qidx;
    __device__ __forceinline__ void operator()(const f32x4 (&acc)[2][2][4][2], const Unit& u, int wr, int wc, int fr_, int fq_) const {
        int t_ = threadIdx.x; asm volatile("" : "+v"(t_)); const int fr = t_ & 15, fq = (t_ & 63) >> 4; (void)fr_; (void)fq_;
        const int row0 = u.pm * BM + wr * 64 + fr; int colt = u.pn * BM; bf16_t* base = qlat; int ldc = 2048;
        if (colt >= 2048) { base = qidx; ldc = 512; colt -= 2048; }
        const int col0 = colt + wc * 32 + 8 * fq;
#pragma unroll
        for (int ai = 0; ai < 2; ++ai)
#pragma unroll
            for (int m = 0; m < 4; ++m) { bf16_t* rowp = base + (size_t)(row0 + ai * HALF + m * 16) * ldc + col0;
#pragma unroll
                for (int bj = 0; bj < 2; ++bj) { const f32x4 v0 = acc[ai][bj][m][0], v1 = acc[ai][bj][m][1];
                    u32x4 w; w.x = cvt_pk_bf16(v0[0], v0[1]); w.y = cvt_pk_bf16(v0[2], v0[3]); w.z = cvt_pk_bf16(v1[0], v1[1]); w.w = cvt_pk_bf16(v1[2], v1[3]);
                    *(u32x4*)(rowp + bj * HALF) = w; } }
    }
};
struct EpiSwiglu {
    static constexpr bool PERM = true, AFTER_DRAIN = false;
    bf16_t* H; const float* bgu;
    __device__ __forceinline__ void operator()(const f32x4 (&acc)[2][2][4][2], const Unit& u, int wr, int wc, int fr_, int fq_) const {
        int t_ = threadIdx.x; asm volatile("" : "+v"(t_)); const int fr = t_ & 15, fq = (t_ & 63) >> 4; (void)fr_; (void)fq_;
        const int e = u.pn >> 3, pnl = u.pn & 7;
        const int row0 = u.pm * BM + wr * 64 + fr, col0 = pnl * 128 + wc * 32 + 8 * fq;
        const float* bg = bgu + (size_t)e * 2048 + col0; const float* bu = bg + 1024;
        f32x4 bgv[2], buv[2];
#pragma unroll
        for (int n = 0; n < 2; ++n) { bgv[n] = *(const f32x4*)(bg + 4 * n); buv[n] = *(const f32x4*)(bu + 4 * n); }
#pragma unroll
        for (int ai = 0; ai < 2; ++ai)
#pragma unroll
            for (int m = 0; m < 4; ++m) { bf16_t* rowp = H + (size_t)(row0 + ai * HALF + m * 16) * 1024 + col0;
                float h[8];
#pragma unroll
                for (int n = 0; n < 2; ++n) { const f32x4 g4 = acc[ai][0][m][n] + bgv[n], u4 = acc[ai][1][m][n] + buv[n];
#pragma unroll
                    for (int i = 0; i < 4; ++i) { const float g = fminf(g4[i], 7.0f); const float up = fminf(fmaxf(u4[i], -7.0f), 7.0f);
                        const float sg = __builtin_amdgcn_rcpf(1.0f + __builtin_amdgcn_exp2f(g * (-1.702f * 1.4426950408889634f)));
                        h[4 * n + i] = (up + 1.0f) * (g * sg); } }
                u32x4 w; w.x = cvt_pk_bf16(h[0], h[1]); w.y = cvt_pk_bf16(h[2], h[3]); w.z = cvt_pk_bf16(h[4], h[5]); w.w = cvt_pk_bf16(h[6], h[7]);
                *(u32x4*)rowp = w; }
    }
};
__device__ __forceinline__ unsigned cvt4_fp8(float a, float b, float c, float d) { int w = 0; w = __builtin_amdgcn_cvt_pk_fp8_f32(a, b, w, false); w = __builtin_amdgcn_cvt_pk_fp8_f32(c, d, w, true); return (unsigned)w; }
struct EpiSwiglu8 {
    static constexpr bool PERM = true, AFTER_DRAIN = false;
    unsigned char* H; const float* bgu; float inv, hs;
    __device__ __forceinline__ void operator()(const f32x4 (&acc)[2][2][4][2], const Unit& u, int wr, int wc, int fr_, int fq_) const {
        int t_ = threadIdx.x; asm volatile("" : "+v"(t_)); const int fr = t_ & 15, fq = (t_ & 63) >> 4; (void)fr_; (void)fq_;
        const int e = u.pn >> 3, pnl = u.pn & 7;
        const int row0 = u.pm * BM + wr * 64 + fr, col0 = pnl * 128 + wc * 32 + 8 * fq;
        const float* bg = bgu + (size_t)e * 2048 + col0; const float* bu = bg + 1024;
        typedef float f32x2e __attribute__((ext_vector_type(2)));
        constexpr float KS = -1.702f * 1.4426950408889634f;
        f32x2e bgk[2][2], buq[2][2];
#pragma unroll
        for (int n = 0; n < 2; ++n) { const f32x4 g4 = *(const f32x4*)(bg + 4 * n) * KS; const f32x4 u4 = *(const f32x4*)(bu + 4 * n);
            bgk[n][0] = (f32x2e){g4[0], g4[1]}; bgk[n][1] = (f32x2e){g4[2], g4[3]}; buq[n][0] = (f32x2e){u4[0], u4[1]}; buq[n][1] = (f32x2e){u4[2], u4[3]}; }
        const float ik = inv * KS, hk = hs / KS; const f32x2e ik2 = {ik, ik}, inv2 = {inv, inv}, hk2 = {hk, hk}, one2 = {1.0f, 1.0f};
#pragma unroll
        for (int ai = 0; ai < 2; ++ai)
#pragma unroll
            for (int m = 0; m < 4; ++m) { unsigned char* rowp = H + (size_t)(row0 + ai * HALF + m * 16) * 1024 + col0;
                f32x2e h[4];
#pragma unroll
                for (int n = 0; n < 2; ++n)
#pragma unroll
                    for (int q = 0; q < 2; ++q) { const f32x4 ag = acc[ai][0][m][n], au = acc[ai][1][m][n];
                        f32x2e gk = __builtin_elementwise_fma((f32x2e){ag[2 * q], ag[2 * q + 1]}, ik2, bgk[n][q]);
                        f32x2e uq = __builtin_elementwise_fma((f32x2e){au[2 * q], au[2 * q + 1]}, inv2, buq[n][q]);
                        gk.x = fmaxf(gk.x, 7.0f * KS); gk.y = fmaxf(gk.y, 7.0f * KS);
                        uq.x = __builtin_amdgcn_fmed3f(uq.x, -7.0f, 7.0f); uq.y = __builtin_amdgcn_fmed3f(uq.y, -7.0f, 7.0f);
                        const f32x2e d2 = (f32x2e){__builtin_amdgcn_exp2f(gk.x), __builtin_amdgcn_exp2f(gk.y)} + one2;
                        const f32x2e r2 = {__builtin_amdgcn_rcpf(d2.x), __builtin_amdgcn_rcpf(d2.y)};
                        h[2 * n + q] = (gk * r2) * __builtin_elementwise_fma(uq, hk2, hk2); }
                typedef unsigned u32x2e __attribute__((ext_vector_type(2)));
                u32x2e w; w.x = cvt4_fp8(h[0].x, h[0].y, h[1].x, h[1].y); w.y = cvt4_fp8(h[2].x, h[2].y, h[3].x, h[3].y);
                *(u32x2e*)rowp = w; }
    }
};
struct EpiDown8 {
    static constexpr bool PERM = true, AFTER_DRAIN = false;
    unsigned char* O; const float* bias; float inv, ys;
    __device__ __forceinline__ void operator()(const f32x4 (&acc)[2][2][4][2], const Unit& u, int wr, int wc, int fr_, int fq_) const {
        int t_ = threadIdx.x; asm volatile("" : "+v"(t_)); const int fr = t_ & 15, fq = (t_ & 63) >> 4; (void)fr_; (void)fq_;
        const int e = u.pn >> 2, pnl = u.pn & 3;
        const int row0 = u.pm * BM + wr * 64 + fr, col0 = pnl * BM + wc * 32 + 8 * fq;
        f32x4 bv[2][2];
#pragma unroll
        for (int bj = 0; bj < 2; ++bj)
#pragma unroll
            for (int n = 0; n < 2; ++n) bv[bj][n] = *(const f32x4*)(bias + (size_t)e * 1024 + col0 + bj * HALF + 4 * n) * ys;
        const float sc = inv * ys;
#pragma unroll
        for (int ai = 0; ai < 2; ++ai)
#pragma unroll
            for (int m = 0; m < 4; ++m) { unsigned char* rowp = O + (size_t)(row0 + ai * HALF + m * 16) * 1024 + col0;
#pragma unroll
                for (int bj = 0; bj < 2; ++bj) { const f32x4 v0 = acc[ai][bj][m][0] * sc + bv[bj][0], v1 = acc[ai][bj][m][1] * sc + bv[bj][1];
                    typedef unsigned u32x2e __attribute__((ext_vector_type(2)));
                    u32x2e w; w.x = cvt4_fp8(v0[0], v0[1], v0[2], v0[3]); w.y = cvt4_fp8(v1[0], v1[1], v1[2], v1[3]);
                    *(u32x2e*)(rowp + bj * HALF) = w; } }
    }
};
struct EpiQkv8 {
    static constexpr bool PERM = true, AFTER_DRAIN = false;
    bf16_t* O; size_t split_stride; float inv, scale0;
    __device__ __forceinline__ void operator()(const f32x4 (&acc)[2][2][4][2], const Unit& u, int wr, int wc, int fr_, int fq_) const {
        int t_ = threadIdx.x; asm volatile("" : "+v"(t_)); const int fr = t_ & 15, fq = (t_ & 63) >> 4; (void)fr_; (void)fq_;
        const int row0 = u.pm * BM + wr * 64 + fr; const int t = (u.pn * BM) >> 10; const int colt = u.pn * BM - (t << 10);
        bf16_t* base = O + (size_t)t * split_stride; const float sc = inv * (t == 0 ? scale0 : 1.f);
        const int col0 = colt + wc * 32 + 8 * fq;
#pragma unroll
        for (int ai = 0; ai < 2; ++ai)
#pragma unroll
            for (int m = 0; m < 4; ++m) { bf16_t* rowp = base + (size_t)(row0 + ai * HALF + m * 16) * 1024 + col0;
#pragma unroll
                for (int bj = 0; bj < 2; ++bj) { const f32x4 v0 = acc[ai][bj][m][0] * sc, v1 = acc[ai][bj][m][1] * sc;
                    u32x4 w; w.x = cvt_pk_bf16(v0[0], v0[1]); w.y = cvt_pk_bf16(v0[2], v0[3]); w.z = cvt_pk_bf16(v1[0], v1[1]); w.w = cvt_pk_bf16(v1[2], v1[3]);
                    *(u32x4*)(rowp + bj * HALF) = w; } }
    }
};
struct EpiBf16s {
    static constexpr bool PERM = true, AFTER_DRAIN = false;
    bf16_t* O; int ldc; float inv;
    __device__ __forceinline__ void operator()(const f32x4 (&acc)[2][2][4][2], const Unit& u, int wr, int wc, int fr_, int fq_) const {
        int t_ = threadIdx.x; asm volatile("" : "+v"(t_)); const int fr = t_ & 15, fq = (t_ & 63) >> 4; (void)fr_; (void)fq_;
        const int row0 = u.pm * BM + wr * 64 + fr, col0 = u.pn * BM + wc * 32 + 8 * fq;
#pragma unroll
        for (int ai = 0; ai < 2; ++ai)
#pragma unroll
            for (int m = 0; m < 4; ++m) { bf16_t* rowp = O + (size_t)(row0 + ai * HALF + m * 16) * ldc + col0;
#pragma unroll
                for (int bj = 0; bj < 2; ++bj) { const f32x4 v0 = acc[ai][bj][m][0] * inv, v1 = acc[ai][bj][m][1] * inv;
                    u32x4 w; w.x = cvt_pk_bf16(v0[0], v0[1]); w.y = cvt_pk_bf16(v0[2], v0[3]); w.z = cvt_pk_bf16(v1[0], v1[1]); w.w = cvt_pk_bf16(v1[2], v1[3]);
                    *(u32x4*)(rowp + bj * HALF) = w; } }
    }
};
struct EpiResF32s {
    static constexpr bool PERM = false, AFTER_DRAIN = false;
    const float* base; float* out; int ldc; float alpha, inv;
    __device__ __forceinline__ void operator()(const f32x4 (&acc)[2][2][4][2], const Unit& u, int wr, int wc, int fr_, int fq_) const {
        int t_ = threadIdx.x; asm volatile("" : "+v"(t_)); const int fr = t_ & 15, fq = (t_ & 63) >> 4; (void)fr_; (void)fq_;
        const int row0 = u.pm * BM + wr * 64 + fr, col0 = u.pn * BM + wc * 32 + 4 * fq;
#pragma unroll
        for (int ai = 0; ai < 2; ++ai)
#pragma unroll
            for (int m = 0; m < 4; ++m) { const size_t off = (size_t)(row0 + ai * HALF + m * 16) * ldc + col0;
                f32x4 bs[2][2];
#pragma unroll
                for (int bj = 0; bj < 2; ++bj)
#pragma unroll
                    for (int n = 0; n < 2; ++n) bs[bj][n] = *(const f32x4*)(base + off + bj * HALF + n * 16);
#pragma unroll
                for (int bj = 0; bj < 2; ++bj)
#pragma unroll
                    for (int n = 0; n < 2; ++n) *(f32x4*)(out + off + bj * HALF + n * 16) = bs[bj][n] * alpha + acc[ai][bj][m][n] * inv; }
    }
};
struct MoeOrder {
    int nT, nNl, G, c; const PG8_LAS int* tile_e;
    __device__ __forceinline__ bool next(int i, Unit& u) const {
        const int nwg = nT * nNl; const long L = (long)i * G + c; if (L >= nwg) return false;
        const int q = nwg / NXCD, r = nwg % NXCD, xcd = (int)(L % NXCD), off = (int)(L / NXCD);
        const int wgid = (xcd < r ? xcd * (q + 1) : r * (q + 1) + (xcd - r) * q) + off;
        const int pm = wgid / nNl, j = wgid % nNl;
        u.pm = pm; u.pn = tile_e[pm] * nNl + j; return true;
    }
    __device__ __forceinline__ void a_ready(const Unit&) const {}
    __device__ __forceinline__ void done(const Unit&) const {}
};
}
#ifndef PG8_SP2
#define PG8_SP2 true
#endif
#ifndef PG8_ALIGN
#define PG8_ALIGN true
#endif
#include <hip/hip_bf16.h>
#include <cmath>
namespace attn_body {
using bf16=__hip_bfloat16;
using bf16x8=__attribute__((ext_vector_type(8)))short;
using s16x4=__attribute__((ext_vector_type(4)))short;
using f32x16=__attribute__((ext_vector_type(16)))float;
using u32x4=__attribute__((ext_vector_type(4)))unsigned;
constexpr int BATCH=8,NHEAD=16,SEQ=4096,D=64,DM=NHEAD*D,XD=16;
constexpr int NW=8,QBLK=32,QB=QBLK*NW,KVBLK=64,NQB=SEQ/QB;
constexpr int ATTN_PITCH=DM, ATTN_UNIT_ROWS=QB;
__device__ __forceinline__ int crow(int r,int hi){return (r&3)+8*(r>>2)+4*hi;}
#define SBAR() __builtin_amdgcn_sched_barrier(0)
__device__ __forceinline__ void cmask(f32x16&p0,f32x16&p1,int jb,int qrel,int hi){
  const float NEG=-INFINITY; int kb=64*jb+4*hi;
  #pragma unroll
  for(int r=0;r<16;++r){int kv=kb+(r&3)+8*(r>>2); if(kv>qrel)p0[r]=NEG; if(kv+32>qrel)p1[r]=NEG;}
}

constexpr int NSLOT=3, SLOTB=10240;
constexpr int LDS_K=0, LDS_V=NSLOT*SLOTB, LDS_WS=2*NSLOT*SLOTB, LDS_OST=LDS_WS+NW*64*4, LDS_BYTES=LDS_OST+NW*4096;
constexpr float C2=0.125f*1.4426950408889634f;
__device__ __forceinline__ void glds16(const void*gsrc,unsigned lds_dst){unsigned keep;
  asm volatile("s_mov_b32 %0, m0\n\ts_mov_b32 m0, %2\n\ts_nop 0\n\tglobal_load_lds_dwordx4 %1, off\n\ts_mov_b32 m0, %0":"=&s"(keep):"v"(gsrc),"s"(lds_dst):"memory");}
__device__ __forceinline__ float max3f(float a,float b,float c){float r;asm("v_max3_f32 %0, %1, %2, %3":"=v"(r):"v"(a),"v"(b),"v"(c));return r;}
__device__ __forceinline__ float max2f(float a,float b){float r;asm("v_max_f32_e32 %0, %1, %2":"=v"(r):"v"(a),"v"(b));return r;}
__device__ __forceinline__ float fadd_s(float a,float b){float r;asm("v_add_f32_e32 %0, %1, %2":"=v"(r):"v"(a),"v"(b));return r;}
__device__ __forceinline__ float fsub_s(float a,float b){float r;asm("v_sub_f32_e32 %0, %1, %2":"=v"(r):"v"(a),"v"(b));return r;}
typedef float f32x2_t __attribute__((ext_vector_type(2))); typedef __bf16 bf16x2_t __attribute__((ext_vector_type(2)));
__device__ __forceinline__ unsigned cvtpk_s(float lo,float hi){f32x2_t v={lo,hi};bf16x2_t b=__builtin_convertvector(v,bf16x2_t);return __builtin_bit_cast(unsigned,b);}
#define WAIT_BAR(N) asm volatile("s_waitcnt vmcnt(" #N ") lgkmcnt(0)\n\ts_barrier":::"memory")

__device__ __forceinline__ void qkt(f32x16&p0,f32x16&p1,const char*Kslot,const bf16x8*qr,int r32,int hi){
  const f32x16 zz=f32x16{};
  const char*kb=Kslot+hi*1024+r32*16;
  #pragma unroll
  for(int d0=0;d0<5;++d0){
    const bf16x8 b0=*reinterpret_cast<const bf16x8*>(kb+d0*2048);
    const bf16x8 b1=*reinterpret_cast<const bf16x8*>(kb+d0*2048+512);
    if(d0==0){p0=__builtin_amdgcn_mfma_f32_32x32x16_bf16(b0,qr[0],zz,0,0,0);p1=__builtin_amdgcn_mfma_f32_32x32x16_bf16(b1,qr[0],zz,0,0,0);}
    else{p0=__builtin_amdgcn_mfma_f32_32x32x16_bf16(b0,qr[d0],p0,0,0,0);p1=__builtin_amdgcn_mfma_f32_32x32x16_bf16(b1,qr[d0],p1,0,0,0);}}
}
typedef __attribute__((address_space(3))) const char* lds_cptr;
typedef short v4i16_t __attribute__((ext_vector_type(4)));
__device__ __forceinline__ void kload8(bf16x8*kf,lds_cptr kp){
  kf[0]=*(const __attribute__((address_space(3))) bf16x8*)(kp);      kf[1]=*(const __attribute__((address_space(3))) bf16x8*)(kp+512);
  kf[2]=*(const __attribute__((address_space(3))) bf16x8*)(kp+2048); kf[3]=*(const __attribute__((address_space(3))) bf16x8*)(kp+2560);
  kf[4]=*(const __attribute__((address_space(3))) bf16x8*)(kp+4096); kf[5]=*(const __attribute__((address_space(3))) bf16x8*)(kp+4608);
  kf[6]=*(const __attribute__((address_space(3))) bf16x8*)(kp+6144); kf[7]=*(const __attribute__((address_space(3))) bf16x8*)(kp+6656);
  kf[8]=*(const __attribute__((address_space(3))) bf16x8*)(kp+8192); kf[9]=*(const __attribute__((address_space(3))) bf16x8*)(kp+8704);
}
__device__ __forceinline__ void kload2(bf16x8*kf,lds_cptr kp,int j){ kf[2*j]=*(const __attribute__((address_space(3))) bf16x8*)(kp+j*2048); kf[2*j+1]=*(const __attribute__((address_space(3))) bf16x8*)(kp+j*2048+512); }
__device__ __forceinline__ s16x4 vtr(lds_cptr p){ return __builtin_bit_cast(s16x4,__builtin_amdgcn_ds_read_tr16_b64_v4i16((__attribute__((address_space(3))) v4i16_t*)p)); }
__device__ __forceinline__ float rowmax(const f32x16&p0,const f32x16&p1){
  float a=max3f(p0[0],p0[1],p1[0]),b=max3f(p0[2],p0[3],p1[1]);a=max3f(a,p1[2],p1[3]);
  #pragma unroll
  for(int r=4;r<16;r+=4){a=max3f(a,p0[r],p0[r+1]);b=max3f(b,p0[r+2],p0[r+3]);a=max3f(a,p1[r],p1[r+1]);b=max3f(b,p1[r+2],p1[r+3]);}
  const float m=max2f(a,b);
  auto rr=__builtin_amdgcn_permlane32_swap(__float_as_uint(m),__float_as_uint(m),false,false);
  return max2f(__uint_as_float(rr[0]),__uint_as_float(rr[1]));
}
__device__ __forceinline__ void pv(f32x16*o,int vb,bf16x8 pa0,bf16x8 pa1,bf16x8 pa2,bf16x8 pa3){
  #pragma unroll
  for(int d0=0;d0<2;++d0){s16x4 lo[4],hi[4];
    #pragma unroll
    for(int ks=0;ks<4;++ks){
      asm volatile("ds_read_b64_tr_b16 %0,%1 offset:%c2":"=&v"(lo[ks]):"v"(vb),"i"(d0*4096+ks*1024):"memory");
      asm volatile("ds_read_b64_tr_b16 %0,%1 offset:%c2":"=&v"(hi[ks]):"v"(vb),"i"(d0*4096+ks*1024+512):"memory");}
    asm volatile("s_waitcnt lgkmcnt(0)":::"memory");SBAR();
    #define PK(k) (bf16x8){lo[k][0],lo[k][1],lo[k][2],lo[k][3],hi[k][0],hi[k][1],hi[k][2],hi[k][3]}
    o[d0]=__builtin_amdgcn_mfma_f32_32x32x16_bf16(pa0,PK(0),o[d0],0,0,0);
    o[d0]=__builtin_amdgcn_mfma_f32_32x32x16_bf16(pa1,PK(1),o[d0],0,0,0);
    o[d0]=__builtin_amdgcn_mfma_f32_32x32x16_bf16(pa2,PK(2),o[d0],0,0,0);
    o[d0]=__builtin_amdgcn_mfma_f32_32x32x16_bf16(pa3,PK(3),o[d0],0,0,0);
    #undef PK
  }
}

#ifndef ATTN_STORE16
#define ATTN_STORE16(p,v) (*(u32x4*)(p)=(v))
#endif
__device__ __forceinline__ void set_m(bf16x8&q4,float mneg,int hi){
  const unsigned p1=cvtpk_s(mneg,0.f)&0xffffu; const float f1=__uint_as_float(p1<<16); const float r1=mneg-f1;
  const unsigned p2=cvtpk_s(r1,0.f)&0xffffu;   const float f2=__uint_as_float(p2<<16); const float r2=r1-f2;
  const unsigned p3=cvtpk_s(r2,0.f)&0xffffu;
  u32x4 w=__builtin_bit_cast(u32x4,q4); w[3]=hi?w[3]:(p1|(p2<<16)); w[0]=hi?p3:w[0]; q4=__builtin_bit_cast(bf16x8,w);
}
template<int THRL,bool GUARD> __device__ __forceinline__ void attn_unit(int b,int h,int qb,const bf16*Q,const bf16*__restrict__ K,const bf16*__restrict__ V,bf16*O,const bf16*__restrict__ QX,const bf16*__restrict__ KX,const float*__restrict__ DG,char*shm,int ts,unsigned*qctr,unsigned*tkslot){
  int tid_o=threadIdx.x; asm volatile("":"+v"(tid_o)); const int tid=tid_o,lane=tid&63,r32=lane&31,hi=lane>>5; const int wid=__builtin_amdgcn_readfirstlane(tid>>6);
  const long rowbase=(long)b*SEQ; const int q0=qb*QB;
  const bf16*Qw=Q+(rowbase+q0+wid*QBLK)*DM+h*D;
  const bf16*Kh=K+(rowbase+(long)ts*KVBLK)*DM+h*D,*Vh=V+(rowbase+(long)ts*KVBLK)*DM+h*D;
  const unsigned lds0=(unsigned)(uintptr_t)shm;
  float*wsf=(float*)(shm+LDS_WS)+wid*64;
  const bf16*ksrc=Kh+(long)lane*DM+wid*8;
  const bf16*vsrc=Vh+(long)(16*(wid&3)+(lane>>2))*DM+(wid>>2)*32+(lane&3)*8;
  const bf16*kxsrc=KX+((rowbase+(long)ts*KVBLK+lane)*NHEAD+h)*XD+(wid&1)*8;
  const unsigned kdst=lds0+LDS_K+wid*1024, vdst=lds0+LDS_V+wid*1024, kxdst=lds0+LDS_K+8192+(wid&1)*1024;
  #define DMA_K(t,slot) do{ glds16(ksrc+(long)(t)*KVBLK*DM,(unsigned)__builtin_amdgcn_readfirstlane(kdst+(slot))); glds16(kxsrc+(long)(t)*KVBLK*NHEAD*XD,(unsigned)__builtin_amdgcn_readfirstlane(kxdst+(slot))); }while(0)
  #define DMA_V(t,slot) glds16(vsrc+(long)(t)*KVBLK*DM,(unsigned)__builtin_amdgcn_readfirstlane(vdst+(slot)))
  const int vb0=(int)(lds0+LDS_V)+((lane>>4)&1)*32+(lane&3)*8+(4*hi+((lane&15)>>2))*64;
  const char*Kbase=shm+LDS_K; bf16x8 kf[10];
  const lds_cptr shm3=(lds_cptr)shm; const lds_cptr kp0=shm3+LDS_K+hi*1024+r32*16; const lds_cptr vp0=shm3+LDS_V+((lane>>4)&1)*32+(lane&3)*8+(4*hi+((lane&15)>>2))*64;
  const int NT=(q0+QB)/KVBLK-ts;
  DMA_K(0,0);DMA_V(0,0);DMA_K(1,SLOTB);
  bf16x8 qr[5];
  #pragma unroll
  for(int d0=0;d0<4;++d0)qr[d0]=*reinterpret_cast<const bf16x8*>(&Qw[(long)r32*DM+d0*16+hi*8]);
  qr[4]=*reinterpret_cast<const bf16x8*>(&QX[((rowbase+q0+wid*QBLK+r32)*NHEAD+h)*XD+hi*8]);
  float mhat=DG[(rowbase+q0+wid*QBLK+r32)*NHEAD+h]; set_m(qr[4],-mhat,hi); asm volatile("":"+v"(qr[4]));
  float l_reg=0.f;f32x16 o[2];o[0]=f32x16{};o[1]=f32x16{};const f32x16 zero16=f32x16{};
  const int qrel=wid*QBLK+r32;
  #define CMASK(P0,P1,t) do{int jb_=(t)-(NT-4); if(jb_>=0)cmask(P0,P1,jb_,qrel,hi);}while(0)
  bool resc=false;
  #define START(P0,P1) do{ resc=false; \
    if constexpr(GUARD){ const float rm=rowmax(P0,P1); if(__any(rm>(float)THRL)){ const float dl=__builtin_fmaxf(rm,0.f); mhat+=dl; \
      _Pragma("unroll") for(int r=0;r<16;++r){P0[r]-=dl;P1[r]-=dl;} set_m(qr[4],-mhat,hi); asm volatile("":"+v"(qr[4])); } } \
    _Pragma("unroll") for(int r=0;r<16;++r)P0[r]=__builtin_amdgcn_exp2f(P0[r]); }while(0)
  #define RESC() do{ if(resc){ asm volatile("s_waitcnt lgkmcnt(0)":::"memory"); \
      _Pragma("unroll") for(int d_=0;d_<2;++d_) _Pragma("unroll") for(int r=0;r<16;++r)o[d_][r]*=wsf[crow(r,hi)]; } }while(0)
  f32x16 pA0,pA1,pB0,pB1;
  int sl_prev=0,sl_cur=0,sl_next=SLOTB;
  #define ROT() do{sl_prev=sl_cur;sl_cur=sl_next;sl_next=(sl_next==(NSLOT-1)*SLOTB)?0:sl_next+SLOTB;}while(0)
  DMA_K(2,2*SLOTB);
  WAIT_BAR(3);
  qkt(pA0,pA1,Kbase,qr,r32,hi);asm volatile("s_nop 15\n\ts_nop 7":"+v"(pA0),"+v"(pA1));CMASK(pA0,pA1,0);
  START(pA0,pA1);
  _Pragma("unroll") for(int r=0;r<16;++r)pA1[r]=__builtin_amdgcn_exp2f(pA1[r]);
  WAIT_BAR(0);
  DMA_K(3,0);DMA_V(1,SLOTB);
  ROT();
  kload8(kf,kp0+sl_cur);
  WAIT_BAR(3);
  s16x4 vlo[8],vhi[8]; u32x4 pw0,pw1,pw2,pw3;
  #define PKW(P,B) cvtpk_s(P[B],P[B+1])
  #define PAF(k) __builtin_bit_cast(bf16x8,pw##k)
  #define VFR(i) (bf16x8){vlo[i][0],vlo[i][1],vlo[i][2],vlo[i][3],vhi[i][0],vhi[i][1],vhi[i][2],vhi[i][3]}
  #define PIN(x) asm volatile("":"+v"(x))
  #define MX3(a,b,c) __builtin_fmaxf(__builtin_fmaxf((a),(b)),(c))
  #define GAPA(MF,A0,A1,A2,A3,W0,W1,PW) do{ MF; sacc+=A0; sacc+=A1; sacc+=A2; sacc+=A3; PIN(sacc); W0; W1; PIN(PW); SBAR(); }while(0)
  #define EX(v) __builtin_amdgcn_exp2f(v)
  #define GAPB(MF,X,B) do{ MF; X[B]=EX(X[B]); X[B+1]=EX(X[B+1]); X[B+2]=EX(X[B+2]); X[B+3]=EX(X[B+3]); PIN(X); SBAR(); }while(0)
  #define VRD(i) do{ vlo[i]=vtr(vp_+(((i)>>2)*4096+((i)&3)*1024)); vhi[i]=vtr(vp_+(((i)>>2)*4096+((i)&3)*1024+512)); }while(0)
  #define KRD(G,j) do{ if(G){ kload2(kf,kp0+sl_next,j); SBAR(); } }while(0)
  #define STEP(C0,C1,P0,P1,t,GK,GV,GL) do{ SBAR(); \
    const lds_cptr vp_=vp0+sl_prev; \
    VRD(0); SBAR(); float sacc=(P0[0]+P0[1]); \
    GAPA(C0=__builtin_amdgcn_mfma_f32_32x32x16_bf16(kf[0],qr[0],zero16,0,0,0), P0[2],P0[3],P0[4],P0[5],     pw0[0]=PKW(P0,0), pw0[1]=PKW(P0,2), pw0); \
    VRD(4); SBAR(); GAPA(C1=__builtin_amdgcn_mfma_f32_32x32x16_bf16(kf[1],qr[0],zero16,0,0,0), P0[6],P0[7],P0[8],P0[9],     pw0[2]=PKW(P0,4), pw0[3]=PKW(P0,6), pw0); \
    VRD(1); SBAR(); GAPA(C0=__builtin_amdgcn_mfma_f32_32x32x16_bf16(kf[2],qr[1],C0,0,0,0),   P0[10],P0[11],P0[12],P0[13], pw1[0]=PKW(P0,8), pw1[1]=PKW(P0,10), pw1); \
    VRD(5); SBAR(); GAPA(C1=__builtin_amdgcn_mfma_f32_32x32x16_bf16(kf[3],qr[1],C1,0,0,0),   P0[14],P0[15],P1[0],P1[1],   pw1[2]=PKW(P0,12),pw1[3]=PKW(P0,14), pw1); \
    VRD(2); SBAR(); GAPA(C0=__builtin_amdgcn_mfma_f32_32x32x16_bf16(kf[4],qr[2],C0,0,0,0),   P1[2],P1[3],P1[4],P1[5],     pw2[0]=PKW(P1,0), pw2[1]=PKW(P1,2), pw2); \
    VRD(6); SBAR(); GAPA(C1=__builtin_amdgcn_mfma_f32_32x32x16_bf16(kf[5],qr[2],C1,0,0,0),   P1[6],P1[7],P1[8],P1[9],     pw2[2]=PKW(P1,4), pw2[3]=PKW(P1,6), pw2); \
    VRD(3); SBAR(); GAPA(C0=__builtin_amdgcn_mfma_f32_32x32x16_bf16(kf[6],qr[3],C0,0,0,0),   P1[10],P1[11],P1[12],P1[13], pw3[0]=PKW(P1,8), pw3[1]=PKW(P1,10), pw3); \
    VRD(7); SBAR(); GAPA(C1=__builtin_amdgcn_mfma_f32_32x32x16_bf16(kf[7],qr[3],C1,0,0,0),   P1[14],P1[15],0.f,0.f,       pw3[2]=PKW(P1,12),pw3[3]=PKW(P1,14), pw3); \
    C0=__builtin_amdgcn_mfma_f32_32x32x16_bf16(kf[8],qr[4],C0,0,0,0); C1=__builtin_amdgcn_mfma_f32_32x32x16_bf16(kf[9],qr[4],C1,0,0,0); SBAR(); \
    l_reg+=sacc; \
    if(GK){DMA_K((t)+3,sl_cur);} if(GV){DMA_V((t)+1,sl_next);} \
    CMASK(C0,C1,t); \
    if constexpr(!GUARD){ resc=false; } else { float a=MX3(C0[0],C0[1],C1[0]),b=MX3(C0[2],C0[3],C1[1]); a=MX3(a,C1[2],C1[3]); \
      _Pragma("unroll") for(int r=4;r<16;r+=4){a=MX3(a,C0[r],C0[r+1]);b=MX3(b,C0[r+2],C0[r+3]);a=MX3(a,C1[r],C1[r+1]);b=MX3(b,C1[r+2],C1[r+3]);} \
      float rm=__builtin_fmaxf(a,b); { auto rr=__builtin_amdgcn_permlane32_swap(__float_as_uint(rm),__float_as_uint(rm),false,false); rm=__builtin_fmaxf(__uint_as_float(rr[0]),__uint_as_float(rr[1])); } \
      resc=false; \
      if(__builtin_expect(__any(rm>(float)THRL),0)){ const float dl=__builtin_fmaxf(rm,0.f); mhat+=dl; \
        _Pragma("unroll") for(int r=0;r<16;++r){C0[r]-=dl;C1[r]-=dl;} \
        set_m(qr[4],-mhat,hi); asm volatile("":"+v"(qr[4])); \
        const float f=__builtin_amdgcn_exp2f(-dl); l_reg*=f; if(hi==0)wsf[r32]=f; resc=true; } } \
    SBAR(); \
    GAPB(o[0]=__builtin_amdgcn_mfma_f32_32x32x16_bf16(PAF(0),VFR(0),o[0],0,0,0), C0,0); \
    GAPB(o[1]=__builtin_amdgcn_mfma_f32_32x32x16_bf16(PAF(0),VFR(4),o[1],0,0,0), C0,4); \
    KRD(GL,0); GAPB(o[0]=__builtin_amdgcn_mfma_f32_32x32x16_bf16(PAF(1),VFR(1),o[0],0,0,0), C0,8); \
    KRD(GL,1); GAPB(o[1]=__builtin_amdgcn_mfma_f32_32x32x16_bf16(PAF(1),VFR(5),o[1],0,0,0), C0,12); \
    KRD(GL,2); GAPB(o[0]=__builtin_amdgcn_mfma_f32_32x32x16_bf16(PAF(2),VFR(2),o[0],0,0,0), C1,0); \
    KRD(GL,3); GAPB(o[1]=__builtin_amdgcn_mfma_f32_32x32x16_bf16(PAF(2),VFR(6),o[1],0,0,0), C1,4); \
    KRD(GL,4); GAPB(o[0]=__builtin_amdgcn_mfma_f32_32x32x16_bf16(PAF(3),VFR(3),o[0],0,0,0), C1,8); \
    GAPB(o[1]=__builtin_amdgcn_mfma_f32_32x32x16_bf16(PAF(3),VFR(7),o[1],0,0,0), C1,12); \
    }while(0)
  int t=1;
  #undef CMASK
  #define CMASK(P0,P1,t) do{}while(0)
  for(;t+5<NT;t+=2){
    STEP(pB0,pB1,pA0,pA1,t,true,true,true);     WAIT_BAR(3); RESC(); ROT();
    STEP(pA0,pA1,pB0,pB1,t+1,true,true,true);   WAIT_BAR(3); RESC(); ROT();
  }
  #undef CMASK
  #define CMASK(P0,P1,t) do{int jb_=(t)-(NT-4); if(jb_>=0)cmask(P0,P1,jb_,qrel,hi);}while(0)
  #define ENDW(tt) do{ if((tt)+3<NT){WAIT_BAR(3);} else if((tt)+2<NT){WAIT_BAR(1);} else {WAIT_BAR(0);} }while(0)
  for(;t+1<NT;t+=2){
    STEP(pB0,pB1,pA0,pA1,t,(t+3<NT),(t+1<NT),(t+1<NT));       ENDW(t);   RESC(); ROT();
    STEP(pA0,pA1,pB0,pB1,t+1,(t+4<NT),(t+2<NT),(t+2<NT));     ENDW(t+1); RESC(); ROT();
  }
  STEP(pB0,pB1,pA0,pA1,NT-1,false,false,false); RESC();
  { float sacc=pB0[0]+pB0[1]; _Pragma("unroll") for(int r=2;r<16;++r)sacc+=pB0[r]; _Pragma("unroll") for(int r=0;r<16;++r)sacc+=pB1[r]; l_reg+=sacc;
    pw0=(u32x4){PKW(pB0,0),PKW(pB0,2),PKW(pB0,4),PKW(pB0,6)};pw1=(u32x4){PKW(pB0,8),PKW(pB0,10),PKW(pB0,12),PKW(pB0,14)};pw2=(u32x4){PKW(pB1,0),PKW(pB1,2),PKW(pB1,4),PKW(pB1,6)};pw3=(u32x4){PKW(pB1,8),PKW(pB1,10),PKW(pB1,12),PKW(pB1,14)};
    SBAR(); pv(o,vb0+sl_cur,PAF(0),PAF(1),PAF(2),PAF(3)); }
  #undef PKW
  #undef PAF
  #undef VFR
  #undef PIN
  #undef MX3
  #undef GAPA
  #undef GAPB
  #undef EX
  #undef VRD
  #undef KRD
  #undef STEP
  #undef ENDW
  unsigned nxt_tk=0u; if(tid==0)nxt_tk=__hip_atomic_fetch_add(qctr,1u,__ATOMIC_RELAXED,__HIP_MEMORY_SCOPE_AGENT);
  {auto rr=__builtin_amdgcn_permlane32_swap(__float_as_uint(l_reg),__float_as_uint(l_reg),false,false);l_reg=__uint_as_float(rr[0])+__uint_as_float(rr[1]);}
  if(hi==0)wsf[32+r32]=l_reg;asm volatile("s_waitcnt lgkmcnt(0)":::"memory");
  float rli[16];
  #pragma unroll
  for(int r=0;r<16;++r)rli[r]=__builtin_amdgcn_rcpf(wsf[32+crow(r,hi)]);
  { unsigned char*stg=(unsigned char*)(shm+LDS_OST)+wid*2048;
    #pragma unroll
    for(int r=0;r<16;++r){const int orow=crow(r,hi); const float sc=rli[r]*32.0f;
      const unsigned pkd=(unsigned)__builtin_amdgcn_cvt_pk_fp8_f32(o[0][r]*sc,o[1][r]*sc,0,false);
      stg[orow*64+r32]=(unsigned char)(pkd&0xffu); stg[orow*64+32+r32]=(unsigned char)((pkd>>8)&0xffu);}
    asm volatile("s_waitcnt lgkmcnt(0)":::"memory");
    unsigned char*Ow8=(unsigned char*)O+(rowbase+q0+wid*QBLK)*DM+h*D;
    #pragma unroll
    for(int i=0;i<2;++i){const int row=i*16+(lane>>2),ch=lane&3; const u32x4 v=*(const u32x4*)(stg+row*64+ch*16); ATTN_STORE16(Ow8+(long)row*DM+ch*16,v);} }
  if(tid==0)*tkslot=nxt_tk;
  asm volatile("s_waitcnt lgkmcnt(0)\n\ts_barrier":::"memory");
  #undef DMA_K
  #undef DMA_V
  #undef CMASK
  #undef START
  #undef RESC
  #undef ROT
}
constexpr int ATTN_LDS_BYTES=LDS_BYTES;
struct AttnTensors { const bf16* Q; const bf16* K; const bf16* V; bf16* O; const bf16* QX; const bf16* KX; const float* DG; };
struct AttnUnit { int bh; int qb; };
struct StaticOrder {
  int vcu, G;
  __device__ __forceinline__ explicit StaticOrder(int grid,int block):vcu((grid%8==0)?(block%8)*(grid/8)+block/8:block),G(grid){}
  __device__ __forceinline__ bool next(int i,AttnUnit&u)const{
    if(G==256){ if(i>=8)return false; const int s=vcu&1,p=i>>1,j=i&1; u.bh=vcu>>1; u.qb=4*p+(j?3-s:s); return true; }
    const int L=i*G+vcu; if(L>=BATCH*NHEAD*NQB)return false; u.bh=L%(BATCH*NHEAD); u.qb=NQB-1-L/(BATCH*NHEAD); return true; }
  __device__ __forceinline__ void a_ready(const AttnUnit&)const{}
  __device__ __forceinline__ void done(const AttnUnit&)const{}
};
template<int THRL=8> __device__ __forceinline__ void attn_phase(char*lds,const AttnTensors&T,unsigned*qctr,const unsigned char*ts_glob){
  unsigned*tkslot=(unsigned*)(lds+LDS_BYTES); unsigned char*tstab=(unsigned char*)(lds+LDS_BYTES+64);
  { const int tid=threadIdx.x; ((unsigned*)tstab)[tid]=((const unsigned*)ts_glob)[tid];
    if(tid==0)*tkslot=__hip_atomic_fetch_add(qctr,1u,__ATOMIC_RELAXED,__HIP_MEMORY_SCOPE_AGENT); }
  __syncthreads();
  for(;;){ const unsigned u=(unsigned)__builtin_amdgcn_readfirstlane((int)*(volatile __attribute__((address_space(3))) unsigned*)tkslot); if(u>=(unsigned)(BATCH*NHEAD*NQB))break;
    const int qb=NQB-1-(int)(u>>7), bh=(int)(u&127); const int tsv=__builtin_amdgcn_readfirstlane((int)tstab[bh*NQB+qb]); const int ts=tsv&~1;
    if(tsv&1) attn_unit<THRL,true>(bh/NHEAD,bh%NHEAD,qb,T.Q,T.K,T.V,T.O,T.QX,T.KX,T.DG,lds,ts,qctr,tkslot);
    else      attn_unit<THRL,false>(bh/NHEAD,bh%NHEAD,qb,T.Q,T.K,T.V,T.O,T.QX,T.KX,T.DG,lds,ts,qctr,tkslot); }
  __syncthreads();
}
#undef SBAR
#undef WAIT_BAR
}

constexpr int NWAVES = 8;
#ifndef MK_N_LAUNCHES
#define MK_N_LAUNCHES 1
#endif
constexpr int BATCH = 8, T = 4096, D = 1024, M = BATCH * T;
constexpr int A_H = 16, A_RQ = 256, A_RKV = 128, IDX_H = 8, IDX_D = 64, A_INW = 456, TOPK = 256;
constexpr int B_INW = 3088;
constexpr int NEXP = 32, MOE_K = 4, DEXP = 1024;
constexpr int NPAIR = M * MOE_K;
constexpr int MAXSLOT = NPAIR + NEXP * 256;
constexpr float LN_EPS = 1e-5f, RMS_EPS = 1e-6f;
constexpr float DN_ALPHA = 1.41421356237309515f;
constexpr float LOG2E = 1.4426950408889634f;
constexpr int N_PHASES = 19;

constexpr size_t MiB = 1u << 20;
constexpr size_t WS_CTL = 0, CTL_ZERO_BYTES = 1 * MiB;
constexpr size_t WS_SMALL = 1 * MiB;
constexpr size_t WS_WAIN = 2 * MiB, WS_WACQ = 3 * MiB, WS_WAO = 5 * MiB, WS_WBIN = 9 * MiB, WS_WBO = 15 * MiB;
constexpr size_t WS_PAR = 18 * MiB;
constexpr int PAR_REL = 0, PAR_AGQ = 512, PAR_AGKV = 768, PAR_AGKI = 896, PAR_ABKI = 960, PAR_BF = 1024, PAR_BROUT = 1088, PAR_LN = 2048  ,
              PAR_WROUT = 16384  , PAR_WF = 81920  , PAR_BGU = 98304  , PAR_BDOWN = 229376  , PAR_END = 294912;
static_assert((size_t)PAR_END * 4 <= 2 * MiB, "parameter copies");
constexpr size_t WS_TOKE = 20 * MiB;
constexpr size_t WS_WGU = 32 * MiB, WS_WD = 288 * MiB;
constexpr size_t WS_XF = 416 * MiB, WS_XB = 544 * MiB;
constexpr size_t WS_PROJ = 608 * MiB, WS_CQN = 672 * MiB, WS_CKV = 688 * MiB, WS_KIDX = 696 * MiB, WS_WIDX = 700 * MiB, WS_BKT = 701 * MiB  , WS_SEL = 712 * MiB  ,
                 WS_QIDX = 736 * MiB, WS_QLAT = 768 * MiB, WS_OLAT = 896 * MiB;
constexpr size_t WS_Q = 608 * MiB, WS_K = 672 * MiB, WS_V = 736 * MiB, WS_LOGF = 800 * MiB, WS_QX = 802 * MiB, WS_KX = 818 * MiB, WS_O = 834 * MiB, WS_CUM2 = 898 * MiB  , WS_KMAX = 900 * MiB  , WS_TS = 901 * MiB  , WS_DG = 902 * MiB  ;
constexpr size_t WS_TOPE = 1024 * MiB, WS_TOPG = 1025 * MiB, WS_POS = 1026 * MiB, WS_SLOT = 1027 * MiB, WS_TOK = 1027 * MiB + 512 * 1024  ;
constexpr size_t WS_XG = 1028 * MiB, WS_H = 1300 * MiB, WS_Y = 1572 * MiB  , WS_XB8 = 1700 * MiB  , WS_END = 1732 * MiB;
constexpr float F8_XS = 8.f, F8_WGS = 512.f, F8_HS = 4.f, F8_WDS = 1024.f, F8_WBINS = 512.f, F8_OLS = 32.f, F8_WAOS = 1024.f, F8_YS = 32.f, F8_OS = 32.f, F8_WBOS = 1024.f;
static_assert((size_t)MAXSLOT * 1024 * 2 <= 272 * MiB, "slot buffers");
constexpr int CW_TMO = 0, CW_CODE = 1;
constexpr int CW_BAR = 4096;
constexpr int CW_CMAX = 20416;
constexpr int CW_QMAX = 20480, CW_MNEG = 22528, CW_ATTQ = 24576;
constexpr int CW_CNT = 16384;
constexpr int SM_NT = 0, SM_TILE_E = 64;
constexpr int RING_OFF = 0, RING_BYTES = 131072;
constexpr int LDS_BYTES = 147456;
constexpr int MISC_OFF = LDS_BYTES - 256;
#define GAS __attribute__((address_space(1)))
#define LAS __attribute__((address_space(3)))
typedef unsigned short bf16;
typedef unsigned v4u __attribute__((ext_vector_type(4)));
typedef float f32x4 __attribute__((ext_vector_type(4)));
typedef short bf16x8 __attribute__((ext_vector_type(8)));
typedef GAS unsigned gu32;
typedef GAS unsigned long long gu64;
#define RLX_AGENT __ATOMIC_RELAXED, __HIP_MEMORY_SCOPE_AGENT
#define LDS_WAIT() asm volatile("s_waitcnt lgkmcnt(0)" ::: "memory")
#define VM_WAIT() asm volatile("s_waitcnt vmcnt(0)" ::: "memory")
__device__ __forceinline__ unsigned long long rt() { return __builtin_amdgcn_s_memrealtime(); }
__device__ __forceinline__ unsigned f2bf(float f) { unsigned u = __builtin_bit_cast(unsigned, f); return (u + 0x7fffu + ((u >> 16) & 1u)) >> 16; }
__device__ __forceinline__ unsigned pk2(float lo, float hi) { return f2bf(lo) | (f2bf(hi) << 16); }

#define XB_TMO      128
#define XB_XCNT(j)  (256  + 64 * (j))
#define XB_XSUB(j)  (1280 + 64 * (j))
#define XB_XGEN(j)  (2304 + 64 * (j))
#define XB_TOP      3328
#define XB_TOPGEN   3392
#define XCD_BAR_WORDS 3456
#define XB_SPIN_CAP (1u << 18)

__device__ __forceinline__ unsigned xb_ld(unsigned* p)              { return __hip_atomic_load(p, __ATOMIC_RELAXED, __HIP_MEMORY_SCOPE_AGENT); }
__device__ __forceinline__ unsigned xb_add(unsigned* p, unsigned v) { return __hip_atomic_fetch_add(p, v, __ATOMIC_RELAXED, __HIP_MEMORY_SCOPE_AGENT); }
__device__ __forceinline__ unsigned xb_xcc_id() { return (unsigned)__builtin_amdgcn_s_getreg((3 << 11) | 20) & 0xFu; }
#define XB_SPIN(cond, bar) do { unsigned _sp = 0; while (cond) { __builtin_amdgcn_s_sleep(1); \
    if ((++_sp & 255u) == 0u) { if (xb_ld(&(bar)[XB_TMO])) break; if (_sp > XB_SPIN_CAP) { atomicAdd(&(bar)[XB_TMO], 1u); break; } } } } while (0)

struct XcdBarrier {
    unsigned* bar; unsigned x;
    volatile LAS unsigned* st;
};

__device__ __forceinline__ XcdBarrier xcd_barrier_post(unsigned* bar, volatile LAS unsigned* st) {
    XcdBarrier b; b.bar = bar; b.x = xb_xcc_id(); b.st = st;
    if (threadIdx.x == 0) (void)xb_add(&bar[XB_XCNT(b.x)], 1u);
    return b;
}
__device__ __forceinline__ void xcd_barrier_complete(unsigned* bar, unsigned x, unsigned& nloc, unsigned& nx) {
    const unsigned G = gridDim.x * gridDim.y * gridDim.z;
    unsigned sum, cnt, mine, sp = 0u;
    for (;;) {
        sum = 0u; cnt = 0u; mine = 0u;
#pragma unroll
        for (unsigned j = 0; j < 16; ++j) { const unsigned c = xb_ld(&bar[XB_XCNT(j)]); sum += c; cnt += (c > 0u) ? 1u : 0u; mine = (j == x) ? c : mine; }
        if (sum == G) break;
        __builtin_amdgcn_s_sleep(1);
        if ((++sp & 255u) == 0u) { if (xb_ld(&bar[XB_TMO])) break; if (sp > XB_SPIN_CAP) { atomicAdd(&bar[XB_TMO], 1u); break; } }
    }
    nloc = mine > 0u ? mine : 1u; nx = cnt > 0u ? cnt : 1u;
}

__device__ __forceinline__ void xcd_barrier(const XcdBarrier& b) {
    asm volatile("s_waitcnt vmcnt(0)" ::: "memory");
    __syncthreads();
    if (threadIdx.x == 0) {
        unsigned* bar = b.bar;
        __builtin_amdgcn_s_waitcnt(0);
        unsigned nloc = b.st[0], nx = b.st[1];
        if (nloc == 0u) { xcd_barrier_complete(bar, b.x, nloc, nx); b.st[0] = nloc; b.st[1] = nx; }
        const unsigned old = xb_add(&bar[XB_XSUB(b.x)], 1u);
        const unsigned gen = old / nloc;
        if (old + 1u == (gen + 1u) * nloc) {
            __builtin_amdgcn_fence(__ATOMIC_RELEASE, "agent");
            asm volatile("s_waitcnt vmcnt(0)" ::: "memory");
            const unsigned og = xb_add(&bar[XB_TOP], 1u);
            const unsigned tg = og / nx;
            if (og + 1u == (tg + 1u) * nx) xb_add(&bar[XB_TOPGEN], 1u);
            else XB_SPIN(xb_ld(&bar[XB_TOPGEN]) == tg, bar);
            __builtin_amdgcn_fence(__ATOMIC_ACQUIRE, "agent");
            xb_add(&bar[XB_XGEN(b.x)], 1u);
            asm volatile("s_waitcnt vmcnt(0)" ::: "memory");
        } else {
            XB_SPIN(xb_ld(&bar[XB_XGEN(b.x)]) == gen, bar);
            __builtin_amdgcn_fence(__ATOMIC_ACQUIRE, "agent");
            asm volatile("s_waitcnt vmcnt(0)" ::: "memory");
        }
    }
    __syncthreads();
}

struct Frame {
    LAS unsigned char* lds;
    volatile LAS unsigned* MISC;
    gu32* ctl;
    int vcu, G;
    unsigned char* ws;
};
__device__ __forceinline__ int opaque_tid() { int t = threadIdx.x; asm volatile("" : "+v"(t)); return t; }
#define PHASE_IDS() const int tid = opaque_tid(), lane = tid & 63, wave = __builtin_amdgcn_readfirstlane(tid >> 6); (void)lane; (void)wave
typedef float f32x2 __attribute__((ext_vector_type(2)));
typedef unsigned u32x4 __attribute__((ext_vector_type(4)));
typedef unsigned u32x2 __attribute__((ext_vector_type(2)));
__device__ __forceinline__ float wave_sum(float x) {
    float v = x;
#define WS_STEP(ctrl, rmask) v += __builtin_bit_cast(float, __builtin_amdgcn_update_dpp(0, __builtin_bit_cast(int, v), ctrl, rmask, 0xf, false))
    WS_STEP(0x111, 0xf); WS_STEP(0x112, 0xf); WS_STEP(0x114, 0xf); WS_STEP(0x118, 0xf); WS_STEP(0x142, 0xa); WS_STEP(0x143, 0xc);
#undef WS_STEP
    return __builtin_bit_cast(float, __builtin_amdgcn_readlane(__builtin_bit_cast(int, v), 63));
}
__device__ __forceinline__ unsigned cvtpk(float lo, float hi) { typedef __bf16 bf2 __attribute__((ext_vector_type(2))); f32x2 v = {lo, hi}; bf2 b = __builtin_convertvector(v, bf2); return __builtin_bit_cast(unsigned, b); }
__device__ __forceinline__ float bf2f(unsigned short h) { return __uint_as_float((unsigned)h << 16); }

struct TrItem { const float* W; int ldw, nvalid, K; unsigned char* WT; int row_off, mode, f8; float fscale; int k0, n0; };
__device__ __forceinline__ void tr_load(const TrItem& t, f32x4 (&v)[8][2], int lane, int wave) {
#pragma unroll
    for (int i = 0; i < 8; ++i)
#pragma unroll
        for (int j = 0; j < 2; ++j) { const int n = t.n0 + 4 * lane + (t.f8 ? 0 : 256 * j); const int k = t.k0 + (t.f8 ? wave * 16 + 2 * i + j : wave * 8 + i);
            v[i][j] = (n < t.nvalid) ? __builtin_nontemporal_load((const f32x4*)(t.W + (size_t)k * t.ldw + n)) : (f32x4){0.f, 0.f, 0.f, 0.f}; }
}
__device__ __forceinline__ void tr_to_lds(const TrItem& t, const f32x4 (&v)[8][2], LAS float* scr, int lane, int wave) {
#pragma unroll
    for (int i = 0; i < 8; ++i)
#pragma unroll
        for (int j = 0; j < 2; ++j) { LAS float* d = t.f8 ? scr + (wave * 16 + 2 * i + j) * 257 + 4 * lane : scr + (wave * 8 + i) * 513 + 4 * lane + 256 * j; d[0] = v[i][j].x; d[1] = v[i][j].y; d[2] = v[i][j].z; d[3] = v[i][j].w; }
}
__device__ __forceinline__ void tr_store(const TrItem& t, LAS float* scr, int tid) {
    const int c = tid & 7;
    if (t.f8) {
        const float fs = t.fscale;
#pragma unroll
        for (int j = 0; j < 4; ++j) { const int n = (tid >> 3) + 64 * j; const LAS float* s = scr + (16 * c) * 257 + n;
            const int ng = t.n0 + n; int row;
            if (t.mode == 0) row = t.row_off + ng; else { const int np = ng & 1023; row = (np >> 7) * 256 + ((ng >> 10) << 7) + (np & 127); }
            v4u o; o.x = pg8::cvt4_fp8(s[0 * 257] * fs, s[1 * 257] * fs, s[2 * 257] * fs, s[3 * 257] * fs); o.y = pg8::cvt4_fp8(s[4 * 257] * fs, s[5 * 257] * fs, s[6 * 257] * fs, s[7 * 257] * fs);
            o.z = pg8::cvt4_fp8(s[8 * 257] * fs, s[9 * 257] * fs, s[10 * 257] * fs, s[11 * 257] * fs); o.w = pg8::cvt4_fp8(s[12 * 257] * fs, s[13 * 257] * fs, s[14 * 257] * fs, s[15 * 257] * fs);
            *(GAS v4u*)(t.WT + (size_t)row * t.K + t.k0 + 16 * c) = o; }
        return; }
#pragma unroll
    for (int j = 0; j < 8; ++j) { const int n = (tid >> 3) + 64 * j; const LAS float* s = scr + (8 * c) * 513 + n;
        const int ng = t.n0 + n; int row;
        if (t.mode == 0) row = t.row_off + ng; else { const int np = ng & 1023; row = (np >> 7) * 256 + ((ng >> 10) << 7) + (np & 127); }
        v4u o; o.x = pk2(s[0 * 513], s[1 * 513]); o.y = pk2(s[2 * 513], s[3 * 513]); o.z = pk2(s[4 * 513], s[5 * 513]); o.w = pk2(s[6 * 513], s[7 * 513]);
        *(GAS v4u*)(t.WT + ((size_t)row * t.K + t.k0 + 8 * c) * 2) = o; }
}
struct P0In { const float *x, *a_w_in, *a_w_uq, *a_w_uk, *a_w_uv, *a_w_qidx, *a_w_o, *b_w_in, *b_w_o, *w_gu, *w_down;
              const float *rel, *a_g_q, *a_g_kv, *a_g_kidx, *a_b_kidx, *b_b_f, *ln_mix_g, *ln_mix_b, *ln_ffn_g, *ln_ffn_b, *w_router, *b_router, *b_gu, *b_down; };
__device__ __forceinline__ void p0_copy(float* dst, const float* src, int n, int g0, int gs) { for (int i = g0; i < n; i += gs) dst[i] = src[i]; }
__device__ __forceinline__ void p0_prologue(Frame& F, const P0In& I) {
    PHASE_IDS();
    bf16* WAIN = (bf16*)(F.ws + WS_WAIN); bf16* WACQ = (bf16*)(F.ws + WS_WACQ); bf16* WAO = (bf16*)(F.ws + WS_WAO); bf16* WBIN = (bf16*)(F.ws + WS_WBIN); bf16* WBO = (bf16*)(F.ws + WS_WBO);
    bf16* WGU = (bf16*)(F.ws + WS_WGU); bf16* WD = (bf16*)(F.ws + WS_WD); bf16* XB = (bf16*)(F.ws + WS_XB);
#ifndef MK_P0_REP
#define MK_P0_REP 0
#endif
    for (int rep0 = 0; rep0 < 1 + (MK_P0_REP & 1); ++rep0)
    for (int it = F.vcu; it < 128 + 256; it += F.G) {
        if (it < 128) {
            const int h = it >> 3, rb = it & 7; const int rq = tid & 255, rs = wave >> 2;
            float q[64];
            const GAS f32x4* qp = (const GAS f32x4*)(I.a_w_uq + ((size_t)rq * A_H + h) * 64);
#pragma unroll
            for (int i = 0; i < 16; ++i) { const f32x4 v = qp[i]; q[4 * i] = v.x; q[4 * i + 1] = v.y; q[4 * i + 2] = v.z; q[4 * i + 3] = v.w; }
            for (int j = 0; j < 8; ++j) { const int r = rb * 16 + rs * 8 + j; const float* kp = I.a_w_uk + ((size_t)r * A_H + h) * 64; float s = 0.f;
#pragma unroll
                for (int d = 0; d < 64; ++d) s += q[d] * kp[d];
                WACQ[(size_t)(h * 128 + r) * 256 + rq] = (bf16)f2bf(s * (0.125f * LOG2E)); }
        } else {
            const int i2 = it - 128, h = i2 >> 4, nc = i2 & 15; LAS float* wo = (LAS float*)F.lds; LAS float* wuv = wo + 4096;
#pragma unroll
            for (int i = 0; i < 8; ++i) { const int idx = tid + 512 * i, d = idx >> 6, n = idx & 63; wo[idx] = I.a_w_o[(size_t)(h * 64 + d) * D + nc * 64 + n]; }
#pragma unroll
            for (int i = 0; i < 16; ++i) { const int idx = tid + 512 * i, r = idx >> 6, d = idx & 63; wuv[idx] = I.a_w_uv[((size_t)r * A_H + h) * 64 + d]; }
            LDS_WAIT(); __syncthreads();
            const int nl = tid & 63, rg = wave; float acc[16];
#pragma unroll
            for (int i = 0; i < 16; ++i) acc[i] = 0.f;
#pragma unroll 8
            for (int d = 0; d < 64; ++d) { const float w = wo[d * 64 + nl];
#pragma unroll
                for (int i = 0; i < 16; ++i) acc[i] += wuv[(rg * 16 + i) * 64 + d] * w; }
#pragma unroll
            for (int i = 0; i < 16; ++i) acc[i] *= F8_WAOS;
            v4u o0; o0.x = pg8::cvt4_fp8(acc[0], acc[1], acc[2], acc[3]); o0.y = pg8::cvt4_fp8(acc[4], acc[5], acc[6], acc[7]); o0.z = pg8::cvt4_fp8(acc[8], acc[9], acc[10], acc[11]); o0.w = pg8::cvt4_fp8(acc[12], acc[13], acc[14], acc[15]);
            *(GAS v4u*)((unsigned char*)WAO + (size_t)(nc * 64 + nl) * 2048 + h * 128 + rg * 16) = o0;
            __syncthreads();
        }
    }
    __syncthreads();
    LAS float* scr = (LAS float*)(F.lds + RING_OFF);
    constexpr int I_AIN = 16 * 1, I_QIDX = 4 * 1, I_BIN = 8 * 12, I_BO = 8 * 4, I_GU1 = 8 * 8, I_D1 = 8 * 4;
    constexpr int I_GU = 64 * I_GU1, I_DN = 64 * I_D1;
    constexpr int NITEMS = I_AIN + I_QIDX + I_BIN + I_BO + I_GU + I_DN;
    auto decode = [&](int it) -> TrItem {
        TrItem t; int r = it; t.mode = 0; t.f8 = 0; t.fscale = 1.f; t.row_off = 0;
        if (r < I_AIN) { t.W = I.a_w_in; t.ldw = A_INW; t.nvalid = A_INW; t.K = 1024; t.WT = (unsigned char*)WAIN; t.k0 = 64 * r; t.n0 = 0; return t; } r -= I_AIN;
        if (r < I_QIDX) { t.W = I.a_w_qidx; t.ldw = 512; t.nvalid = 512; t.K = 256; t.WT = (unsigned char*)WACQ; t.row_off = 2048; t.k0 = 64 * r; t.n0 = 0; return t; } r -= I_QIDX;
        if (r < I_BIN) { t.W = I.b_w_in; t.ldw = B_INW; t.nvalid = 3072; t.K = 1024; t.WT = (unsigned char*)WBIN; t.f8 = 1; t.fscale = F8_WBINS; t.k0 = 128 * (r / 12); t.n0 = 256 * (r % 12); return t; } r -= I_BIN;
        if (r < I_BO) { t.W = I.b_w_o; t.ldw = 1024; t.nvalid = 1024; t.K = 1024; t.WT = (unsigned char*)WBO; t.f8 = 1; t.fscale = F8_WBOS; t.k0 = 128 * (r / 4); t.n0 = 256 * (r % 4); return t; } r -= I_BO;
        if (r < I_GU) { const int mi = r / I_GU1, rr = r % I_GU1; t.W = I.w_gu + (size_t)mi * 1024 * 2048; t.ldw = 2048; t.nvalid = 2048; t.K = 1024; t.WT = (unsigned char*)WGU + (size_t)mi * 2048 * 1024; t.mode = 1; t.f8 = 1; t.fscale = F8_WGS;
            t.k0 = 128 * (rr / 8); t.n0 = 256 * (rr % 8); return t; } r -= I_GU;
        { const int mi = r / I_D1, rr = r % I_D1; t.W = I.w_down + (size_t)mi * 1024 * 1024; t.ldw = 1024; t.nvalid = 1024; t.K = 1024; t.WT = (unsigned char*)WD + (size_t)mi * 1024 * 1024; t.f8 = 1; t.fscale = F8_WDS;
            t.k0 = 128 * (rr / 4); t.n0 = 256 * (rr % 4); return t; }
    };
    for (int rep1 = 0; rep1 < 1 + ((MK_P0_REP >> 1) & 1); ++rep1) {
        f32x4 v[8][2]; int it = F.vcu;
        if (it < NITEMS) { const TrItem t0 = decode(it); tr_load(t0, v, lane, wave); }
        for (; it < NITEMS; it += F.G) {
            const TrItem t = decode(it);
            tr_to_lds(t, v, scr, lane, wave);
            LDS_WAIT(); __syncthreads();
            if (it + F.G < NITEMS) { const TrItem tn = decode(it + F.G); tr_load(tn, v, lane, wave); }
            tr_store(t, scr, tid);
            LDS_WAIT(); __syncthreads();
        }
    }
    { float* PAR = (float*)(F.ws + WS_PAR); const int g0 = F.vcu * 512 + tid, gs = F.G * 512;
      p0_copy(PAR + PAR_REL, I.rel, 512, g0, gs); p0_copy(PAR + PAR_AGQ, I.a_g_q, 256, g0, gs); p0_copy(PAR + PAR_AGKV, I.a_g_kv, 128, g0, gs); p0_copy(PAR + PAR_AGKI, I.a_g_kidx, 64, g0, gs);
      p0_copy(PAR + PAR_ABKI, I.a_b_kidx, 64, g0, gs); p0_copy(PAR + PAR_BF, I.b_b_f, 16, g0, gs); p0_copy(PAR + PAR_BROUT, I.b_router, 64, g0, gs);
      p0_copy(PAR + PAR_LN, I.ln_mix_g, 2048, g0, gs); p0_copy(PAR + PAR_LN + 2048, I.ln_mix_b, 2048, g0, gs); p0_copy(PAR + PAR_LN + 4096, I.ln_ffn_g, 2048, g0, gs); p0_copy(PAR + PAR_LN + 6144, I.ln_ffn_b, 2048, g0, gs);
      p0_copy(PAR + PAR_WROUT, I.w_router, 65536, g0, gs); p0_copy(PAR + PAR_BGU, I.b_gu, 131072, g0, gs); p0_copy(PAR + PAR_BDOWN, I.b_down, 65536, g0, gs);
      for (int i = g0; i < 16384; i += gs) PAR[PAR_WF + i] = I.b_w_in[(size_t)(i >> 4) * B_INW + 3072 + (i & 15)]; }
    { const size_t n8 = (size_t)M * D / 8; const size_t g0 = (size_t)F.vcu * 512 + tid, gs = (size_t)F.G * 512;
      for (int rep2 = 0; rep2 < 1 + ((MK_P0_REP >> 2) & 1); ++rep2)
      for (size_t i = g0; i < n8; i += 4 * gs) { f32x4 a[4], b[4];
#pragma unroll
          for (int q = 0; q < 4; ++q) { const size_t ii = i + q * gs; if (ii < n8) { const GAS f32x4* p = (const GAS f32x4*)(I.x + ii * 8); a[q] = __builtin_nontemporal_load(p); b[q] = __builtin_nontemporal_load(p + 1); } }
#pragma unroll
          for (int q = 0; q < 4; ++q) { const size_t ii = i + q * gs; if (ii < n8) { v4u o; o.x = pk2(a[q].x, a[q].y); o.y = pk2(a[q].z, a[q].w); o.z = pk2(b[q].x, b[q].y); o.w = pk2(b[q].z, b[q].w); *(GAS v4u*)(XB + ii * 8) = o; } } } }
}

__device__ __forceinline__ void p_dsa_norms(Frame& F, const float* g_q, const float* g_kv, const float* g_kidx, const float* b_kidx) {
    PHASE_IDS();
    const float* PROJ = (const float*)(F.ws + WS_PROJ); bf16* CQN = (bf16*)(F.ws + WS_CQN); bf16* CKV = (bf16*)(F.ws + WS_CKV); bf16* KIDX = (bf16*)(F.ws + WS_KIDX); float* WIDX = (float*)(F.ws + WS_WIDX);
    const int l = lane; const int gw = F.vcu * NWAVES + wave, NGW = F.G * NWAVES;
    const f32x4 gq = *(const f32x4*)(g_q + 4 * l); const f32x2 gkv = *(const f32x2*)(g_kv + 2 * l); const float gki = g_kidx[l], bki = b_kidx[l];
    float cmx = 0.f;
    f32x4 cq_n = {0.f, 0.f, 0.f, 0.f}; f32x2 ckv_n = {0.f, 0.f}; float ki_n = 0.f, wi_n = 0.f;
    if (gw < M) { const float* p = PROJ + (size_t)gw * 512; cq_n = *(const f32x4*)(p + 4 * l); ckv_n = *(const f32x2*)(p + 256 + 2 * l); ki_n = p[384 + l]; wi_n = p[448 + (l & 7)]; }
    for (int row = gw; row < M; row += NGW) {
        const f32x4 cq = cq_n; const f32x2 ckv = ckv_n; const float ki = ki_n; const float wi = wi_n;
        if (row + NGW < M) { const float* p = PROJ + (size_t)(row + NGW) * 512; cq_n = *(const f32x4*)(p + 4 * l); ckv_n = *(const f32x2*)(p + 256 + 2 * l); ki_n = p[384 + l]; wi_n = p[448 + (l & 7)]; }
        const float rq = 1.0f / sqrtf(wave_sum(cq.x * cq.x + cq.y * cq.y + cq.z * cq.z + cq.w * cq.w) * (1.0f / 256.0f) + RMS_EPS);
        const float rkv = 1.0f / sqrtf(wave_sum(ckv.x * ckv.x + ckv.y * ckv.y) * (1.0f / 128.0f) + RMS_EPS);
        const float mean = wave_sum(ki) * (1.0f / 64.0f); const float dk = ki - mean; const float rki = 1.0f / sqrtf(wave_sum(dk * dk) * (1.0f / 64.0f) + LN_EPS);
        u32x2 oq; oq.x = cvtpk(cq.x * rq * gq.x, cq.y * rq * gq.y); oq.y = cvtpk(cq.z * rq * gq.z, cq.w * rq * gq.w);
        *(GAS u32x2*)(CQN + (size_t)row * 256 + 4 * l) = oq;
        const float c0 = ckv.x * rkv * gkv.x, c1 = ckv.y * rkv * gkv.y;
        *(GAS unsigned*)(CKV + (size_t)row * 128 + 2 * l) = cvtpk(c0, c1);
        cmx = fmaxf(cmx, wave_sum(c0 * c0 + c1 * c1));
        KIDX[(size_t)row * 64 + l] = (bf16)f2bf(dk * rki * gki + bki);
        if (l < 8) WIDX[(size_t)row * 8 + l] = wi * 0.04419417382415922f;
    }
    if (l == 0) __hip_atomic_fetch_max(F.ctl + CW_CMAX, __float_as_uint(sqrtf(cmx)), __ATOMIC_RELAXED, __HIP_MEMORY_SCOPE_AGENT);
}

__device__ __forceinline__ int t5_bucket(int n) {
    if (n < 16) return n; if (n >= 128) return 31;
    const int v = 16 + (int)(__builtin_amdgcn_logf((float)n * 0.0625f) * (16.0f / 3.0f));
    return v < 31 ? v : 31;
}
__device__ __forceinline__ unsigned fkey(float f) { const unsigned u = __float_as_uint(f); return (u & 0x80000000u) ? ~u : (u | 0x80000000u); }
__device__ __forceinline__ int popc64(unsigned long long m) { return __builtin_popcountll(m); }
__device__ __forceinline__ int mbcnt(unsigned long long m) { return (int)__builtin_amdgcn_mbcnt_hi((unsigned)(m >> 32), __builtin_amdgcn_mbcnt_lo((unsigned)m, 0u)); }
typedef float f32x16 __attribute__((ext_vector_type(16)));
typedef unsigned short u16x2 __attribute__((ext_vector_type(2)));
__device__ __forceinline__ int wave_total_i(int x) {
    int v = x;
    v += __builtin_amdgcn_update_dpp(0, v, 0x111, 0xf, 0xf, false);
    v += __builtin_amdgcn_update_dpp(0, v, 0x112, 0xf, 0xf, false);
    v += __builtin_amdgcn_update_dpp(0, v, 0x114, 0xf, 0xf, false);
    v += __builtin_amdgcn_update_dpp(0, v, 0x118, 0xf, 0xf, false);
    v += __builtin_amdgcn_update_dpp(0, v, 0x142, 0xa, 0xf, false);
    v += __builtin_amdgcn_update_dpp(0, v, 0x143, 0xc, 0xf, false);
    return __builtin_amdgcn_readlane(v, 63);
}
#ifndef MK_IDX_REP
#define MK_IDX_REP 0
#endif
#ifndef MK_CHECK_SEL
#define MK_CHECK_SEL 0
#endif
__device__ __forceinline__ void select_top256(const unsigned (&u)[64], int nj, int l, LAS unsigned short* selst, LAS unsigned* cand  ) {
    constexpr int SEL_CAP = 1024;
    unsigned pk[32];
#pragma unroll
    for (int p = 0; p < 32; ++p) pk[p] = (u[2 * p] >> 17) | ((u[2 * p + 1] >> 1) & 0xffff0000u);
    const int ngrp = (nj + 7) >> 3; const int nconsidered = ngrp * 512;
    auto count_ge = [&](unsigned c) -> int {
        const u16x2 cpk = __builtin_bit_cast(u16x2, c * 0x10001u); u16x2 acc = {0, 0};
#pragma unroll
        for (int jb = 0; jb < 8; ++jb) { if (jb < ngrp) {
#pragma unroll
            for (int q = 0; q < 4; ++q) { const u16x2 d = __builtin_bit_cast(u16x2, pk[4 * jb + q]) - cpk; acc += (d >> (unsigned short)15); } } }
        const unsigned a = __builtin_bit_cast(unsigned, acc);
        return nconsidered - wave_total_i((int)((a & 0xffffu) + (a >> 16)));
    };
    unsigned P = 0u;
    for (int bit = 14; bit >= 0; --bit) { const unsigned c = P | (1u << bit); if (count_ge(c) >= TOPK) P = c; }
    const int c_above = count_ge(P + 1u); const int need = TOPK - c_above;
    int off = 0, coff = 0;
#pragma unroll
    for (int j = 0; j < 64; ++j) { if ((j >> 3) < ngrp) {
        const unsigned k15 = u[j] >> 17; const unsigned long long m1 = __ballot(k15 > P), mc = __ballot(k15 == P);
        if (k15 > P) selst[off + mbcnt(m1)] = (unsigned short)(j * 64 + l);
        off += popc64(m1);
        if (mc != 0ull) { if (k15 == P) { const int pos = coff + mbcnt(mc); if (pos < SEL_CAP) { cand[pos] = u[j]; cand[SEL_CAP + pos] = (unsigned)(j * 64 + l); } } coff += popc64(mc); } }
        __builtin_amdgcn_sched_barrier(0); }
    LDS_WAIT(); asm volatile("" ::: "memory");
    const int ncand = coff;
    if (ncand == need && ncand <= SEL_CAP) { for (int i = l; i < ncand; i += 64) selst[c_above + i] = (unsigned short)cand[SEL_CAP + i]; }
    else if (ncand <= 256) {
        unsigned mk[4], mi[4]; int rk[4];
#pragma unroll
        for (int r = 0; r < 4; ++r) { const int i = l + 64 * r; const bool v = i < ncand; mk[r] = v ? cand[i] : 0u; mi[r] = v ? cand[SEL_CAP + i] : 0xffffffffu; rk[r] = 0; }
        for (int c2 = 0; c2 < ncand; ++c2) { const unsigned k2 = cand[c2], i2 = cand[SEL_CAP + c2];
#pragma unroll
            for (int r = 0; r < 4; ++r) rk[r] += (k2 > mk[r] || (k2 == mk[r] && i2 < mi[r])) ? 1 : 0; }
#pragma unroll
        for (int r = 0; r < 4; ++r) { if (l + 64 * r < ncand && rk[r] < need) selst[c_above + rk[r]] = (unsigned short)mi[r]; }
    } else {
        unsigned Tk = P << 17;
        for (int bit = 16; bit >= 0; --bit) { const unsigned cd = Tk | (1u << bit); int cnt = 0;
#pragma unroll
            for (int j = 0; j < 64; ++j) cnt += (u[j] >= cd) ? 1 : 0;
            if (wave_total_i(cnt) >= TOPK) Tk = cd; }
        int cg = 0;
#pragma unroll
        for (int j = 0; j < 64; ++j) cg += (u[j] > Tk && (u[j] >> 17) == P) ? 1 : 0;
        const int ngt = wave_total_i(cg); const int need2 = need - ngt; int o2 = c_above, t2 = 0;
        unsigned Tk2 = Tk, P2 = P; asm volatile("" : "+s"(Tk2), "+s"(P2));
#pragma unroll
        for (int j = 0; j < 64; ++j) { const bool isc = (u[j] >> 17) == P2; const unsigned long long m1 = __ballot(isc && u[j] > Tk2), m2 = __ballot(isc && u[j] == Tk2);
            if (isc && u[j] > Tk2) selst[o2 + mbcnt(m1)] = (unsigned short)(j * 64 + l);
            if (isc && u[j] == Tk2) { const int rk2 = t2 + mbcnt(m2); if (rk2 < need2) selst[c_above + ngt + rk2] = (unsigned short)(j * 64 + l); }
            o2 += popc64(m1); t2 += popc64(m2); __builtin_amdgcn_sched_barrier(0); }
    }
    LDS_WAIT(); asm volatile("" ::: "memory");
}
#if MK_CHECK_SEL
__device__ __forceinline__ void select_ref(const unsigned (&u)[64], int l, LAS unsigned short* selst) {
    unsigned Tk = 0u;
    for (int bit = 31; bit >= 0; --bit) { const unsigned cand = Tk | (1u << bit); int cnt = 0;
#pragma unroll
        for (int j = 0; j < 64; ++j) cnt += popc64(__ballot(u[j] >= cand));
        if (cnt >= TOPK) Tk = cand; }
    int cgt = 0;
#pragma unroll
    for (int j = 0; j < 64; ++j) cgt += popc64(__ballot(u[j] > Tk));
    const int need = TOPK - cgt; int off = 0, toff = 0;
#pragma unroll
    for (int j = 0; j < 64; ++j) { const unsigned long long m1 = __ballot(u[j] > Tk), m2 = __ballot(u[j] == Tk);
        if (u[j] > Tk) selst[off + mbcnt(m1)] = (unsigned short)(j * 64 + l);
        if (u[j] == Tk) { const int rk = toff + mbcnt(m2); if (rk < need) selst[cgt + rk] = (unsigned short)(j * 64 + l); }
        off += popc64(m1); toff += popc64(m2); }
    LDS_WAIT(); asm volatile("" ::: "memory");
}
#endif
__device__ __forceinline__ int wave_scan_i(int x) {
    int v = x;
    v += __builtin_amdgcn_update_dpp(0, v, 0x111, 0xf, 0xf, false);
    v += __builtin_amdgcn_update_dpp(0, v, 0x112, 0xf, 0xf, false);
    v += __builtin_amdgcn_update_dpp(0, v, 0x114, 0xf, 0xf, false);
    v += __builtin_amdgcn_update_dpp(0, v, 0x118, 0xf, 0xf, false);
    v += __builtin_amdgcn_update_dpp(0, v, 0x142, 0xa, 0xf, false);
    v += __builtin_amdgcn_update_dpp(0, v, 0x143, 0xc, 0xf, false);
    return v;
}
__device__ __forceinline__ int radix_pick(LAS unsigned* hist, int want, int l, int& above) {
    const u32x4 h4 = *(const LAS u32x4*)(hist + 4 * l);
    const int tot = (int)((h4.x + h4.y) + (h4.z + h4.w)); const int pre = wave_scan_i(tot); const int total = __builtin_amdgcn_readlane(pre, 63);
    const int a3 = total - pre, a2 = a3 + (int)h4.w, a1 = a2 + (int)h4.z, a0 = a1 + (int)h4.y;
    const bool c3 = a3 < want && a3 + (int)h4.w >= want, c2 = a2 < want && a2 + (int)h4.z >= want, c1 = a1 < want && a1 + (int)h4.y >= want, c0 = a0 < want && a0 + (int)h4.x >= want;
    const unsigned long long m = __ballot(c3 || c2 || c1 || c0); const int src = (int)__builtin_ctzll(m | (1ull << 63));
    const int mybin = 4 * l + (c3 ? 3 : c2 ? 2 : c1 ? 1 : 0), myab = c3 ? a3 : c2 ? a2 : c1 ? a1 : a0;
    above = __builtin_amdgcn_readlane(myab, src);
    return __builtin_amdgcn_readlane(mybin, src);
}
__device__ __forceinline__ void select_top256_radix(const unsigned (&k)[64], int nj, int l, LAS unsigned short* selst, LAS unsigned* hist) {
    const int ngrp = (nj + 7) >> 3;
    *(LAS u32x4*)(hist + 4 * l) = (u32x4){0u, 0u, 0u, 0u};
    LDS_WAIT(); asm volatile("" ::: "memory");
#pragma unroll
    for (int j = 0; j < 64; ++j) { if ((j >> 3) < ngrp) (void)__hip_atomic_fetch_add(hist + (k[j] >> 8), 1u, __ATOMIC_RELAXED, __HIP_MEMORY_SCOPE_WORKGROUP); }
    LDS_WAIT(); asm volatile("" ::: "memory");
    int above1 = 0; const int bhi = radix_pick(hist, TOPK, l, above1); const int want2 = TOPK - above1;
    LDS_WAIT(); asm volatile("" ::: "memory");
    *(LAS u32x4*)(hist + 4 * l) = (u32x4){0u, 0u, 0u, 0u};
    LDS_WAIT(); asm volatile("" ::: "memory");
#pragma unroll
    for (int j = 0; j < 64; ++j) { if ((j >> 3) < ngrp) { if ((int)(k[j] >> 8) == bhi) (void)__hip_atomic_fetch_add(hist + (k[j] & 255u), 1u, __ATOMIC_RELAXED, __HIP_MEMORY_SCOPE_WORKGROUP); } }
    LDS_WAIT(); asm volatile("" ::: "memory");
    int above2 = 0; const int blo = radix_pick(hist, want2, l, above2);
    const unsigned T16 = ((unsigned)bhi << 8) | (unsigned)blo; const int cgt = above1 + above2, need = TOPK - cgt;
    int off = 0, toff = 0;
#pragma unroll
    for (int j = 0; j < 64; ++j) { if ((j >> 3) < ngrp) {
        const unsigned long long m1 = __ballot(k[j] > T16), m2 = __ballot(k[j] == T16);
        if (k[j] > T16) selst[off + mbcnt(m1)] = (unsigned short)(j * 64 + l);
        if (m2 != 0ull) { if (k[j] == T16) { const int rk = toff + mbcnt(m2); if (rk < need) selst[cgt + rk] = (unsigned short)(j * 64 + l); } toff += popc64(m2); }
        off += popc64(m1); }
        __builtin_amdgcn_sched_barrier(0); }
    LDS_WAIT(); asm volatile("" ::: "memory");
}
__device__ __forceinline__ void p_indexer(Frame& F) {
    PHASE_IDS();
    const bf16* QIDX = (const bf16*)(F.ws + WS_QIDX); const bf16* KIDX = (const bf16*)(F.ws + WS_KIDX); const float* WIDX = (const float*)(F.ws + WS_WIDX);
    unsigned short* SEL = (unsigned short*)(F.ws + WS_SEL); unsigned char* BKT = (unsigned char*)(F.ws + WS_BKT);
    LAS unsigned short* selst = (LAS unsigned short*)(F.lds + 131072) + wave * 256;
    const int l = lane, l31 = l & 31, hi = l >> 5;
    { const int gw = F.vcu * NWAVES + wave, NGW = F.G * NWAVES;
      for (int rr = gw; rr < BATCH * 256; rr += NGW) { const int b = rr >> 8, t = rr & 255; const size_t row = (size_t)b * T + t;
          unsigned short s4[4]; unsigned bk = 0;
#pragma unroll
          for (int i = 0; i < 4; ++i) { const int k = 4 * l + i; const bool v = k <= t; s4[i] = v ? (unsigned short)k : (unsigned short)0xFFFF; bk |= (unsigned)(v ? t5_bucket(t - k) : 32) << (8 * i); }
          u32x2 o; o.x = (unsigned)s4[0] | ((unsigned)s4[1] << 16); o.y = (unsigned)s4[2] | ((unsigned)s4[3] << 16);
          *(GAS u32x2*)(SEL + row * 256 + 4 * l) = o; *(GAS unsigned*)(BKT + row * 256 + 4 * l) = bk; } }
    LAS unsigned short* S16 = (LAS unsigned short*)F.lds;
    LAS float* wtab = (LAS float*)(F.lds + 131072 + 4096);
    for (int i = 0; ; ++i) {
        const int L = i * F.G + F.vcu; const int rnd = L >> 8, pos = L & 255;
        if (rnd >= 8) break;
        const int b = pos & 7, gs = pos >> 3; const int g = 239 - 32 * rnd - ((rnd & 1) ? (31 - gs) : gs);
        if (g < 0) continue;
        const int t0 = 256 + 16 * g, nk = t0 + 16, nkt = (nk + 31) >> 5; const size_t rowb = (size_t)b * T;
        int lt_ = threadIdx.x; asm volatile("" : "+v"(lt_)); const int l = lt_ & 63, l31 = l & 31, hi = l >> 5;
        bf16x8 af[4][4];
        { const int tl = 2 * ((l31 >> 2) & 1) + (l31 >> 4), hd = (l31 & 3) + 4 * ((l31 >> 3) & 1);
#pragma unroll
          for (int mt = 0; mt < 4; ++mt) { const bf16* qp = QIDX + (rowb + t0 + mt * 4 + tl) * 512 + hd * 64 + hi * 8;
#pragma unroll
              for (int ks = 0; ks < 4; ++ks) af[mt][ks] = *(const GAS bf16x8*)(qp + ks * 16); }
          if (lt_ < 128) wtab[lt_] = WIDX[(rowb + t0) * 8 + lt_] * 0.5f;
          LDS_WAIT(); __syncthreads(); }
        for (int rep1 = 0; rep1 < 1 + (MK_IDX_REP & 1); ++rep1) {
        bf16x8 bfr[4], bn1[4], bnx[4];
        { const bf16* kp = KIDX + (rowb + wave * 32 + l31) * 64 + hi * 8;
#pragma unroll
          for (int ks = 0; ks < 4; ++ks) bfr[ks] = (wave < nkt) ? *(const GAS bf16x8*)(kp + ks * 16) : (bf16x8){0, 0, 0, 0, 0, 0, 0, 0};
          const int kt1 = wave + NWAVES; const bf16* kp1 = KIDX + (rowb + (kt1 < nkt ? kt1 : 0) * 32 + l31) * 64 + hi * 8;
#pragma unroll
          for (int ks = 0; ks < 4; ++ks) bn1[ks] = *(const GAS bf16x8*)(kp1 + ks * 16); }
        auto tile = [&](const int kt, const bf16x8 (&cur)[4], bf16x8 (&ld)[4]) {
            const int key = kt * 32 + l31; const int ktn = kt + 2 * NWAVES;
            LAS float* wtab_k = wtab; asm volatile("" : "+v"(wtab_k));
            { const bf16* kp = KIDX + (rowb + (ktn < nkt ? ktn : kt) * 32 + l31) * 64 + hi * 8;
#pragma unroll
              for (int ks = 0; ks < 4; ++ks) ld[ks] = *(const GAS bf16x8*)(kp + ks * 16); }
#pragma unroll
            for (int mt = 0; mt < 4; ++mt) { f32x16 acc = f32x16{};
#pragma unroll
                for (int ks = 0; ks < 4; ++ks) acc = __builtin_amdgcn_mfma_f32_32x32x16_bf16(af[mt][ks], cur[ks], acc, 0, 0, 0);
                float sA = 0.f, sB = 0.f;
                const LAS f32x4* wq = (const LAS f32x4*)(wtab_k + (mt * 4 + 2 * hi) * 8); const f32x4 wa0 = wq[0], wa1 = wq[1], wb0 = wq[2], wb1 = wq[3];
                const float wA[8] = {wa0.x, wa0.y, wa0.z, wa0.w, wa1.x, wa1.y, wa1.z, wa1.w}, wB[8] = {wb0.x, wb0.y, wb0.z, wb0.w, wb1.x, wb1.y, wb1.z, wb1.w};
#pragma unroll
                for (int r = 0; r < 8; ++r) { sA += wA[r] * (acc[r] + __builtin_fabsf(acc[r])); sB += wB[r] * (acc[8 + r] + __builtin_fabsf(acc[8 + r])); }
                const int tokA = mt * 4 + 2 * hi; const int tA = t0 + tokA;
                const _Float16 hA = (_Float16)((key <= tA) ? sA : -INFINITY), hB = (_Float16)((key <= tA + 1) ? sB : -INFINITY);
                S16[tokA * 4096 + key] = __builtin_bit_cast(unsigned short, hA); S16[(tokA + 1) * 4096 + key] = __builtin_bit_cast(unsigned short, hB); }
        };
        for (int kt = wave; kt < nkt; ) {
            tile(kt, bfr, bnx); kt += NWAVES; if (kt >= nkt) break;
            tile(kt, bn1, bfr); kt += NWAVES; if (kt >= nkt) break;
            tile(kt, bnx, bn1); kt += NWAVES;
        }
        }
        LDS_WAIT(); __syncthreads();
        { const int nvalid = nkt * 32; const int nj = (nvalid + 63) >> 6;
#pragma unroll
          for (int s2 = 0; s2 < 2; ++s2) {
              const int t = t0 + 2 * wave + s2; LAS unsigned short* srow = S16 + (2 * wave + s2) * 4096;
              int nvalid_ = nvalid; asm volatile("" : "+s"(nvalid_));
              unsigned u[64];
#pragma unroll
              for (int j = 0; j < 64; ++j) { const int idx = j * 64 + l; const unsigned h0 = srow[idx];
                  const unsigned k0 = (h0 & 0x8000u) ? (~h0 & 0xffffu) : (h0 | 0x8000u);
                  u[j] = (idx < nvalid_) ? k0 : 0u; }
              LDS_WAIT(); asm volatile("" ::: "memory");
              select_top256_radix(u, nj, l, selst, (LAS unsigned*)srow);
              if (MK_IDX_REP & 2) select_top256_radix(u, nj, l, selst, (LAS unsigned*)srow);
#if MK_CHECK_SEL
              { LAS unsigned* bm = (LAS unsigned*)srow + 512;
                for (int w2 = l; w2 < 128; w2 += 64) bm[w2] = 0u;
                LDS_WAIT(); asm volatile("" ::: "memory");
                unsigned short mine[4];
#pragma unroll
                for (int i2 = 0; i2 < 4; ++i2) { mine[i2] = selst[4 * l + i2]; atomicOr((unsigned*)(bm + (mine[i2] >> 5)), 1u << (mine[i2] & 31)); }
                LDS_WAIT(); asm volatile("" ::: "memory");
                unsigned u32k[64];
#pragma unroll
                for (int j = 0; j < 64; ++j) u32k[j] = u[j] << 16;
                select_ref(u32k, l, selst);
                int bad = 0;
#pragma unroll
                for (int i2 = 0; i2 < 4; ++i2) { const unsigned short r2 = selst[4 * l + i2]; bad += ((bm[r2 >> 5] >> (r2 & 31)) & 1u) ? 0 : 1; }
                int nset = 0; for (int w2 = l; w2 < 128; w2 += 64) nset += __builtin_popcount(bm[w2]);
                bad = wave_total_i(bad) + (wave_total_i(nset) != TOPK ? 1 : 0);
                if (bad && l == 0) __hip_atomic_store(F.ctl + CW_TMO, 0xBAD5E1u, __ATOMIC_RELAXED, __HIP_MEMORY_SCOPE_AGENT);
#pragma unroll
                for (int i2 = 0; i2 < 4; ++i2) selst[4 * l + i2] = mine[i2];
                LDS_WAIT(); asm volatile("" ::: "memory"); }
#endif
              int t2_ = threadIdx.x; asm volatile("" : "+v"(t2_)); const int l2 = t2_ & 63;
              const size_t row = rowb + t; unsigned short s4[4]; unsigned bk = 0;
#pragma unroll
              for (int i2 = 0; i2 < 4; ++i2) { s4[i2] = selst[4 * l2 + i2]; bk |= (unsigned)t5_bucket(t - (int)s4[i2]) << (8 * i2); }
              u32x2 o; o.x = (unsigned)s4[0] | ((unsigned)s4[1] << 16); o.y = (unsigned)s4[2] | ((unsigned)s4[3] << 16);
              *(GAS u32x2*)(SEL + row * 256 + 4 * l2) = o; *(GAS unsigned*)(BKT + row * 256 + 4 * l2) = bk;
              LDS_WAIT(); asm volatile("" ::: "memory"); } }
        LDS_WAIT(); __syncthreads();
    }
}

typedef short v4i16_t __attribute__((ext_vector_type(4)));
__device__ __forceinline__ void p_sparse_attn(Frame& F, const float* rel_table) {
    PHASE_IDS();
    const bf16* QLAT = (const bf16*)(F.ws + WS_QLAT); const unsigned char* CKV8 = (const unsigned char*)(F.ws + WS_CKV); unsigned char* OLAT = (unsigned char*)(F.ws + WS_OLAT);
    const unsigned short* SEL = (const unsigned short*)(F.ws + WS_SEL); const unsigned char* BKT = (const unsigned char*)(F.ws + WS_BKT);
    LAS unsigned char* cb = F.lds + wave * 16384;
    LAS unsigned char* sb = F.lds + 131072 + wave * 1536;
    LAS float* relt = (LAS float*)(F.lds + 131072 + 8 * 1536);
    for (int i = tid; i < 33 * 16; i += NWAVES * 64) relt[i] = (i < 512) ? rel_table[i] * LOG2E : -INFINITY;
    LDS_WAIT(); __syncthreads();
    if (tid < 16) { float m = relt[tid]; for (int b = 1; b < 32; ++b) m = fmaxf(m, relt[b * 16 + tid]); relt[33 * 16 + tid] = m; }
    LDS_WAIT(); __syncthreads();
    const int l = lane, l15 = l & 15, g = l >> 4;
    const float cmax = __uint_as_float(__hip_atomic_load(F.ctl + CW_CMAX, __ATOMIC_RELAXED, __HIP_MEMORY_SCOPE_AGENT)) * 1.15f;
    const float bmaxh = relt[33 * 16 + l15];
    const int gw = F.vcu * NWAVES + wave, NGW = F.G * NWAVES;
    const int ntok = (M - gw + NGW - 1) / NGW;
#define SA_PARK_BKT(base_, bv_) do { _Pragma("unroll") for (int i_ = 0; i_ < 4; ++i_) { const int s_ = 4 * l + i_, sl_ = s_ & 31; (base_)[(s_ & ~31) + 4 * (sl_ & 7) + (sl_ >> 3)] = (unsigned char)((bv_) >> (8 * i_)); } } while (0)
#define SA_ROW(i_) ((NGW == 2048) ? ((size_t)(gw >> 8) * T + (size_t)((gw & 255) + 256 * (i_))) : (size_t)(gw + NGW * (i_)))
    if (ntok > 0) { const size_t row = SA_ROW(0); const u32x2 sv = *(const GAS u32x2*)(SEL + row * 256 + 4 * l); const unsigned bv = *(const GAS unsigned*)(BKT + row * 256 + 4 * l);
        *(LAS u32x2*)(sb + 8 * l) = sv; SA_PARK_BKT(sb + 512, bv); }
    LDS_WAIT();
    for (int it = 0; it < ntok; ++it) {
        const size_t row = SA_ROW(it); const size_t rowb = row & ~(size_t)(T - 1);
        LAS unsigned short* selw = (LAS unsigned short*)(sb + (it & 1) * 768); LAS unsigned char* bktw = sb + (it & 1) * 768 + 512;
        u32x2 svn = {0u, 0u}; unsigned bvn = 0u;
        if (it + 1 < ntok) { const size_t rown = SA_ROW(it + 1); svn = *(const GAS u32x2*)(SEL + rown * 256 + 4 * l); bvn = *(const GAS unsigned*)(BKT + rown * 256 + 4 * l); }
        pg8::i32x8 q8; float qq = 0.f;
        { bf16x8 bq[4];
#pragma unroll
          for (int i = 0; i < 4; ++i) bq[i] = __builtin_nontemporal_load((const bf16x8*)(QLAT + row * 2048 + l15 * 128 + g * 32 + i * 8));
#pragma unroll
          for (int i = 0; i < 4; ++i) { float x[8];
#pragma unroll
              for (int e2 = 0; e2 < 8; ++e2) { x[e2] = __uint_as_float((unsigned)(unsigned short)bq[i][e2] << 16); qq += x[e2] * x[e2]; }
              int w0 = __builtin_amdgcn_cvt_pk_fp8_f32(x[0], x[1], 0, false); w0 = __builtin_amdgcn_cvt_pk_fp8_f32(x[2], x[3], w0, true);
              int w1 = __builtin_amdgcn_cvt_pk_fp8_f32(x[4], x[5], 0, false); w1 = __builtin_amdgcn_cvt_pk_fp8_f32(x[6], x[7], w1, true);
              q8[2 * i] = w0; q8[2 * i + 1] = w1; } }
        qq += __shfl_xor(qq, 16); qq += __shfl_xor(qq, 32);
        const float mh = sqrtf(qq) * cmax + bmaxh;
        const float nmh = -mh; f32x4 lsum = (f32x4){0.f, 0.f, 0.f, 0.f}; f32x4 o[8];
#pragma unroll
        for (int mt = 0; mt < 8; ++mt) o[mt] = (f32x4){0.f, 0.f, 0.f, 0.f};
#define SA_SW(r_) ((((r_) >> 1) & 3) | (((((r_) >> 2) ^ ((r_) >> 4)) & 1) << 2))
#define SA_DMA(c_) do { _Pragma("unroll") for (int q = 0; q < 4; ++q) { const int r_ = 8 * q + (l >> 3); unsigned idx = selw[32 * (c_) + 8 * (r_ & 3) + (r_ >> 2)]; idx = (idx == 0xFFFFu) ? 0u : idx; \
            const unsigned char* src = CKV8 + (rowb + idx) * 128 + (((l & 7) ^ SA_SW(r_)) * 16); \
            __builtin_amdgcn_global_load_lds((const GAS unsigned*)src, (LAS unsigned*)(cb + ((c_) & 3) * 4096 + q * 1024), 16, 0, 0); } } while (0)
        SA_DMA(0); SA_DMA(1);
        unsigned f8one = 0x7f7f7f7fu; asm volatile("" : "+v"(f8one));
        const bf16x8 ones8 = (bf16x8){0x3F80, 0x3F80, 0x3F80, 0x3F80, 0x3F80, 0x3F80, 0x3F80, 0x3F80};
        const int pvr = (l15 >> 1) < 4 ? 4 * g + (l15 >> 1) : 16 + 4 * g + ((l15 >> 1) - 4); const int pvoff = pvr * 128 + (l15 & 1) * 8, pvsw = SA_SW(pvr);
#pragma unroll
        for (int c = 0; c < 8; c += 2) {
            if (c + 2 < 8) { SA_DMA(c + 2); SA_DMA(c + 3); asm volatile("s_waitcnt vmcnt(8)" ::: "memory"); } else { asm volatile("s_waitcnt vmcnt(0)" ::: "memory"); }
            pg8::i32x8 a8[4]; float bias[4][4]; u32x2 vt[16]; unsigned bk[4];
#pragma unroll
            for (int h2 = 0; h2 < 2; ++h2) { LAS unsigned char* cbc = cb + ((c + h2) & 3) * 4096;
                bk[2 * h2] = *(const LAS unsigned*)(bktw + (c + h2) * 32 + 4 * g); bk[2 * h2 + 1] = *(const LAS unsigned*)(bktw + (c + h2) * 32 + 16 + 4 * g);
#pragma unroll
                for (int tt = 0; tt < 2; ++tt) { const int R = 16 * tt + l15; const v4u lo = *(const LAS v4u*)(cbc + R * 128 + (((2 * g) ^ SA_SW(R)) * 16)), hi = *(const LAS v4u*)(cbc + R * 128 + (((2 * g + 1) ^ SA_SW(R)) * 16));
                    a8[2 * h2 + tt] = (pg8::i32x8){(int)lo.x, (int)lo.y, (int)lo.z, (int)lo.w, (int)hi.x, (int)hi.y, (int)hi.z, (int)hi.w}; }
#pragma unroll
                for (int mt = 0; mt < 8; ++mt) { typedef int v2i_t __attribute__((ext_vector_type(2)));
                    const v2i_t t8 = __builtin_amdgcn_ds_read_tr8_b64_v2i32((LAS v2i_t*)(cbc + pvoff + ((mt ^ pvsw) * 16))); vt[8 * h2 + mt] = (u32x2){(unsigned)t8.x, (unsigned)t8.y}; } }
#pragma unroll
            for (int q = 0; q < 4; ++q)
#pragma unroll
                for (int r = 0; r < 4; ++r) bias[q][r] = relt[((bk[q] >> (8 * r)) & 0xffu) * 16 + l15];
            __builtin_amdgcn_sched_barrier(0);
            f32x4 s0 = (f32x4){nmh, nmh, nmh, nmh}, s1 = s0, s2 = s0, s3 = s0;
            asm volatile("v_mfma_scale_f32_16x16x128_f8f6f4 %0, %4, %8, %0, %9, %9 op_sel_hi:[0,0,0]\n\tv_mfma_scale_f32_16x16x128_f8f6f4 %1, %5, %8, %1, %9, %9 op_sel_hi:[0,0,0]\n\t"
                         "v_mfma_scale_f32_16x16x128_f8f6f4 %2, %6, %8, %2, %9, %9 op_sel_hi:[0,0,0]\n\tv_mfma_scale_f32_16x16x128_f8f6f4 %3, %7, %8, %3, %9, %9 op_sel_hi:[0,0,0]\n\ts_nop 15\n\ts_nop 3"
                         : "+v"(s0), "+v"(s1), "+v"(s2), "+v"(s3) : "v"(a8[0]), "v"(a8[1]), "v"(a8[2]), "v"(a8[3]), "v"(q8), "v"(f8one));
#pragma unroll
            for (int r = 0; r < 4; ++r) { s0[r] = __builtin_amdgcn_exp2f(s0[r] + bias[0][r]); s1[r] = __builtin_amdgcn_exp2f(s1[r] + bias[1][r]); s2[r] = __builtin_amdgcn_exp2f(s2[r] + bias[2][r]); s3[r] = __builtin_amdgcn_exp2f(s3[r] + bias[3][r]); }
            u32x4 pw0, pw1; pw0.x = cvtpk(s0[0], s0[1]); pw0.y = cvtpk(s0[2], s0[3]); pw0.z = cvtpk(s1[0], s1[1]); pw0.w = cvtpk(s1[2], s1[3]);
            pw1.x = cvtpk(s2[0], s2[1]); pw1.y = cvtpk(s2[2], s2[3]); pw1.z = cvtpk(s3[0], s3[1]); pw1.w = cvtpk(s3[2], s3[3]);
#pragma unroll
            for (int h2 = 0; h2 < 2; ++h2) { const bf16x8 pb = __builtin_bit_cast(bf16x8, h2 ? pw1 : pw0);
                lsum = __builtin_amdgcn_mfma_f32_16x16x32_bf16(ones8, pb, lsum, 0, 0, 0);
#pragma unroll
                for (int mt = 0; mt < 8; ++mt) { typedef __bf16 bf2_t __attribute__((ext_vector_type(2))); const u32x2 v = vt[8 * h2 + mt];
                    u32x4 aw; aw.x = __builtin_bit_cast(unsigned, (bf2_t)__builtin_amdgcn_cvt_scalef32_pk_bf16_fp8(v.x, 1.0f, false)); aw.y = __builtin_bit_cast(unsigned, (bf2_t)__builtin_amdgcn_cvt_scalef32_pk_bf16_fp8(v.x, 1.0f, true));
                    aw.z = __builtin_bit_cast(unsigned, (bf2_t)__builtin_amdgcn_cvt_scalef32_pk_bf16_fp8(v.y, 1.0f, false)); aw.w = __builtin_bit_cast(unsigned, (bf2_t)__builtin_amdgcn_cvt_scalef32_pk_bf16_fp8(v.y, 1.0f, true));
                    o[mt] = __builtin_amdgcn_mfma_f32_16x16x32_bf16(__builtin_bit_cast(bf16x8, aw), pb, o[mt], 0, 0, 0); } }
            LDS_WAIT();
        }
#undef SA_DMA
#undef SA_SW
        const float inv = F8_OLS / lsum[0];
#pragma unroll
        for (int mt = 0; mt < 8; ++mt) __builtin_nontemporal_store(pg8::cvt4_fp8(o[mt][0] * inv, o[mt][1] * inv, o[mt][2] * inv, o[mt][3] * inv), (unsigned*)(OLAT + row * 2048 + l15 * 128 + 16 * mt + 4 * g));
        { LAS unsigned char* sn = sb + ((it + 1) & 1) * 768; *(LAS u32x2*)(sn + 8 * l) = svn; SA_PARK_BKT(sn + 512, bvn); }
        LDS_WAIT();
    }
#undef SA_ROW
#undef SA_PARK_BKT
    LDS_WAIT(); __syncthreads();
}

typedef float f32x4v __attribute__((ext_vector_type(4)));
__device__ __forceinline__ void p_ln_router(Frame& F, const float* xbase, const bool base16  , const float* lg, const float* lb, const float* w_router, const float* b_router, int layer) {
    PHASE_IDS();
    const bf16* HB = (const bf16*)(F.ws + WS_Y); bf16* XF = (bf16*)(F.ws + WS_XF); unsigned char* XB8 = (unsigned char*)(F.ws + WS_XB8);
    int* TOPE = (int*)(F.ws + WS_TOPE); float* TOPG = (float*)(F.ws + WS_TOPG); int* POS = (int*)(F.ws + WS_POS); unsigned short* TOKE = (unsigned short*)(F.ws + WS_TOKE);
    gu32* gcnt = F.ctl + CW_CNT + 64 * layer;
    LAS float* lgt = (LAS float*)F.lds;
    LAS int* hist = (LAS int*)(F.lds + 128 * 33 * 4);
    LAS int* base = hist + 32;
    const int l = lane, l15 = l & 15, g = l >> 4;
    f32x4 gv[4], bv[4];
#pragma unroll
    for (int j = 0; j < 4; ++j) { gv[j] = *(const f32x4*)(lg + 4 * l + 256 * j); bv[j] = *(const f32x4*)(lb + 4 * l + 256 * j); }
    for (int unit = F.vcu; unit < M / 128; unit += F.G) {
        const int r0 = unit * 128 + wave * 16;
        if (tid < 32) hist[tid] = 0;
        u32x4 vn[4]; u32x2 hn[4];
#define LNR_LOAD(row_) do { const GAS u32x2* hp = (const GAS u32x2*)(HB + (size_t)(row_) * D) + l; \
            if (base16) { const GAS u32x2* yp = (const GAS u32x2*)((const bf16*)xbase + (size_t)(row_) * D) + l; _Pragma("unroll") for (int j = 0; j < 4; ++j) { const u32x2 t2 = yp[64 * j]; vn[j] = (u32x4){t2.x, t2.y, 0u, 0u}; hn[j] = hp[64 * j]; } } \
            else { const GAS u32x4* yp = (const GAS u32x4*)(xbase + (size_t)(row_) * D) + l; _Pragma("unroll") for (int j = 0; j < 4; ++j) { vn[j] = yp[64 * j]; hn[j] = hp[64 * j]; } } } while (0)
        LNR_LOAD(r0);
        for (int i = 0; i < 16; ++i) { const size_t row = (size_t)(r0 + i);
            f32x4 v[4]; float s = 0.f;
#pragma unroll
            for (int j = 0; j < 4; ++j) { const u32x2 w = hn[j]; const u32x4 bb = vn[j]; f32x4 xb;
                if (base16) xb = (f32x4){__uint_as_float(bb.x << 16), __uint_as_float(bb.x & 0xffff0000u), __uint_as_float(bb.y << 16), __uint_as_float(bb.y & 0xffff0000u)};
                else xb = (f32x4){__uint_as_float(bb.x), __uint_as_float(bb.y), __uint_as_float(bb.z), __uint_as_float(bb.w)};
                v[j].x = xb.x * DN_ALPHA + __uint_as_float(w.x << 16); v[j].y = xb.y * DN_ALPHA + __uint_as_float(w.x & 0xffff0000u);
                v[j].z = xb.z * DN_ALPHA + __uint_as_float(w.y << 16); v[j].w = xb.w * DN_ALPHA + __uint_as_float(w.y & 0xffff0000u);
                s += (v[j].x + v[j].y) + (v[j].z + v[j].w); }
            if (i < 15) { LNR_LOAD(row + 1); }
            const float mean = wave_sum(s) * (1.f / D); float s2 = 0.f;
#pragma unroll
            for (int j = 0; j < 4; ++j) { v[j] = v[j] - mean; s2 += (v[j].x * v[j].x + v[j].y * v[j].y) + (v[j].z * v[j].z + v[j].w * v[j].w); }
            const float rstd = 1.f / sqrtf(wave_sum(s2) * (1.f / D) + LN_EPS);
            GAS u32x2* xo = (GAS u32x2*)(XF + row * D) + l; GAS unsigned* bo = (GAS unsigned*)(XB8 + row * D) + l;
#pragma unroll
            for (int j = 0; j < 4; ++j) { const f32x4 o = v[j] * rstd * gv[j] + bv[j]; u32x2 ow; ow.x = cvtpk(o.x, o.y); ow.y = cvtpk(o.z, o.w); xo[64 * j] = ow; bo[64 * j] = pg8::cvt4_fp8(o.x * F8_XS, o.y * F8_XS, o.z * F8_XS, o.w * F8_XS); } }
#undef LNR_LOAD
        asm volatile("s_waitcnt vmcnt(0)" ::: "memory");
        f32x4 acc0 = (f32x4){0.f, 0.f, 0.f, 0.f}, acc1 = acc0;
        { const bf16* xr = XF + (size_t)(r0 + l15) * D + 4 * g;
#pragma unroll 1
          for (int k0 = 0; k0 < D; k0 += 64) {
              f32x4 a[4]; float w0[4][4], w1[4][4];
#pragma unroll
              for (int q = 0; q < 4; ++q) { const u32x2 ab = __builtin_nontemporal_load((const u32x2*)(xr + k0 + 16 * q));
                  a[q] = (f32x4){__uint_as_float(ab.x << 16), __uint_as_float(ab.x & 0xffff0000u), __uint_as_float(ab.y << 16), __uint_as_float(ab.y & 0xffff0000u)}; const float* wp = w_router + (size_t)(k0 + 16 * q + 4 * g) * NEXP + l15;
#pragma unroll
                  for (int j = 0; j < 4; ++j) { w0[q][j] = wp[j * NEXP]; w1[q][j] = wp[j * NEXP + 16]; } }
#pragma unroll
              for (int q = 0; q < 4; ++q)
#pragma unroll
                  for (int j = 0; j < 4; ++j) { acc0 = __builtin_amdgcn_mfma_f32_16x16x4f32(a[q][j], w0[q][j], acc0, 0, 0, 0); acc1 = __builtin_amdgcn_mfma_f32_16x16x4f32(a[q][j], w1[q][j], acc1, 0, 0, 0); } } }
        { const float b0 = b_router[l15], b1 = b_router[l15 + 16];
#pragma unroll
          for (int r = 0; r < 4; ++r) { lgt[(wave * 16 + 4 * g + r) * 33 + l15] = acc0[r] + b0; lgt[(wave * 16 + 4 * g + r) * 33 + l15 + 16] = acc1[r] + b1; } }
        LDS_WAIT(); __syncthreads();
        int te[4] = {0, 0, 0, 0}, lp[4] = {0, 0, 0, 0}; float tg[4] = {0.f, 0.f, 0.f, 0.f};
        if (l < 16) { const LAS float* rp = lgt + (wave * 16 + l) * 33; float tv[4] = {-INFINITY, -INFINITY, -INFINITY, -INFINITY};
            for (int e = 0; e < NEXP; ++e) { const float v = rp[e];
                if (v > tv[3]) { if (v > tv[0]) { tv[3] = tv[2]; te[3] = te[2]; tv[2] = tv[1]; te[2] = te[1]; tv[1] = tv[0]; te[1] = te[0]; tv[0] = v; te[0] = e; }
                    else if (v > tv[1]) { tv[3] = tv[2]; te[3] = te[2]; tv[2] = tv[1]; te[2] = te[1]; tv[1] = v; te[1] = e; }
                    else if (v > tv[2]) { tv[3] = tv[2]; te[3] = te[2]; tv[2] = v; te[2] = e; }
                    else { tv[3] = v; te[3] = e; } } }
            const float e1 = __expf(tv[1] - tv[0]), e2 = __expf(tv[2] - tv[0]), e3 = __expf(tv[3] - tv[0]); const float inv = 1.0f / (1.0f + e1 + e2 + e3);
            tg[0] = inv; tg[1] = e1 * inv; tg[2] = e2 * inv; tg[3] = e3 * inv;
#pragma unroll
            for (int k = 0; k < 4; ++k) lp[k] = atomicAdd((int*)(hist + te[k]), 1); }
        LDS_WAIT(); __syncthreads();
        if (tid < 32) base[tid] = (int)__hip_atomic_fetch_add(gcnt + tid, (unsigned)hist[tid], __ATOMIC_RELAXED, __HIP_MEMORY_SCOPE_AGENT);
        LDS_WAIT(); __syncthreads();
        if (l < 16) { const size_t row = (size_t)(r0 + l);
            typedef int i32x4 __attribute__((ext_vector_type(4)));
            *(GAS i32x4*)(TOPE + row * 4) = (i32x4){te[0], te[1], te[2], te[3]};
            *(GAS f32x4*)(TOPG + row * 4) = (f32x4){tg[0], tg[1], tg[2], tg[3]};
            const int p0 = base[te[0]] + lp[0], p1 = base[te[1]] + lp[1], p2 = base[te[2]] + lp[2], p3 = base[te[3]] + lp[3];
            *(GAS i32x4*)(POS + row * 4) = (i32x4){p0, p1, p2, p3};
            TOKE[(size_t)te[0] * 32768 + p0] = (unsigned short)row; TOKE[(size_t)te[1] * 32768 + p1] = (unsigned short)row; TOKE[(size_t)te[2] * 32768 + p2] = (unsigned short)row; TOKE[(size_t)te[3] * 32768 + p3] = (unsigned short)row; }
        LDS_WAIT(); __syncthreads();
    }
}

__device__ __forceinline__ int moe_tables(Frame& F, int layer, LAS int* tab) {
    gu32* gcnt = F.ctl + CW_CNT + 64 * layer;
    if (threadIdx.x < NEXP) tab[64 + threadIdx.x] = (int)__hip_atomic_load(gcnt + threadIdx.x, __ATOMIC_RELAXED, __HIP_MEMORY_SCOPE_AGENT);
    LDS_WAIT(); __syncthreads();
    if (threadIdx.x == 0) { int acc = 0; for (int e = 0; e < NEXP; ++e) { tab[e] = acc; acc += (tab[64 + e] + 255) >> 8; } tab[NEXP] = acc; }
    LDS_WAIT(); __syncthreads();
    const int nT = tab[NEXP];
    for (int pm = threadIdx.x; pm < nT; pm += NWAVES * 64) { int e = 0; for (int k = 1; k < NEXP; ++k) e += (tab[k] <= pm) ? 1 : 0;
        tab[128 + pm] = e; }
    LDS_WAIT(); __syncthreads();
    return nT;
}

__device__ __forceinline__ void p_moe_combine_ln(Frame& F, const float* lg, const float* lb, float* out_final, int layer) {
    PHASE_IDS();
    LAS int* tab = (LAS int*)F.lds; (void)moe_tables(F, layer, tab);
    bf16* XF = (bf16*)(F.ws + WS_XF); unsigned char* XB8 = (unsigned char*)(F.ws + WS_XB8); const unsigned char* Y2 = (const unsigned char*)(F.ws + WS_XG);
    const int* TOPE = (const int*)(F.ws + WS_TOPE); const int* POS = (const int*)(F.ws + WS_POS); const float* TOPG = (const float*)(F.ws + WS_TOPG);
    const int l = lane; const int gw = F.vcu * NWAVES + wave, NGW = F.G * NWAVES;
    f32x4 gv[4], bv[4];
#pragma unroll
    for (int j = 0; j < 4; ++j) { gv[j] = *(const f32x4*)(lg + 4 * l + 256 * j); bv[j] = *(const f32x4*)(lb + 4 * l + 256 * j); }
    for (int row = gw; row < M; row += NGW) {
        typedef int i32x4 __attribute__((ext_vector_type(4)));
        const i32x4 e4 = *(const GAS i32x4*)(TOPE + (size_t)row * 4), p4 = *(const GAS i32x4*)(POS + (size_t)row * 4); const f32x4 gt = *(const GAS f32x4*)(TOPG + (size_t)row * 4);
        i32x4 sl; sl[0] = 256 * tab[e4[0]] + p4[0]; sl[1] = 256 * tab[e4[1]] + p4[1]; sl[2] = 256 * tab[e4[2]] + p4[2]; sl[3] = 256 * tab[e4[3]] + p4[3];
        GAS u32x2* xp = (GAS u32x2*)(XF + (size_t)row * D) + l; f32x4 v[4];
#pragma unroll
        for (int j = 0; j < 4; ++j) { const u32x2 xb = xp[64 * j]; v[j] = (f32x4){__uint_as_float(xb.x << 16), __uint_as_float(xb.x & 0xffff0000u), __uint_as_float(xb.y << 16), __uint_as_float(xb.y & 0xffff0000u)} * DN_ALPHA; }
#pragma unroll
        for (int k = 0; k < 4; ++k) { const GAS int* yp = (const GAS int*)(Y2 + (size_t)sl[k] * D) + l; const float gk = gt[k] * (1.0f / F8_YS);
#pragma unroll
            for (int j = 0; j < 4; ++j) { const int w = yp[64 * j];
                v[j].x += gk * __builtin_amdgcn_cvt_f32_fp8(w, 0); v[j].y += gk * __builtin_amdgcn_cvt_f32_fp8(w, 1); v[j].z += gk * __builtin_amdgcn_cvt_f32_fp8(w, 2); v[j].w += gk * __builtin_amdgcn_cvt_f32_fp8(w, 3); } }
        float s = 0.f;
#pragma unroll
        for (int j = 0; j < 4; ++j) s += (v[j].x + v[j].y) + (v[j].z + v[j].w);
        const float mean = wave_sum(s) * (1.f / D); float s2 = 0.f;
#pragma unroll
        for (int j = 0; j < 4; ++j) { v[j] = v[j] - mean; s2 += (v[j].x * v[j].x + v[j].y * v[j].y) + (v[j].z * v[j].z + v[j].w * v[j].w); }
        const float rstd = 1.f / sqrtf(wave_sum(s2) * (1.f / D) + LN_EPS);
        if (out_final) { GAS f32x4* op = (GAS f32x4*)(out_final + (size_t)row * D) + l;
            const float poison = (__hip_atomic_load(F.ctl + CW_TMO, __ATOMIC_RELAXED, __HIP_MEMORY_SCOPE_AGENT) != 0u) ? __builtin_nanf("") : 0.f;
#pragma unroll
            for (int j = 0; j < 4; ++j) op[64 * j] = v[j] * rstd * gv[j] + bv[j] + poison; }
        else { GAS unsigned* bo = (GAS unsigned*)(XB8 + (size_t)row * D) + l;
#pragma unroll
            for (int j = 0; j < 4; ++j) { const f32x4 o = v[j] * rstd * gv[j] + bv[j]; u32x2 ow; ow.x = cvtpk(o.x, o.y); ow.y = cvtpk(o.z, o.w); xp[64 * j] = ow; bo[64 * j] = pg8::cvt4_fp8(o.x * F8_XS, o.y * F8_XS, o.z * F8_XS, o.w * F8_XS); } }
    }
}

__device__ __forceinline__ void p_fox_gate(Frame& F, const float* w_f, const float* b_f) {
    PHASE_IDS();
    const bf16* XF = (const bf16*)(F.ws + WS_XF); float* LOGF = (float*)(F.ws + WS_LOGF);
    const int l = lane, l15 = l & 15, g = l >> 4; const int gw = F.vcu * NWAVES + wave, NGW = F.G * NWAVES;
    const float bf = b_f[l15];
    for (int tile = gw; tile < M / 16; tile += NGW) {
        f32x4 acc = (f32x4){0.f, 0.f, 0.f, 0.f}; const bf16* xr = XF + (size_t)(tile * 16 + l15) * D + 4 * g;
#pragma unroll 1
        for (int k0 = 0; k0 < D; k0 += 64) {
            f32x4 a[4]; float w[4][4];
#pragma unroll
            for (int q = 0; q < 4; ++q) { const u32x2 ab = *(const GAS u32x2*)(xr + k0 + 16 * q);
                a[q] = (f32x4){__uint_as_float(ab.x << 16), __uint_as_float(ab.x & 0xffff0000u), __uint_as_float(ab.y << 16), __uint_as_float(ab.y & 0xffff0000u)}; const float* wp = w_f + (size_t)(k0 + 16 * q + 4 * g) * 16 + l15;
#pragma unroll
                for (int j = 0; j < 4; ++j) w[q][j] = wp[j * 16]; }
#pragma unroll
            for (int q = 0; q < 4; ++q)
#pragma unroll
                for (int j = 0; j < 4; ++j) acc = __builtin_amdgcn_mfma_f32_16x16x4f32(a[q][j], w[q][j], acc, 0, 0, 0); }
#pragma unroll
        for (int r = 0; r < 4; ++r) { const float z = acc[r] + bf; const float ls = fminf(z, 0.f) - log1pf(__expf(-fabsf(z)));
            LOGF[(size_t)(tile * 16 + 4 * g + r) * 16 + l15] = ls; }
    }
}
__device__ __forceinline__ void split3(float f, unsigned short& h, unsigned short& m, unsigned short& lo) {
    const unsigned p1 = f2bf(f); const float f1 = __uint_as_float(p1 << 16); const float r1 = f - f1;
    const unsigned p2 = f2bf(r1); const float f2 = __uint_as_float(p2 << 16); const float r2 = r1 - f2;
    h = (unsigned short)p1; m = (unsigned short)p2; lo = (unsigned short)f2bf(r2);
}
__device__ __forceinline__ void p_fox_cum(Frame& F) {
    PHASE_IDS();
    const float* LOGF = (const float*)(F.ws + WS_LOGF); bf16* QX = (bf16*)(F.ws + WS_QX); bf16* KX = (bf16*)(F.ws + WS_KX);
    const bf16* Q = (const bf16*)(F.ws + WS_Q); const bf16* K = (const bf16*)(F.ws + WS_K);
    float* CUM2 = (float*)(F.ws + WS_CUM2); float* KMAX = (float*)(F.ws + WS_KMAX); float* DG = (float*)(F.ws + WS_DG);
    LAS double* red = (LAS double*)F.lds;
    LAS double* pre = red + 512;
    LAS double* tot = pre + 16;
    LAS float* kn2 = (LAS float*)(tot + 512);
    LAS float* qn2 = kn2 + 512;
    LAS float* dgm = qn2 + 512;
    const int h = tid & 15, sub = tid >> 4;
    for (int unit = F.vcu; unit < BATCH * 32; unit += F.G) {
        const int b = unit >> 5, seg = unit & 31; const size_t rowb = (size_t)b * T;
        double s = 0.0;
        { const int nprev = seg * 128; int t = sub;
          for (; t + 7 * 32 < nprev; t += 8 * 32) { float a[8];
#pragma unroll
              for (int q = 0; q < 8; ++q) a[q] = LOGF[(rowb + t + 32 * q) * 16 + h];
              s += (((double)a[0] + (double)a[1]) + ((double)a[2] + (double)a[3])) + (((double)a[4] + (double)a[5]) + ((double)a[6] + (double)a[7])); }
          for (; t < nprev; t += 32) s += (double)LOGF[(rowb + t) * 16 + h]; }
        red[sub * 16 + h] = s;
        const int t0 = seg * 128 + sub * 4; float lf[4];
#pragma unroll
        for (int i = 0; i < 4; ++i) lf[i] = LOGF[(rowb + t0 + i) * 16 + h];
        tot[sub * 16 + h] = (double)lf[0] + (double)lf[1] + (double)lf[2] + (double)lf[3];
        { float kmx = 0.f, qmx = 0.f, dmn = INFINITY;
#pragma unroll
          for (int i = 0; i < 4; ++i) { const GAS v4u* qp = (const GAS v4u*)(Q + (rowb + t0 + i) * D + h * 64); const GAS v4u* kp = (const GAS v4u*)(K + (rowb + t0 + i) * D + h * 64);
              float qq = 0.f, kk = 0.f, qk = 0.f;
#pragma unroll
              for (int c = 0; c < 8; ++c) { const v4u a = qp[c], bb = kp[c]; const unsigned aw[4] = {a.x, a.y, a.z, a.w}, bw[4] = {bb.x, bb.y, bb.z, bb.w};
#pragma unroll
                  for (int e = 0; e < 4; ++e) { const float a0 = __uint_as_float(aw[e] << 16), a1 = __uint_as_float(aw[e] & 0xffff0000u), b0 = __uint_as_float(bw[e] << 16), b1 = __uint_as_float(bw[e] & 0xffff0000u);
                      qq += a0 * a0 + a1 * a1; kk += b0 * b0 + b1 * b1; qk += a0 * b0 + a1 * b1; } }
              kmx = fmaxf(kmx, kk); qmx = fmaxf(qmx, qq); dmn = fminf(dmn, qk); DG[(rowb + t0 + i) * 16 + h] = qk; }
          kn2[sub * 16 + h] = kmx; qn2[sub * 16 + h] = qmx; dgm[sub * 16 + h] = dmn; }
        LDS_WAIT(); __syncthreads();
        if (tid < 16) { double a = 0.0; for (int j = 0; j < 32; ++j) a += red[j * 16 + tid]; pre[tid] = a; }
        if (tid >= 64 && tid < 96) { const int hh = tid & 15, tl = (tid >> 4) & 1; float m = 0.f; for (int j = 0; j < 16; ++j) m = fmaxf(m, kn2[(tl * 16 + j) * 16 + hh]);
            KMAX[(size_t)(b * 16 + hh) * 64 + seg * 2 + tl] = sqrtf(m); }
        if (tid >= 128 && tid < 144) { const int hh = tid & 15; float m = 0.f, d = INFINITY; for (int j = 0; j < 32; ++j) { m = fmaxf(m, qn2[j * 16 + hh]); d = fminf(d, dgm[j * 16 + hh]); }
            const int qi = (b * 16 + hh) * 16 + (seg >> 1);
            __hip_atomic_fetch_max(F.ctl + CW_QMAX + qi, __float_as_uint(sqrtf(m)), __ATOMIC_RELAXED, __HIP_MEMORY_SCOPE_AGENT);
            __hip_atomic_fetch_max(F.ctl + CW_MNEG + qi, fkey(-d), __ATOMIC_RELAXED, __HIP_MEMORY_SCOPE_AGENT); }
        LDS_WAIT(); __syncthreads();
        double c = pre[h]; for (int j = 0; j < sub; ++j) c += tot[j * 16 + h];
#pragma unroll
        for (int i = 0; i < 4; ++i) { c += (double)lf[i]; const float cf = (float)(c * 1.4426950408889634);
            unsigned short ch, cm, cl; split3(cf, ch, cm, cl); unsigned short nh, nm, nl; split3(-cf, nh, nm, nl);
            const size_t o = ((rowb + t0 + i) * 16 + h) * 16;
            CUM2[(rowb + t0 + i) * 16 + h] = cf;
            const unsigned one2 = 0x3F803F80u;
            v4u q0; q0.x = one2; q0.y = 0x3F80u | ((unsigned)ch << 16); q0.z = (unsigned)cm | ((unsigned)cl << 16); q0.w = 0u;
            v4u q1; q1.x = 0u; q1.y = 0u; q1.z = 0u; q1.w = 0u;
            v4u k0; k0.x = (unsigned)nh | ((unsigned)nm << 16); k0.y = (unsigned)nl | (0x3F80u << 16); k0.z = one2; k0.w = one2;
            v4u k1; k1.x = 0x3F80u; k1.y = 0u; k1.z = 0u; k1.w = 0u;
            *(GAS v4u*)(QX + o) = q0; *(GAS v4u*)(QX + o + 8) = q1; *(GAS v4u*)(KX + o) = k0; *(GAS v4u*)(KX + o + 8) = k1; }
        LDS_WAIT(); __syncthreads();
    }
}
__device__ __forceinline__ void p_fox_ts(Frame& F) {
    PHASE_IDS();
    const float* CUM2 = (const float*)(F.ws + WS_CUM2); const float* KMAX = (const float*)(F.ws + WS_KMAX); unsigned char* TS = (unsigned char*)(F.ws + WS_TS);
    const int gw = F.vcu * NWAVES + wave, NGW = F.G * NWAVES;
    for (int u = gw; u < BATCH * 16 * 16; u += NGW) { const int bh = u >> 4, qb = u & 15, b = bh >> 4, h = bh & 15; const size_t rowb = (size_t)b * T;
        const float qmax = __uint_as_float(__hip_atomic_load(F.ctl + CW_QMAX + u, __ATOMIC_RELAXED, __HIP_MEMORY_SCOPE_AGENT));
        const unsigned kk = __hip_atomic_load(F.ctl + CW_MNEG + u, __ATOMIC_RELAXED, __HIP_MEMORY_SCOPE_AGENT); const float negmlo = __uint_as_float((kk & 0x80000000u) ? (kk & 0x7fffffffu) : ~kk);
        const float cq = CUM2[(rowb + 256 * qb) * 16 + h]; const float ck = CUM2[(rowb + 64 * lane + 63) * 16 + h]; const float km = KMAX[(size_t)bh * 64 + lane];
        const float bound = (cq - ck) + qmax * km + negmlo + 1.0f;
        const bool keep = (lane >= 4 * qb) || !(bound < -36.0f);
        const unsigned long long m = __ballot(keep); int first = __builtin_ctzll(m); if (first > 4 * qb) first = 4 * qb;
        const bool risky = (lane <= 4 * qb + 3) && !(qmax * km + negmlo < 60.0f);
        const unsigned guard = __ballot(risky) != 0ull ? 1u : 0u;
        if (lane == 0) TS[u] = (unsigned char)((first & ~1) | guard); }
}

struct Args { const float* in[25]; float* out; unsigned char* ws; int ph_lo, ph_hi, li, pad; };

#define IN(k) (lo <= (k) && (k) < hi)
#define BOTH(k) (IN(k) && IN((k) + 1))
#define GRID_BAR(k) do { if (BOTH(k)) xcd_barrier(bar); } while (0)
#ifndef MK_REP_MASK
#define MK_REP_MASK 0u
#endif
#define RUN(k, ...) do { if (IN(k)) { __VA_ARGS__ if ((MK_REP_MASK >> (k)) & 1u) { __VA_ARGS__ } } } while (0)

__device__ __forceinline__ void moe_phases(Frame& F, const XcdBarrier& bar, int lo, int hi, const int layer, const int pb, const float* base, const bool base16, float* out_final) {
    const float* PAR = (const float*)(F.ws + WS_PAR);
    const float* lnm_g = PAR + PAR_LN + layer * D; const float* lnm_b = PAR + PAR_LN + 2048 + layer * D; const float* lnf_g = PAR + PAR_LN + 4096 + layer * D; const float* lnf_b = PAR + PAR_LN + 6144 + layer * D;
    LAS int* tab = (LAS int*)(F.lds + RING_BYTES);
    RUN(pb,  p_ln_router(F, base, base16, lnm_g, lnm_b, PAR + PAR_WROUT + (size_t)layer * D * NEXP, PAR + PAR_BROUT + layer * NEXP, layer); GRID_BAR(pb); );
    RUN(pb + 1,
        const int nT = moe_tables(F, layer, tab);
        pg8::Gemm g{(const pg8::bf16_t*)(F.ws + WS_XB8), (const pg8::bf16_t*)(F.ws + WS_WGU + (size_t)layer * NEXP * 2048 * 1024), nT * 256, NEXP * 2048, 512};
        pg8::MoeOrder S{nT, 8, F.G, (int)blockIdx.x, (const LAS int*)(tab + 128)};
        LAS unsigned short* tokl = (LAS unsigned short*)(F.lds + RING_BYTES + 5120);
        { const unsigned short* TOKE = (const unsigned short*)(F.ws + WS_TOKE);
          if (threadIdx.x < 256) { unsigned short tk[17]; unsigned vm = 0u, um = 0u;
              _Pragma("unroll") for (int i = 0; i < 17; ++i) { pg8::Unit uu; uu.pm = 0; uu.pn = 0; const bool ok = S.next(i, uu); const int e = tab[128 + uu.pm], idx = (uu.pm - tab[e]) * 256 + (int)threadIdx.x; const bool v = ok && idx < tab[64 + e];
                  tk[i] = TOKE[v ? (size_t)e * 32768 + idx : (size_t)0]; vm |= (v ? 1u : 0u) << i; um |= (ok ? 1u : 0u) << i; }
              _Pragma("unroll") for (int i = 0; i < 17; ++i) { if ((um >> i) & 1u) tokl[i * 256 + threadIdx.x] = ((vm >> i) & 1u) ? tk[i] : (unsigned short)0; } }
          LDS_WAIT(); __syncthreads(); }
        pg8::EpiSwiglu8 E{(unsigned char*)(F.ws + WS_H), PAR + PAR_BGU + (size_t)layer * NEXP * 2048, 1.0f / (F8_XS * F8_WGS), F8_HS};
        pg8::gemm_phase<pg8::EpiSwiglu8, pg8::MoeOrder, PG8_ALIGN, PG8_SP2, true, true>(F.lds + RING_OFF, g, S, E, tokl);
        GRID_BAR(pb + 1);
    );
    RUN(pb + 2,
        const int nT = moe_tables(F, layer, tab);
        pg8::Gemm g{(const pg8::bf16_t*)(F.ws + WS_H), (const pg8::bf16_t*)(F.ws + WS_WD + (size_t)layer * NEXP * 1024 * 1024), nT * 256, NEXP * 1024, 512};
        pg8::MoeOrder S{nT, 4, F.G, (int)blockIdx.x, (const LAS int*)(tab + 128)};
        pg8::EpiDown8 E{(unsigned char*)(F.ws + WS_XG), PAR + PAR_BDOWN + (size_t)layer * NEXP * 1024, 1.0f / (F8_HS * F8_WDS), F8_YS};
        pg8::gemm_phase<pg8::EpiDown8, pg8::MoeOrder, PG8_ALIGN, PG8_SP2, false, true>(F.lds + RING_OFF, g, S, E);
        GRID_BAR(pb + 2);
    );
    RUN(pb + 3,  p_moe_combine_ln(F, lnf_g, lnf_b, out_final, layer); if (!out_final) GRID_BAR(pb + 3); );
}

__global__ void __launch_bounds__(NWAVES * 64, 2) mk_fwd(Args args) {
    extern __shared__ __attribute__((aligned(16))) unsigned char lds[];
    Frame F;
    F.lds = (LAS unsigned char*)lds;
    F.MISC = (volatile LAS unsigned*)(F.lds + MISC_OFF);
    F.G = gridDim.x; { const int bx = blockIdx.x; F.vcu = (F.G % 8 == 0) ? (bx % 8) * (F.G / 8) + bx / 8 : bx; }
    F.ws = args.ws; F.ctl = (gu32*)(args.ws + WS_CTL);
    if (threadIdx.x < 64) ((LAS unsigned*)(F.lds + MISC_OFF))[threadIdx.x] = 0u;
    __syncthreads();
    XcdBarrier bar; bar.bar = (unsigned*)(F.ctl + CW_BAR); bar.x = 0; bar.st = nullptr;
    if (MK_N_LAUNCHES == 1) bar = xcd_barrier_post((unsigned*)(F.ctl + CW_BAR), F.MISC + 8);
    const int lo = args.ph_lo, hi = args.ph_hi;

    RUN(0,
        P0In I{args.in[0], args.in[2], args.in[7], args.in[8], args.in[9], args.in[10], args.in[11], args.in[12], args.in[14], args.in[21], args.in[23],
               args.in[1], args.in[3], args.in[4], args.in[5], args.in[6], args.in[13], args.in[15], args.in[16], args.in[17], args.in[18], args.in[19], args.in[20], args.in[22], args.in[24]};
        p0_prologue(F, I); GRID_BAR(0);
    );
#if defined(MK_XBAR) && MK_XBAR
    if (MK_N_LAUNCHES == 1) { for (int xb_i = 0; xb_i < MK_XBAR; ++xb_i) xcd_barrier(bar); }
#endif
    RUN(1,
        pg8::Gemm g{(const pg8::bf16_t*)(F.ws + WS_XB), (const pg8::bf16_t*)(F.ws + WS_WAIN), M, 512, 1024}; pg8::StaticOrder S; S.init(M, 512, F.G, (int)blockIdx.x);
        const float* PAR = (const float*)(F.ws + WS_PAR);
        pg8::EpiDsaNorm E{(pg8::bf16_t*)(F.ws + WS_CQN), (pg8::bf16_t*)(F.ws + WS_CKV), (pg8::bf16_t*)(F.ws + WS_KIDX), (float*)(F.ws + WS_WIDX), PAR + PAR_AGQ, PAR + PAR_AGKV, PAR + PAR_AGKI, PAR + PAR_ABKI,
                          (unsigned*)(F.ctl + CW_CMAX), (LAS float*)(F.lds + RING_BYTES), RMS_EPS, LN_EPS};
        pg8::gemm_phase<pg8::EpiDsaNorm, pg8::StaticOrder, true, PG8_SP2>(F.lds + RING_OFF, g, S, E);
        GRID_BAR(1);
    );
    RUN(2,
        pg8::Gemm g{(const pg8::bf16_t*)(F.ws + WS_CQN), (const pg8::bf16_t*)(F.ws + WS_WACQ), M, 2560, 256}; pg8::StaticOrder S; S.init(M, 2560, F.G, (int)blockIdx.x);
        pg8::EpiCq E{(pg8::bf16_t*)(F.ws + WS_QLAT), (pg8::bf16_t*)(F.ws + WS_QIDX)};
        pg8::gemm_phase<pg8::EpiCq, pg8::StaticOrder, PG8_ALIGN, PG8_SP2>(F.lds + RING_OFF, g, S, E);
        GRID_BAR(2);
    );
    RUN(3,  p_indexer(F); GRID_BAR(3); );
    RUN(4,  p_sparse_attn(F, (const float*)(F.ws + WS_PAR) + PAR_REL); GRID_BAR(4); );
    RUN(5,
        pg8::Gemm g{(const pg8::bf16_t*)(F.ws + WS_OLAT), (const pg8::bf16_t*)(F.ws + WS_WAO), M, 1024, 1024}; pg8::StaticOrder S; S.init(M, 1024, F.G, (int)blockIdx.x);
        pg8::EpiBf16s E{(pg8::bf16_t*)(F.ws + WS_Y), D, 1.0f / (F8_OLS * F8_WAOS)};
        pg8::gemm_phase<pg8::EpiBf16s, pg8::StaticOrder, PG8_ALIGN, PG8_SP2, false, true>(F.lds + RING_OFF, g, S, E);
        GRID_BAR(5);
    );
    moe_phases(F, bar, lo, hi, 0, 6, args.in[0], false, nullptr);
    RUN(10,
        p_fox_gate(F, (const float*)(F.ws + WS_PAR) + PAR_WF, (const float*)(F.ws + WS_PAR) + PAR_BF);
        pg8::Gemm g{(const pg8::bf16_t*)(F.ws + WS_XB8), (const pg8::bf16_t*)(F.ws + WS_WBIN), M, 3072, 512}; pg8::StaticOrder S; S.init(M, 3072, F.G, (int)blockIdx.x);
        pg8::EpiQkv8 E{(pg8::bf16_t*)(F.ws + WS_Q), (size_t)(WS_K - WS_Q) / 2, 1.0f / (F8_XS * F8_WBINS), attn_body::C2};
        pg8::gemm_phase<pg8::EpiQkv8, pg8::StaticOrder, PG8_ALIGN, PG8_SP2, false, true>(F.lds + RING_OFF, g, S, E);
        GRID_BAR(10);
    );
    RUN(11,  p_fox_cum(F); GRID_BAR(11); );
    RUN(12,  p_fox_ts(F); GRID_BAR(12); );
    RUN(13,
        const attn_body::AttnTensors AT{(const attn_body::bf16*)(F.ws + WS_Q), (const attn_body::bf16*)(F.ws + WS_K), (const attn_body::bf16*)(F.ws + WS_V), (attn_body::bf16*)(F.ws + WS_O),
                                        (const attn_body::bf16*)(F.ws + WS_QX), (const attn_body::bf16*)(F.ws + WS_KX), (const float*)(F.ws + WS_DG)};
        attn_body::attn_phase<64>((char*)lds + RING_OFF, AT, (unsigned*)(F.ctl + CW_ATTQ), (const unsigned char*)(F.ws + WS_TS));
        GRID_BAR(13);
    );
    RUN(14,
        pg8::Gemm g{(const pg8::bf16_t*)(F.ws + WS_O), (const pg8::bf16_t*)(F.ws + WS_WBO), M, 1024, 512}; pg8::StaticOrder S; S.init(M, 1024, F.G, (int)blockIdx.x);
        pg8::EpiBf16s E{(pg8::bf16_t*)(F.ws + WS_Y), D, 1.0f / (F8_OS * F8_WBOS)};
        pg8::gemm_phase<pg8::EpiBf16s, pg8::StaticOrder, PG8_ALIGN, PG8_SP2, false, true>(F.lds + RING_OFF, g, S, E);
        GRID_BAR(14);
    );
    moe_phases(F, bar, lo, hi, 1, 15, (const float*)(F.ws + WS_XF), true, args.out);
}
#undef IN
#undef BOTH
#undef GRID_BAR

extern "C" void kernel_launch(void* const* d_in, const int* in_sizes, int n_in, void* d_out, int out_size, void* d_ws, size_t ws_size, hipStream_t stream) {
    static int grid = 0;
    if (grid == 0) {
        if (n_in != 25 || in_sizes[0] != M * D || out_size != M * D || ws_size < WS_END) { fprintf(stderr, "kernel_launch: unexpected shapes (n_in %d, in0 %d, out %d, ws %zu); nothing launched\n", n_in, n_in > 0 ? in_sizes[0] : -1, out_size, ws_size); grid = -1; return; }
        int dev = 0, cus = 0, per_cu = 0;
        if (hipGetDevice(&dev) != hipSuccess || hipDeviceGetAttribute(&cus, hipDeviceAttributeMultiprocessorCount, dev) != hipSuccess) { grid = -1; return; }
        if (hipFuncSetAttribute((const void*)mk_fwd, hipFuncAttributeMaxDynamicSharedMemorySize, LDS_BYTES) != hipSuccess) { fprintf(stderr, "kernel_launch: hipFuncSetAttribute failed\n"); grid = -1; return; }
        if (hipOccupancyMaxActiveBlocksPerMultiprocessor(&per_cu, (const void*)mk_fwd, NWAVES * 64, LDS_BYTES) != hipSuccess || per_cu < 1) fprintf(stderr, "kernel_launch: occupancy query reports %d workgroups per CU\n", per_cu);
        (void)hipGetLastError();
        grid = cus;
    }
    if (grid < 0) return;
    if (hipMemsetAsync((char*)d_ws + WS_CTL, 0, CTL_ZERO_BYTES, stream) != hipSuccess) return;
    Args a{};
    for (int i = 0; i < 25; ++i) a.in[i] = (const float*)d_in[i];
    a.out = (float*)d_out; a.ws = (unsigned char*)d_ws;
    constexpr int NPH = 19;
    for (int li = 0; li < MK_N_LAUNCHES; ++li) {
        if (MK_N_LAUNCHES == 1) { a.ph_lo = 0; a.ph_hi = NPH; } else { a.ph_lo = li; a.ph_hi = li + 1; }
        a.li = li;
        hipLaunchKernelGGL(mk_fwd, dim3(grid), dim3(NWAVES * 64), LDS_BYTES, stream, a);
        if (MK_N_LAUNCHES != 1 && li + 1 == NPH) break;
    }
}
```

```cpp
#define MK_N_LAUNCHES 1
#define MK_REP_MASK 0u
#define MK_P0_REP 0
#define MK_CHECK_SEL 0
#define MK_IDX_REP 0
#define MK_EPI_REP 0
#define MK_XBAR 0
#define MK_SA_EXP 0
#include <hip/hip_runtime.h>
#include <cstdio>
#include <cstdint>
namespace pg8 {
#define PG8_LAS __attribute__((address_space(3)))
typedef unsigned short bf16_t;
typedef short bf16x8 __attribute__((ext_vector_type(8)));
typedef float f32x4 __attribute__((ext_vector_type(4)));
typedef unsigned u32x4 __attribute__((ext_vector_type(4)));
typedef short bf16x16 __attribute__((ext_vector_type(16)));
typedef int i32x8 __attribute__((ext_vector_type(8)));
constexpr int BM = 256, BK = 64, HALF = 128, HTB = HALF * BK * 2  , STAGE_BYTES = 8 * HTB, NXCD = 8, WGM = 8;

__host__ __device__ __forceinline__ int lds_byte(int r, int c) { const int st = (r >> 4) * 2 + (c >> 5), rr = r & 15, cc = c & 31, ob = rr * 64 + cc * 2; return st * 1024 + (ob ^ (((ob >> 9) & 1) << 5)); }
__host__ __device__ __forceinline__ void stage_rc(int b, int& R, int& C) { const int st = b / 1024, sb = b % 1024, swz = sb ^ (((sb >> 9) & 1) << 5); R = (st >> 1) * 16 + swz / 64; C = (st & 1) * 32 + (swz % 64) / 2; }
__host__ __device__ __forceinline__ int perm32(int rho) { const int n = rho >> 4, i = rho & 15; return 8 * (i >> 2) + 4 * n + (i & 3); }

struct Unit { int pm, pn; };
struct Gemm { const bf16_t* A; const bf16_t* Bt; int M, N, K; };

struct StaticOrder {
    int nM, nN, nwg, G, c;
    __host__ __device__ void init(int M, int N, int G_, int c_) { nM = M / BM; nN = N / BM; nwg = nM * nN; G = G_; c = c_; }
    __host__ __device__ bool next(int i, Unit& u) const {
        const long L = (long)i * G + c; if (L >= nwg) return false;
        int wgid = (int)L; { const int q = nwg / NXCD, r = nwg % NXCD, xcd = wgid % NXCD, off = wgid / NXCD; wgid = (xcd < r ? xcd * (q + 1) : r * (q + 1) + (xcd - r) * q) + off; }
        const int nig = WGM * nN, gid = wgid / nig, fm = gid * WGM, gsz = (nM - fm) < WGM ? (nM - fm) : WGM;
        u.pm = fm + ((wgid % nig) % gsz); u.pn = (wgid % nig) / gsz; return true;
    }
    __device__ __forceinline__ void a_ready(const Unit&) const {}
    __device__ __forceinline__ void done(const Unit&) const {}
};

__device__ __forceinline__ unsigned cvt_pk_bf16(float lo, float hi) { unsigned r; asm volatile("v_cvt_pk_bf16_f32 %0, %1, %2" : "=v"(r) : "v"(lo), "v"(hi)); return r; }
typedef float f32x2 __attribute__((ext_vector_type(2)));
__device__ __forceinline__ f32x2 gelu_pk(f32x2 v) {
    const f32x2 av = __builtin_elementwise_abs(v), d = av * 0.2316418882f + 1.0f;
    f32x2 t; t.x = __builtin_amdgcn_rcpf(d.x); t.y = __builtin_amdgcn_rcpf(d.y);
    f32x2 q = t * 0.5307027145f + (-0.7265760135f); q = q * t + 0.7107068705f; q = q * t + (-0.142248368f); q = q * t + 0.127414796f; q = q * t;
    const f32x2 s = (v * v) * (-0.72134752044f);
    f32x2 e; e.x = __builtin_amdgcn_exp2f(s.x); e.y = __builtin_amdgcn_exp2f(s.y);
    const f32x2 m = v * (q * e), r = v - m;
    f32x2 o; o.x = v.x < 0.f ? m.x : r.x; o.y = v.y < 0.f ? m.y : r.y; return o;
}

template <int ACT  > struct EpiBf16 {
    static constexpr bool PERM = true, AFTER_DRAIN = false; static_assert(ACT == 0 || ACT == 1, "EpiBf16: ACT is 0 (none) or 1 (gelu_pk)");
    bf16_t* O; int ldc; const float* bias; int split_cols; size_t split_stride; float scale0;
    __device__ __forceinline__ void operator()(const f32x4 (&acc)[2][2][4][2], const Unit& u, int wr, int wc, int fr, int fq) const {
        const int row0 = u.pm * BM + wr * 64 + fr; int colt = u.pn * BM; bf16_t* base = O;
        float sc = 1.f; if (split_cols) { const int t = colt / split_cols; base += (size_t)t * split_stride; colt -= t * split_cols; if (t == 0) sc = scale0; }
        const int col0 = colt + wc * 32 + 8 * fq, bcol0 = u.pn * BM + wc * 32 + 8 * fq;
        f32x4 bv[2][2];
#pragma unroll
        for (int bj = 0; bj < 2; ++bj)
#pragma unroll
            for (int n = 0; n < 2; ++n) bv[bj][n] = bias ? *(const f32x4*)(bias + bcol0 + bj * HALF + 4 * n) : (f32x4){0.f, 0.f, 0.f, 0.f};
#pragma unroll
        for (int ai = 0; ai < 2; ++ai)
#pragma unroll
            for (int m = 0; m < 4; ++m) { bf16_t* rowp = base + (size_t)(row0 + ai * HALF + m * 16) * ldc + col0;
#pragma unroll
                for (int bj = 0; bj < 2; ++bj) { f32x4 v0 = acc[ai][bj][m][0] + bv[bj][0], v1 = acc[ai][bj][m][1] + bv[bj][1];
                    if (ACT == 1) { f32x2 a = gelu_pk((f32x2){v0[0], v0[1]}), b = gelu_pk((f32x2){v0[2], v0[3]}), c = gelu_pk((f32x2){v1[0], v1[1]}), d = gelu_pk((f32x2){v1[2], v1[3]});
                        v0 = (f32x4){a.x, a.y, b.x, b.y}; v1 = (f32x4){c.x, c.y, d.x, d.y}; }
                    v0 = v0 * sc; v1 = v1 * sc; u32x4 w; w.x = cvt_pk_bf16(v0[0], v0[1]); w.y = cvt_pk_bf16(v0[2], v0[3]); w.z = cvt_pk_bf16(v1[0], v1[1]); w.w = cvt_pk_bf16(v1[2], v1[3]);
                    *(u32x4*)(rowp + bj * HALF) = w; } }
    }
};

struct PanelStats {
    unsigned* xbuf;
    unsigned* cnt;
    unsigned* tmo;
    int ntn; float eps;
    unsigned code;
    __device__ __forceinline__ bool run(const f32x4 (&v)[2][2][4][2], const Unit& u, int wr, int wc, int fr, int fq, PG8_LAS unsigned char* lds, int wid, int lane) const {
        typedef float f32x2v __attribute__((ext_vector_type(2)));
        PG8_LAS f32x2v* P = (PG8_LAS f32x2v*)lds;
        PG8_LAS f32x2v* S = (PG8_LAS f32x2v*)(lds + 8192);
        PG8_LAS unsigned* flag = (PG8_LAS unsigned*)(lds + 8192 + 2048);
#pragma unroll
        for (int ai = 0; ai < 2; ++ai)
#pragma unroll
            for (int m = 0; m < 4; ++m) {
                float s = 0.f;
#pragma unroll
                for (int bj = 0; bj < 2; ++bj)
#pragma unroll
                    for (int n = 0; n < 2; ++n) { const f32x4 x = v[ai][bj][m][n]; s += (x[0] + x[1]) + (x[2] + x[3]); }
                s += __shfl_xor(s, 16); s += __shfl_xor(s, 32);
                const float mw = s * (1.0f / 64.0f); float q = 0.f;
#pragma unroll
                for (int bj = 0; bj < 2; ++bj)
#pragma unroll
                    for (int n = 0; n < 2; ++n) { const f32x4 d = v[ai][bj][m][n] - mw; q += (d[0] * d[0] + d[1] * d[1]) + (d[2] * d[2] + d[3] * d[3]); }
                q += __shfl_xor(q, 16); q += __shfl_xor(q, 32);
                if (fq == 0) P[(ai * HALF + wr * 64 + m * 16 + fr) * 4 + wc] = (f32x2v){mw, q};
            }
        asm volatile("s_waitcnt lgkmcnt(0)" ::: "memory"); __builtin_amdgcn_s_barrier(); asm volatile("" ::: "memory");
#if defined(BROKEN_EXCHANGE_NO_WAIT)
#warning BROKEN CONTROL BUILD: the row-statistics exchange does not wait; results are wrong by design
        if (blockIdx.x >= 64) { const long long t0_ = clock64(); while (clock64() - t0_ < 60000) __builtin_amdgcn_s_sleep(8); }
#endif
        const int row = wid * 32 + (lane & 31);
        if (lane < 32) {
            const f32x2v a = P[row * 4 + 0], b = P[row * 4 + 1], c = P[row * 4 + 2], d = P[row * 4 + 3];
            const float mt = (a.x + b.x + c.x + d.x) * 0.25f;
            const float da = a.x - mt, db = b.x - mt, dc = c.x - mt, dd = d.x - mt;
            const float m2 = (a.y + b.y) + (c.y + d.y) + 64.0f * ((da * da + db * db) + (dc * dc + dd * dd));
            unsigned long long* slot = (unsigned long long*)xbuf + ((size_t)(u.pm * BM + row) * 4 + u.pn);
            __hip_atomic_store(slot, ((unsigned long long)__float_as_uint(m2) << 32) | __float_as_uint(mt), __ATOMIC_RELAXED, __HIP_MEMORY_SCOPE_AGENT);
        }
        asm volatile("s_waitcnt vmcnt(0)" ::: "memory");
        if (lane == 0) __hip_atomic_fetch_add(cnt + 64 * u.pm, 1u, __ATOMIC_RELAXED, __HIP_MEMORY_SCOPE_AGENT);
        if (wid == 0) {
            bool dead = false; const unsigned long long t0 = __builtin_amdgcn_s_memrealtime(); const unsigned want = 8u * (unsigned)ntn;
            for (;;) {
#if defined(BROKEN_EXCHANGE_NO_WAIT)
                break;
#endif
                if ((unsigned)__builtin_amdgcn_readfirstlane(__hip_atomic_load(cnt + 64 * u.pm, __ATOMIC_RELAXED, __HIP_MEMORY_SCOPE_AGENT)) >= want) break;
                if (__builtin_amdgcn_s_memrealtime() - t0 > 2000000ull) {
                    if (lane == 0) { unsigned expect = 0u; __hip_atomic_compare_exchange_strong(tmo + 1, &expect, code | (unsigned)(u.pm & 0xff), __ATOMIC_RELAXED, __ATOMIC_RELAXED, __HIP_MEMORY_SCOPE_AGENT);
                                     __hip_atomic_store(tmo, 1u, __ATOMIC_RELAXED, __HIP_MEMORY_SCOPE_AGENT); }
                    dead = true; break; }
                __builtin_amdgcn_s_sleep(2);
            }
            __builtin_amdgcn_fence(__ATOMIC_ACQUIRE, "agent");
            if (lane == 0) flag[0] = dead ? 1u : 0u;
        }
        asm volatile("s_waitcnt vmcnt(0) lgkmcnt(0)" ::: "memory"); __builtin_amdgcn_s_barrier(); asm volatile("" ::: "memory");
        const bool bad = flag[0] != 0u;
        if (lane < 32) {
            const unsigned long long* slot = (const unsigned long long*)xbuf + (size_t)(u.pm * BM + row) * 4; float mt[4], m2[4]; float ms = 0.f;
#pragma unroll
            for (int t = 0; t < 4; ++t) { if (t < ntn) { const unsigned long long w = __hip_atomic_load(slot + t, __ATOMIC_RELAXED, __HIP_MEMORY_SCOPE_AGENT); mt[t] = __uint_as_float((unsigned)w); m2[t] = __uint_as_float((unsigned)(w >> 32)); } else { mt[t] = 0.f; m2[t] = 0.f; } ms += mt[t]; }
            const float mean = ms / (float)ntn; float q = 0.f;
#pragma unroll
            for (int t = 0; t < 4; ++t) if (t < ntn) { const float dm = mt[t] - mean; q += m2[t] + 256.0f * dm * dm; }
            S[row] = (f32x2v){mean, 1.0f / sqrtf(q / (256.0f * (float)ntn) + eps)};
        }
        asm volatile("s_waitcnt lgkmcnt(0)" ::: "memory"); __builtin_amdgcn_s_barrier(); asm volatile("" ::: "memory");
        return bad;
    }
};
struct EpiLnRes {
    static constexpr bool PERM = false, AFTER_DRAIN = true;
    const float* base; float* out; int ldc; const float* bias; PanelStats st; unsigned poison;
    __device__ __forceinline__ void fused(f32x4 (&acc)[2][2][4][2], const Unit& u, int wr, int wc, int fr, int fq, PG8_LAS unsigned char* lds, int wid, int lane) const {
        typedef float f32x2v __attribute__((ext_vector_type(2)));
        const PG8_LAS f32x2v* S = (const PG8_LAS f32x2v*)(lds + 8192);
        const int col0 = u.pn * BM + wc * 32 + 4 * fq;
#pragma unroll
        for (int bj = 0; bj < 2; ++bj)
#pragma unroll
            for (int n = 0; n < 2; ++n) { const f32x4 bv = bias ? *(const f32x4*)(bias + col0 + bj * HALF + n * 16) : (f32x4){0.f, 0.f, 0.f, 0.f};
#pragma unroll
                for (int ai = 0; ai < 2; ++ai)
#pragma unroll
                    for (int m = 0; m < 4; ++m) acc[ai][bj][m][n] += bv; }
        f32x4 pre[4][2][2];
#pragma unroll
        for (int m = 0; m < 4; ++m) { const size_t off = (size_t)(u.pm * BM + wr * 64 + m * 16 + fr) * ldc + col0;
#pragma unroll
            for (int bj = 0; bj < 2; ++bj)
#pragma unroll
                for (int n = 0; n < 2; ++n) pre[m][bj][n] = *(const f32x4*)(base + off + bj * HALF + n * 16); }
        const bool bad = st.run(acc, u, wr, wc, fr, fq, lds, wid, lane) || poison != 0u;
        const float qnan = __builtin_nanf("");
#pragma unroll
        for (int ai = 0; ai < 2; ++ai)
#pragma unroll
            for (int m = 0; m < 4; ++m) { const int r = ai * HALF + wr * 64 + m * 16 + fr; const f32x2v sr = S[r]; const size_t off = (size_t)(u.pm * BM + r) * ldc + col0;
#pragma unroll
                for (int bj = 0; bj < 2; ++bj)
#pragma unroll
                    for (int n = 0; n < 2; ++n) { const f32x4 bs = ai == 0 ? pre[m][bj][n] : *(const f32x4*)(base + off + bj * HALF + n * 16); f32x4 o = bs + (acc[ai][bj][m][n] - sr.x) * sr.y;
                        if (bad) o = (f32x4){qnan, qnan, qnan, qnan}; *(f32x4*)(out + off + bj * HALF + n * 16) = o; }
                if (m & 1) asm volatile("" ::: "memory"); }
    }
};
struct EpiLnResLn {
    static constexpr bool PERM = false, AFTER_DRAIN = true;
    const float* base; float* out; bf16_t* xn; int ldc; const float* bias; PanelStats st1, st2; unsigned poison;
    __device__ __forceinline__ void fused(f32x4 (&acc)[2][2][4][2], const Unit& u, int wr, int wc, int fr, int fq, PG8_LAS unsigned char* lds, int wid, int lane) const {
        typedef float f32x2v __attribute__((ext_vector_type(2))); typedef unsigned u32x2v __attribute__((ext_vector_type(2)));
        const PG8_LAS f32x2v* S = (const PG8_LAS f32x2v*)(lds + 8192);
        const int col0 = u.pn * BM + wc * 32 + 4 * fq;
#pragma unroll
        for (int bj = 0; bj < 2; ++bj)
#pragma unroll
            for (int n = 0; n < 2; ++n) { const f32x4 bv = bias ? *(const f32x4*)(bias + col0 + bj * HALF + n * 16) : (f32x4){0.f, 0.f, 0.f, 0.f};
#pragma unroll
                for (int ai = 0; ai < 2; ++ai)
#pragma unroll
                    for (int m = 0; m < 4; ++m) acc[ai][bj][m][n] += bv; }
        bool bad = st1.run(acc, u, wr, wc, fr, fq, lds, wid, lane) || poison != 0u;
        const float qnan = __builtin_nanf("");
#pragma unroll
        for (int ai = 0; ai < 2; ++ai)
#pragma unroll
            for (int m = 0; m < 4; ++m) { const int r = ai * HALF + wr * 64 + m * 16 + fr; const f32x2v sr = S[r]; const size_t off = (size_t)(u.pm * BM + r) * ldc + col0;
#pragma unroll
                for (int bj = 0; bj < 2; ++bj)
#pragma unroll
                    for (int n = 0; n < 2; ++n) { const f32x4 bs = *(const f32x4*)(base + off + bj * HALF + n * 16); acc[ai][bj][m][n] = bs + (acc[ai][bj][m][n] - sr.x) * sr.y; }
                asm volatile("" : "+v"(acc[ai][0][m][0]), "+v"(acc[ai][0][m][1]), "+v"(acc[ai][1][m][0]), "+v"(acc[ai][1][m][1]));
                if (m & 1) asm volatile("" ::: "memory"); }
        const bool bad1 = bad;
        bad = st2.run(acc, u, wr, wc, fr, fq, lds, wid, lane) || bad;
#pragma unroll
        for (int ai = 0; ai < 2; ++ai)
#pragma unroll
            for (int m = 0; m < 4; ++m) { const int r = ai * HALF + wr * 64 + m * 16 + fr; const f32x2v sr = S[r]; const size_t off = (size_t)(u.pm * BM + r) * ldc + col0;
#pragma unroll
                for (int bj = 0; bj < 2; ++bj)
#pragma unroll
                    for (int n = 0; n < 2; ++n) { const f32x4 x1 = acc[ai][bj][m][n]; *(f32x4*)(out + off + bj * HALF + n * 16) = bad1 ? (f32x4){qnan, qnan, qnan, qnan} : x1;
                        const f32x4 o = (x1 - sr.x) * sr.y; u32x2v w; w.x = cvt_pk_bf16(o[0], o[1]); w.y = cvt_pk_bf16(o[2], o[3]);
                        if (bad) { w.x = 0x7fc07fc0u; w.y = 0x7fc07fc0u; } *(u32x2v*)(xn + off + bj * HALF + n * 16) = w; }
                asm volatile("" ::: "memory"); }
    }
};

template <class Epi, class Sched, bool ALIGN_EPI = false, bool SP2 = false, bool GATHER = false, bool F8 = false>
__device__ __forceinline__ void gemm_phase(PG8_LAS unsigned char* lds, const Gemm g, const Sched& S, const Epi& E, const PG8_LAS unsigned short* tokl = nullptr) {
    int tid_ = threadIdx.x; asm volatile("" : "+v"(tid_));
    const int tid = tid_, wid = __builtin_amdgcn_readfirstlane(tid >> 6), lane = tid & 63, wr = wid >> 2, wc = wid & 3, fr = lane & 15, fq = lane >> 4;
    const int K = g.K, nt = K / BK;
    unsigned voffA[2], voffB[2];
#pragma unroll
    for (int i = 0; i < 2; ++i) { int R, C; stage_rc(tid * 16 + i * 8192, R, C); const int Rb = Epi::PERM ? ((R & ~31) + perm32(R & 31)) : R;
        voffA[i] = GATHER ? (unsigned)C * 2u : (unsigned)(R * K + C) * 2u; voffB[i] = (unsigned)(Rb * K + C) * 2u; }
    const size_t rowbytes = (size_t)K * 2; unsigned tkc[2] = {0u, 0u}; (void)rowbytes;
#define PG8_LOADTK(dst, unit_i) do { int R0_, C0_, R1_, C1_; stage_rc(tid * 16, R0_, C0_); stage_rc(tid * 16 + 8192, R1_, C1_); (void)C0_; (void)C1_; \
        _Pragma("unroll") for (int h_ = 0; h_ < 2; ++h_) dst[h_] = (unsigned)tokl[(unit_i) * 256 + h_ * HALF + R0_] | ((unsigned)tokl[(unit_i) * 256 + h_ * HALF + R1_] << 16); } while (0)
#define PG8_STAGE_A(bufoff, gbase, half, TK) do { if constexpr (GATHER) { _Pragma("unroll") for (int _i = 0; _i < 2; ++_i) { const unsigned _tok = ((TK)[half] >> (16 * _i)) & 0xffffu; \
        __builtin_amdgcn_global_load_lds((const unsigned*)((const char*)(gbase) + (size_t)_tok * rowbytes + voffA[_i]), (PG8_LAS unsigned*)(lds + (bufoff) + ldsw + _i * 8192), 16, 0, 0); } } \
    else { PG8_STAGE(bufoff, (gbase) + (half) * hstep, voffA); } } while (0)
    const size_t kstep = (size_t)(BK * 2);
    const size_t hstep = (size_t)HALF * K * 2;
    const size_t tstep = 2 * hstep;
    const unsigned ldsw = (unsigned)wid * 1024u;
    const int aoff = lds_byte(wr * 64 + fr, fq * 8), boff = lds_byte(wc * 32 + fr, fq * 8);
    unsigned f8scl = 0x7f7f7f7fu; asm volatile("" : "+v"(f8scl)); (void)f8scl;
    constexpr int KFS = 1024;
#define PG8_SA(b, h) (((b) * 2 + (h)) * HTB)
#define PG8_SB(b, h) ((4 + (b) * 2 + (h)) * HTB)
#define PG8_STAGE(bufoff, gbase, voff) do { _Pragma("unroll") for (int _i = 0; _i < 2; ++_i) \
        __builtin_amdgcn_global_load_lds((const unsigned*)((const char*)(gbase) + (voff)[_i]), (PG8_LAS unsigned*)(lds + (bufoff) + ldsw + _i * 8192), 16, 0, 0); } while (0)
#define PG8_LDA(dst, b, h) do { _Pragma("unroll") for (int m = 0; m < 4; ++m) _Pragma("unroll") for (int k = 0; k < 2; ++k) dst[m][k] = *(const PG8_LAS bf16x8*)(lds + PG8_SA(b, h) + aoff + m * 2048 + k * KFS); } while (0)
#define PG8_LDB(dst, b, h) do { _Pragma("unroll") for (int n = 0; n < 2; ++n) _Pragma("unroll") for (int k = 0; k < 2; ++k) dst[n][k] = *(const PG8_LAS bf16x8*)(lds + PG8_SB(b, h) + boff + n * 2048 + k * KFS); } while (0)
#define PG8_F8FRAG(X) __builtin_bit_cast(i32x8, __builtin_shufflevector(X[0], X[1], 0, 1, 2, 3, 4, 5, 6, 7, 8, 9, 10, 11, 12, 13, 14, 15))
#define PG8_MMA(ai, bj, At, Bt) do { __builtin_amdgcn_s_setprio(1); if constexpr (F8) { const i32x8 b80_ = PG8_F8FRAG(Bt[0]), b81_ = PG8_F8FRAG(Bt[1]); _Pragma("unroll") for (int m = 0; m < 4; ++m) { const i32x8 a8_ = PG8_F8FRAG(At[m]); \
        asm volatile("v_mfma_scale_f32_16x16x128_f8f6f4 %0, %1, %2, %0, %3, %3 op_sel_hi:[0,0,0]" : "+v"(acc[ai][bj][m][0]) : "v"(b80_), "v"(a8_), "v"(f8scl)); \
        asm volatile("v_mfma_scale_f32_16x16x128_f8f6f4 %0, %1, %2, %0, %3, %3 op_sel_hi:[0,0,0]" : "+v"(acc[ai][bj][m][1]) : "v"(b81_), "v"(a8_), "v"(f8scl)); } } else { \
        _Pragma("unroll") for (int m = 0; m < 4; ++m) _Pragma("unroll") for (int n = 0; n < 2; ++n) _Pragma("unroll") for (int k = 0; k < 2; ++k) \
        acc[ai][bj][m][n] = __builtin_amdgcn_mfma_f32_16x16x32_bf16(Bt[n][k], At[m][k], acc[ai][bj][m][n], 0, 0, 0); } __builtin_amdgcn_s_setprio(0); } while (0)
#define PG8_WAIT_V(n) asm volatile("s_waitcnt vmcnt(" #n ")" ::: "memory")
#define PG8_WAIT_L(n) asm volatile("s_waitcnt lgkmcnt(" #n ")" ::: "memory")
#define PG8_BAR __builtin_amdgcn_s_barrier()
#define PG8_SCHED __builtin_amdgcn_sched_barrier(0)
    Unit cur, nxt; int ui = 0;
    if (!S.next(0, cur)) return;
    f32x4 acc[2][2][4][2];
#pragma unroll
    for (int a = 0; a < 2; ++a)
#pragma unroll
        for (int b = 0; b < 2; ++b)
#pragma unroll
            for (int m = 0; m < 4; ++m)
#pragma unroll
                for (int n = 0; n < 2; ++n) acc[a][b][m][n] = (f32x4){0.f, 0.f, 0.f, 0.f};
    bf16x8 At[4][2], B0[2][2], B1[2][2];
    const char* cA = (const char*)g.A + (GATHER ? (size_t)0 : (size_t)cur.pm * tstep); const char* cB = (const char*)g.Bt + (size_t)cur.pn * tstep;
    if constexpr (GATHER) { PG8_LOADTK(tkc, 0); }
    S.a_ready(cur);
    if constexpr (SP2) {
        PG8_STAGE(PG8_SB(0, 0), cB, voffB); PG8_STAGE(PG8_SB(0, 1), cB + hstep, voffB); PG8_STAGE_A(PG8_SA(0, 0), cA, 0, tkc); PG8_STAGE_A(PG8_SA(0, 1), cA, 1, tkc);
        if (wr == 1) PG8_BAR;
        PG8_WAIT_V(2); PG8_BAR;
        PG8_STAGE(PG8_SB(1, 0), cB + kstep, voffB); PG8_STAGE_A(PG8_SA(1, 0), cA + kstep, 0, tkc); PG8_STAGE(PG8_SB(1, 1), cB + hstep + kstep, voffB);
        PG8_WAIT_V(6); PG8_BAR;
    } else {
        PG8_STAGE(PG8_SB(0, 0), cB, voffB); PG8_STAGE_A(PG8_SA(0, 0), cA, 0, tkc); PG8_STAGE(PG8_SB(0, 1), cB + hstep, voffB); PG8_STAGE_A(PG8_SA(0, 1), cA, 1, tkc);
        if (wr == 1) PG8_BAR;
        PG8_WAIT_V(4); PG8_BAR;
        PG8_STAGE(PG8_SB(1, 0), cB + kstep, voffB); PG8_STAGE_A(PG8_SA(1, 0), cA + kstep, 0, tkc); PG8_STAGE(PG8_SB(1, 1), cB + hstep + kstep, voffB);
        PG8_WAIT_V(6); PG8_BAR;
    }
    for (;;) {
        const bool has_next = S.next(ui + 1, nxt);
        const char* nA = has_next ? (const char*)g.A + (GATHER ? (size_t)0 : (size_t)nxt.pm * tstep) : cA;
 const char* nB = has_next ? (const char*)g.Bt + (size_t)nxt.pn * tstep : cB;
        for (int t = 0; t < nt; t += 2) {
            const bool last = (t == nt - 2);
            const char* a1 = cA + (size_t)(t + 1) * kstep;
            const char* a2 = last ? nA : cA + (size_t)(t + 2) * kstep; const char* b2 = last ? nB : cB + (size_t)(t + 2) * kstep;
            const char* a3 = a2 + kstep; const char* b3 = b2 + kstep;
            unsigned tk2[2]; tk2[0] = tkc[0]; tk2[1] = tkc[1]; (void)tk2;
            if constexpr (GATHER) { if (last && has_next) { PG8_LOADTK(tk2, ui + 1); } }
            if (last && has_next) S.a_ready(nxt);
            if constexpr (SP2) {
            PG8_LDB(B0, 0, 0); PG8_LDB(B1, 0, 1); PG8_SCHED; PG8_LDA(At, 0, 0); PG8_STAGE_A(PG8_SA(1, 1), a1, 1, tkc);
            PG8_WAIT_V(8); PG8_WAIT_L(0); PG8_BAR; PG8_MMA(0, 0, At, B0); PG8_MMA(0, 1, At, B1); PG8_BAR; PG8_SCHED;
            PG8_LDA(At, 0, 1); PG8_STAGE(PG8_SB(0, 0), b2, voffB); PG8_STAGE(PG8_SB(0, 1), b2 + hstep, voffB); PG8_STAGE_A(PG8_SA(0, 0), a2, 0, tk2);
            PG8_WAIT_V(8); PG8_WAIT_L(0); PG8_BAR; PG8_MMA(1, 0, At, B0); PG8_MMA(1, 1, At, B1); PG8_BAR; PG8_SCHED;
            PG8_LDB(B0, 1, 0); PG8_LDB(B1, 1, 1); PG8_SCHED; PG8_LDA(At, 1, 0); PG8_STAGE_A(PG8_SA(0, 1), a2, 1, tk2);
            PG8_WAIT_V(8); PG8_WAIT_L(0); PG8_BAR; PG8_MMA(0, 0, At, B0); PG8_MMA(0, 1, At, B1); PG8_BAR; PG8_SCHED;
            PG8_LDA(At, 1, 1); PG8_STAGE(PG8_SB(1, 0), b3, voffB); PG8_STAGE(PG8_SB(1, 1), b3 + hstep, voffB); PG8_STAGE_A(PG8_SA(1, 0), a3, 0, tk2);
            PG8_WAIT_V(8); PG8_WAIT_L(0); PG8_BAR; PG8_MMA(1, 0, At, B0); PG8_MMA(1, 1, At, B1); PG8_BAR; PG8_SCHED;
            } else {
            PG8_LDB(B0, 0, 0); PG8_SCHED; PG8_LDA(At, 0, 0); PG8_STAGE_A(PG8_SA(1, 1), a1, 1, tkc);
            PG8_WAIT_L(8); PG8_BAR; PG8_WAIT_L(0); PG8_MMA(0, 0, At, B0); PG8_BAR; PG8_SCHED;
            PG8_LDB(B1, 0, 1); PG8_STAGE(PG8_SB(0, 0), b2, voffB);
            PG8_BAR; PG8_WAIT_L(0); PG8_MMA(0, 1, At, B1); PG8_BAR;
            PG8_LDA(At, 0, 1); PG8_STAGE_A(PG8_SA(0, 0), a2, 0, tk2);
            PG8_BAR; PG8_WAIT_L(0); PG8_MMA(1, 0, At, B0); PG8_BAR; PG8_SCHED;
            PG8_STAGE(PG8_SB(0, 1), b2 + hstep, voffB);
            PG8_WAIT_V(6); PG8_BAR; PG8_MMA(1, 1, At, B1); PG8_BAR;
            PG8_LDB(B0, 1, 0); PG8_SCHED; PG8_LDA(At, 1, 0); PG8_STAGE_A(PG8_SA(0, 1), a2, 1, tk2);
            PG8_WAIT_L(8); PG8_BAR; PG8_WAIT_L(0); PG8_MMA(0, 0, At, B0); PG8_BAR; PG8_SCHED;
            PG8_LDB(B1, 1, 1); PG8_STAGE(PG8_SB(1, 0), b3, voffB);
            PG8_BAR; PG8_WAIT_L(0); PG8_MMA(0, 1, At, B1); PG8_BAR;
            PG8_LDA(At, 1, 1); PG8_STAGE_A(PG8_SA(1, 0), a3, 0, tk2);
            PG8_BAR; PG8_WAIT_L(0); PG8_MMA(1, 0, At, B0); PG8_BAR; PG8_SCHED;
            PG8_STAGE(PG8_SB(1, 1), b3 + hstep, voffB);
            PG8_WAIT_V(6); PG8_BAR; PG8_MMA(1, 1, At, B1); PG8_BAR;
            }
        }
        if constexpr (ALIGN_EPI) { if (wr == 0) PG8_BAR; }
        if constexpr (F8) asm volatile("s_nop 15\n\ts_nop 15" ::: "memory");
        if constexpr (!Epi::AFTER_DRAIN) { E(acc, cur, wr, wc, fr, fq);
#if defined(MK_EPI_REP) && MK_EPI_REP
            E(acc, cur, wr, wc, fr, fq);
#endif
            S.done(cur); }
        if (!has_next) break;
#pragma unroll
        for (int a = 0; a < 2; ++a)
#pragma unroll
            for (int b = 0; b < 2; ++b)
#pragma unroll
                for (int m = 0; m < 4; ++m)
#pragma unroll
                    for (int n = 0; n < 2; ++n) acc[a][b][m][n] = (f32x4){0.f, 0.f, 0.f, 0.f};
        cur = nxt; cA = nA; cB = nB; ++ui; if constexpr (GATHER) { PG8_LOADTK(tkc, ui); }
        if constexpr (ALIGN_EPI) { if (wr == 1) PG8_BAR; }
    }
    PG8_WAIT_V(0);
    if constexpr (!ALIGN_EPI) { if (wr == 0) PG8_BAR; }
    PG8_BAR;
    if constexpr (Epi::AFTER_DRAIN) { E.fused(acc, cur, wr, wc, fr, fq, lds, wid, lane); S.done(cur); }
#undef PG8_SA
#undef PG8_SB
#undef PG8_STAGE
#undef PG8_STAGE_A
#undef PG8_LOADTK
#undef PG8_LDA
#undef PG8_LDB
#undef PG8_MMA
#undef PG8_F8FRAG
#undef PG8_WAIT_V
#undef PG8_WAIT_L
#undef PG8_BAR
#undef PG8_SCHED
}
}
namespace pg8 {
struct EpiF32 {
    static constexpr bool PERM = false, AFTER_DRAIN = false;
    float* O; int ldc;
    __device__ __forceinline__ void operator()(const f32x4 (&acc)[2][2][4][2], const Unit& u, int wr, int wc, int fr_, int fq_) const {
        int t_ = threadIdx.x; asm volatile("" : "+v"(t_)); const int fr = t_ & 15, fq = (t_ & 63) >> 4; (void)fr_; (void)fq_;
        const int row0 = u.pm * BM + wr * 64 + fr, col0 = u.pn * BM + wc * 32 + 4 * fq;
#pragma unroll
        for (int ai = 0; ai < 2; ++ai)
#pragma unroll
            for (int m = 0; m < 4; ++m) { float* rowp = O + (size_t)(row0 + ai * HALF + m * 16) * ldc + col0;
#pragma unroll
                for (int bj = 0; bj < 2; ++bj)
#pragma unroll
                    for (int n = 0; n < 2; ++n) *(f32x4*)(rowp + bj * HALF + n * 16) = acc[ai][bj][m][n]; }
    }
};
struct EpiResF32 {
    static constexpr bool PERM = false, AFTER_DRAIN = false;
    const float* base; float* out; int ldc; float alpha;
    __device__ __forceinline__ void operator()(const f32x4 (&acc)[2][2][4][2], const Unit& u, int wr, int wc, int fr_, int fq_) const {
        int t_ = threadIdx.x; asm volatile("" : "+v"(t_)); const int fr = t_ & 15, fq = (t_ & 63) >> 4; (void)fr_; (void)fq_;
        const int row0 = u.pm * BM + wr * 64 + fr, col0 = u.pn * BM + wc * 32 + 4 * fq;
#pragma unroll
        for (int ai = 0; ai < 2; ++ai)
#pragma unroll
            for (int m = 0; m < 4; ++m) { const size_t off = (size_t)(row0 + ai * HALF + m * 16) * ldc + col0;
                f32x4 bs[2][2];
#pragma unroll
                for (int bj = 0; bj < 2; ++bj)
#pragma unroll
                    for (int n = 0; n < 2; ++n) bs[bj][n] = *(const f32x4*)(base + off + bj * HALF + n * 16);
#pragma unroll
                for (int bj = 0; bj < 2; ++bj)
#pragma unroll
                    for (int n = 0; n < 2; ++n) *(f32x4*)(out + off + bj * HALF + n * 16) = bs[bj][n] * alpha + acc[ai][bj][m][n]; }
    }
};
struct EpiDsaNorm {
    static constexpr bool PERM = false, AFTER_DRAIN = false;
    bf16_t* cqn; bf16_t* ckv; bf16_t* kidx; float* widx; const float* gq; const float* gkv; const float* gki; const float* bki; unsigned* cmaxw; PG8_LAS float* scr; float rms_eps, ln_eps;
    __device__ __forceinline__ void operator()(const f32x4 (&acc)[2][2][4][2], const Unit& u, int wr, int wc, int fr_, int fq_) const {
        int t_ = threadIdx.x; asm volatile("" : "+v"(t_)); const int fr = t_ & 15, fq = (t_ & 63) >> 4; (void)fr_; (void)fq_;
#define EDN_RED4(v_) do { v_ += __shfl_xor(v_, 16); v_ += __shfl_xor(v_, 32); } while (0)
#define EDN_BAR() asm volatile("s_waitcnt lgkmcnt(0)\n\ts_barrier" ::: "memory")
#define EDN_PK(v_) ({ u32x2e w_; w_.x = cvt_pk_bf16((v_)[0], (v_)[1]); w_.y = cvt_pk_bf16((v_)[2], (v_)[3]); w_; })
        typedef unsigned u32x2e __attribute__((ext_vector_type(2)));
        if (u.pn == 0) {
#pragma unroll
            for (int ai = 0; ai < 2; ++ai)
#pragma unroll
                for (int m = 0; m < 4; ++m) { float s = 0.f;
#pragma unroll
                    for (int bj = 0; bj < 2; ++bj)
#pragma unroll
                        for (int n = 0; n < 2; ++n) { const f32x4 x = acc[ai][bj][m][n]; s += (x[0] * x[0] + x[1] * x[1]) + (x[2] * x[2] + x[3] * x[3]); }
                    EDN_RED4(s); if (fq == 0) scr[(ai * HALF + wr * 64 + m * 16 + fr) * 4 + wc] = s; }
            EDN_BAR();
#pragma unroll
            for (int ai = 0; ai < 2; ++ai)
#pragma unroll
                for (int m = 0; m < 4; ++m) { const int rl = ai * HALF + wr * 64 + m * 16 + fr; const f32x4 p4 = *(const PG8_LAS f32x4*)(scr + rl * 4);
                    const float rq = 1.0f / sqrtf(((p4[0] + p4[1]) + (p4[2] + p4[3])) * (1.0f / 256.0f) + rms_eps); bf16_t* rowp = cqn + (size_t)(u.pm * BM + rl) * 256;
#pragma unroll
                    for (int bj = 0; bj < 2; ++bj)
#pragma unroll
                        for (int n = 0; n < 2; ++n) { const int col = bj * HALF + wc * 32 + n * 16 + 4 * fq; const f32x4 v = acc[ai][bj][m][n] * rq * *(const f32x4*)(gq + col); *(u32x2e*)(rowp + col) = EDN_PK(v); } }
        } else {
            float cmx = 0.f;
#pragma unroll
            for (int ai = 0; ai < 2; ++ai)
#pragma unroll
                for (int m = 0; m < 4; ++m) { const int rl = ai * HALF + wr * 64 + m * 16 + fr; float s1 = 0.f, s4 = 0.f, s2 = 0.f, s3 = 0.f;
#pragma unroll
                    for (int n = 0; n < 2; ++n) { const f32x4 x = acc[ai][0][m][n]; const f32x4 xg = x * *(const f32x4*)(gkv + wc * 32 + n * 16 + 4 * fq);
                        s1 += (x[0] * x[0] + x[1] * x[1]) + (x[2] * x[2] + x[3] * x[3]); s4 += (xg[0] * xg[0] + xg[1] * xg[1]) + (xg[2] * xg[2] + xg[3] * xg[3]);
                        const f32x4 y = acc[ai][1][m][n]; s2 += (y[0] + y[1]) + (y[2] + y[3]); s3 += (y[0] * y[0] + y[1] * y[1]) + (y[2] * y[2] + y[3] * y[3]); }
                    EDN_RED4(s1); EDN_RED4(s4); EDN_RED4(s2); EDN_RED4(s3);
                    if (fq == 0) { scr[rl * 4 + wc] = s1; scr[1024 + rl * 4 + wc] = s4; if (wc < 2) { scr[2048 + rl * 2 + wc] = s2; scr[2560 + rl * 2 + wc] = s3; } } }
            EDN_BAR();
#pragma unroll
            for (int ai = 0; ai < 2; ++ai)
#pragma unroll
                for (int m = 0; m < 4; ++m) { const int rl = ai * HALF + wr * 64 + m * 16 + fr; const size_t grow = (size_t)(u.pm * BM + rl);
                    const f32x4 p1 = *(const PG8_LAS f32x4*)(scr + rl * 4), p4 = *(const PG8_LAS f32x4*)(scr + 1024 + rl * 4);
                    const float rkv = 1.0f / sqrtf(((p1[0] + p1[1]) + (p1[2] + p1[3])) * (1.0f / 128.0f) + rms_eps);
                    cmx = fmaxf(cmx, ((p4[0] + p4[1]) + (p4[2] + p4[3])) * rkv * rkv);
#pragma unroll
                    for (int n = 0; n < 2; ++n) { const int col = wc * 32 + n * 16 + 4 * fq; const f32x4 v = acc[ai][0][m][n] * rkv * *(const f32x4*)(gkv + col); { int w8 = __builtin_amdgcn_cvt_pk_fp8_f32(v[0], v[1], 0, false); w8 = __builtin_amdgcn_cvt_pk_fp8_f32(v[2], v[3], w8, true); *(unsigned*)((unsigned char*)ckv + grow * 128 + col) = (unsigned)w8; } }
                    if (wc < 2) { const float sm = scr[2048 + rl * 2] + scr[2048 + rl * 2 + 1], sq = scr[2560 + rl * 2] + scr[2560 + rl * 2 + 1];
                        const float mean = sm * (1.0f / 64.0f); const float var = fmaxf(sq * (1.0f / 64.0f) - mean * mean, 0.f); const float rstd = 1.0f / sqrtf(var + ln_eps);
#pragma unroll
                        for (int n = 0; n < 2; ++n) { const int col = wc * 32 + n * 16 + 4 * fq; const f32x4 v = (acc[ai][1][m][n] - mean) * rstd * *(const f32x4*)(gki + col) + *(const f32x4*)(bki + col); *(u32x2e*)(kidx + grow * 64 + col) = EDN_PK(v); } }
                    if (wc == 2 && fq < 2) *(f32x4*)(widx + grow * 8 + 4 * fq) = acc[ai][1][m][0] * 0.04419417382415922f; }
            if (wc == 0 && fq == 0) __hip_atomic_fetch_max(cmaxw, __builtin_bit_cast(unsigned, sqrtf(cmx)), __ATOMIC_RELAXED, __HIP_MEMORY_SCOPE_AGENT);
        }
        EDN_BAR();
#undef EDN_RED4
#undef EDN_BAR
#undef EDN_PK
    }
};
struct EpiCq {
    static constexpr bool PERM = true, AFTER_DRAIN = false;
    bf16_t* qlat; bf16_t* qidx;
    __device__ __forceinline__ void operator()(const f32x4 (&acc)[2][2][4][2], const Unit& u, int wr, int wc, int fr_, int fq_) const {
        int t_ = threadIdx.x; asm volatile("" : "+v"(t_)); const int fr = t_ & 15, fq = (t_ & 63) >> 4; (void)fr_; (void)fq_;
        const int row0 = u.pm * BM + wr * 64 + fr; int colt = u.pn * BM; bf16_t* base = qlat; int ldc = 2048;
        if (colt >= 2048) { base = qidx; ldc = 512; colt -= 2048; }
        const int col0 = colt + wc * 32 + 8 * fq;
#pragma unroll
        for (int ai = 0; ai < 2; ++ai)
#pragma unroll
            for (int m = 0; m < 4; ++m) { bf16_t* rowp = base + (size_t)(row0 + ai * HALF + m * 16) * ldc + col0;
#pragma unroll
                for (int bj = 0; bj < 2; ++bj) { const f32x4 v0 = acc[ai][bj][m][0], v1 = acc[ai][bj][m][1];
                    u32x4 w; w.x = cvt_pk_bf16(v0[0], v0[1]); w.y = cvt_pk_bf16(v0[2], v0[3]); w.z = cvt_pk_bf16(v1[0], v1[1]); w.w = cvt_pk_bf16(v1[2], v1[3]);
                    *(u32x4*)(rowp + bj * HALF) = w; } }
    }
};
struct EpiSwiglu {
    static constexpr bool PERM = true, AFTER_DRAIN = false;
    bf16_t* H; const float* bgu;
    __device__ __forceinline__ void operator()(const f32x4 (&acc)[2][2][4][2], const Unit& u, int wr, int wc, int fr_, int fq_) const {
        int t_ = threadIdx.x; asm volatile("" : "+v"(t_)); const int fr = t_ & 15, fq = (t_ & 63) >> 4; (void)fr_; (void)fq_;
        const int e = u.pn >> 3, pnl = u.pn & 7;
        const int row0 = u.pm * BM + wr * 64 + fr, col0 = pnl * 128 + wc * 32 + 8 * fq;
        const float* bg = bgu + (size_t)e * 2048 + col0; const float* bu = bg + 1024;
        f32x4 bgv[2], buv[2];
#pragma unroll
        for (int n = 0; n < 2; ++n) { bgv[n] = *(const f32x4*)(bg + 4 * n); buv[n] = *(const f32x4*)(bu + 4 * n); }
#pragma unroll
        for (int ai = 0; ai < 2; ++ai)
#pragma unroll
            for (int m = 0; m < 4; ++m) { bf16_t* rowp = H + (size_t)(row0 + ai * HALF + m * 16) * 1024 + col0;
                float h[8];
#pragma unroll
                for (int n = 0; n < 2; ++n) { const f32x4 g4 = acc[ai][0][m][n] + bgv[n], u4 = acc[ai][1][m][n] + buv[n];
#pragma unroll
                    for (int i = 0; i < 4; ++i) { const float g = fminf(g4[i], 7.0f); const float up = fminf(fmaxf(u4[i], -7.0f), 7.0f);
                        const float sg = __builtin_amdgcn_rcpf(1.0f + __builtin_amdgcn_exp2f(g * (-1.702f * 1.4426950408889634f)));
                        h[4 * n + i] = (up + 1.0f) * (g * sg); } }
                u32x4 w; w.x = cvt_pk_bf16(h[0], h[1]); w.y = cvt_pk_bf16(h[2], h[3]); w.z = cvt_pk_bf16(h[4], h[5]); w.w = cvt_pk_bf16(h[6], h[7]);
                *(u32x4*)rowp = w; }
    }
};
__device__ __forceinline__ unsigned cvt4_fp8(float a, float b, float c, float d) { int w = 0; w = __builtin_amdgcn_cvt_pk_fp8_f32(a, b, w, false); w = __builtin_amdgcn_cvt_pk_fp8_f32(c, d, w, true); return (unsigned)w; }
struct EpiSwiglu8 {
    static constexpr bool PERM = true, AFTER_DRAIN = false;
    unsigned char* H; const float* bgu; float inv, hs;
    __device__ __forceinline__ void operator()(const f32x4 (&acc)[2][2][4][2], const Unit& u, int wr, int wc, int fr_, int fq_) const {
        int t_ = threadIdx.x; asm volatile("" : "+v"(t_)); const int fr = t_ & 15, fq = (t_ & 63) >> 4; (void)fr_; (void)fq_;
        const int e = u.pn >> 3, pnl = u.pn & 7;
        const int row0 = u.pm * BM + wr * 64 + fr, col0 = pnl * 128 + wc * 32 + 8 * fq;
        const float* bg = bgu + (size_t)e * 2048 + col0; const float* bu = bg + 1024;
        typedef float f32x2e __attribute__((ext_vector_type(2)));
        constexpr float KS = -1.702f * 1.4426950408889634f;
        f32x2e bgk[2][2], buq[2][2];
#pragma unroll
        for (int n = 0; n < 2; ++n) { const f32x4 g4 = *(const f32x4*)(bg + 4 * n) * KS; const f32x4 u4 = *(const f32x4*)(bu + 4 * n);
            bgk[n][0] = (f32x2e){g4[0], g4[1]}; bgk[n][1] = (f32x2e){g4[2], g4[3]}; buq[n][0] = (f32x2e){u4[0], u4[1]}; buq[n][1] = (f32x2e){u4[2], u4[3]}; }
        const float ik = inv * KS, hk = hs / KS; const f32x2e ik2 = {ik, ik}, inv2 = {inv, inv}, hk2 = {hk, hk}, one2 = {1.0f, 1.0f};
#pragma unroll
        for (int ai = 0; ai < 2; ++ai)
#pragma unroll
            for (int m = 0; m < 4; ++m) { unsigned char* rowp = H + (size_t)(row0 + ai * HALF + m * 16) * 1024 + col0;
                f32x2e h[4];
#pragma unroll
                for (int n = 0; n < 2; ++n)
#pragma unroll
                    for (int q = 0; q < 2; ++q) { const f32x4 ag = acc[ai][0][m][n], au = acc[ai][1][m][n];
                        f32x2e gk = __builtin_elementwise_fma((f32x2e){ag[2 * q], ag[2 * q + 1]}, ik2, bgk[n][q]);
                        f32x2e uq = __builtin_elementwise_fma((f32x2e){au[2 * q], au[2 * q + 1]}, inv2, buq[n][q]);
                        gk.x = fmaxf(gk.x, 7.0f * KS); gk.y = fmaxf(gk.y, 7.0f * KS);
                        uq.x = __builtin_amdgcn_fmed3f(uq.x, -7.0f, 7.0f); uq.y = __builtin_amdgcn_fmed3f(uq.y, -7.0f, 7.0f);
                        const f32x2e d2 = (f32x2e){__builtin_amdgcn_exp2f(gk.x), __builtin_amdgcn_exp2f(gk.y)} + one2;
                        const f32x2e r2 = {__builtin_amdgcn_rcpf(d2.x), __builtin_amdgcn_rcpf(d2.y)};
                        h[2 * n + q] = (gk * r2) * __builtin_elementwise_fma(uq, hk2, hk2); }
                typedef unsigned u32x2e __attribute__((ext_vector_type(2)));
                u32x2e w; w.x = cvt4_fp8(h[0].x, h[0].y, h[1].x, h[1].y); w.y = cvt4_fp8(h[2].x, h[2].y, h[3].x, h[3].y);
                *(u32x2e*)rowp = w; }
    }
};
struct EpiDown8 {
    static constexpr bool PERM = true, AFTER_DRAIN = false;
    unsigned char* O; const float* bias; float inv, ys;
    __device__ __forceinline__ void operator()(const f32x4 (&acc)[2][2][4][2], const Unit& u, int wr, int wc, int fr_, int fq_) const {
        int t_ = threadIdx.x; asm volatile("" : "+v"(t_)); const int fr = t_ & 15, fq = (t_ & 63) >> 4; (void)fr_; (void)fq_;
        const int e = u.pn >> 2, pnl = u.pn & 3;
        const int row0 = u.pm * BM + wr * 64 + fr, col0 = pnl * BM + wc * 32 + 8 * fq;
        f32x4 bv[2][2];
#pragma unroll
        for (int bj = 0; bj < 2; ++bj)
#pragma unroll
            for (int n = 0; n < 2; ++n) bv[bj][n] = *(const f32x4*)(bias + (size_t)e * 1024 + col0 + bj * HALF + 4 * n) * ys;
        const float sc = inv * ys;
#pragma unroll
        for (int ai = 0; ai < 2; ++ai)
#pragma unroll
            for (int m = 0; m < 4; ++m) { unsigned char* rowp = O + (size_t)(row0 + ai * HALF + m * 16) * 1024 + col0;
#pragma unroll
                for (int bj = 0; bj < 2; ++bj) { const f32x4 v0 = acc[ai][bj][m][0] * sc + bv[bj][0], v1 = acc[ai][bj][m][1] * sc + bv[bj][1];
                    typedef unsigned u32x2e __attribute__((ext_vector_type(2)));
                    u32x2e w; w.x = cvt4_fp8(v0[0], v0[1], v0[2], v0[3]); w.y = cvt4_fp8(v1[0], v1[1], v1[2], v1[3]);
                    *(u32x2e*)(rowp + bj * HALF) = w; } }
    }
};
struct EpiQkv8 {
    static constexpr bool PERM = true, AFTER_DRAIN = false;
    bf16_t* O; size_t split_stride; float inv, scale0;
    __device__ __forceinline__ void operator()(const f32x4 (&acc)[2][2][4][2], const Unit& u, int wr, int wc, int fr_, int fq_) const {
        int t_ = threadIdx.x; asm volatile("" : "+v"(t_)); const int fr = t_ & 15, fq = (t_ & 63) >> 4; (void)fr_; (void)fq_;
        const int row0 = u.pm * BM + wr * 64 + fr; const int t = (u.pn * BM) >> 10; const int colt = u.pn * BM - (t << 10);
        bf16_t* base = O + (size_t)t * split_stride; const float sc = inv * (t == 0 ? scale0 : 1.f);
        const int col0 = colt + wc * 32 + 8 * fq;
#pragma unroll
        for (int ai = 0; ai < 2; ++ai)
#pragma unroll
            for (int m = 0; m < 4; ++m) { bf16_t* rowp = base + (size_t)(row0 + ai * HALF + m * 16) * 1024 + col0;
#pragma unroll
                for (int bj = 0; bj < 2; ++bj) { const f32x4 v0 = acc[ai][bj][m][0] * sc, v1 = acc[ai][bj][m][1] * sc;
                    u32x4 w; w.x = cvt_pk_bf16(v0[0], v0[1]); w.y = cvt_pk_bf16(v0[2], v0[3]); w.z = cvt_pk_bf16(v1[0], v1[1]); w.w = cvt_pk_bf16(v1[2], v1[3]);
                    *(u32x4*)(rowp + bj * HALF) = w; } }
    }
};
struct EpiBf16s {
    static constexpr bool PERM = true, AFTER_DRAIN = false;
    bf16_t* O; int ldc; float inv;
    __device__ __forceinline__ void operator()(const f32x4 (&acc)[2][2][4][2], const Unit& u, int wr, int wc, int fr_, int fq_) const {
        int t_ = threadIdx.x; asm volatile("" : "+v"(t_)); const int fr = t_ & 15, fq = (t_ & 63) >> 4; (void)fr_; (void)fq_;
        const int row0 = u.pm * BM + wr * 64 + fr, col0 = u.pn * BM + wc * 32 + 8 * fq;
#pragma unroll
        for (int ai = 0; ai < 2; ++ai)
#pragma unroll
            for (int m = 0; m < 4; ++m) { bf16_t* rowp = O + (size_t)(row0 + ai * HALF + m * 16) * ldc + col0;
#pragma unroll
                for (int bj = 0; bj < 2; ++bj) { const f32x4 v0 = acc[ai][bj][m][0] * inv, v1 = acc[ai][bj][m][1] * inv;
                    u32x4 w; w.x = cvt_pk_bf16(v0[0], v0[1]); w.y = cvt_pk_bf16(v0[2], v0[3]); w.z = cvt_pk_bf16(v1[0], v1[1]); w.w = cvt_pk_bf16(v1[2], v1[3]);
                    *(u32x4*)(rowp + bj * HALF) = w; } }
    }
};
struct EpiResF32s {
    static constexpr bool PERM = false, AFTER_DRAIN = false;
    const float* base; float* out; int ldc; float alpha, inv;
    __device__ __forceinline__ void operator()(const f32x4 (&acc)[2][2][4][2], const Unit& u, int wr, int wc, int fr_, int fq_) const {
        int t_ = threadIdx.x; asm volatile("" : "+v"(t_)); const int fr = t_ & 15, fq = (t_ & 63) >> 4; (void)fr_; (void)fq_;
        const int row0 = u.pm * BM + wr * 64 + fr, col0 = u.pn * BM + wc * 32 + 4 * fq;
#pragma unroll
        for (int ai = 0; ai < 2; ++ai)
#pragma unroll
            for (int m = 0; m < 4; ++m) { const size_t off = (size_t)(row0 + ai * HALF + m * 16) * ldc + col0;
                f32x4 bs[2][2];
#pragma unroll
                for (int bj = 0; bj < 2; ++bj)
#pragma unroll
                    for (int n = 0; n < 2; ++n) bs[bj][n] = *(const f32x4*)(base + off + bj * HALF + n * 16);
#pragma unroll
                for (int bj = 0; bj < 2; ++bj)
#pragma unroll
                    for (int n = 0; n < 2; ++n) *(f32x4*)(out + off + bj * HALF + n * 16) = bs[bj][n] * alpha + acc[ai][bj][m][n] * inv; }
    }
};
struct MoeOrder {
    int nT, nNl, G, c; const PG8_LAS int* tile_e;
    __device__ __forceinline__ bool next(int i, Unit& u) const {
        const int nwg = nT * nNl; const long L = (long)i * G + c; if (L >= nwg) return false;
        const int q = nwg / NXCD, r = nwg % NXCD, xcd = (int)(L % NXCD), off = (int)(L / NXCD);
        const int wgid = (xcd < r ? xcd * (q + 1) : r * (q + 1) + (xcd - r) * q) + off;
        const int pm = wgid / nNl, j = wgid % nNl;
        u.pm = pm; u.pn = tile_e[pm] * nNl + j; return true;
    }
    __device__ __forceinline__ void a_ready(const Unit&) const {}
    __device__ __forceinline__ void done(const Unit&) const {}
};
}
#ifndef PG8_SP2
#define PG8_SP2 true
#endif
#ifndef PG8_ALIGN
#define PG8_ALIGN true
#endif
#include <hip/hip_bf16.h>
#include <cmath>
namespace attn_body {
using bf16=__hip_bfloat16;
using bf16x8=__attribute__((ext_vector_type(8)))short;
using s16x4=__attribute__((ext_vector_type(4)))short;
using f32x16=__attribute__((ext_vector_type(16)))float;
using u32x4=__attribute__((ext_vector_type(4)))unsigned;
constexpr int BATCH=8,NHEAD=16,SEQ=4096,D=64,DM=NHEAD*D,XD=16;
constexpr int NW=8,QBLK=32,QB=QBLK*NW,KVBLK=64,NQB=SEQ/QB;
constexpr int ATTN_PITCH=DM, ATTN_UNIT_ROWS=QB;
__device__ __forceinline__ int crow(int r,int hi){return (r&3)+8*(r>>2)+4*hi;}
#define SBAR() __builtin_amdgcn_sched_barrier(0)
__device__ __forceinline__ void cmask(f32x16&p0,f32x16&p1,int jb,int qrel,int hi){
  const float NEG=-INFINITY; int kb=64*jb+4*hi;
  #pragma unroll
  for(int r=0;r<16;++r){int kv=kb+(r&3)+8*(r>>2); if(kv>qrel)p0[r]=NEG; if(kv+32>qrel)p1[r]=NEG;}
}

constexpr int NSLOT=3, SLOTB=10240;
constexpr int LDS_K=0, LDS_V=NSLOT*SLOTB, LDS_WS=2*NSLOT*SLOTB, LDS_OST=LDS_WS+NW*64*4, LDS_BYTES=LDS_OST+NW*4096;
constexpr float C2=0.125f*1.4426950408889634f;
__device__ __forceinline__ void glds16(const void*gsrc,unsigned lds_dst){unsigned keep;
  asm volatile("s_mov_b32 %0, m0\n\ts_mov_b32 m0, %2\n\ts_nop 0\n\tglobal_load_lds_dwordx4 %1, off\n\ts_mov_b32 m0, %0":"=&s"(keep):"v"(gsrc),"s"(lds_dst):"memory");}
__device__ __forceinline__ float max3f(float a,float b,float c){float r;asm("v_max3_f32 %0, %1, %2, %3":"=v"(r):"v"(a),"v"(b),"v"(c));return r;}
__device__ __forceinline__ float max2f(float a,float b){float r;asm("v_max_f32_e32 %0, %1, %2":"=v"(r):"v"(a),"v"(b));return r;}
__device__ __forceinline__ float fadd_s(float a,float b){float r;asm("v_add_f32_e32 %0, %1, %2":"=v"(r):"v"(a),"v"(b));return r;}
__device__ __forceinline__ float fsub_s(float a,float b){float r;asm("v_sub_f32_e32 %0, %1, %2":"=v"(r):"v"(a),"v"(b));return r;}
typedef float f32x2_t __attribute__((ext_vector_type(2))); typedef __bf16 bf16x2_t __attribute__((ext_vector_type(2)));
__device__ __forceinline__ unsigned cvtpk_s(float lo,float hi){f32x2_t v={lo,hi};bf16x2_t b=__builtin_convertvector(v,bf16x2_t);return __builtin_bit_cast(unsigned,b);}
#define WAIT_BAR(N) asm volatile("s_waitcnt vmcnt(" #N ") lgkmcnt(0)\n\ts_barrier":::"memory")

__device__ __forceinline__ void qkt(f32x16&p0,f32x16&p1,const char*Kslot,const bf16x8*qr,int r32,int hi){
  const f32x16 zz=f32x16{};
  const char*kb=Kslot+hi*1024+r32*16;
  #pragma unroll
  for(int d0=0;d0<5;++d0){
    const bf16x8 b0=*reinterpret_cast<const bf16x8*>(kb+d0*2048);
    const bf16x8 b1=*reinterpret_cast<const bf16x8*>(kb+d0*2048+512);
    if(d0==0){p0=__builtin_amdgcn_mfma_f32_32x32x16_bf16(b0,qr[0],zz,0,0,0);p1=__builtin_amdgcn_mfma_f32_32x32x16_bf16(b1,qr[0],zz,0,0,0);}
    else{p0=__builtin_amdgcn_mfma_f32_32x32x16_bf16(b0,qr[d0],p0,0,0,0);p1=__builtin_amdgcn_mfma_f32_32x32x16_bf16(b1,qr[d0],p1,0,0,0);}}
}
typedef __attribute__((address_space(3))) const char* lds_cptr;
typedef short v4i16_t __attribute__((ext_vector_type(4)));
__device__ __forceinline__ void kload8(bf16x8*kf,lds_cptr kp){
  kf[0]=*(const __attribute__((address_space(3))) bf16x8*)(kp);      kf[1]=*(const __attribute__((address_space(3))) bf16x8*)(kp+512);
  kf[2]=*(const __attribute__((address_space(3))) bf16x8*)(kp+2048); kf[3]=*(const __attribute__((address_space(3))) bf16x8*)(kp+2560);
  kf[4]=*(const __attribute__((address_space(3))) bf16x8*)(kp+4096); kf[5]=*(const __attribute__((address_space(3))) bf16x8*)(kp+4608);
  kf[6]=*(const __attribute__((address_space(3))) bf16x8*)(kp+6144); kf[7]=*(const __attribute__((address_space(3))) bf16x8*)(kp+6656);
  kf[8]=*(const __attribute__((address_space(3))) bf16x8*)(kp+8192); kf[9]=*(const __attribute__((address_space(3))) bf16x8*)(kp+8704);
}
__device__ __forceinline__ void kload2(bf16x8*kf,lds_cptr kp,int j){ kf[2*j]=*(const __attribute__((address_space(3))) bf16x8*)(kp+j*2048); kf[2*j+1]=*(const __attribute__((address_space(3))) bf16x8*)(kp+j*2048+512); }
__device__ __forceinline__ s16x4 vtr(lds_cptr p){ return __builtin_bit_cast(s16x4,__builtin_amdgcn_ds_read_tr16_b64_v4i16((__attribute__((address_space(3))) v4i16_t*)p)); }
__device__ __forceinline__ float rowmax(const f32x16&p0,const f32x16&p1){
  float a=max3f(p0[0],p0[1],p1[0]),b=max3f(p0[2],p0[3],p1[1]);a=max3f(a,p1[2],p1[3]);
  #pragma unroll
  for(int r=4;r<16;r+=4){a=max3f(a,p0[r],p0[r+1]);b=max3f(b,p0[r+2],p0[r+3]);a=max3f(a,p1[r],p1[r+1]);b=max3f(b,p1[r+2],p1[r+3]);}
  const float m=max2f(a,b);
  auto rr=__builtin_amdgcn_permlane32_swap(__float_as_uint(m),__float_as_uint(m),false,false);
  return max2f(__uint_as_float(rr[0]),__uint_as_float(rr[1]));
}
__device__ __forceinline__ void pv(f32x16*o,int vb,bf16x8 pa0,bf16x8 pa1,bf16x8 pa2,bf16x8 pa3){
  #pragma unroll
  for(int d0=0;d0<2;++d0){s16x4 lo[4],hi[4];
    #pragma unroll
    for(int ks=0;ks<4;++ks){
      asm volatile("ds_read_b64_tr_b16 %0,%1 offset:%c2":"=&v"(lo[ks]):"v"(vb),"i"(d0*4096+ks*1024):"memory");
      asm volatile("ds_read_b64_tr_b16 %0,%1 offset:%c2":"=&v"(hi[ks]):"v"(vb),"i"(d0*4096+ks*1024+512):"memory");}
    asm volatile("s_waitcnt lgkmcnt(0)":::"memory");SBAR();
    #define PK(k) (bf16x8){lo[k][0],lo[k][1],lo[k][2],lo[k][3],hi[k][0],hi[k][1],hi[k][2],hi[k][3]}
    o[d0]=__builtin_amdgcn_mfma_f32_32x32x16_bf16(pa0,PK(0),o[d0],0,0,0);
    o[d0]=__builtin_amdgcn_mfma_f32_32x32x16_bf16(pa1,PK(1),o[d0],0,0,0);
    o[d0]=__builtin_amdgcn_mfma_f32_32x32x16_bf16(pa2,PK(2),o[d0],0,0,0);
    o[d0]=__builtin_amdgcn_mfma_f32_32x32x16_bf16(pa3,PK(3),o[d0],0,0,0);
    #undef PK
  }
}

#ifndef ATTN_STORE16
#define ATTN_STORE16(p,v) (*(u32x4*)(p)=(v))
#endif
__device__ __forceinline__ void set_m(bf16x8&q4,float mneg,int hi){
  const unsigned p1=cvtpk_s(mneg,0.f)&0xffffu; const float f1=__uint_as_float(p1<<16); const float r1=mneg-f1;
  const unsigned p2=cvtpk_s(r1,0.f)&0xffffu;   const float f2=__uint_as_float(p2<<16); const float r2=r1-f2;
  const unsigned p3=cvtpk_s(r2,0.f)&0xffffu;
  u32x4 w=__builtin_bit_cast(u32x4,q4); w[3]=hi?w[3]:(p1|(p2<<16)); w[0]=hi?p3:w[0]; q4=__builtin_bit_cast(bf16x8,w);
}
template<int THRL,bool GUARD> __device__ __forceinline__ void attn_unit(int b,int h,int qb,const bf16*Q,const bf16*__restrict__ K,const bf16*__restrict__ V,bf16*O,const bf16*__restrict__ QX,const bf16*__restrict__ KX,const float*__restrict__ DG,char*shm,int ts,unsigned*qctr,unsigned*tkslot){
  int tid_o=threadIdx.x; asm volatile("":"+v"(tid_o)); const int tid=tid_o,lane=tid&63,r32=lane&31,hi=lane>>5; const int wid=__builtin_amdgcn_readfirstlane(tid>>6);
  const long rowbase=(long)b*SEQ; const int q0=qb*QB;
  const bf16*Qw=Q+(rowbase+q0+wid*QBLK)*DM+h*D;
  const bf16*Kh=K+(rowbase+(long)ts*KVBLK)*DM+h*D,*Vh=V+(rowbase+(long)ts*KVBLK)*DM+h*D;
  const unsigned lds0=(unsigned)(uintptr_t)shm;
  float*wsf=(float*)(shm+LDS_WS)+wid*64;
  const bf16*ksrc=Kh+(long)lane*DM+wid*8;
  const bf16*vsrc=Vh+(long)(16*(wid&3)+(lane>>2))*DM+(wid>>2)*32+(lane&3)*8;
  const bf16*kxsrc=KX+((rowbase+(long)ts*KVBLK+lane)*NHEAD+h)*XD+(wid&1)*8;
  const unsigned kdst=lds0+LDS_K+wid*1024, vdst=lds0+LDS_V+wid*1024, kxdst=lds0+LDS_K+8192+(wid&1)*1024;
  #define DMA_K(t,slot) do{ glds16(ksrc+(long)(t)*KVBLK*DM,(unsigned)__builtin_amdgcn_readfirstlane(kdst+(slot))); glds16(kxsrc+(long)(t)*KVBLK*NHEAD*XD,(unsigned)__builtin_amdgcn_readfirstlane(kxdst+(slot))); }while(0)
  #define DMA_V(t,slot) glds16(vsrc+(long)(t)*KVBLK*DM,(unsigned)__builtin_amdgcn_readfirstlane(vdst+(slot)))
  const int vb0=(int)(lds0+LDS_V)+((lane>>4)&1)*32+(lane&3)*8+(4*hi+((lane&15)>>2))*64;
  const char*Kbase=shm+LDS_K; bf16x8 kf[10];
  const lds_cptr shm3=(lds_cptr)shm; const lds_cptr kp0=shm3+LDS_K+hi*1024+r32*16; const lds_cptr vp0=shm3+LDS_V+((lane>>4)&1)*32+(lane&3)*8+(4*hi+((lane&15)>>2))*64;
  const int NT=(q0+QB)/KVBLK-ts;
  DMA_K(0,0);DMA_V(0,0);DMA_K(1,SLOTB);
  bf16x8 qr[5];
  #pragma unroll
  for(int d0=0;d0<4;++d0)qr[d0]=*reinterpret_cast<const bf16x8*>(&Qw[(long)r32*DM+d0*16+hi*8]);
  qr[4]=*reinterpret_cast<const bf16x8*>(&QX[((rowbase+q0+wid*QBLK+r32)*NHEAD+h)*XD+hi*8]);
  float mhat=DG[(rowbase+q0+wid*QBLK+r32)*NHEAD+h]; set_m(qr[4],-mhat,hi); asm volatile("":"+v"(qr[4]));
  float l_reg=0.f;f32x16 o[2];o[0]=f32x16{};o[1]=f32x16{};const f32x16 zero16=f32x16{};
  const int qrel=wid*QBLK+r32;
  #define CMASK(P0,P1,t) do{int jb_=(t)-(NT-4); if(jb_>=0)cmask(P0,P1,jb_,qrel,hi);}while(0)
  bool resc=false;
  #define START(P0,P1) do{ resc=false; \
    if constexpr(GUARD){ const float rm=rowmax(P0,P1); if(__any(rm>(float)THRL)){ const float dl=__builtin_fmaxf(rm,0.f); mhat+=dl; \
      _Pragma("unroll") for(int r=0;r<16;++r){P0[r]-=dl;P1[r]-=dl;} set_m(qr[4],-mhat,hi); asm volatile("":"+v"(qr[4])); } } \
    _Pragma("unroll") for(int r=0;r<16;++r)P0[r]=__builtin_amdgcn_exp2f(P0[r]); }while(0)
  #define RESC() do{ if(resc){ asm volatile("s_waitcnt lgkmcnt(0)":::"memory"); \
      _Pragma("unroll") for(int d_=0;d_<2;++d_) _Pragma("unroll") for(int r=0;r<16;++r)o[d_][r]*=wsf[crow(r,hi)]; } }while(0)
  f32x16 pA0,pA1,pB0,pB1;
  int sl_prev=0,sl_cur=0,sl_next=SLOTB;
  #define ROT() do{sl_prev=sl_cur;sl_cur=sl_next;sl_next=(sl_next==(NSLOT-1)*SLOTB)?0:sl_next+SLOTB;}while(0)
  DMA_K(2,2*SLOTB);
  WAIT_BAR(3);
  qkt(pA0,pA1,Kbase,qr,r32,hi);asm volatile("s_nop 15\n\ts_nop 7":"+v"(pA0),"+v"(pA1));CMASK(pA0,pA1,0);
  START(pA0,pA1);
  _Pragma("unroll") for(int r=0;r<16;++r)pA1[r]=__builtin_amdgcn_exp2f(pA1[r]);
  WAIT_BAR(0);
  DMA_K(3,0);DMA_V(1,SLOTB);
  ROT();
  kload8(kf,kp0+sl_cur);
  WAIT_BAR(3);
  s16x4 vlo[8],vhi[8]; u32x4 pw0,pw1,pw2,pw3;
  #define PKW(P,B) cvtpk_s(P[B],P[B+1])
  #define PAF(k) __builtin_bit_cast(bf16x8,pw##k)
  #define VFR(i) (bf16x8){vlo[i][0],vlo[i][1],vlo[i][2],vlo[i][3],vhi[i][0],vhi[i][1],vhi[i][2],vhi[i][3]}
  #define PIN(x) asm volatile("":"+v"(x))
  #define MX3(a,b,c) __builtin_fmaxf(__builtin_fmaxf((a),(b)),(c))
  #define GAPA(MF,A0,A1,A2,A3,W0,W1,PW) do{ MF; sacc+=A0; sacc+=A1; sacc+=A2; sacc+=A3; PIN(sacc); W0; W1; PIN(PW); SBAR(); }while(0)
  #define EX(v) __builtin_amdgcn_exp2f(v)
  #define GAPB(MF,X,B) do{ MF; X[B]=EX(X[B]); X[B+1]=EX(X[B+1]); X[B+2]=EX(X[B+2]); X[B+3]=EX(X[B+3]); PIN(X); SBAR(); }while(0)
  #define VRD(i) do{ vlo[i]=vtr(vp_+(((i)>>2)*4096+((i)&3)*1024)); vhi[i]=vtr(vp_+(((i)>>2)*4096+((i)&3)*1024+512)); }while(0)
  #define KRD(G,j) do{ if(G){ kload2(kf,kp0+sl_next,j); SBAR(); } }while(0)
  #define STEP(C0,C1,P0,P1,t,GK,GV,GL) do{ SBAR(); \
    const lds_cptr vp_=vp0+sl_prev; \
    VRD(0); SBAR(); float sacc=(P0[0]+P0[1]); \
    GAPA(C0=__builtin_amdgcn_mfma_f32_32x32x16_bf16(kf[0],qr[0],zero16,0,0,0), P0[2],P0[3],P0[4],P0[5],     pw0[0]=PKW(P0,0), pw0[1]=PKW(P0,2), pw0); \
    VRD(4); SBAR(); GAPA(C1=__builtin_amdgcn_mfma_f32_32x32x16_bf16(kf[1],qr[0],zero16,0,0,0), P0[6],P0[7],P0[8],P0[9],     pw0[2]=PKW(P0,4), pw0[3]=PKW(P0,6), pw0); \
    VRD(1); SBAR(); GAPA(C0=__builtin_amdgcn_mfma_f32_32x32x16_bf16(kf[2],qr[1],C0,0,0,0),   P0[10],P0[11],P0[12],P0[13], pw1[0]=PKW(P0,8), pw1[1]=PKW(P0,10), pw1); \
    VRD(5); SBAR(); GAPA(C1=__builtin_amdgcn_mfma_f32_32x32x16_bf16(kf[3],qr[1],C1,0,0,0),   P0[14],P0[15],P1[0],P1[1],   pw1[2]=PKW(P0,12),pw1[3]=PKW(P0,14), pw1); \
    VRD(2); SBAR(); GAPA(C0=__builtin_amdgcn_mfma_f32_32x32x16_bf16(kf[4],qr[2],C0,0,0,0),   P1[2],P1[3],P1[4],P1[5],     pw2[0]=PKW(P1,0), pw2[1]=PKW(P1,2), pw2); \
    VRD(6); SBAR(); GAPA(C1=__builtin_amdgcn_mfma_f32_32x32x16_bf16(kf[5],qr[2],C1,0,0,0),   P1[6],P1[7],P1[8],P1[9],     pw2[2]=PKW(P1,4), pw2[3]=PKW(P1,6), pw2); \
    VRD(3); SBAR(); GAPA(C0=__builtin_amdgcn_mfma_f32_32x32x16_bf16(kf[6],qr[3],C0,0,0,0),   P1[10],P1[11],P1[12],P1[13], pw3[0]=PKW(P1,8), pw3[1]=PKW(P1,10), pw3); \
    VRD(7); SBAR(); GAPA(C1=__builtin_amdgcn_mfma_f32_32x32x16_bf16(kf[7],qr[3],C1,0,0,0),   P1[14],P1[15],0.f,0.f,       pw3[2]=PKW(P1,12),pw3[3]=PKW(P1,14), pw3); \
    C0=__builtin_amdgcn_mfma_f32_32x32x16_bf16(kf[8],qr[4],C0,0,0,0); C1=__builtin_amdgcn_mfma_f32_32x32x16_bf16(kf[9],qr[4],C1,0,0,0); SBAR(); \
    l_reg+=sacc; \
    if(GK){DMA_K((t)+3,sl_cur);} if(GV){DMA_V((t)+1,sl_next);} \
    CMASK(C0,C1,t); \
    if constexpr(!GUARD){ resc=false; } else { float a=MX3(C0[0],C0[1],C1[0]),b=MX3(C0[2],C0[3],C1[1]); a=MX3(a,C1[2],C1[3]); \
      _Pragma("unroll") for(int r=4;r<16;r+=4){a=MX3(a,C0[r],C0[r+1]);b=MX3(b,C0[r+2],C0[r+3]);a=MX3(a,C1[r],C1[r+1]);b=MX3(b,C1[r+2],C1[r+3]);} \
      float rm=__builtin_fmaxf(a,b); { auto rr=__builtin_amdgcn_permlane32_swap(__float_as_uint(rm),__float_as_uint(rm),false,false); rm=__builtin_fmaxf(__uint_as_float(rr[0]),__uint_as_float(rr[1])); } \
      resc=false; \
      if(__builtin_expect(__any(rm>(float)THRL),0)){ const float dl=__builtin_fmaxf(rm,0.f); mhat+=dl; \
        _Pragma("unroll") for(int r=0;r<16;++r){C0[r]-=dl;C1[r]-=dl;} \
        set_m(qr[4],-mhat,hi); asm volatile("":"+v"(qr[4])); \
        const float f=__builtin_amdgcn_exp2f(-dl); l_reg*=f; if(hi==0)wsf[r32]=f; resc=true; } } \
    SBAR(); \
    GAPB(o[0]=__builtin_amdgcn_mfma_f32_32x32x16_bf16(PAF(0),VFR(0),o[0],0,0,0), C0,0); \
    GAPB(o[1]=__builtin_amdgcn_mfma_f32_32x32x16_bf16(PAF(0),VFR(4),o[1],0,0,0), C0,4); \
    KRD(GL,0); GAPB(o[0]=__builtin_amdgcn_mfma_f32_32x32x16_bf16(PAF(1),VFR(1),o[0],0,0,0), C0,8); \
    KRD(GL,1); GAPB(o[1]=__builtin_amdgcn_mfma_f32_32x32x16_bf16(PAF(1),VFR(5),o[1],0,0,0), C0,12); \
    KRD(GL,2); GAPB(o[0]=__builtin_amdgcn_mfma_f32_32x32x16_bf16(PAF(2),VFR(2),o[0],0,0,0), C1,0); \
    KRD(GL,3); GAPB(o[1]=__builtin_amdgcn_mfma_f32_32x32x16_bf16(PAF(2),VFR(6),o[1],0,0,0), C1,4); \
    KRD(GL,4); GAPB(o[0]=__builtin_amdgcn_mfma_f32_32x32x16_bf16(PAF(3),VFR(3),o[0],0,0,0), C1,8); \
    GAPB(o[1]=__builtin_amdgcn_mfma_f32_32x32x16_bf16(PAF(3),VFR(7),o[1],0,0,0), C1,12); \
    }while(0)
  int t=1;
  #undef CMASK
  #define CMASK(P0,P1,t) do{}while(0)
  for(;t+5<NT;t+=2){
    STEP(pB0,pB1,pA0,pA1,t,true,true,true);     WAIT_BAR(3); RESC(); ROT();
    STEP(pA0,pA1,pB0,pB1,t+1,true,true,true);   WAIT_BAR(3); RESC(); ROT();
  }
  #undef CMASK
  #define CMASK(P0,P1,t) do{int jb_=(t)-(NT-4); if(jb_>=0)cmask(P0,P1,jb_,qrel,hi);}while(0)
  #define ENDW(tt) do{ if((tt)+3<NT){WAIT_BAR(3);} else if((tt)+2<NT){WAIT_BAR(1);} else {WAIT_BAR(0);} }while(0)
  for(;t+1<NT;t+=2){
    STEP(pB0,pB1,pA0,pA1,t,(t+3<NT),(t+1<NT),(t+1<NT));       ENDW(t);   RESC(); ROT();
    STEP(pA0,pA1,pB0,pB1,t+1,(t+4<NT),(t+2<NT),(t+2<NT));     ENDW(t+1); RESC(); ROT();
  }
  STEP(pB0,pB1,pA0,pA1,NT-1,false,false,false); RESC();
  { float sacc=pB0[0]+pB0[1]; _Pragma("unroll") for(int r=2;r<16;++r)sacc+=pB0[r]; _Pragma("unroll") for(int r=0;r<16;++r)sacc+=pB1[r]; l_reg+=sacc;
    pw0=(u32x4){PKW(pB0,0),PKW(pB0,2),PKW(pB0,4),PKW(pB0,6)};pw1=(u32x4){PKW(pB0,8),PKW(pB0,10),PKW(pB0,12),PKW(pB0,14)};pw2=(u32x4){PKW(pB1,0),PKW(pB1,2),PKW(pB1,4),PKW(pB1,6)};pw3=(u32x4){PKW(pB1,8),PKW(pB1,10),PKW(pB1,12),PKW(pB1,14)};
    SBAR(); pv(o,vb0+sl_cur,PAF(0),PAF(1),PAF(2),PAF(3)); }
  #undef PKW
  #undef PAF
  #undef VFR
  #undef PIN
  #undef MX3
  #undef GAPA
  #undef GAPB
  #undef EX
  #undef VRD
  #undef KRD
  #undef STEP
  #undef ENDW
  unsigned nxt_tk=0u; if(tid==0)nxt_tk=__hip_atomic_fetch_add(qctr,1u,__ATOMIC_RELAXED,__HIP_MEMORY_SCOPE_AGENT);
  {auto rr=__builtin_amdgcn_permlane32_swap(__float_as_uint(l_reg),__float_as_uint(l_reg),false,false);l_reg=__uint_as_float(rr[0])+__uint_as_float(rr[1]);}
  if(hi==0)wsf[32+r32]=l_reg;asm volatile("s_waitcnt lgkmcnt(0)":::"memory");
  float rli[16];
  #pragma unroll
  for(int r=0;r<16;++r)rli[r]=__builtin_amdgcn_rcpf(wsf[32+crow(r,hi)]);
  { unsigned char*stg=(unsigned char*)(shm+LDS_OST)+wid*2048;
    #pragma unroll
    for(int r=0;r<16;++r){const int orow=crow(r,hi); const float sc=rli[r]*32.0f;
      const unsigned pkd=(unsigned)__builtin_amdgcn_cvt_pk_fp8_f32(o[0][r]*sc,o[1][r]*sc,0,false);
      stg[orow*64+r32]=(unsigned char)(pkd&0xffu); stg[orow*64+32+r32]=(unsigned char)((pkd>>8)&0xffu);}
    asm volatile("s_waitcnt lgkmcnt(0)":::"memory");
    unsigned char*Ow8=(unsigned char*)O+(rowbase+q0+wid*QBLK)*DM+h*D;
    #pragma unroll
    for(int i=0;i<2;++i){const int row=i*16+(lane>>2),ch=lane&3; const u32x4 v=*(const u32x4*)(stg+row*64+ch*16); ATTN_STORE16(Ow8+(long)row*DM+ch*16,v);} }
  if(tid==0)*tkslot=nxt_tk;
  asm volatile("s_waitcnt lgkmcnt(0)\n\ts_barrier":::"memory");
  #undef DMA_K
  #undef DMA_V
  #undef CMASK
  #undef START
  #undef RESC
  #undef ROT
}
constexpr int ATTN_LDS_BYTES=LDS_BYTES;
struct AttnTensors { const bf16* Q; const bf16* K; const bf16* V; bf16* O; const bf16* QX; const bf16* KX; const float* DG; };
struct AttnUnit { int bh; int qb; };
struct StaticOrder {
  int vcu, G;
  __device__ __forceinline__ explicit StaticOrder(int grid,int block):vcu((grid%8==0)?(block%8)*(grid/8)+block/8:block),G(grid){}
  __device__ __forceinline__ bool next(int i,AttnUnit&u)const{
    if(G==256){ if(i>=8)return false; const int s=vcu&1,p=i>>1,j=i&1; u.bh=vcu>>1; u.qb=4*p+(j?3-s:s); return true; }
    const int L=i*G+vcu; if(L>=BATCH*NHEAD*NQB)return false; u.bh=L%(BATCH*NHEAD); u.qb=NQB-1-L/(BATCH*NHEAD); return true; }
  __device__ __forceinline__ void a_ready(const AttnUnit&)const{}
  __device__ __forceinline__ void done(const AttnUnit&)const{}
};
template<int THRL=8> __device__ __forceinline__ void attn_phase(char*lds,const AttnTensors&T,unsigned*qctr,const unsigned char*ts_glob){
  unsigned*tkslot=(unsigned*)(lds+LDS_BYTES); unsigned char*tstab=(unsigned char*)(lds+LDS_BYTES+64);
  { const int tid=threadIdx.x; ((unsigned*)tstab)[tid]=((const unsigned*)ts_glob)[tid];
    if(tid==0)*tkslot=__hip_atomic_fetch_add(qctr,1u,__ATOMIC_RELAXED,__HIP_MEMORY_SCOPE_AGENT); }
  __syncthreads();
  for(;;){ const unsigned u=(unsigned)__builtin_amdgcn_readfirstlane((int)*(volatile __attribute__((address_space(3))) unsigned*)tkslot); if(u>=(unsigned)(BATCH*NHEAD*NQB))break;
    const int qb=NQB-1-(int)(u>>7), bh=(int)(u&127); const int tsv=__builtin_amdgcn_readfirstlane((int)tstab[bh*NQB+qb]); const int ts=tsv&~1;
    if(tsv&1) attn_unit<THRL,true>(bh/NHEAD,bh%NHEAD,qb,T.Q,T.K,T.V,T.O,T.QX,T.KX,T.DG,lds,ts,qctr,tkslot);
    else      attn_unit<THRL,false>(bh/NHEAD,bh%NHEAD,qb,T.Q,T.K,T.V,T.O,T.QX,T.KX,T.DG,lds,ts,qctr,tkslot); }
  __syncthreads();
}
#undef SBAR
#undef WAIT_BAR
}

constexpr int NWAVES = 8;
#ifndef MK_N_LAUNCHES
#define MK_N_LAUNCHES 1
#endif
constexpr int BATCH = 8, T = 4096, D = 1024, M = BATCH * T;
constexpr int A_H = 16, A_RQ = 256, A_RKV = 128, IDX_H = 8, IDX_D = 64, A_INW = 456, TOPK = 256;
constexpr int B_INW = 3088;
constexpr int NEXP = 32, MOE_K = 4, DEXP = 1024;
constexpr int NPAIR = M * MOE_K;
constexpr int MAXSLOT = NPAIR + NEXP * 256;
constexpr float LN_EPS = 1e-5f, RMS_EPS = 1e-6f;
constexpr float DN_ALPHA = 1.41421356237309515f;
constexpr float LOG2E = 1.4426950408889634f;
constexpr int N_PHASES = 19;

constexpr size_t MiB = 1u << 20;
constexpr size_t WS_CTL = 0, CTL_ZERO_BYTES = 1 * MiB;
constexpr size_t WS_SMALL = 1 * MiB;
constexpr size_t WS_WAIN = 2 * MiB, WS_WACQ = 3 * MiB, WS_WAO = 5 * MiB, WS_WBIN = 9 * MiB, WS_WBO = 15 * MiB;
constexpr size_t WS_PAR = 18 * MiB;
constexpr int PAR_REL = 0, PAR_AGQ = 512, PAR_AGKV = 768, PAR_AGKI = 896, PAR_ABKI = 960, PAR_BF = 1024, PAR_BROUT = 1088, PAR_LN = 2048  ,
              PAR_WROUT = 16384  , PAR_WF = 81920  , PAR_BGU = 98304  , PAR_BDOWN = 229376  , PAR_END = 294912;
static_assert((size_t)PAR_END * 4 <= 2 * MiB, "parameter copies");
constexpr size_t WS_TOKE = 20 * MiB;
constexpr size_t WS_WGU = 32 * MiB, WS_WD = 288 * MiB;
constexpr size_t WS_XF = 416 * MiB, WS_XB = 544 * MiB;
constexpr size_t WS_PROJ = 608 * MiB, WS_CQN = 672 * MiB, WS_CKV = 688 * MiB, WS_KIDX = 696 * MiB, WS_WIDX = 700 * MiB, WS_BKT = 701 * MiB  , WS_SEL = 712 * MiB  ,
                 WS_QIDX = 736 * MiB, WS_QLAT = 768 * MiB, WS_OLAT = 896 * MiB;
constexpr size_t WS_Q = 608 * MiB, WS_K = 672 * MiB, WS_V = 736 * MiB, WS_LOGF = 800 * MiB, WS_QX = 802 * MiB, WS_KX = 818 * MiB, WS_O = 834 * MiB, WS_CUM2 = 898 * MiB  , WS_KMAX = 900 * MiB  , WS_TS = 901 * MiB  , WS_DG = 902 * MiB  ;
constexpr size_t WS_TOPE = 1024 * MiB, WS_TOPG = 1025 * MiB, WS_POS = 1026 * MiB, WS_SLOT = 1027 * MiB, WS_TOK = 1027 * MiB + 512 * 1024  ;
constexpr size_t WS_XG = 1028 * MiB, WS_H = 1300 * MiB, WS_Y = 1572 * MiB  , WS_XB8 = 1700 * MiB  , WS_END = 1732 * MiB;
constexpr float F8_XS = 8.f, F8_WGS = 512.f, F8_HS = 4.f, F8_WDS = 1024.f, F8_WBINS = 512.f, F8_OLS = 32.f, F8_WAOS = 1024.f, F8_YS = 32.f, F8_OS = 32.f, F8_WBOS = 1024.f;
static_assert((size_t)MAXSLOT * 1024 * 2 <= 272 * MiB, "slot buffers");
constexpr int CW_TMO = 0, CW_CODE = 1;
constexpr int CW_BAR = 4096;
constexpr int CW_CMAX = 20416;
constexpr int CW_QMAX = 20480, CW_MNEG = 22528, CW_ATTQ = 24576;
constexpr int CW_CNT = 16384;
constexpr int SM_NT = 0, SM_TILE_E = 64;
constexpr int RING_OFF = 0, RING_BYTES = 131072;
constexpr int LDS_BYTES = 147456;
constexpr int MISC_OFF = LDS_BYTES - 256;
#define GAS __attribute__((address_space(1)))
#define LAS __attribute__((address_space(3)))
typedef unsigned short bf16;
typedef unsigned v4u __attribute__((ext_vector_type(4)));
typedef float f32x4 __attribute__((ext_vector_type(4)));
typedef short bf16x8 __attribute__((ext_vector_type(8)));
typedef GAS unsigned gu32;
typedef GAS unsigned long long gu64;
#define RLX_AGENT __ATOMIC_RELAXED, __HIP_MEMORY_SCOPE_AGENT
#define LDS_WAIT() asm volatile("s_waitcnt lgkmcnt(0)" ::: "memory")
#define VM_WAIT() asm volatile("s_waitcnt vmcnt(0)" ::: "memory")
__device__ __forceinline__ unsigned long long rt() { return __builtin_amdgcn_s_memrealtime(); }
__device__ __forceinline__ unsigned f2bf(float f) { unsigned u = __builtin_bit_cast(unsigned, f); return (u + 0x7fffu + ((u >> 16) & 1u)) >> 16; }
__device__ __forceinline__ unsigned pk2(float lo, float hi) { return f2bf(lo) | (f2bf(hi) << 16); }

#define XB_TMO      128
#define XB_XCNT(j)  (256  + 64 * (j))
#define XB_XSUB(j)  (1280 + 64 * (j))
#define XB_XGEN(j)  (2304 + 64 * (j))
#define XB_TOP      3328
#define XB_TOPGEN   3392
#define XCD_BAR_WORDS 3456
#define XB_SPIN_CAP (1u << 18)

__device__ __forceinline__ unsigned xb_ld(unsigned* p)              { return __hip_atomic_load(p, __ATOMIC_RELAXED, __HIP_MEMORY_SCOPE_AGENT); }
__device__ __forceinline__ unsigned xb_add(unsigned* p, unsigned v) { return __hip_atomic_fetch_add(p, v, __ATOMIC_RELAXED, __HIP_MEMORY_SCOPE_AGENT); }
__device__ __forceinline__ unsigned xb_xcc_id() { return (unsigned)__builtin_amdgcn_s_getreg((3 << 11) | 20) & 0xFu; }
#define XB_SPIN(cond, bar) do { unsigned _sp = 0; while (cond) { __builtin_amdgcn_s_sleep(1); \
    if ((++_sp & 255u) == 0u) { if (xb_ld(&(bar)[XB_TMO])) break; if (_sp > XB_SPIN_CAP) { atomicAdd(&(bar)[XB_TMO], 1u); break; } } } } while (0)

struct XcdBarrier {
    unsigned* bar; unsigned x;
    volatile LAS unsigned* st;
};

__device__ __forceinline__ XcdBarrier xcd_barrier_post(unsigned* bar, volatile LAS unsigned* st) {
    XcdBarrier b; b.bar = bar; b.x = xb_xcc_id(); b.st = st;
    if (threadIdx.x == 0) (void)xb_add(&bar[XB_XCNT(b.x)], 1u);
    return b;
}
__device__ __forceinline__ void xcd_barrier_complete(unsigned* bar, unsigned x, unsigned& nloc, unsigned& nx) {
    const unsigned G = gridDim.x * gridDim.y * gridDim.z;
    unsigned sum, cnt, mine, sp = 0u;
    for (;;) {
        sum = 0u; cnt = 0u; mine = 0u;
#pragma unroll
        for (unsigned j = 0; j < 16; ++j) { const unsigned c = xb_ld(&bar[XB_XCNT(j)]); sum += c; cnt += (c > 0u) ? 1u : 0u; mine = (j == x) ? c : mine; }
        if (sum == G) break;
        __builtin_amdgcn_s_sleep(1);
        if ((++sp & 255u) == 0u) { if (xb_ld(&bar[XB_TMO])) break; if (sp > XB_SPIN_CAP) { atomicAdd(&bar[XB_TMO], 1u); break; } }
    }
    nloc = mine > 0u ? mine : 1u; nx = cnt > 0u ? cnt : 1u;
}

__device__ __forceinline__ void xcd_barrier(const XcdBarrier& b) {
    asm volatile("s_waitcnt vmcnt(0)" ::: "memory");
    __syncthreads();
    if (threadIdx.x == 0) {
        unsigned* bar = b.bar;
        __builtin_amdgcn_s_waitcnt(0);
        unsigned nloc = b.st[0], nx = b.st[1];
        if (nloc == 0u) { xcd_barrier_complete(bar, b.x, nloc, nx); b.st[0] = nloc; b.st[1] = nx; }
        const unsigned old = xb_add(&bar[XB_XSUB(b.x)], 1u);
        const unsigned gen = old / nloc;
        if (old + 1u == (gen + 1u) * nloc) {
            __builtin_amdgcn_fence(__ATOMIC_RELEASE, "agent");
            asm volatile("s_waitcnt vmcnt(0)" ::: "memory");
            const unsigned og = xb_add(&bar[XB_TOP], 1u);
            const unsigned tg = og / nx;
            if (og + 1u == (tg + 1u) * nx) xb_add(&bar[XB_TOPGEN], 1u);
            else XB_SPIN(xb_ld(&bar[XB_TOPGEN]) == tg, bar);
            __builtin_amdgcn_fence(__ATOMIC_ACQUIRE, "agent");
            xb_add(&bar[XB_XGEN(b.x)], 1u);
            asm volatile("s_waitcnt vmcnt(0)" ::: "memory");
        } else {
            XB_SPIN(xb_ld(&bar[XB_XGEN(b.x)]) == gen, bar);
            __builtin_amdgcn_fence(__ATOMIC_ACQUIRE, "agent");
            asm volatile("s_waitcnt vmcnt(0)" ::: "memory");
        }
    }
    __syncthreads();
}

struct Frame {
    LAS unsigned char* lds;
    volatile LAS unsigned* MISC;
    gu32* ctl;
    int vcu, G;
    unsigned char* ws;
};
__device__ __forceinline__ int opaque_tid() { int t = threadIdx.x; asm volatile("" : "+v"(t)); return t; }
#define PHASE_IDS() const int tid = opaque_tid(), lane = tid & 63, wave = __builtin_amdgcn_readfirstlane(tid >> 6); (void)lane; (void)wave
typedef float f32x2 __attribute__((ext_vector_type(2)));
typedef unsigned u32x4 __attribute__((ext_vector_type(4)));
typedef unsigned u32x2 __attribute__((ext_vector_type(2)));
__device__ __forceinline__ float wave_sum(float x) {
    float v = x;
#define WS_STEP(ctrl, rmask) v += __builtin_bit_cast(float, __builtin_amdgcn_update_dpp(0, __builtin_bit_cast(int, v), ctrl, rmask, 0xf, false))
    WS_STEP(0x111, 0xf); WS_STEP(0x112, 0xf); WS_STEP(0x114, 0xf); WS_STEP(0x118, 0xf); WS_STEP(0x142, 0xa); WS_STEP(0x143, 0xc);
#undef WS_STEP
    return __builtin_bit_cast(float, __builtin_amdgcn_readlane(__builtin_bit_cast(int, v), 63));
}
__device__ __forceinline__ unsigned cvtpk(float lo, float hi) { typedef __bf16 bf2 __attribute__((ext_vector_type(2))); f32x2 v = {lo, hi}; bf2 b = __builtin_convertvector(v, bf2); return __builtin_bit_cast(unsigned, b); }
__device__ __forceinline__ float bf2f(unsigned short h) { return __uint_as_float((unsigned)h << 16); }

struct TrItem { const float* W; int ldw, nvalid, K; unsigned char* WT; int row_off, mode, f8; float fscale; int k0, n0; };
__device__ __forceinline__ void tr_load(const TrItem& t, f32x4 (&v)[8][2], int lane, int wave) {
#pragma unroll
    for (int i = 0; i < 8; ++i)
#pragma unroll
        for (int j = 0; j < 2; ++j) { const int n = t.n0 + 4 * lane + (t.f8 ? 0 : 256 * j); const int k = t.k0 + (t.f8 ? wave * 16 + 2 * i + j : wave * 8 + i);
            v[i][j] = (n < t.nvalid) ? __builtin_nontemporal_load((const f32x4*)(t.W + (size_t)k * t.ldw + n)) : (f32x4){0.f, 0.f, 0.f, 0.f}; }
}
__device__ __forceinline__ void tr_to_lds(const TrItem& t, const f32x4 (&v)[8][2], LAS float* scr, int lane, int wave) {
#pragma unroll
    for (int i = 0; i < 8; ++i)
#pragma unroll
        for (int j = 0; j < 2; ++j) { LAS float* d = t.f8 ? scr + (wave * 16 + 2 * i + j) * 257 + 4 * lane : scr + (wave * 8 + i) * 513 + 4 * lane + 256 * j; d[0] = v[i][j].x; d[1] = v[i][j].y; d[2] = v[i][j].z; d[3] = v[i][j].w; }
}
__device__ __forceinline__ void tr_store(const TrItem& t, LAS float* scr, int tid) {
    const int c = tid & 7;
    if (t.f8) {
        const float fs = t.fscale;
#pragma unroll
        for (int j = 0; j < 4; ++j) { const int n = (tid >> 3) + 64 * j; const LAS float* s = scr + (16 * c) * 257 + n;
            const int ng = t.n0 + n; int row;
            if (t.mode == 0) row = t.row_off + ng; else { const int np = ng & 1023; row = (np >> 7) * 256 + ((ng >> 10) << 7) + (np & 127); }
            v4u o; o.x = pg8::cvt4_fp8(s[0 * 257] * fs, s[1 * 257] * fs, s[2 * 257] * fs, s[3 * 257] * fs); o.y = pg8::cvt4_fp8(s[4 * 257] * fs, s[5 * 257] * fs, s[6 * 257] * fs, s[7 * 257] * fs);
            o.z = pg8::cvt4_fp8(s[8 * 257] * fs, s[9 * 257] * fs, s[10 * 257] * fs, s[11 * 257] * fs); o.w = pg8::cvt4_fp8(s[12 * 257] * fs, s[13 * 257] * fs, s[14 * 257] * fs, s[15 * 257] * fs);
            *(GAS v4u*)(t.WT + (size_t)row * t.K + t.k0 + 16 * c) = o; }
        return; }
#pragma unroll
    for (int j = 0; j < 8; ++j) { const int n = (tid >> 3) + 64 * j; const LAS float* s = scr + (8 * c) * 513 + n;
        const int ng = t.n0 + n; int row;
        if (t.mode == 0) row = t.row_off + ng; else { const int np = ng & 1023; row = (np >> 7) * 256 + ((ng >> 10) << 7) + (np & 127); }
        v4u o; o.x = pk2(s[0 * 513], s[1 * 513]); o.y = pk2(s[2 * 513], s[3 * 513]); o.z = pk2(s[4 * 513], s[5 * 513]); o.w = pk2(s[6 * 513], s[7 * 513]);
        *(GAS v4u*)(t.WT + ((size_t)row * t.K + t.k0 + 8 * c) * 2) = o; }
}
struct P0In { const float *x, *a_w_in, *a_w_uq, *a_w_uk, *a_w_uv, *a_w_qidx, *a_w_o, *b_w_in, *b_w_o, *w_gu, *w_down;
              const float *rel, *a_g_q, *a_g_kv, *a_g_kidx, *a_b_kidx, *b_b_f, *ln_mix_g, *ln_mix_b, *ln_ffn_g, *ln_ffn_b, *w_router, *b_router, *b_gu, *b_down; };
__device__ __forceinline__ void p0_copy(float* dst, const float* src, int n, int g0, int gs) { for (int i = g0; i < n; i += gs) dst[i] = src[i]; }
__device__ __forceinline__ void p0_prologue(Frame& F, const P0In& I) {
    PHASE_IDS();
    bf16* WAIN = (bf16*)(F.ws + WS_WAIN); bf16* WACQ = (bf16*)(F.ws + WS_WACQ); bf16* WAO = (bf16*)(F.ws + WS_WAO); bf16* WBIN = (bf16*)(F.ws + WS_WBIN); bf16* WBO = (bf16*)(F.ws + WS_WBO);
    bf16* WGU = (bf16*)(F.ws + WS_WGU); bf16* WD = (bf16*)(F.ws + WS_WD); bf16* XB = (bf16*)(F.ws + WS_XB);
#ifndef MK_P0_REP
#define MK_P0_REP 0
#endif
    for (int rep0 = 0; rep0 < 1 + (MK_P0_REP & 1); ++rep0)
    for (int it = F.vcu; it < 128 + 256; it += F.G) {
        if (it < 128) {
            const int h = it >> 3, rb = it & 7; const int rq = tid & 255, rs = wave >> 2;
            float q[64];
            const GAS f32x4* qp = (const GAS f32x4*)(I.a_w_uq + ((size_t)rq * A_H + h) * 64);
#pragma unroll
            for (int i = 0; i < 16; ++i) { const f32x4 v = qp[i]; q[4 * i] = v.x; q[4 * i + 1] = v.y; q[4 * i + 2] = v.z; q[4 * i + 3] = v.w; }
            for (int j = 0; j < 8; ++j) { const int r = rb * 16 + rs * 8 + j; const float* kp = I.a_w_uk + ((size_t)r * A_H + h) * 64; float s = 0.f;
#pragma unroll
                for (int d = 0; d < 64; ++d) s += q[d] * kp[d];
                WACQ[(size_t)(h * 128 + r) * 256 + rq] = (bf16)f2bf(s * (0.125f * LOG2E)); }
        } else {
            const int i2 = it - 128, h = i2 >> 4, nc = i2 & 15; LAS float* wo = (LAS float*)F.lds; LAS float* wuv = wo + 4096;
#pragma unroll
            for (int i = 0; i < 8; ++i) { const int idx = tid + 512 * i, d = idx >> 6, n = idx & 63; wo[idx] = I.a_w_o[(size_t)(h * 64 + d) * D + nc * 64 + n]; }
#pragma unroll
            for (int i = 0; i < 16; ++i) { const int idx = tid + 512 * i, r = idx >> 6, d = idx & 63; wuv[idx] = I.a_w_uv[((size_t)r * A_H + h) * 64 + d]; }
            LDS_WAIT(); __syncthreads();
            const int nl = tid & 63, rg = wave; float acc[16];
#pragma unroll
            for (int i = 0; i < 16; ++i) acc[i] = 0.f;
#pragma unroll 8
            for (int d = 0; d < 64; ++d) { const float w = wo[d * 64 + nl];
#pragma unroll
                for (int i = 0; i < 16; ++i) acc[i] += wuv[(rg * 16 + i) * 64 + d] * w; }
#pragma unroll
            for (int i = 0; i < 16; ++i) acc[i] *= F8_WAOS;
            v4u o0; o0.x = pg8::cvt4_fp8(acc[0], acc[1], acc[2], acc[3]); o0.y = pg8::cvt4_fp8(acc[4], acc[5], acc[6], acc[7]); o0.z = pg8::cvt4_fp8(acc[8], acc[9], acc[10], acc[11]); o0.w = pg8::cvt4_fp8(acc[12], acc[13], acc[14], acc[15]);
            *(GAS v4u*)((unsigned char*)WAO + (size_t)(nc * 64 + nl) * 2048 + h * 128 + rg * 16) = o0;
            __syncthreads();
        }
    }
    __syncthreads();
    LAS float* scr = (LAS float*)(F.lds + RING_OFF);
    constexpr int I_AIN = 16 * 1, I_QIDX = 4 * 1, I_BIN = 8 * 12, I_BO = 8 * 4, I_GU1 = 8 * 8, I_D1 = 8 * 4;
    constexpr int I_GU = 64 * I_GU1, I_DN = 64 * I_D1;
    constexpr int NITEMS = I_AIN + I_QIDX + I_BIN + I_BO + I_GU + I_DN;
    auto decode = [&](int it) -> TrItem {
        TrItem t; int r = it; t.mode = 0; t.f8 = 0; t.fscale = 1.f; t.row_off = 0;
        if (r < I_AIN) { t.W = I.a_w_in; t.ldw = A_INW; t.nvalid = A_INW; t.K = 1024; t.WT = (unsigned char*)WAIN; t.k0 = 64 * r; t.n0 = 0; return t; } r -= I_AIN;
        if (r < I_QIDX) { t.W = I.a_w_qidx; t.ldw = 512; t.nvalid = 512; t.K = 256; t.WT = (unsigned char*)WACQ; t.row_off = 2048; t.k0 = 64 * r; t.n0 = 0; return t; } r -= I_QIDX;
        if (r < I_BIN) { t.W = I.b_w_in; t.ldw = B_INW; t.nvalid = 3072; t.K = 1024; t.WT = (unsigned char*)WBIN; t.f8 = 1; t.fscale = F8_WBINS; t.k0 = 128 * (r / 12); t.n0 = 256 * (r % 12); return t; } r -= I_BIN;
        if (r < I_BO) { t.W = I.b_w_o; t.ldw = 1024; t.nvalid = 1024; t.K = 1024; t.WT = (unsigned char*)WBO; t.f8 = 1; t.fscale = F8_WBOS; t.k0 = 128 * (r / 4); t.n0 = 256 * (r % 4); return t; } r -= I_BO;
        if (r < I_GU) { const int mi = r / I_GU1, rr = r % I_GU1; t.W = I.w_gu + (size_t)mi * 1024 * 2048; t.ldw = 2048; t.nvalid = 2048; t.K = 1024; t.WT = (unsigned char*)WGU + (size_t)mi * 2048 * 1024; t.mode = 1; t.f8 = 1; t.fscale = F8_WGS;
            t.k0 = 128 * (rr / 8); t.n0 = 256 * (rr % 8); return t; } r -= I_GU;
        { const int mi = r / I_D1, rr = r % I_D1; t.W = I.w_down + (size_t)mi * 1024 * 1024; t.ldw = 1024; t.nvalid = 1024; t.K = 1024; t.WT = (unsigned char*)WD + (size_t)mi * 1024 * 1024; t.f8 = 1; t.fscale = F8_WDS;
            t.k0 = 128 * (rr / 4); t.n0 = 256 * (rr % 4); return t; }
    };
    for (int rep1 = 0; rep1 < 1 + ((MK_P0_REP >> 1) & 1); ++rep1) {
        f32x4 v[8][2]; int it = F.vcu;
        if (it < NITEMS) { const TrItem t0 = decode(it); tr_load(t0, v, lane, wave); }
        for (; it < NITEMS; it += F.G) {
            const TrItem t = decode(it);
            tr_to_lds(t, v, scr, lane, wave);
            LDS_WAIT(); __syncthreads();
            if (it + F.G < NITEMS) { const TrItem tn = decode(it + F.G); tr_load(tn, v, lane, wave); }
            tr_store(t, scr, tid);
            LDS_WAIT(); __syncthreads();
        }
    }
    { float* PAR = (float*)(F.ws + WS_PAR); const int g0 = F.vcu * 512 + tid, gs = F.G * 512;
      p0_copy(PAR + PAR_REL, I.rel, 512, g0, gs); p0_copy(PAR + PAR_AGQ, I.a_g_q, 256, g0, gs); p0_copy(PAR + PAR_AGKV, I.a_g_kv, 128, g0, gs); p0_copy(PAR + PAR_AGKI, I.a_g_kidx, 64, g0, gs);
      p0_copy(PAR + PAR_ABKI, I.a_b_kidx, 64, g0, gs); p0_copy(PAR + PAR_BF, I.b_b_f, 16, g0, gs); p0_copy(PAR + PAR_BROUT, I.b_router, 64, g0, gs);
      p0_copy(PAR + PAR_LN, I.ln_mix_g, 2048, g0, gs); p0_copy(PAR + PAR_LN + 2048, I.ln_mix_b, 2048, g0, gs); p0_copy(PAR + PAR_LN + 4096, I.ln_ffn_g, 2048, g0, gs); p0_copy(PAR + PAR_LN + 6144, I.ln_ffn_b, 2048, g0, gs);
      p0_copy(PAR + PAR_WROUT, I.w_router, 65536, g0, gs); p0_copy(PAR + PAR_BGU, I.b_gu, 131072, g0, gs); p0_copy(PAR + PAR_BDOWN, I.b_down, 65536, g0, gs);
      for (int i = g0; i < 16384; i += gs) PAR[PAR_WF + i] = I.b_w_in[(size_t)(i >> 4) * B_INW + 3072 + (i & 15)]; }
    { const size_t n8 = (size_t)M * D / 8; const size_t g0 = (size_t)F.vcu * 512 + tid, gs = (size_t)F.G * 512;
      for (int rep2 = 0; rep2 < 1 + ((MK_P0_REP >> 2) & 1); ++rep2)
      for (size_t i = g0; i < n8; i += 4 * gs) { f32x4 a[4], b[4];
#pragma unroll
          for (int q = 0; q < 4; ++q) { const size_t ii = i + q * gs; if (ii < n8) { const GAS f32x4* p = (const GAS f32x4*)(I.x + ii * 8); a[q] = __builtin_nontemporal_load(p); b[q] = __builtin_nontemporal_load(p + 1); } }
#pragma unroll
          for (int q = 0; q < 4; ++q) { const size_t ii = i + q * gs; if (ii < n8) { v4u o; o.x = pk2(a[q].x, a[q].y); o.y = pk2(a[q].z, a[q].w); o.z = pk2(b[q].x, b[q].y); o.w = pk2(b[q].z, b[q].w); *(GAS v4u*)(XB + ii * 8) = o; } } } }
}

__device__ __forceinline__ void p_dsa_norms(Frame& F, const float* g_q, const float* g_kv, const float* g_kidx, const float* b_kidx) {
    PHASE_IDS();
    const float* PROJ = (const float*)(F.ws + WS_PROJ); bf16* CQN = (bf16*)(F.ws + WS_CQN); bf16* CKV = (bf16*)(F.ws + WS_CKV); bf16* KIDX = (bf16*)(F.ws + WS_KIDX); float* WIDX = (float*)(F.ws + WS_WIDX);
    const int l = lane; const int gw = F.vcu * NWAVES + wave, NGW = F.G * NWAVES;
    const f32x4 gq = *(const f32x4*)(g_q + 4 * l); const f32x2 gkv = *(const f32x2*)(g_kv + 2 * l); const float gki = g_kidx[l], bki = b_kidx[l];
    float cmx = 0.f;
    f32x4 cq_n = {0.f, 0.f, 0.f, 0.f}; f32x2 ckv_n = {0.f, 0.f}; float ki_n = 0.f, wi_n = 0.f;
    if (gw < M) { const float* p = PROJ + (size_t)gw * 512; cq_n = *(const f32x4*)(p + 4 * l); ckv_n = *(const f32x2*)(p + 256 + 2 * l); ki_n = p[384 + l]; wi_n = p[448 + (l & 7)]; }
    for (int row = gw; row < M; row += NGW) {
        const f32x4 cq = cq_n; const f32x2 ckv = ckv_n; const float ki = ki_n; const float wi = wi_n;
        if (row + NGW < M) { const float* p = PROJ + (size_t)(row + NGW) * 512; cq_n = *(const f32x4*)(p + 4 * l); ckv_n = *(const f32x2*)(p + 256 + 2 * l); ki_n = p[384 + l]; wi_n = p[448 + (l & 7)]; }
        const float rq = 1.0f / sqrtf(wave_sum(cq.x * cq.x + cq.y * cq.y + cq.z * cq.z + cq.w * cq.w) * (1.0f / 256.0f) + RMS_EPS);
        const float rkv = 1.0f / sqrtf(wave_sum(ckv.x * ckv.x + ckv.y * ckv.y) * (1.0f / 128.0f) + RMS_EPS);
        const float mean = wave_sum(ki) * (1.0f / 64.0f); const float dk = ki - mean; const float rki = 1.0f / sqrtf(wave_sum(dk * dk) * (1.0f / 64.0f) + LN_EPS);
        u32x2 oq; oq.x = cvtpk(cq.x * rq * gq.x, cq.y * rq * gq.y); oq.y = cvtpk(cq.z * rq * gq.z, cq.w * rq * gq.w);
        *(GAS u32x2*)(CQN + (size_t)row * 256 + 4 * l) = oq;
        const float c0 = ckv.x * rkv * gkv.x, c1 = ckv.y * rkv * gkv.y;
        *(GAS unsigned*)(CKV + (size_t)row * 128 + 2 * l) = cvtpk(c0, c1);
        cmx = fmaxf(cmx, wave_sum(c0 * c0 + c1 * c1));
        KIDX[(size_t)row * 64 + l] = (bf16)f2bf(dk * rki * gki + bki);
        if (l < 8) WIDX[(size_t)row * 8 + l] = wi * 0.04419417382415922f;
    }
    if (l == 0) __hip_atomic_fetch_max(F.ctl + CW_CMAX, __float_as_uint(sqrtf(cmx)), __ATOMIC_RELAXED, __HIP_MEMORY_SCOPE_AGENT);
}

__device__ __forceinline__ int t5_bucket(int n) {
    if (n < 16) return n; if (n >= 128) return 31;
    const int v = 16 + (int)(__builtin_amdgcn_logf((float)n * 0.0625f) * (16.0f / 3.0f));
    return v < 31 ? v : 31;
}
__device__ __forceinline__ unsigned fkey(float f) { const unsigned u = __float_as_uint(f); return (u & 0x80000000u) ? ~u : (u | 0x80000000u); }
__device__ __forceinline__ int popc64(unsigned long long m) { return __builtin_popcountll(m); }
__device__ __forceinline__ int mbcnt(unsigned long long m) { return (int)__builtin_amdgcn_mbcnt_hi((unsigned)(m >> 32), __builtin_amdgcn_mbcnt_lo((unsigned)m, 0u)); }
typedef float f32x16 __attribute__((ext_vector_type(16)));
typedef unsigned short u16x2 __attribute__((ext_vector_type(2)));
__device__ __forceinline__ int wave_total_i(int x) {
    int v = x;
    v += __builtin_amdgcn_update_dpp(0, v, 0x111, 0xf, 0xf, false);
    v += __builtin_amdgcn_update_dpp(0, v, 0x112, 0xf, 0xf, false);
    v += __builtin_amdgcn_update_dpp(0, v, 0x114, 0xf, 0xf, false);
    v += __builtin_amdgcn_update_dpp(0, v, 0x118, 0xf, 0xf, false);
    v += __builtin_amdgcn_update_dpp(0, v, 0x142, 0xa, 0xf, false);
    v += __builtin_amdgcn_update_dpp(0, v, 0x143, 0xc, 0xf, false);
    return __builtin_amdgcn_readlane(v, 63);
}
#ifndef MK_IDX_REP
#define MK_IDX_REP 0
#endif
#ifndef MK_CHECK_SEL
#define MK_CHECK_SEL 0
#endif
__device__ __forceinline__ void select_top256(const unsigned (&u)[64], int nj, int l, LAS unsigned short* selst, LAS unsigned* cand  ) {
    constexpr int SEL_CAP = 1024;
    unsigned pk[32];
#pragma unroll
    for (int p = 0; p < 32; ++p) pk[p] = (u[2 * p] >> 17) | ((u[2 * p + 1] >> 1) & 0xffff0000u);
    const int ngrp = (nj + 7) >> 3; const int nconsidered = ngrp * 512;
    auto count_ge = [&](unsigned c) -> int {
        const u16x2 cpk = __builtin_bit_cast(u16x2, c * 0x10001u); u16x2 acc = {0, 0};
#pragma unroll
        for (int jb = 0; jb < 8; ++jb) { if (jb < ngrp) {
#pragma unroll
            for (int q = 0; q < 4; ++q) { const u16x2 d = __builtin_bit_cast(u16x2, pk[4 * jb + q]) - cpk; acc += (d >> (unsigned short)15); } } }
        const unsigned a = __builtin_bit_cast(unsigned, acc);
        return nconsidered - wave_total_i((int)((a & 0xffffu) + (a >> 16)));
    };
    unsigned P = 0u;
    for (int bit = 14; bit >= 0; --bit) { const unsigned c = P | (1u << bit); if (count_ge(c) >= TOPK) P = c; }
    const int c_above = count_ge(P + 1u); const int need = TOPK - c_above;
    int off = 0, coff = 0;
#pragma unroll
    for (int j = 0; j < 64; ++j) { if ((j >> 3) < ngrp) {
        const unsigned k15 = u[j] >> 17; const unsigned long long m1 = __ballot(k15 > P), mc = __ballot(k15 == P);
        if (k15 > P) selst[off + mbcnt(m1)] = (unsigned short)(j * 64 + l);
        off += popc64(m1);
        if (mc != 0ull) { if (k15 == P) { const int pos = coff + mbcnt(mc); if (pos < SEL_CAP) { cand[pos] = u[j]; cand[SEL_CAP + pos] = (unsigned)(j * 64 + l); } } coff += popc64(mc); } }
        __builtin_amdgcn_sched_barrier(0); }
    LDS_WAIT(); asm volatile("" ::: "memory");
    const int ncand = coff;
    if (ncand == need && ncand <= SEL_CAP) { for (int i = l; i < ncand; i += 64) selst[c_above + i] = (unsigned short)cand[SEL_CAP + i]; }
    else if (ncand <= 256) {
        unsigned mk[4], mi[4]; int rk[4];
#pragma unroll
        for (int r = 0; r < 4; ++r) { const int i = l + 64 * r; const bool v = i < ncand; mk[r] = v ? cand[i] : 0u; mi[r] = v ? cand[SEL_CAP + i] : 0xffffffffu; rk[r] = 0; }
        for (int c2 = 0; c2 < ncand; ++c2) { const unsigned k2 = cand[c2], i2 = cand[SEL_CAP + c2];
#pragma unroll
            for (int r = 0; r < 4; ++r) rk[r] += (k2 > mk[r] || (k2 == mk[r] && i2 < mi[r])) ? 1 : 0; }
#pragma unroll
        for (int r = 0; r < 4; ++r) { if (l + 64 * r < ncand && rk[r] < need) selst[c_above + rk[r]] = (unsigned short)mi[r]; }
    } else {
        unsigned Tk = P << 17;
        for (int bit = 16; bit >= 0; --bit) { const unsigned cd = Tk | (1u << bit); int cnt = 0;
#pragma unroll
            for (int j = 0; j < 64; ++j) cnt += (u[j] >= cd) ? 1 : 0;
            if (wave_total_i(cnt) >= TOPK) Tk = cd; }
        int cg = 0;
#pragma unroll
        for (int j = 0; j < 64; ++j) cg += (u[j] > Tk && (u[j] >> 17) == P) ? 1 : 0;
        const int ngt = wave_total_i(cg); const int need2 = need - ngt; int o2 = c_above, t2 = 0;
        unsigned Tk2 = Tk, P2 = P; asm volatile("" : "+s"(Tk2), "+s"(P2));
#pragma unroll
        for (int j = 0; j < 64; ++j) { const bool isc = (u[j] >> 17) == P2; const unsigned long long m1 = __ballot(isc && u[j] > Tk2), m2 = __ballot(isc && u[j] == Tk2);
            if (isc && u[j] > Tk2) selst[o2 + mbcnt(m1)] = (unsigned short)(j * 64 + l);
            if (isc && u[j] == Tk2) { const int rk2 = t2 + mbcnt(m2); if (rk2 < need2) selst[c_above + ngt + rk2] = (unsigned short)(j * 64 + l); }
            o2 += popc64(m1); t2 += popc64(m2); __builtin_amdgcn_sched_barrier(0); }
    }
    LDS_WAIT(); asm volatile("" ::: "memory");
}
#if MK_CHECK_SEL
__device__ __forceinline__ void select_ref(const unsigned (&u)[64], int l, LAS unsigned short* selst) {
    unsigned Tk = 0u;
    for (int bit = 31; bit >= 0; --bit) { const unsigned cand = Tk | (1u << bit); int cnt = 0;
#pragma unroll
        for (int j = 0; j < 64; ++j) cnt += popc64(__ballot(u[j] >= cand));
        if (cnt >= TOPK) Tk = cand; }
    int cgt = 0;
#pragma unroll
    for (int j = 0; j < 64; ++j) cgt += popc64(__ballot(u[j] > Tk));
    const int need = TOPK - cgt; int off = 0, toff = 0;
#pragma unroll
    for (int j = 0; j < 64; ++j) { const unsigned long long m1 = __ballot(u[j] > Tk), m2 = __ballot(u[j] == Tk);
        if (u[j] > Tk) selst[off + mbcnt(m1)] = (unsigned short)(j * 64 + l);
        if (u[j] == Tk) { const int rk = toff + mbcnt(m2); if (rk < need) selst[cgt + rk] = (unsigned short)(j * 64 + l); }
        off += popc64(m1); toff += popc64(m2); }
    LDS_WAIT(); asm volatile("" ::: "memory");
}
#endif
__device__ __forceinline__ int wave_scan_i(int x) {
    int v = x;
    v += __builtin_amdgcn_update_dpp(0, v, 0x111, 0xf, 0xf, false);
    v += __builtin_amdgcn_update_dpp(0, v, 0x112, 0xf, 0xf, false);
    v += __builtin_amdgcn_update_dpp(0, v, 0x114, 0xf, 0xf, false);
    v += __builtin_amdgcn_update_dpp(0, v, 0x118, 0xf, 0xf, false);
    v += __builtin_amdgcn_update_dpp(0, v, 0x142, 0xa, 0xf, false);
    v += __builtin_amdgcn_update_dpp(0, v, 0x143, 0xc, 0xf, false);
    return v;
}
__device__ __forceinline__ int radix_pick(LAS unsigned* hist, int want, int l, int& above) {
    const u32x4 h4 = *(const LAS u32x4*)(hist + 4 * l);
    const int tot = (int)((h4.x + h4.y) + (h4.z + h4.w)); const int pre = wave_scan_i(tot); const int total = __builtin_amdgcn_readlane(pre, 63);
    const int a3 = total - pre, a2 = a3 + (int)h4.w, a1 = a2 + (int)h4.z, a0 = a1 + (int)h4.y;
    const bool c3 = a3 < want && a3 + (int)h4.w >= want, c2 = a2 < want && a2 + (int)h4.z >= want, c1 = a1 < want && a1 + (int)h4.y >= want, c0 = a0 < want && a0 + (int)h4.x >= want;
    const unsigned long long m = __ballot(c3 || c2 || c1 || c0); const int src = (int)__builtin_ctzll(m | (1ull << 63));
    const int mybin = 4 * l + (c3 ? 3 : c2 ? 2 : c1 ? 1 : 0), myab = c3 ? a3 : c2 ? a2 : c1 ? a1 : a0;
    above = __builtin_amdgcn_readlane(myab, src);
    return __builtin_amdgcn_readlane(mybin, src);
}
__device__ __forceinline__ void select_top256_radix(const unsigned (&k)[64], int nj, int l, LAS unsigned short* selst, LAS unsigned* hist) {
    const int ngrp = (nj + 7) >> 3;
    *(LAS u32x4*)(hist + 4 * l) = (u32x4){0u, 0u, 0u, 0u};
    LDS_WAIT(); asm volatile("" ::: "memory");
#pragma unroll
    for (int j = 0; j < 64; ++j) { if ((j >> 3) < ngrp) (void)__hip_atomic_fetch_add(hist + (k[j] >> 8), 1u, __ATOMIC_RELAXED, __HIP_MEMORY_SCOPE_WORKGROUP); }
    LDS_WAIT(); asm volatile("" ::: "memory");
    int above1 = 0; const int bhi = radix_pick(hist, TOPK, l, above1); const int want2 = TOPK - above1;
    LDS_WAIT(); asm volatile("" ::: "memory");
    *(LAS u32x4*)(hist + 4 * l) = (u32x4){0u, 0u, 0u, 0u};
    LDS_WAIT(); asm volatile("" ::: "memory");
#pragma unroll
    for (int j = 0; j < 64; ++j) { if ((j >> 3) < ngrp) { if ((int)(k[j] >> 8) == bhi) (void)__hip_atomic_fetch_add(hist + (k[j] & 255u), 1u, __ATOMIC_RELAXED, __HIP_MEMORY_SCOPE_WORKGROUP); } }
    LDS_WAIT(); asm volatile("" ::: "memory");
    int above2 = 0; const int blo = radix_pick(hist, want2, l, above2);
    const unsigned T16 = ((unsigned)bhi << 8) | (unsigned)blo; const int cgt = above1 + above2, need = TOPK - cgt;
    int off = 0, toff = 0;
#pragma unroll
    for (int j = 0; j < 64; ++j) { if ((j >> 3) < ngrp) {
        const unsigned long long m1 = __ballot(k[j] > T16), m2 = __ballot(k[j] == T16);
        if (k[j] > T16) selst[off + mbcnt(m1)] = (unsigned short)(j * 64 + l);
        if (m2 != 0ull) { if (k[j] == T16) { const int rk = toff + mbcnt(m2); if (rk < need) selst[cgt + rk] = (unsigned short)(j * 64 + l); } toff += popc64(m2); }
        off += popc64(m1); }
        __builtin_amdgcn_sched_barrier(0); }
    LDS_WAIT(); asm volatile("" ::: "memory");
}
__device__ __forceinline__ void p_indexer(Frame& F) {
    PHASE_IDS();
    const bf16* QIDX = (const bf16*)(F.ws + WS_QIDX); const bf16* KIDX = (const bf16*)(F.ws + WS_KIDX); const float* WIDX = (const float*)(F.ws + WS_WIDX);
    unsigned short* SEL = (unsigned short*)(F.ws + WS_SEL); unsigned char* BKT = (unsigned char*)(F.ws + WS_BKT);
    LAS unsigned short* selst = (LAS unsigned short*)(F.lds + 131072) + wave * 256;
    const int l = lane, l31 = l & 31, hi = l >> 5;
    { const int gw = F.vcu * NWAVES + wave, NGW = F.G * NWAVES;
      for (int rr = gw; rr < BATCH * 256; rr += NGW) { const int b = rr >> 8, t = rr & 255; const size_t row = (size_t)b * T + t;
          unsigned short s4[4]; unsigned bk = 0;
#pragma unroll
          for (int i = 0; i < 4; ++i) { const int k = 4 * l + i; const bool v = k <= t; s4[i] = v ? (unsigned short)k : (unsigned short)0xFFFF; bk |= (unsigned)(v ? t5_bucket(t - k) : 32) << (8 * i); }
          u32x2 o; o.x = (unsigned)s4[0] | ((unsigned)s4[1] << 16); o.y = (unsigned)s4[2] | ((unsigned)s4[3] << 16);
          *(GAS u32x2*)(SEL + row * 256 + 4 * l) = o; *(GAS unsigned*)(BKT + row * 256 + 4 * l) = bk; } }
    LAS unsigned short* S16 = (LAS unsigned short*)F.lds;
    LAS float* wtab = (LAS float*)(F.lds + 131072 + 4096);
    for (int i = 0; ; ++i) {
        const int L = i * F.G + F.vcu; const int rnd = L >> 8, pos = L & 255;
        if (rnd >= 8) break;
        const int b = pos & 7, gs = pos >> 3; const int g = 239 - 32 * rnd - ((rnd & 1) ? (31 - gs) : gs);
        if (g < 0) continue;
        const int t0 = 256 + 16 * g, nk = t0 + 16, nkt = (nk + 31) >> 5; const size_t rowb = (size_t)b * T;
        int lt_ = threadIdx.x; asm volatile("" : "+v"(lt_)); const int l = lt_ & 63, l31 = l & 31, hi = l >> 5;
        bf16x8 af[4][4];
        { const int tl = 2 * ((l31 >> 2) & 1) + (l31 >> 4), hd = (l31 & 3) + 4 * ((l31 >> 3) & 1);
#pragma unroll
          for (int mt = 0; mt < 4; ++mt) { const bf16* qp = QIDX + (rowb + t0 + mt * 4 + tl) * 512 + hd * 64 + hi * 8;
#pragma unroll
              for (int ks = 0; ks < 4; ++ks) af[mt][ks] = *(const GAS bf16x8*)(qp + ks * 16); }
          if (lt_ < 128) wtab[lt_] = WIDX[(rowb + t0) * 8 + lt_] * 0.5f;
          LDS_WAIT(); __syncthreads(); }
        for (int rep1 = 0; rep1 < 1 + (MK_IDX_REP & 1); ++rep1) {
        bf16x8 bfr[4], bn1[4], bnx[4];
        { const bf16* kp = KIDX + (rowb + wave * 32 + l31) * 64 + hi * 8;
#pragma unroll
          for (int ks = 0; ks < 4; ++ks) bfr[ks] = (wave < nkt) ? *(const GAS bf16x8*)(kp + ks * 16) : (bf16x8){0, 0, 0, 0, 0, 0, 0, 0};
          const int kt1 = wave + NWAVES; const bf16* kp1 = KIDX + (rowb + (kt1 < nkt ? kt1 : 0) * 32 + l31) * 64 + hi * 8;
#pragma unroll
          for (int ks = 0; ks < 4; ++ks) bn1[ks] = *(const GAS bf16x8*)(kp1 + ks * 16); }
        auto tile = [&](const int kt, const bf16x8 (&cur)[4], bf16x8 (&ld)[4]) {
            const int key = kt * 32 + l31; const int ktn = kt + 2 * NWAVES;
            LAS float* wtab_k = wtab; asm volatile("" : "+v"(wtab_k));
            { const bf16* kp = KIDX + (rowb + (ktn < nkt ? ktn : kt) * 32 + l31) * 64 + hi * 8;
#pragma unroll
              for (int ks = 0; ks < 4; ++ks) ld[ks] = *(const GAS bf16x8*)(kp + ks * 16); }
#pragma unroll
            for (int mt = 0; mt < 4; ++mt) { f32x16 acc = f32x16{};
#pragma unroll
                for (int ks = 0; ks < 4; ++ks) acc = __builtin_amdgcn_mfma_f32_32x32x16_bf16(af[mt][ks], cur[ks], acc, 0, 0, 0);
                float sA = 0.f, sB = 0.f;
                const LAS f32x4* wq = (const LAS f32x4*)(wtab_k + (mt * 4 + 2 * hi) * 8); const f32x4 wa0 = wq[0], wa1 = wq[1], wb0 = wq[2], wb1 = wq[3];
                const float wA[8] = {wa0.x, wa0.y, wa0.z, wa0.w, wa1.x, wa1.y, wa1.z, wa1.w}, wB[8] = {wb0.x, wb0.y, wb0.z, wb0.w, wb1.x, wb1.y, wb1.z, wb1.w};
#pragma unroll
                for (int r = 0; r < 8; ++r) { sA += wA[r] * (acc[r] + __builtin_fabsf(acc[r])); sB += wB[r] * (acc[8 + r] + __builtin_fabsf(acc[8 + r])); }
                const int tokA = mt * 4 + 2 * hi; const int tA = t0 + tokA;
                const _Float16 hA = (_Float16)((key <= tA) ? sA : -INFINITY), hB = (_Float16)((key <= tA + 1) ? sB : -INFINITY);
                S16[tokA * 4096 + key] = __builtin_bit_cast(unsigned short, hA); S16[(tokA + 1) * 4096 + key] = __builtin_bit_cast(unsigned short, hB); }
        };
        for (int kt = wave; kt < nkt; ) {
            tile(kt, bfr, bnx); kt += NWAVES; if (kt >= nkt) break;
            tile(kt, bn1, bfr); kt += NWAVES; if (kt >= nkt) break;
            tile(kt, bnx, bn1); kt += NWAVES;
        }
        }
        LDS_WAIT(); __syncthreads();
        { const int nvalid = nkt * 32; const int nj = (nvalid + 63) >> 6;
#pragma unroll
          for (int s2 = 0; s2 < 2; ++s2) {
              const int t = t0 + 2 * wave + s2; LAS unsigned short* srow = S16 + (2 * wave + s2) * 4096;
              int nvalid_ = nvalid; asm volatile("" : "+s"(nvalid_));
              unsigned u[64];
#pragma unroll
              for (int j = 0; j < 64; ++j) { const int idx = j * 64 + l; const unsigned h0 = srow[idx];
                  const unsigned k0 = (h0 & 0x8000u) ? (~h0 & 0xffffu) : (h0 | 0x8000u);
                  u[j] = (idx < nvalid_) ? k0 : 0u; }
              LDS_WAIT(); asm volatile("" ::: "memory");
              select_top256_radix(u, nj, l, selst, (LAS unsigned*)srow);
              if (MK_IDX_REP & 2) select_top256_radix(u, nj, l, selst, (LAS unsigned*)srow);
#if MK_CHECK_SEL
              { LAS unsigned* bm = (LAS unsigned*)srow + 512;
                for (int w2 = l; w2 < 128; w2 += 64) bm[w2] = 0u;
                LDS_WAIT(); asm volatile("" ::: "memory");
                unsigned short mine[4];
#pragma unroll
                for (int i2 = 0; i2 < 4; ++i2) { mine[i2] = selst[4 * l + i2]; atomicOr((unsigned*)(bm + (mine[i2] >> 5)), 1u << (mine[i2] & 31)); }
                LDS_WAIT(); asm volatile("" ::: "memory");
                unsigned u32k[64];
#pragma unroll
                for (int j = 0; j < 64; ++j) u32k[j] = u[j] << 16;
                select_ref(u32k, l, selst);
                int bad = 0;
#pragma unroll
                for (int i2 = 0; i2 < 4; ++i2) { const unsigned short r2 = selst[4 * l + i2]; bad += ((bm[r2 >> 5] >> (r2 & 31)) & 1u) ? 0 : 1; }
                int nset = 0; for (int w2 = l; w2 < 128; w2 += 64) nset += __builtin_popcount(bm[w2]);
                bad = wave_total_i(bad) + (wave_total_i(nset) != TOPK ? 1 : 0);
                if (bad && l == 0) __hip_atomic_store(F.ctl + CW_TMO, 0xBAD5E1u, __ATOMIC_RELAXED, __HIP_MEMORY_SCOPE_AGENT);
#pragma unroll
                for (int i2 = 0; i2 < 4; ++i2) selst[4 * l + i2] = mine[i2];
                LDS_WAIT(); asm volatile("" ::: "memory"); }
#endif
              int t2_ = threadIdx.x; asm volatile("" : "+v"(t2_)); const int l2 = t2_ & 63;
              const size_t row = rowb + t; unsigned short s4[4]; unsigned bk = 0;
#pragma unroll
              for (int i2 = 0; i2 < 4; ++i2) { s4[i2] = selst[4 * l2 + i2]; bk |= (unsigned)t5_bucket(t - (int)s4[i2]) << (8 * i2); }
              u32x2 o; o.x = (unsigned)s4[0] | ((unsigned)s4[1] << 16); o.y = (unsigned)s4[2] | ((unsigned)s4[3] << 16);
              *(GAS u32x2*)(SEL + row * 256 + 4 * l2) = o; *(GAS unsigned*)(BKT + row * 256 + 4 * l2) = bk;
              LDS_WAIT(); asm volatile("" ::: "memory"); } }
        LDS_WAIT(); __syncthreads();
    }
}

typedef short v4i16_t __attribute__((ext_vector_type(4)));
__device__ __forceinline__ void p_sparse_attn(Frame& F, const float* rel_table) {
    PHASE_IDS();
    const bf16* QLAT = (const bf16*)(F.ws + WS_QLAT); const unsigned char* CKV8 = (const unsigned char*)(F.ws + WS_CKV); unsigned char* OLAT = (unsigned char*)(F.ws + WS_OLAT);
    const unsigned short* SEL = (const unsigned short*)(F.ws + WS_SEL); const unsigned char* BKT = (const unsigned char*)(F.ws + WS_BKT);
    LAS unsigned char* cb = F.lds + wave * 16384;
    LAS unsigned char* sb = F.lds + 131072 + wave * 1536;
    LAS float* relt = (LAS float*)(F.lds + 131072 + 8 * 1536);
    for (int i = tid; i < 33 * 16; i += NWAVES * 64) relt[i] = (i < 512) ? rel_table[i] * LOG2E : -INFINITY;
    LDS_WAIT(); __syncthreads();
    if (tid < 16) { float m = relt[tid]; for (int b = 1; b < 32; ++b) m = fmaxf(m, relt[b * 16 + tid]); relt[33 * 16 + tid] = m; }
    LDS_WAIT(); __syncthreads();
    const int l = lane, l15 = l & 15, g = l >> 4;
    const float cmax = __uint_as_float(__hip_atomic_load(F.ctl + CW_CMAX, __ATOMIC_RELAXED, __HIP_MEMORY_SCOPE_AGENT)) * 1.15f;
    const float bmaxh = relt[33 * 16 + l15];
    const int gw = F.vcu * NWAVES + wave, NGW = F.G * NWAVES;
    const int ntok = (M - gw + NGW - 1) / NGW;
#define SA_PARK_BKT(base_, bv_) do { _Pragma("unroll") for (int i_ = 0; i_ < 4; ++i_) { const int s_ = 4 * l + i_, sl_ = s_ & 31; (base_)[(s_ & ~31) + 4 * (sl_ & 7) + (sl_ >> 3)] = (unsigned char)((bv_) >> (8 * i_)); } } while (0)
#define SA_ROW(i_) ((NGW == 2048) ? ((size_t)(gw >> 8) * T + (size_t)((gw & 255) + 256 * (i_))) : (size_t)(gw + NGW * (i_)))
    if (ntok > 0) { const size_t row = SA_ROW(0); const u32x2 sv = *(const GAS u32x2*)(SEL + row * 256 + 4 * l); const unsigned bv = *(const GAS unsigned*)(BKT + row * 256 + 4 * l);
        *(LAS u32x2*)(sb + 8 * l) = sv; SA_PARK_BKT(sb + 512, bv); }
    LDS_WAIT();
    for (int it = 0; it < ntok; ++it) {
        const size_t row = SA_ROW(it); const size_t rowb = row & ~(size_t)(T - 1);
        LAS unsigned short* selw = (LAS unsigned short*)(sb + (it & 1) * 768); LAS unsigned char* bktw = sb + (it & 1) * 768 + 512;
        u32x2 svn = {0u, 0u}; unsigned bvn = 0u;
        if (it + 1 < ntok) { const size_t rown = SA_ROW(it + 1); svn = *(const GAS u32x2*)(SEL + rown * 256 + 4 * l); bvn = *(const GAS unsigned*)(BKT + rown * 256 + 4 * l); }
        pg8::i32x8 q8; float qq = 0.f;
        { bf16x8 bq[4];
#pragma unroll
          for (int i = 0; i < 4; ++i) bq[i] = __builtin_nontemporal_load((const bf16x8*)(QLAT + row * 2048 + l15 * 128 + g * 32 + i * 8));
#pragma unroll
          for (int i = 0; i < 4; ++i) { float x[8];
#pragma unroll
              for (int e2 = 0; e2 < 8; ++e2) { x[e2] = __uint_as_float((unsigned)(unsigned short)bq[i][e2] << 16); qq += x[e2] * x[e2]; }
              int w0 = __builtin_amdgcn_cvt_pk_fp8_f32(x[0], x[1], 0, false); w0 = __builtin_amdgcn_cvt_pk_fp8_f32(x[2], x[3], w0, true);
              int w1 = __builtin_amdgcn_cvt_pk_fp8_f32(x[4], x[5], 0, false); w1 = __builtin_amdgcn_cvt_pk_fp8_f32(x[6], x[7], w1, true);
              q8[2 * i] = w0; q8[2 * i + 1] = w1; } }
        qq += __shfl_xor(qq, 16); qq += __shfl_xor(qq, 32);
        const float mh = sqrtf(qq) * cmax + bmaxh;
        const float nmh = -mh; f32x4 lsum = (f32x4){0.f, 0.f, 0.f, 0.f}; f32x4 o[8];
#pragma unroll
        for (int mt = 0; mt < 8; ++mt) o[mt] = (f32x4){0.f, 0.f, 0.f, 0.f};
#define SA_SW(r_) ((((r_) >> 1) & 3) | (((((r_) >> 2) ^ ((r_) >> 4)) & 1) << 2))
#define SA_DMA(c_) do { _Pragma("unroll") for (int q = 0; q < 4; ++q) { const int r_ = 8 * q + (l >> 3); unsigned idx = selw[32 * (c_) + 8 * (r_ & 3) + (r_ >> 2)]; idx = (idx == 0xFFFFu) ? 0u : idx; \
            const unsigned char* src = CKV8 + (rowb + idx) * 128 + (((l & 7) ^ SA_SW(r_)) * 16); \
            __builtin_amdgcn_global_load_lds((const GAS unsigned*)src, (LAS unsigned*)(cb + ((c_) & 3) * 4096 + q * 1024), 16, 0, 0); } } while (0)
        SA_DMA(0); SA_DMA(1);
        unsigned f8one = 0x7f7f7f7fu; asm volatile("" : "+v"(f8one));
        const bf16x8 ones8 = (bf16x8){0x3F80, 0x3F80, 0x3F80, 0x3F80, 0x3F80, 0x3F80, 0x3F80, 0x3F80};
        const int pvr = (l15 >> 1) < 4 ? 4 * g + (l15 >> 1) : 16 + 4 * g + ((l15 >> 1) - 4); const int pvoff = pvr * 128 + (l15 & 1) * 8, pvsw = SA_SW(pvr);
#pragma unroll
        for (int c = 0; c < 8; c += 2) {
            if (c + 2 < 8) { SA_DMA(c + 2); SA_DMA(c + 3); asm volatile("s_waitcnt vmcnt(8)" ::: "memory"); } else { asm volatile("s_waitcnt vmcnt(0)" ::: "memory"); }
            pg8::i32x8 a8[4]; float bias[4][4]; u32x2 vt[16]; unsigned bk[4];
#pragma unroll
            for (int h2 = 0; h2 < 2; ++h2) { LAS unsigned char* cbc = cb + ((c + h2) & 3) * 4096;
                bk[2 * h2] = *(const LAS unsigned*)(bktw + (c + h2) * 32 + 4 * g); bk[2 * h2 + 1] = *(const LAS unsigned*)(bktw + (c + h2) * 32 + 16 + 4 * g);
#pragma unroll
                for (int tt = 0; tt < 2; ++tt) { const int R = 16 * tt + l15; const v4u lo = *(const LAS v4u*)(cbc + R * 128 + (((2 * g) ^ SA_SW(R)) * 16)), hi = *(const LAS v4u*)(cbc + R * 128 + (((2 * g + 1) ^ SA_SW(R)) * 16));
                    a8[2 * h2 + tt] = (pg8::i32x8){(int)lo.x, (int)lo.y, (int)lo.z, (int)lo.w, (int)hi.x, (int)hi.y, (int)hi.z, (int)hi.w}; }
#pragma unroll
                for (int mt = 0; mt < 8; ++mt) { typedef int v2i_t __attribute__((ext_vector_type(2)));
                    const v2i_t t8 = __builtin_amdgcn_ds_read_tr8_b64_v2i32((LAS v2i_t*)(cbc + pvoff + ((mt ^ pvsw) * 16))); vt[8 * h2 + mt] = (u32x2){(unsigned)t8.x, (unsigned)t8.y}; } }
#pragma unroll
            for (int q = 0; q < 4; ++q)
#pragma unroll
                for (int r = 0; r < 4; ++r) bias[q][r] = relt[((bk[q] >> (8 * r)) & 0xffu) * 16 + l15];
            __builtin_amdgcn_sched_barrier(0);
            f32x4 s0 = (f32x4){nmh, nmh, nmh, nmh}, s1 = s0, s2 = s0, s3 = s0;
            asm volatile("v_mfma_scale_f32_16x16x128_f8f6f4 %0, %4, %8, %0, %9, %9 op_sel_hi:[0,0,0]\n\tv_mfma_scale_f32_16x16x128_f8f6f4 %1, %5, %8, %1, %9, %9 op_sel_hi:[0,0,0]\n\t"
                         "v_mfma_scale_f32_16x16x128_f8f6f4 %2, %6, %8, %2, %9, %9 op_sel_hi:[0,0,0]\n\tv_mfma_scale_f32_16x16x128_f8f6f4 %3, %7, %8, %3, %9, %9 op_sel_hi:[0,0,0]\n\ts_nop 15\n\ts_nop 3"
                         : "+v"(s0), "+v"(s1), "+v"(s2), "+v"(s3) : "v"(a8[0]), "v"(a8[1]), "v"(a8[2]), "v"(a8[3]), "v"(q8), "v"(f8one));
#pragma unroll
            for (int r = 0; r < 4; ++r) { s0[r] = __builtin_amdgcn_exp2f(s0[r] + bias[0][r]); s1[r] = __builtin_amdgcn_exp2f(s1[r] + bias[1][r]); s2[r] = __builtin_amdgcn_exp2f(s2[r] + bias[2][r]); s3[r] = __builtin_amdgcn_exp2f(s3[r] + bias[3][r]); }
            u32x4 pw0, pw1; pw0.x = cvtpk(s0[0], s0[1]); pw0.y = cvtpk(s0[2], s0[3]); pw0.z = cvtpk(s1[0], s1[1]); pw0.w = cvtpk(s1[2], s1[3]);
            pw1.x = cvtpk(s2[0], s2[1]); pw1.y = cvtpk(s2[2], s2[3]); pw1.z = cvtpk(s3[0], s3[1]); pw1.w = cvtpk(s3[2], s3[3]);
#pragma unroll
            for (int h2 = 0; h2 < 2; ++h2) { const bf16x8 pb = __builtin_bit_cast(bf16x8, h2 ? pw1 : pw0);
                lsum = __builtin_amdgcn_mfma_f32_16x16x32_bf16(ones8, pb, lsum, 0, 0, 0);
#pragma unroll
                for (int mt = 0; mt < 8; ++mt) { typedef __bf16 bf2_t __attribute__((ext_vector_type(2))); const u32x2 v = vt[8 * h2 + mt];
                    u32x4 aw; aw.x = __builtin_bit_cast(unsigned, (bf2_t)__builtin_amdgcn_cvt_scalef32_pk_bf16_fp8(v.x, 1.0f, false)); aw.y = __builtin_bit_cast(unsigned, (bf2_t)__builtin_amdgcn_cvt_scalef32_pk_bf16_fp8(v.x, 1.0f, true));
                    aw.z = __builtin_bit_cast(unsigned, (bf2_t)__builtin_amdgcn_cvt_scalef32_pk_bf16_fp8(v.y, 1.0f, false)); aw.w = __builtin_bit_cast(unsigned, (bf2_t)__builtin_amdgcn_cvt_scalef32_pk_bf16_fp8(v.y, 1.0f, true));
                    o[mt] = __builtin_amdgcn_mfma_f32_16x16x32_bf16(__builtin_bit_cast(bf16x8, aw), pb, o[mt], 0, 0, 0); } }
            LDS_WAIT();
        }
#undef SA_DMA
#undef SA_SW
        const float inv = F8_OLS / lsum[0];
#pragma unroll
        for (int mt = 0; mt < 8; ++mt) __builtin_nontemporal_store(pg8::cvt4_fp8(o[mt][0] * inv, o[mt][1] * inv, o[mt][2] * inv, o[mt][3] * inv), (unsigned*)(OLAT + row * 2048 + l15 * 128 + 16 * mt + 4 * g));
        { LAS unsigned char* sn = sb + ((it + 1) & 1) * 768; *(LAS u32x2*)(sn + 8 * l) = svn; SA_PARK_BKT(sn + 512, bvn); }
        LDS_WAIT();
    }
#undef SA_ROW
#undef SA_PARK_BKT
    LDS_WAIT(); __syncthreads();
}

typedef float f32x4v __attribute__((ext_vector_type(4)));
__device__ __forceinline__ void p_ln_router(Frame& F, const float* xbase, const bool base16  , const float* lg, const float* lb, const float* w_router, const float* b_router, int layer) {
    PHASE_IDS();
    const bf16* HB = (const bf16*)(F.ws + WS_Y); bf16* XF = (bf16*)(F.ws + WS_XF); unsigned char* XB8 = (unsigned char*)(F.ws + WS_XB8);
    int* TOPE = (int*)(F.ws + WS_TOPE); float* TOPG = (float*)(F.ws + WS_TOPG); int* POS = (int*)(F.ws + WS_POS); unsigned short* TOKE = (unsigned short*)(F.ws + WS_TOKE);
    gu32* gcnt = F.ctl + CW_CNT + 64 * layer;
    LAS float* lgt = (LAS float*)F.lds;
    LAS int* hist = (LAS int*)(F.lds + 128 * 33 * 4);
    LAS int* base = hist + 32;
    const int l = lane, l15 = l & 15, g = l >> 4;
    f32x4 gv[4], bv[4];
#pragma unroll
    for (int j = 0; j < 4; ++j) { gv[j] = *(const f32x4*)(lg + 4 * l + 256 * j); bv[j] = *(const f32x4*)(lb + 4 * l + 256 * j); }
    for (int unit = F.vcu; unit < M / 128; unit += F.G) {
        const int r0 = unit * 128 + wave * 16;
        if (tid < 32) hist[tid] = 0;
        u32x4 vn[4]; u32x2 hn[4];
#define LNR_LOAD(row_) do { const GAS u32x2* hp = (const GAS u32x2*)(HB + (size_t)(row_) * D) + l; \
            if (base16) { const GAS u32x2* yp = (const GAS u32x2*)((const bf16*)xbase + (size_t)(row_) * D) + l; _Pragma("unroll") for (int j = 0; j < 4; ++j) { const u32x2 t2 = yp[64 * j]; vn[j] = (u32x4){t2.x, t2.y, 0u, 0u}; hn[j] = hp[64 * j]; } } \
            else { const GAS u32x4* yp = (const GAS u32x4*)(xbase + (size_t)(row_) * D) + l; _Pragma("unroll") for (int j = 0; j < 4; ++j) { vn[j] = yp[64 * j]; hn[j] = hp[64 * j]; } } } while (0)
        LNR_LOAD(r0);
        for (int i = 0; i < 16; ++i) { const size_t row = (size_t)(r0 + i);
            f32x4 v[4]; float s = 0.f;
#pragma unroll
            for (int j = 0; j < 4; ++j) { const u32x2 w = hn[j]; const u32x4 bb = vn[j]; f32x4 xb;
                if (base16) xb = (f32x4){__uint_as_float(bb.x << 16), __uint_as_float(bb.x & 0xffff0000u), __uint_as_float(bb.y << 16), __uint_as_float(bb.y & 0xffff0000u)};
                else xb = (f32x4){__uint_as_float(bb.x), __uint_as_float(bb.y), __uint_as_float(bb.z), __uint_as_float(bb.w)};
                v[j].x = xb.x * DN_ALPHA + __uint_as_float(w.x << 16); v[j].y = xb.y * DN_ALPHA + __uint_as_float(w.x & 0xffff0000u);
                v[j].z = xb.z * DN_ALPHA + __uint_as_float(w.y << 16); v[j].w = xb.w * DN_ALPHA + __uint_as_float(w.y & 0xffff0000u);
                s += (v[j].x + v[j].y) + (v[j].z + v[j].w); }
            if (i < 15) { LNR_LOAD(row + 1); }
            const float mean = wave_sum(s) * (1.f / D); float s2 = 0.f;
#pragma unroll
            for (int j = 0; j < 4; ++j) { v[j] = v[j] - mean; s2 += (v[j].x * v[j].x + v[j].y * v[j].y) + (v[j].z * v[j].z + v[j].w * v[j].w); }
            const float rstd = 1.f / sqrtf(wave_sum(s2) * (1.f / D) + LN_EPS);
            GAS u32x2* xo = (GAS u32x2*)(XF + row * D) + l; GAS unsigned* bo = (GAS unsigned*)(XB8 + row * D) + l;
#pragma unroll
            for (int j = 0; j < 4; ++j) { const f32x4 o = v[j] * rstd * gv[j] + bv[j]; u32x2 ow; ow.x = cvtpk(o.x, o.y); ow.y = cvtpk(o.z, o.w); xo[64 * j] = ow; bo[64 * j] = pg8::cvt4_fp8(o.x * F8_XS, o.y * F8_XS, o.z * F8_XS, o.w * F8_XS); } }
#undef LNR_LOAD
        asm volatile("s_waitcnt vmcnt(0)" ::: "memory");
        f32x4 acc0 = (f32x4){0.f, 0.f, 0.f, 0.f}, acc1 = acc0;
        { const bf16* xr = XF + (size_t)(r0 + l15) * D + 4 * g;
#pragma unroll 1
          for (int k0 = 0; k0 < D; k0 += 64) {
              f32x4 a[4]; float w0[4][4], w1[4][4];
#pragma unroll
              for (int q = 0; q < 4; ++q) { const u32x2 ab = __builtin_nontemporal_load((const u32x2*)(xr + k0 + 16 * q));
                  a[q] = (f32x4){__uint_as_float(ab.x << 16), __uint_as_float(ab.x & 0xffff0000u), __uint_as_float(ab.y << 16), __uint_as_float(ab.y & 0xffff0000u)}; const float* wp = w_router + (size_t)(k0 + 16 * q + 4 * g) * NEXP + l15;
#pragma unroll
                  for (int j = 0; j < 4; ++j) { w0[q][j] = wp[j * NEXP]; w1[q][j] = wp[j * NEXP + 16]; } }
#pragma unroll
              for (int q = 0; q < 4; ++q)
#pragma unroll
                  for (int j = 0; j < 4; ++j) { acc0 = __builtin_amdgcn_mfma_f32_16x16x4f32(a[q][j], w0[q][j], acc0, 0, 0, 0); acc1 = __builtin_amdgcn_mfma_f32_16x16x4f32(a[q][j], w1[q][j], acc1, 0, 0, 0); } } }
        { const float b0 = b_router[l15], b1 = b_router[l15 + 16];
#pragma unroll
          for (int r = 0; r < 4; ++r) { lgt[(wave * 16 + 4 * g + r) * 33 + l15] = acc0[r] + b0; lgt[(wave * 16 + 4 * g + r) * 33 + l15 + 16] = acc1[r] + b1; } }
        LDS_WAIT(); __syncthreads();
        int te[4] = {0, 0, 0, 0}, lp[4] = {0, 0, 0, 0}; float tg[4] = {0.f, 0.f, 0.f, 0.f};
        if (l < 16) { const LAS float* rp = lgt + (wave * 16 + l) * 33; float tv[4] = {-INFINITY, -INFINITY, -INFINITY, -INFINITY};
            for (int e = 0; e < NEXP; ++e) { const float v = rp[e];
                if (v > tv[3]) { if (v > tv[0]) { tv[3] = tv[2]; te[3] = te[2]; tv[2] = tv[1]; te[2] = te[1]; tv[1] = tv[0]; te[1] = te[0]; tv[0] = v; te[0] = e; }
                    else if (v > tv[1]) { tv[3] = tv[2]; te[3] = te[2]; tv[2] = tv[1]; te[2] = te[1]; tv[1] = v; te[1] = e; }
                    else if (v > tv[2]) { tv[3] = tv[2]; te[3] = te[2]; tv[2] = v; te[2] = e; }
                    else { tv[3] = v; te[3] = e; } } }
            const float e1 = __expf(tv[1] - tv[0]), e2 = __expf(tv[2] - tv[0]), e3 = __expf(tv[3] - tv[0]); const float inv = 1.0f / (1.0f + e1 + e2 + e3);
            tg[0] = inv; tg[1] = e1 * inv; tg[2] = e2 * inv; tg[3] = e3 * inv;
#pragma unroll
            for (int k = 0; k < 4; ++k) lp[k] = atomicAdd((int*)(hist + te[k]), 1); }
        LDS_WAIT(); __syncthreads();
        if (tid < 32) base[tid] = (int)__hip_atomic_fetch_add(gcnt + tid, (unsigned)hist[tid], __ATOMIC_RELAXED, __HIP_MEMORY_SCOPE_AGENT);
        LDS_WAIT(); __syncthreads();
        if (l < 16) { const size_t row = (size_t)(r0 + l);
            typedef int i32x4 __attribute__((ext_vector_type(4)));
            *(GAS i32x4*)(TOPE + row * 4) = (i32x4){te[0], te[1], te[2], te[3]};
            *(GAS f32x4*)(TOPG + row * 4) = (f32x4){tg[0], tg[1], tg[2], tg[3]};
            const int p0 = base[te[0]] + lp[0], p1 = base[te[1]] + lp[1], p2 = base[te[2]] + lp[2], p3 = base[te[3]] + lp[3];
            *(GAS i32x4*)(POS + row * 4) = (i32x4){p0, p1, p2, p3};
            TOKE[(size_t)te[0] * 32768 + p0] = (unsigned short)row; TOKE[(size_t)te[1] * 32768 + p1] = (unsigned short)row; TOKE[(size_t)te[2] * 32768 + p2] = (unsigned short)row; TOKE[(size_t)te[3] * 32768 + p3] = (unsigned short)row; }
        LDS_WAIT(); __syncthreads();
    }
}

__device__ __forceinline__ int moe_tables(Frame& F, int layer, LAS int* tab) {
    gu32* gcnt = F.ctl + CW_CNT + 64 * layer;
    if (threadIdx.x < NEXP) tab[64 + threadIdx.x] = (int)__hip_atomic_load(gcnt + threadIdx.x, __ATOMIC_RELAXED, __HIP_MEMORY_SCOPE_AGENT);
    LDS_WAIT(); __syncthreads();
    if (threadIdx.x == 0) { int acc = 0; for (int e = 0; e < NEXP; ++e) { tab[e] = acc; acc += (tab[64 + e] + 255) >> 8; } tab[NEXP] = acc; }
    LDS_WAIT(); __syncthreads();
    const int nT = tab[NEXP];
    for (int pm = threadIdx.x; pm < nT; pm += NWAVES * 64) { int e = 0; for (int k = 1; k < NEXP; ++k) e += (tab[k] <= pm) ? 1 : 0;
        tab[128 + pm] = e; }
    LDS_WAIT(); __syncthreads();
    return nT;
}

__device__ __forceinline__ void p_moe_combine_ln(Frame& F, const float* lg, const float* lb, float* out_final, int layer) {
    PHASE_IDS();
    LAS int* tab = (LAS int*)F.lds; (void)moe_tables(F, layer, tab);
    bf16* XF = (bf16*)(F.ws + WS_XF); unsigned char* XB8 = (unsigned char*)(F.ws + WS_XB8); const unsigned char* Y2 = (const unsigned char*)(F.ws + WS_XG);
    const int* TOPE = (const int*)(F.ws + WS_TOPE); const int* POS = (const int*)(F.ws + WS_POS); const float* TOPG = (const float*)(F.ws + WS_TOPG);
    const int l = lane; const int gw = F.vcu * NWAVES + wave, NGW = F.G * NWAVES;
    f32x4 gv[4], bv[4];
#pragma unroll
    for (int j = 0; j < 4; ++j) { gv[j] = *(const f32x4*)(lg + 4 * l + 256 * j); bv[j] = *(const f32x4*)(lb + 4 * l + 256 * j); }
    for (int row = gw; row < M; row += NGW) {
        typedef int i32x4 __attribute__((ext_vector_type(4)));
        const i32x4 e4 = *(const GAS i32x4*)(TOPE + (size_t)row * 4), p4 = *(const GAS i32x4*)(POS + (size_t)row * 4); const f32x4 gt = *(const GAS f32x4*)(TOPG + (size_t)row * 4);
        i32x4 sl; sl[0] = 256 * tab[e4[0]] + p4[0]; sl[1] = 256 * tab[e4[1]] + p4[1]; sl[2] = 256 * tab[e4[2]] + p4[2]; sl[3] = 256 * tab[e4[3]] + p4[3];
        GAS u32x2* xp = (GAS u32x2*)(XF + (size_t)row * D) + l; f32x4 v[4];
#pragma unroll
        for (int j = 0; j < 4; ++j) { const u32x2 xb = xp[64 * j]; v[j] = (f32x4){__uint_as_float(xb.x << 16), __uint_as_float(xb.x & 0xffff0000u), __uint_as_float(xb.y << 16), __uint_as_float(xb.y & 0xffff0000u)} * DN_ALPHA; }
#pragma unroll
        for (int k = 0; k < 4; ++k) { const GAS int* yp = (const GAS int*)(Y2 + (size_t)sl[k] * D) + l; const float gk = gt[k] * (1.0f / F8_YS);
#pragma unroll
            for (int j = 0; j < 4; ++j) { const int w = yp[64 * j];
                v[j].x += gk * __builtin_amdgcn_cvt_f32_fp8(w, 0); v[j].y += gk * __builtin_amdgcn_cvt_f32_fp8(w, 1); v[j].z += gk * __builtin_amdgcn_cvt_f32_fp8(w, 2); v[j].w += gk * __builtin_amdgcn_cvt_f32_fp8(w, 3); } }
        float s = 0.f;
#pragma unroll
        for (int j = 0; j < 4; ++j) s += (v[j].x + v[j].y) + (v[j].z + v[j].w);
        const float mean = wave_sum(s) * (1.f / D); float s2 = 0.f;
#pragma unroll
        for (int j = 0; j < 4; ++j) { v[j] = v[j] - mean; s2 += (v[j].x * v[j].x + v[j].y * v[j].y) + (v[j].z * v[j].z + v[j].w * v[j].w); }
        const float rstd = 1.f / sqrtf(wave_sum(s2) * (1.f / D) + LN_EPS);
        if (out_final) { GAS f32x4* op = (GAS f32x4*)(out_final + (size_t)row * D) + l;
            const float poison = (__hip_atomic_load(F.ctl + CW_TMO, __ATOMIC_RELAXED, __HIP_MEMORY_SCOPE_AGENT) != 0u) ? __builtin_nanf("") : 0.f;
#pragma unroll
            for (int j = 0; j < 4; ++j) op[64 * j] = v[j] * rstd * gv[j] + bv[j] + poison; }
        else { GAS unsigned* bo = (GAS unsigned*)(XB8 + (size_t)row * D) + l;
#pragma unroll
            for (int j = 0; j < 4; ++j) { const f32x4 o = v[j] * rstd * gv[j] + bv[j]; u32x2 ow; ow.x = cvtpk(o.x, o.y); ow.y = cvtpk(o.z, o.w); xp[64 * j] = ow; bo[64 * j] = pg8::cvt4_fp8(o.x * F8_XS, o.y * F8_XS, o.z * F8_XS, o.w * F8_XS); } }
    }
}

__device__ __forceinline__ void p_fox_gate(Frame& F, const float* w_f, const float* b_f) {
    PHASE_IDS();
    const bf16* XF = (const bf16*)(F.ws + WS_XF); float* LOGF = (float*)(F.ws + WS_LOGF);
    const int l = lane, l15 = l & 15, g = l >> 4; const int gw = F.vcu * NWAVES + wave, NGW = F.G * NWAVES;
    const float bf = b_f[l15];
    for (int tile = gw; tile < M / 16; tile += NGW) {
        f32x4 acc = (f32x4){0.f, 0.f, 0.f, 0.f}; const bf16* xr = XF + (size_t)(tile * 16 + l15) * D + 4 * g;
#pragma unroll 1
        for (int k0 = 0; k0 < D; k0 += 64) {
            f32x4 a[4]; float w[4][4];
#pragma unroll
            for (int q = 0; q < 4; ++q) { const u32x2 ab = *(const GAS u32x2*)(xr + k0 + 16 * q);
                a[q] = (f32x4){__uint_as_float(ab.x << 16), __uint_as_float(ab.x & 0xffff0000u), __uint_as_float(ab.y << 16), __uint_as_float(ab.y & 0xffff0000u)}; const float* wp = w_f + (size_t)(k0 + 16 * q + 4 * g) * 16 + l15;
#pragma unroll
                for (int j = 0; j < 4; ++j) w[q][j] = wp[j * 16]; }
#pragma unroll
            for (int q = 0; q < 4; ++q)
#pragma unroll
                for (int j = 0; j < 4; ++j) acc = __builtin_amdgcn_mfma_f32_16x16x4f32(a[q][j], w[q][j], acc, 0, 0, 0); }
#pragma unroll
        for (int r = 0; r < 4; ++r) { const float z = acc[r] + bf; const float ls = fminf(z, 0.f) - log1pf(__expf(-fabsf(z)));
            LOGF[(size_t)(tile * 16 + 4 * g + r) * 16 + l15] = ls; }
    }
}
__device__ __forceinline__ void split3(float f, unsigned short& h, unsigned short& m, unsigned short& lo) {
    const unsigned p1 = f2bf(f); const float f1 = __uint_as_float(p1 << 16); const float r1 = f - f1;
    const unsigned p2 = f2bf(r1); const float f2 = __uint_as_float(p2 << 16); const float r2 = r1 - f2;
    h = (unsigned short)p1; m = (unsigned short)p2; lo = (unsigned short)f2bf(r2);
}
__device__ __forceinline__ void p_fox_cum(Frame& F) {
    PHASE_IDS();
    const float* LOGF = (const float*)(F.ws + WS_LOGF); bf16* QX = (bf16*)(F.ws + WS_QX); bf16* KX = (bf16*)(F.ws + WS_KX);
    const bf16* Q = (const bf16*)(F.ws + WS_Q); const bf16* K = (const bf16*)(F.ws + WS_K);
    float* CUM2 = (float*)(F.ws + WS_CUM2); float* KMAX = (float*)(F.ws + WS_KMAX); float* DG = (float*)(F.ws + WS_DG);
    LAS double* red = (LAS double*)F.lds;
    LAS double* pre = red + 512;
    LAS double* tot = pre + 16;
    LAS float* kn2 = (LAS float*)(tot + 512);
    LAS float* qn2 = kn2 + 512;
    LAS float* dgm = qn2 + 512;
    const int h = tid & 15, sub = tid >> 4;
    for (int unit = F.vcu; unit < BATCH * 32; unit += F.G) {
        const int b = unit >> 5, seg = unit & 31; const size_t rowb = (size_t)b * T;
        double s = 0.0;
        { const int nprev = seg * 128; int t = sub;
          for (; t + 7 * 32 < nprev; t += 8 * 32) { float a[8];
#pragma unroll
              for (int q = 0; q < 8; ++q) a[q] = LOGF[(rowb + t + 32 * q) * 16 + h];
              s += (((double)a[0] + (double)a[1]) + ((double)a[2] + (double)a[3])) + (((double)a[4] + (double)a[5]) + ((double)a[6] + (double)a[7])); }
          for (; t < nprev; t += 32) s += (double)LOGF[(rowb + t) * 16 + h]; }
        red[sub * 16 + h] = s;
        const int t0 = seg * 128 + sub * 4; float lf[4];
#pragma unroll
        for (int i = 0; i < 4; ++i) lf[i] = LOGF[(rowb + t0 + i) * 16 + h];
        tot[sub * 16 + h] = (double)lf[0] + (double)lf[1] + (double)lf[2] + (double)lf[3];
        { float kmx = 0.f, qmx = 0.f, dmn = INFINITY;
#pragma unroll
          for (int i = 0; i < 4; ++i) { const GAS v4u* qp = (const GAS v4u*)(Q + (rowb + t0 + i) * D + h * 64); const GAS v4u* kp = (const GAS v4u*)(K + (rowb + t0 + i) * D + h * 64);
              float qq = 0.f, kk = 0.f, qk = 0.f;
#pragma unroll
              for (int c = 0; c < 8; ++c) { const v4u a = qp[c], bb = kp[c]; const unsigned aw[4] = {a.x, a.y, a.z, a.w}, bw[4] = {bb.x, bb.y, bb.z, bb.w};
#pragma unroll
                  for (int e = 0; e < 4; ++e) { const float a0 = __uint_as_float(aw[e] << 16), a1 = __uint_as_float(aw[e] & 0xffff0000u), b0 = __uint_as_float(bw[e] << 16), b1 = __uint_as_float(bw[e] & 0xffff0000u);
                      qq += a0 * a0 + a1 * a1; kk += b0 * b0 + b1 * b1; qk += a0 * b0 + a1 * b1; } }
              kmx = fmaxf(kmx, kk); qmx = fmaxf(qmx, qq); dmn = fminf(dmn, qk); DG[(rowb + t0 + i) * 16 + h] = qk; }
          kn2[sub * 16 + h] = kmx; qn2[sub * 16 + h] = qmx; dgm[sub * 16 + h] = dmn; }
        LDS_WAIT(); __syncthreads();
        if (tid < 16) { double a = 0.0; for (int j = 0; j < 32; ++j) a += red[j * 16 + tid]; pre[tid] = a; }
        if (tid >= 64 && tid < 96) { const int hh = tid & 15, tl = (tid >> 4) & 1; float m = 0.f; for (int j = 0; j < 16; ++j) m = fmaxf(m, kn2[(tl * 16 + j) * 16 + hh]);
            KMAX[(size_t)(b * 16 + hh) * 64 + seg * 2 + tl] = sqrtf(m); }
        if (tid >= 128 && tid < 144) { const int hh = tid & 15; float m = 0.f, d = INFINITY; for (int j = 0; j < 32; ++j) { m = fmaxf(m, qn2[j * 16 + hh]); d = fminf(d, dgm[j * 16 + hh]); }
            const int qi = (b * 16 + hh) * 16 + (seg >> 1);
            __hip_atomic_fetch_max(F.ctl + CW_QMAX + qi, __float_as_uint(sqrtf(m)), __ATOMIC_RELAXED, __HIP_MEMORY_SCOPE_AGENT);
            __hip_atomic_fetch_max(F.ctl + CW_MNEG + qi, fkey(-d), __ATOMIC_RELAXED, __HIP_MEMORY_SCOPE_AGENT); }
        LDS_WAIT(); __syncthreads();
        double c = pre[h]; for (int j = 0; j < sub; ++j) c += tot[j * 16 + h];
#pragma unroll
        for (int i = 0; i < 4; ++i) { c += (double)lf[i]; const float cf = (float)(c * 1.4426950408889634);
            unsigned short ch, cm, cl; split3(cf, ch, cm, cl); unsigned short nh, nm, nl; split3(-cf, nh, nm, nl);
            const size_t o = ((rowb + t0 + i) * 16 + h) * 16;
            CUM2[(rowb + t0 + i) * 16 + h] = cf;
            const unsigned one2 = 0x3F803F80u;
            v4u q0; q0.x = one2; q0.y = 0x3F80u | ((unsigned)ch << 16); q0.z = (unsigned)cm | ((unsigned)cl << 16); q0.w = 0u;
            v4u q1; q1.x = 0u; q1.y = 0u; q1.z = 0u; q1.w = 0u;
            v4u k0; k0.x = (unsigned)nh | ((unsigned)nm << 16); k0.y = (unsigned)nl | (0x3F80u << 16); k0.z = one2; k0.w = one2;
            v4u k1; k1.x = 0x3F80u; k1.y = 0u; k1.z = 0u; k1.w = 0u;
            *(GAS v4u*)(QX + o) = q0; *(GAS v4u*)(QX + o + 8) = q1; *(GAS v4u*)(KX + o) = k0; *(GAS v4u*)(KX + o + 8) = k1; }
        LDS_WAIT(); __syncthreads();
    }
}
__device__ __forceinline__ void p_fox_ts(Frame& F) {
    PHASE_IDS();
    const float* CUM2 = (const float*)(F.ws + WS_CUM2); const float* KMAX = (const float*)(F.ws + WS_KMAX); unsigned char* TS = (unsigned char*)(F.ws + WS_TS);
    const int gw = F.vcu * NWAVES + wave, NGW = F.G * NWAVES;
    for (int u = gw; u < BATCH * 16 * 16; u += NGW) { const int bh = u >> 4, qb = u & 15, b = bh >> 4, h = bh & 15; const size_t rowb = (size_t)b * T;
        const float qmax = __uint_as_float(__hip_atomic_load(F.ctl + CW_QMAX + u, __ATOMIC_RELAXED, __HIP_MEMORY_SCOPE_AGENT));
        const unsigned kk = __hip_atomic_load(F.ctl + CW_MNEG + u, __ATOMIC_RELAXED, __HIP_MEMORY_SCOPE_AGENT); const float negmlo = __uint_as_float((kk & 0x80000000u) ? (kk & 0x7fffffffu) : ~kk);
        const float cq = CUM2[(rowb + 256 * qb) * 16 + h]; const float ck = CUM2[(rowb + 64 * lane + 63) * 16 + h]; const float km = KMAX[(size_t)bh * 64 + lane];
        const float bound = (cq - ck) + qmax * km + negmlo + 1.0f;
        const bool keep = (lane >= 4 * qb) || !(bound < -36.0f);
        const unsigned long long m = __ballot(keep); int first = __builtin_ctzll(m); if (first > 4 * qb) first = 4 * qb;
        const bool risky = (lane <= 4 * qb + 3) && !(qmax * km + negmlo < 60.0f);
        const unsigned guard = __ballot(risky) != 0ull ? 1u : 0u;
        if (lane == 0) TS[u] = (unsigned char)((first & ~1) | guard); }
}

struct Args { const float* in[25]; float* out; unsigned char* ws; int ph_lo, ph_hi, li, pad; };

#define IN(k) (lo <= (k) && (k) < hi)
#define BOTH(k) (IN(k) && IN((k) + 1))
#define GRID_BAR(k) do { if (BOTH(k)) xcd_barrier(bar); } while (0)
#ifndef MK_REP_MASK
#define MK_REP_MASK 0u
#endif
#define RUN(k, ...) do { if (IN(k)) { __VA_ARGS__ if ((MK_REP_MASK >> (k)) & 1u) { __VA_ARGS__ } } } while (0)

__device__ __forceinline__ void moe_phases(Frame& F, const XcdBarrier& bar, int lo, int hi, const int layer, const int pb, const float* base, const bool base16, float* out_final) {
    const float* PAR = (const float*)(F.ws + WS_PAR);
    const float* lnm_g = PAR + PAR_LN + layer * D; const float* lnm_b = PAR + PAR_LN + 2048 + layer * D; const float* lnf_g = PAR + PAR_LN + 4096 + layer * D; const float* lnf_b = PAR + PAR_LN + 6144 + layer * D;
    LAS int* tab = (LAS int*)(F.lds + RING_BYTES);
    RUN(pb,  p_ln_router(F, base, base16, lnm_g, lnm_b, PAR + PAR_WROUT + (size_t)layer * D * NEXP, PAR + PAR_BROUT + layer * NEXP, layer); GRID_BAR(pb); );
    RUN(pb + 1,
        const int nT = moe_tables(F, layer, tab);
        pg8::Gemm g{(const pg8::bf16_t*)(F.ws + WS_XB8), (const pg8::bf16_t*)(F.ws + WS_WGU + (size_t)layer * NEXP * 2048 * 1024), nT * 256, NEXP * 2048, 512};
        pg8::MoeOrder S{nT, 8, F.G, (int)blockIdx.x, (const LAS int*)(tab + 128)};
        LAS unsigned short* tokl = (LAS unsigned short*)(F.lds + RING_BYTES + 5120);
        { const unsigned short* TOKE = (const unsigned short*)(F.ws + WS_TOKE);
          if (threadIdx.x < 256) { unsigned short tk[17]; unsigned vm = 0u, um = 0u;
              _Pragma("unroll") for (int i = 0; i < 17; ++i) { pg8::Unit uu; uu.pm = 0; uu.pn = 0; const bool ok = S.next(i, uu); const int e = tab[128 + uu.pm], idx = (uu.pm - tab[e]) * 256 + (int)threadIdx.x; const bool v = ok && idx < tab[64 + e];
                  tk[i] = TOKE[v ? (size_t)e * 32768 + idx : (size_t)0]; vm |= (v ? 1u : 0u) << i; um |= (ok ? 1u : 0u) << i; }
              _Pragma("unroll") for (int i = 0; i < 17; ++i) { if ((um >> i) & 1u) tokl[i * 256 + threadIdx.x] = ((vm >> i) & 1u) ? tk[i] : (unsigned short)0; } }
          LDS_WAIT(); __syncthreads(); }
        pg8::EpiSwiglu8 E{(unsigned char*)(F.ws + WS_H), PAR + PAR_BGU + (size_t)layer * NEXP * 2048, 1.0f / (F8_XS * F8_WGS), F8_HS};
        pg8::gemm_phase<pg8::EpiSwiglu8, pg8::MoeOrder, PG8_ALIGN, PG8_SP2, true, true>(F.lds + RING_OFF, g, S, E, tokl);
        GRID_BAR(pb + 1);
    );
    RUN(pb + 2,
        const int nT = moe_tables(F, layer, tab);
        pg8::Gemm g{(const pg8::bf16_t*)(F.ws + WS_H), (const pg8::bf16_t*)(F.ws + WS_WD + (size_t)layer * NEXP * 1024 * 1024), nT * 256, NEXP * 1024, 512};
        pg8::MoeOrder S{nT, 4, F.G, (int)blockIdx.x, (const LAS int*)(tab + 128)};
        pg8::EpiDown8 E{(unsigned char*)(F.ws + WS_XG), PAR + PAR_BDOWN + (size_t)layer * NEXP * 1024, 1.0f / (F8_HS * F8_WDS), F8_YS};
        pg8::gemm_phase<pg8::EpiDown8, pg8::MoeOrder, PG8_ALIGN, PG8_SP2, false, true>(F.lds + RING_OFF, g, S, E);
        GRID_BAR(pb + 2);
    );
    RUN(pb + 3,  p_moe_combine_ln(F, lnf_g, lnf_b, out_final, layer); if (!out_final) GRID_BAR(pb + 3); );
}

__global__ void __launch_bounds__(NWAVES * 64, 2) mk_fwd(Args args) {
    extern __shared__ __attribute__((aligned(16))) unsigned char lds[];
    Frame F;
    F.lds = (LAS unsigned char*)lds;
    F.MISC = (volatile LAS unsigned*)(F.lds + MISC_OFF);
    F.G = gridDim.x; { const int bx = blockIdx.x; F.vcu = (F.G % 8 == 0) ? (bx % 8) * (F.G / 8) + bx / 8 : bx; }
    F.ws = args.ws; F.ctl = (gu32*)(args.ws + WS_CTL);
    if (threadIdx.x < 64) ((LAS unsigned*)(F.lds + MISC_OFF))[threadIdx.x] = 0u;
    __syncthreads();
    XcdBarrier bar; bar.bar = (unsigned*)(F.ctl + CW_BAR); bar.x = 0; bar.st = nullptr;
    if (MK_N_LAUNCHES == 1) bar = xcd_barrier_post((unsigned*)(F.ctl + CW_BAR), F.MISC + 8);
    const int lo = args.ph_lo, hi = args.ph_hi;

    RUN(0,
        P0In I{args.in[0], args.in[2], args.in[7], args.in[8], args.in[9], args.in[10], args.in[11], args.in[12], args.in[14], args.in[21], args.in[23],
               args.in[1], args.in[3], args.in[4], args.in[5], args.in[6], args.in[13], args.in[15], args.in[16], args.in[17], args.in[18], args.in[19], args.in[20], args.in[22], args.in[24]};
        p0_prologue(F, I); GRID_BAR(0);
    );
#if defined(MK_XBAR) && MK_XBAR
    if (MK_N_LAUNCHES == 1) { for (int xb_i = 0; xb_i < MK_XBAR; ++xb_i) xcd_barrier(bar); }
#endif
    RUN(1,
        pg8::Gemm g{(const pg8::bf16_t*)(F.ws + WS_XB), (const pg8::bf16_t*)(F.ws + WS_WAIN), M, 512, 1024}; pg8::StaticOrder S; S.init(M, 512, F.G, (int)blockIdx.x);
        const float* PAR = (const float*)(F.ws + WS_PAR);
        pg8::EpiDsaNorm E{(pg8::bf16_t*)(F.ws + WS_CQN), (pg8::bf16_t*)(F.ws + WS_CKV), (pg8::bf16_t*)(F.ws + WS_KIDX), (float*)(F.ws + WS_WIDX), PAR + PAR_AGQ, PAR + PAR_AGKV, PAR + PAR_AGKI, PAR + PAR_ABKI,
                          (unsigned*)(F.ctl + CW_CMAX), (LAS float*)(F.lds + RING_BYTES), RMS_EPS, LN_EPS};
        pg8::gemm_phase<pg8::EpiDsaNorm, pg8::StaticOrder, true, PG8_SP2>(F.lds + RING_OFF, g, S, E);
        GRID_BAR(1);
    );
    RUN(2,
        pg8::Gemm g{(const pg8::bf16_t*)(F.ws + WS_CQN), (const pg8::bf16_t*)(F.ws + WS_WACQ), M, 2560, 256}; pg8::StaticOrder S; S.init(M, 2560, F.G, (int)blockIdx.x);
        pg8::EpiCq E{(pg8::bf16_t*)(F.ws + WS_QLAT), (pg8::bf16_t*)(F.ws + WS_QIDX)};
        pg8::gemm_phase<pg8::EpiCq, pg8::StaticOrder, PG8_ALIGN, PG8_SP2>(F.lds + RING_OFF, g, S, E);
        GRID_BAR(2);
    );
    RUN(3,  p_indexer(F); GRID_BAR(3); );
    RUN(4,  p_sparse_attn(F, (const float*)(F.ws + WS_PAR) + PAR_REL); GRID_BAR(4); );
    RUN(5,
        pg8::Gemm g{(const pg8::bf16_t*)(F.ws + WS_OLAT), (const pg8::bf16_t*)(F.ws + WS_WAO), M, 1024, 1024}; pg8::StaticOrder S; S.init(M, 1024, F.G, (int)blockIdx.x);
        pg8::EpiBf16s E{(pg8::bf16_t*)(F.ws + WS_Y), D, 1.0f / (F8_OLS * F8_WAOS)};
        pg8::gemm_phase<pg8::EpiBf16s, pg8::StaticOrder, PG8_ALIGN, PG8_SP2, false, true>(F.lds + RING_OFF, g, S, E);
        GRID_BAR(5);
    );
    moe_phases(F, bar, lo, hi, 0, 6, (const float*)(F.ws + WS_XB), true, nullptr);
    RUN(10,
        p_fox_gate(F, (const float*)(F.ws + WS_PAR) + PAR_WF, (const float*)(F.ws + WS_PAR) + PAR_BF);
        pg8::Gemm g{(const pg8::bf16_t*)(F.ws + WS_XB8), (const pg8::bf16_t*)(F.ws + WS_WBIN), M, 3072, 512}; pg8::StaticOrder S; S.init(M, 3072, F.G, (int)blockIdx.x);
        pg8::EpiQkv8 E{(pg8::bf16_t*)(F.ws + WS_Q), (size_t)(WS_K - WS_Q) / 2, 1.0f / (F8_XS * F8_WBINS), attn_body::C2};
        pg8::gemm_phase<pg8::EpiQkv8, pg8::StaticOrder, PG8_ALIGN, PG8_SP2, false, true>(F.lds + RING_OFF, g, S, E);
        GRID_BAR(10);
    );
    RUN(11,  p_fox_cum(F); GRID_BAR(11); );
    RUN(12,  p_fox_ts(F); GRID_BAR(12); );
    RUN(13,
        const attn_body::AttnTensors AT{(const attn_body::bf16*)(F.ws + WS_Q), (const attn_body::bf16*)(F.ws + WS_K), (const attn_body::bf16*)(F.ws + WS_V), (attn_body::bf16*)(F.ws + WS_O),
                                        (const attn_body::bf16*)(F.ws + WS_QX), (const attn_body::bf16*)(F.ws + WS_KX), (const float*)(F.ws + WS_DG)};
        attn_body::attn_phase<64>((char*)lds + RING_OFF, AT, (unsigned*)(F.ctl + CW_ATTQ), (const unsigned char*)(F.ws + WS_TS));
        GRID_BAR(13);
    );
    RUN(14,
        pg8::Gemm g{(const pg8::bf16_t*)(F.ws + WS_O), (const pg8::bf16_t*)(F.ws + WS_WBO), M, 1024, 512}; pg8::StaticOrder S; S.init(M, 1024, F.G, (int)blockIdx.x);
        pg8::EpiBf16s E{(pg8::bf16_t*)(F.ws + WS_Y), D, 1.0f / (F8_OS * F8_WBOS)};
        pg8::gemm_phase<pg8::EpiBf16s, pg8::StaticOrder, PG8_ALIGN, PG8_SP2, false, true>(F.lds + RING_OFF, g, S, E);
        GRID_BAR(14);
    );
    moe_phases(F, bar, lo, hi, 1, 15, (const float*)(F.ws + WS_XF), true, args.out);
}
#undef IN
#undef BOTH
#undef GRID_BAR

extern "C" void kernel_launch(void* const* d_in, const int* in_sizes, int n_in, void* d_out, int out_size, void* d_ws, size_t ws_size, hipStream_t stream) {
    static int grid = 0;
    if (grid == 0) {
        if (n_in != 25 || in_sizes[0] != M * D || out_size != M * D || ws_size < WS_END) { fprintf(stderr, "kernel_launch: unexpected shapes (n_in %d, in0 %d, out %d, ws %zu); nothing launched\n", n_in, n_in > 0 ? in_sizes[0] : -1, out_size, ws_size); grid = -1; return; }
        int dev = 0, cus = 0, per_cu = 0;
        if (hipGetDevice(&dev) != hipSuccess || hipDeviceGetAttribute(&cus, hipDeviceAttributeMultiprocessorCount, dev) != hipSuccess) { grid = -1; return; }
        if (hipFuncSetAttribute((const void*)mk_fwd, hipFuncAttributeMaxDynamicSharedMemorySize, LDS_BYTES) != hipSuccess) { fprintf(stderr, "kernel_launch: hipFuncSetAttribute failed\n"); grid = -1; return; }
        if (hipOccupancyMaxActiveBlocksPerMultiprocessor(&per_cu, (const void*)mk_fwd, NWAVES * 64, LDS_BYTES) != hipSuccess || per_cu < 1) fprintf(stderr, "kernel_launch: occupancy query reports %d workgroups per CU\n", per_cu);
        (void)hipGetLastError();
        grid = cus;
    }
    if (grid < 0) return;
    if (hipMemsetAsync((char*)d_ws + WS_CTL, 0, CTL_ZERO_BYTES, stream) != hipSuccess) return;
    Args a{};
    for (int i = 0; i < 25; ++i) a.in[i] = (const float*)d_in[i];
    a.out = (float*)d_out; a.ws = (unsigned char*)d_ws;
    constexpr int NPH = 19;
    for (int li = 0; li < MK_N_LAUNCHES; ++li) {
        if (MK_N_LAUNCHES == 1) { a.ph_lo = 0; a.ph_hi = NPH; } else { a.ph_lo = li; a.ph_hi = li + 1; }
        a.li = li;
        hipLaunchKernelGGL(mk_fwd, dim3(grid), dim3(NWAVES * 64), LDS_BYTES, stream, a);
        if (MK_N_LAUNCHES != 1 && li + 1 == NPH) break;
    }
}
```

```cpp
#define MK_N_LAUNCHES 1
#define MK_REP_MASK 0u
#define MK_P0_REP 0
#define MK_CHECK_SEL 0
#define MK_IDX_REP 0
#define MK_EPI_REP 0
#define MK_XBAR 0
#define MK_SA_EXP 0
#include <hip/hip_runtime.h>
#include <cstdio>
#include <cstdint>
namespace pg8 {
#define PG8_LAS __attribute__((address_space(3)))
typedef unsigned short bf16_t;
typedef short bf16x8 __attribute__((ext_vector_type(8)));
typedef float f32x4 __attribute__((ext_vector_type(4)));
typedef unsigned u32x4 __attribute__((ext_vector_type(4)));
typedef short bf16x16 __attribute__((ext_vector_type(16)));
typedef int i32x8 __attribute__((ext_vector_type(8)));
constexpr int BM = 256, BK = 64, HALF = 128, HTB = HALF * BK * 2  , STAGE_BYTES = 8 * HTB, NXCD = 8, WGM = 8;

__host__ __device__ __forceinline__ int lds_byte(int r, int c) { const int st = (r >> 4) * 2 + (c >> 5), rr = r & 15, cc = c & 31, ob = rr * 64 + cc * 2; return st * 1024 + (ob ^ (((ob >> 9) & 1) << 5)); }
__host__ __device__ __forceinline__ void stage_rc(int b, int& R, int& C) { const int st = b / 1024, sb = b % 1024, swz = sb ^ (((sb >> 9) & 1) << 5); R = (st >> 1) * 16 + swz / 64; C = (st & 1) * 32 + (swz % 64) / 2; }
__host__ __device__ __forceinline__ int perm32(int rho) { const int n = rho >> 4, i = rho & 15; return 8 * (i >> 2) + 4 * n + (i & 3); }

struct Unit { int pm, pn; };
struct Gemm { const bf16_t* A; const bf16_t* Bt; int M, N, K; };

struct StaticOrder {
    int nM, nN, nwg, G, c;
    __host__ __device__ void init(int M, int N, int G_, int c_) { nM = M / BM; nN = N / BM; nwg = nM * nN; G = G_; c = c_; }
    __host__ __device__ bool next(int i, Unit& u) const {
        const long L = (long)i * G + c; if (L >= nwg) return false;
        int wgid = (int)L; { const int q = nwg / NXCD, r = nwg % NXCD, xcd = wgid % NXCD, off = wgid / NXCD; wgid = (xcd < r ? xcd * (q + 1) : r * (q + 1) + (xcd - r) * q) + off; }
        const int nig = WGM * nN, gid = wgid / nig, fm = gid * WGM, gsz = (nM - fm) < WGM ? (nM - fm) : WGM;
        u.pm = fm + ((wgid % nig) % gsz); u.pn = (wgid % nig) / gsz; return true;
    }
    __device__ __forceinline__ void a_ready(const Unit&) const {}
    __device__ __forceinline__ void done(const Unit&) const {}
};

__device__ __forceinline__ unsigned cvt_pk_bf16(float lo, float hi) { unsigned r; asm volatile("v_cvt_pk_bf16_f32 %0, %1, %2" : "=v"(r) : "v"(lo), "v"(hi)); return r; }
typedef float f32x2 __attribute__((ext_vector_type(2)));
__device__ __forceinline__ f32x2 gelu_pk(f32x2 v) {
    const f32x2 av = __builtin_elementwise_abs(v), d = av * 0.2316418882f + 1.0f;
    f32x2 t; t.x = __builtin_amdgcn_rcpf(d.x); t.y = __builtin_amdgcn_rcpf(d.y);
    f32x2 q = t * 0.5307027145f + (-0.7265760135f); q = q * t + 0.7107068705f; q = q * t + (-0.142248368f); q = q * t + 0.127414796f; q = q * t;
    const f32x2 s = (v * v) * (-0.72134752044f);
    f32x2 e; e.x = __builtin_amdgcn_exp2f(s.x); e.y = __builtin_amdgcn_exp2f(s.y);
    const f32x2 m = v * (q * e), r = v - m;
    f32x2 o; o.x = v.x < 0.f ? m.x : r.x; o.y = v.y < 0.f ? m.y : r.y; return o;
}

template <int ACT  > struct EpiBf16 {
    static constexpr bool PERM = true, AFTER_DRAIN = false; static_assert(ACT == 0 || ACT == 1, "EpiBf16: ACT is 0 (none) or 1 (gelu_pk)");
    bf16_t* O; int ldc; const float* bias; int split_cols; size_t split_stride; float scale0;
    __device__ __forceinline__ void operator()(const f32x4 (&acc)[2][2][4][2], const Unit& u, int wr, int wc, int fr, int fq) const {
        const int row0 = u.pm * BM + wr * 64 + fr; int colt = u.pn * BM; bf16_t* base = O;
        float sc = 1.f; if (split_cols) { const int t = colt / split_cols; base += (size_t)t * split_stride; colt -= t * split_cols; if (t == 0) sc = scale0; }
        const int col0 = colt + wc * 32 + 8 * fq, bcol0 = u.pn * BM + wc * 32 + 8 * fq;
        f32x4 bv[2][2];
#pragma unroll
        for (int bj = 0; bj < 2; ++bj)
#pragma unroll
            for (int n = 0; n < 2; ++n) bv[bj][n] = bias ? *(const f32x4*)(bias + bcol0 + bj * HALF + 4 * n) : (f32x4){0.f, 0.f, 0.f, 0.f};
#pragma unroll
        for (int ai = 0; ai < 2; ++ai)
#pragma unroll
            for (int m = 0; m < 4; ++m) { bf16_t* rowp = base + (size_t)(row0 + ai * HALF + m * 16) * ldc + col0;
#pragma unroll
                for (int bj = 0; bj < 2; ++bj) { f32x4 v0 = acc[ai][bj][m][0] + bv[bj][0], v1 = acc[ai][bj][m][1] + bv[bj][1];
                    if (ACT == 1) { f32x2 a = gelu_pk((f32x2){v0[0], v0[1]}), b = gelu_pk((f32x2){v0[2], v0[3]}), c = gelu_pk((f32x2){v1[0], v1[1]}), d = gelu_pk((f32x2){v1[2], v1[3]});
                        v0 = (f32x4){a.x, a.y, b.x, b.y}; v1 = (f32x4){c.x, c.y, d.x, d.y}; }
                    v0 = v0 * sc; v1 = v1 * sc; u32x4 w; w.x = cvt_pk_bf16(v0[0], v0[1]); w.y = cvt_pk_bf16(v0[2], v0[3]); w.z = cvt_pk_bf16(v1[0], v1[1]); w.w = cvt_pk_bf16(v1[2], v1[3]);
                    *(u32x4*)(rowp + bj * HALF) = w; } }
    }
};

struct PanelStats {
    unsigned* xbuf;
    unsigned* cnt;
    unsigned* tmo;
    int ntn; float eps;
    unsigned code;
    __device__ __forceinline__ bool run(const f32x4 (&v)[2][2][4][2], const Unit& u, int wr, int wc, int fr, int fq, PG8_LAS unsigned char* lds, int wid, int lane) const {
        typedef float f32x2v __attribute__((ext_vector_type(2)));
        PG8_LAS f32x2v* P = (PG8_LAS f32x2v*)lds;
        PG8_LAS f32x2v* S = (PG8_LAS f32x2v*)(lds + 8192);
        PG8_LAS unsigned* flag = (PG8_LAS unsigned*)(lds + 8192 + 2048);
#pragma unroll
        for (int ai = 0; ai < 2; ++ai)
#pragma unroll
            for (int m = 0; m < 4; ++m) {
                float s = 0.f;
#pragma unroll
                for (int bj = 0; bj < 2; ++bj)
#pragma unroll
                    for (int n = 0; n < 2; ++n) { const f32x4 x = v[ai][bj][m][n]; s += (x[0] + x[1]) + (x[2] + x[3]); }
                s += __shfl_xor(s, 16); s += __shfl_xor(s, 32);
                const float mw = s * (1.0f / 64.0f); float q = 0.f;
#pragma unroll
                for (int bj = 0; bj < 2; ++bj)
#pragma unroll
                    for (int n = 0; n < 2; ++n) { const f32x4 d = v[ai][bj][m][n] - mw; q += (d[0] * d[0] + d[1] * d[1]) + (d[2] * d[2] + d[3] * d[3]); }
                q += __shfl_xor(q, 16); q += __shfl_xor(q, 32);
                if (fq == 0) P[(ai * HALF + wr * 64 + m * 16 + fr) * 4 + wc] = (f32x2v){mw, q};
            }
        asm volatile("s_waitcnt lgkmcnt(0)" ::: "memory"); __builtin_amdgcn_s_barrier(); asm volatile("" ::: "memory");
#if defined(BROKEN_EXCHANGE_NO_WAIT)
#warning BROKEN CONTROL BUILD: the row-statistics exchange does not wait; results are wrong by design
        if (blockIdx.x >= 64) { const long long t0_ = clock64(); while (clock64() - t0_ < 60000) __builtin_amdgcn_s_sleep(8); }
#endif
        const int row = wid * 32 + (lane & 31);
        if (lane < 32) {
            const f32x2v a = P[row * 4 + 0], b = P[row * 4 + 1], c = P[row * 4 + 2], d = P[row * 4 + 3];
            const float mt = (a.x + b.x + c.x + d.x) * 0.25f;
            const float da = a.x - mt, db = b.x - mt, dc = c.x - mt, dd = d.x - mt;
            const float m2 = (a.y + b.y) + (c.y + d.y) + 64.0f * ((da * da + db * db) + (dc * dc + dd * dd));
            unsigned long long* slot = (unsigned long long*)xbuf + ((size_t)(u.pm * BM + row) * 4 + u.pn);
            __hip_atomic_store(slot, ((unsigned long long)__float_as_uint(m2) << 32) | __float_as_uint(mt), __ATOMIC_RELAXED, __HIP_MEMORY_SCOPE_AGENT);
        }
        asm volatile("s_waitcnt vmcnt(0)" ::: "memory");
        if (lane == 0) __hip_atomic_fetch_add(cnt + 64 * u.pm, 1u, __ATOMIC_RELAXED, __HIP_MEMORY_SCOPE_AGENT);
        if (wid == 0) {
            bool dead = false; const unsigned long long t0 = __builtin_amdgcn_s_memrealtime(); const unsigned want = 8u * (unsigned)ntn;
            for (;;) {
#if defined(BROKEN_EXCHANGE_NO_WAIT)
                break;
#endif
                if ((unsigned)__builtin_amdgcn_readfirstlane(__hip_atomic_load(cnt + 64 * u.pm, __ATOMIC_RELAXED, __HIP_MEMORY_SCOPE_AGENT)) >= want) break;
                if (__builtin_amdgcn_s_memrealtime() - t0 > 2000000ull) {
                    if (lane == 0) { unsigned expect = 0u; __hip_atomic_compare_exchange_strong(tmo + 1, &expect, code | (unsigned)(u.pm & 0xff), __ATOMIC_RELAXED, __ATOMIC_RELAXED, __HIP_MEMORY_SCOPE_AGENT);
                                     __hip_atomic_store(tmo, 1u, __ATOMIC_RELAXED, __HIP_MEMORY_SCOPE_AGENT); }
                    dead = true; break; }
                __builtin_amdgcn_s_sleep(2);
            }
            __builtin_amdgcn_fence(__ATOMIC_ACQUIRE, "agent");
            if (lane == 0) flag[0] = dead ? 1u : 0u;
        }
        asm volatile("s_waitcnt vmcnt(0) lgkmcnt(0)" ::: "memory"); __builtin_amdgcn_s_barrier(); asm volatile("" ::: "memory");
        const bool bad = flag[0] != 0u;
        if (lane < 32) {
            const unsigned long long* slot = (const unsigned long long*)xbuf + (size_t)(u.pm * BM + row) * 4; float mt[4], m2[4]; float ms = 0.f;
#pragma unroll
            for (int t = 0; t < 4; ++t) { if (t < ntn) { const unsigned long long w = __hip_atomic_load(slot + t, __ATOMIC_RELAXED, __HIP_MEMORY_SCOPE_AGENT); mt[t] = __uint_as_float((unsigned)w); m2[t] = __uint_as_float((unsigned)(w >> 32)); } else { mt[t] = 0.f; m2[t] = 0.f; } ms += mt[t]; }
            const float mean = ms / (float)ntn; float q = 0.f;
#pragma unroll
            for (int t = 0; t < 4; ++t) if (t < ntn) { const float dm = mt[t] - mean; q += m2[t] + 256.0f * dm * dm; }
            S[row] = (f32x2v){mean, 1.0f / sqrtf(q / (256.0f * (float)ntn) + eps)};
        }
        asm volatile("s_waitcnt lgkmcnt(0)" ::: "memory"); __builtin_amdgcn_s_barrier(); asm volatile("" ::: "memory");
        return bad;
    }
};
struct EpiLnRes {
    static constexpr bool PERM = false, AFTER_DRAIN = true;
    const float* base; float* out; int ldc; const float* bias; PanelStats st; unsigned poison;
    __device__ __forceinline__ void fused(f32x4 (&acc)[2][2][4][2], const Unit& u, int wr, int wc, int fr, int fq, PG8_LAS unsigned char* lds, int wid, int lane) const {
        typedef float f32x2v __attribute__((ext_vector_type(2)));
        const PG8_LAS f32x2v* S = (const PG8_LAS f32x2v*)(lds + 8192);
        const int col0 = u.pn * BM + wc * 32 + 4 * fq;
#pragma unroll
        for (int bj = 0; bj < 2; ++bj)
#pragma unroll
            for (int n = 0; n < 2; ++n) { const f32x4 bv = bias ? *(const f32x4*)(bias + col0 + bj * HALF + n * 16) : (f32x4){0.f, 0.f, 0.f, 0.f};
#pragma unroll
                for (int ai = 0; ai < 2; ++ai)
#pragma unroll
                    for (int m = 0; m < 4; ++m) acc[ai][bj][m][n] += bv; }
        f32x4 pre[4][2][2];
#pragma unroll
        for (int m = 0; m < 4; ++m) { const size_t off = (size_t)(u.pm * BM + wr * 64 + m * 16 + fr) * ldc + col0;
#pragma unroll
            for (int bj = 0; bj < 2; ++bj)
#pragma unroll
                for (int n = 0; n < 2; ++n) pre[m][bj][n] = *(const f32x4*)(base + off + bj * HALF + n * 16); }
        const bool bad = st.run(acc, u, wr, wc, fr, fq, lds, wid, lane) || poison != 0u;
        const float qnan = __builtin_nanf("");
#pragma unroll
        for (int ai = 0; ai < 2; ++ai)
#pragma unroll
            for (int m = 0; m < 4; ++m) { const int r = ai * HALF + wr * 64 + m * 16 + fr; const f32x2v sr = S[r]; const size_t off = (size_t)(u.pm * BM + r) * ldc + col0;
#pragma unroll
                for (int bj = 0; bj < 2; ++bj)
#pragma unroll
                    for (int n = 0; n < 2; ++n) { const f32x4 bs = ai == 0 ? pre[m][bj][n] : *(const f32x4*)(base + off + bj * HALF + n * 16); f32x4 o = bs + (acc[ai][bj][m][n] - sr.x) * sr.y;
                        if (bad) o = (f32x4){qnan, qnan, qnan, qnan}; *(f32x4*)(out + off + bj * HALF + n * 16) = o; }
                if (m & 1) asm volatile("" ::: "memory"); }
    }
};
struct EpiLnResLn {
    static constexpr bool PERM = false, AFTER_DRAIN = true;
    const float* base; float* out; bf16_t* xn; int ldc; const float* bias; PanelStats st1, st2; unsigned poison;
    __device__ __forceinline__ void fused(f32x4 (&acc)[2][2][4][2], const Unit& u, int wr, int wc, int fr, int fq, PG8_LAS unsigned char* lds, int wid, int lane) const {
        typedef float f32x2v __attribute__((ext_vector_type(2))); typedef unsigned u32x2v __attribute__((ext_vector_type(2)));
        const PG8_LAS f32x2v* S = (const PG8_LAS f32x2v*)(lds + 8192);
        const int col0 = u.pn * BM + wc * 32 + 4 * fq;
#pragma unroll
        for (int bj = 0; bj < 2; ++bj)
#pragma unroll
            for (int n = 0; n < 2; ++n) { const f32x4 bv = bias ? *(const f32x4*)(bias + col0 + bj * HALF + n * 16) : (f32x4){0.f, 0.f, 0.f, 0.f};
#pragma unroll
                for (int ai = 0; ai < 2; ++ai)
#pragma unroll
                    for (int m = 0; m < 4; ++m) acc[ai][bj][m][n] += bv; }
        bool bad = st1.run(acc, u, wr, wc, fr, fq, lds, wid, lane) || poison != 0u;
        const float qnan = __builtin_nanf("");
#pragma unroll
        for (int ai = 0; ai < 2; ++ai)
#pragma unroll
            for (int m = 0; m < 4; ++m) { const int r = ai * HALF + wr * 64 + m * 16 + fr; const f32x2v sr = S[r]; const size_t off = (size_t)(u.pm * BM + r) * ldc + col0;
#pragma unroll
                for (int bj = 0; bj < 2; ++bj)
#pragma unroll
                    for (int n = 0; n < 2; ++n) { const f32x4 bs = *(const f32x4*)(base + off + bj * HALF + n * 16); acc[ai][bj][m][n] = bs + (acc[ai][bj][m][n] - sr.x) * sr.y; }
                asm volatile("" : "+v"(acc[ai][0][m][0]), "+v"(acc[ai][0][m][1]), "+v"(acc[ai][1][m][0]), "+v"(acc[ai][1][m][1]));
                if (m & 1) asm volatile("" ::: "memory"); }
        const bool bad1 = bad;
        bad = st2.run(acc, u, wr, wc, fr, fq, lds, wid, lane) || bad;
#pragma unroll
        for (int ai = 0; ai < 2; ++ai)
#pragma unroll
            for (int m = 0; m < 4; ++m) { const int r = ai * HALF + wr * 64 + m * 16 + fr; const f32x2v sr = S[r]; const size_t off = (size_t)(u.pm * BM + r) * ldc + col0;
#pragma unroll
                for (int bj = 0; bj < 2; ++bj)
#pragma unroll
                    for (int n = 0; n < 2; ++n) { const f32x4 x1 = acc[ai][bj][m][n]; *(f32x4*)(out + off + bj * HALF + n * 16) = bad1 ? (f32x4){qnan, qnan, qnan, qnan} : x1;
                        const f32x4 o = (x1 - sr.x) * sr.y; u32x2v w; w.x = cvt_pk_bf16(o[0], o[1]); w.y = cvt_pk_bf16(o[2], o[3]);
                        if (bad) { w.x = 0x7fc07fc0u; w.y = 0x7fc07fc0u; } *(u32x2v*)(xn + off + bj * HALF + n * 16) = w; }
                asm volatile("" ::: "memory"); }
    }
};

template <class Epi, class Sched, bool ALIGN_EPI = false, bool SP2 = false, bool GATHER = false, bool F8 = false>
__device__ __forceinline__ void gemm_phase(PG8_LAS unsigned char* lds, const Gemm g, const Sched& S, const Epi& E, const PG8_LAS unsigned short* tokl = nullptr) {
    int tid_ = threadIdx.x; asm volatile("" : "+v"(tid_));
    const int tid = tid_, wid = __builtin_amdgcn_readfirstlane(tid >> 6), lane = tid & 63, wr = wid >> 2, wc = wid & 3, fr = lane & 15, fq = lane >> 4;
    const int K = g.K, nt = K / BK;
    unsigned voffA[2], voffB[2];
#pragma unroll
    for (int i = 0; i < 2; ++i) { int R, C; stage_rc(tid * 16 + i * 8192, R, C); const int Rb = Epi::PERM ? ((R & ~31) + perm32(R & 31)) : R;
        voffA[i] = GATHER ? (unsigned)C * 2u : (unsigned)(R * K + C) * 2u; voffB[i] = (unsigned)(Rb * K + C) * 2u; }
    const size_t rowbytes = (size_t)K * 2; unsigned tkc[2] = {0u, 0u}; (void)rowbytes;
#define PG8_LOADTK(dst, unit_i) do { int R0_, C0_, R1_, C1_; stage_rc(tid * 16, R0_, C0_); stage_rc(tid * 16 + 8192, R1_, C1_); (void)C0_; (void)C1_; \
        _Pragma("unroll") for (int h_ = 0; h_ < 2; ++h_) dst[h_] = (unsigned)tokl[(unit_i) * 256 + h_ * HALF + R0_] | ((unsigned)tokl[(unit_i) * 256 + h_ * HALF + R1_] << 16); } while (0)
#define PG8_STAGE_A(bufoff, gbase, half, TK) do { if constexpr (GATHER) { _Pragma("unroll") for (int _i = 0; _i < 2; ++_i) { const unsigned _tok = ((TK)[half] >> (16 * _i)) & 0xffffu; \
        __builtin_amdgcn_global_load_lds((const unsigned*)((const char*)(gbase) + (size_t)_tok * rowbytes + voffA[_i]), (PG8_LAS unsigned*)(lds + (bufoff) + ldsw + _i * 8192), 16, 0, 0); } } \
    else { PG8_STAGE(bufoff, (gbase) + (half) * hstep, voffA); } } while (0)
    const size_t kstep = (size_t)(BK * 2);
    const size_t hstep = (size_t)HALF * K * 2;
    const size_t tstep = 2 * hstep;
    const unsigned ldsw = (unsigned)wid * 1024u;
    const int aoff = lds_byte(wr * 64 + fr, fq * 8), boff = lds_byte(wc * 32 + fr, fq * 8);
    unsigned f8scl = 0x7f7f7f7fu; asm volatile("" : "+v"(f8scl)); (void)f8scl;
    constexpr int KFS = 1024;
#define PG8_SA(b, h) (((b) * 2 + (h)) * HTB)
#define PG8_SB(b, h) ((4 + (b) * 2 + (h)) * HTB)
#define PG8_STAGE(bufoff, gbase, voff) do { _Pragma("unroll") for (int _i = 0; _i < 2; ++_i) \
        __builtin_amdgcn_global_load_lds((const unsigned*)((const char*)(gbase) + (voff)[_i]), (PG8_LAS unsigned*)(lds + (bufoff) + ldsw + _i * 8192), 16, 0, 0); } while (0)
#define PG8_LDA(dst, b, h) do { _Pragma("unroll") for (int m = 0; m < 4; ++m) _Pragma("unroll") for (int k = 0; k < 2; ++k) dst[m][k] = *(const PG8_LAS bf16x8*)(lds + PG8_SA(b, h) + aoff + m * 2048 + k * KFS); } while (0)
#define PG8_LDB(dst, b, h) do { _Pragma("unroll") for (int n = 0; n < 2; ++n) _Pragma("unroll") for (int k = 0; k < 2; ++k) dst[n][k] = *(const PG8_LAS bf16x8*)(lds + PG8_SB(b, h) + boff + n * 2048 + k * KFS); } while (0)
#define PG8_F8FRAG(X) __builtin_bit_cast(i32x8, __builtin_shufflevector(X[0], X[1], 0, 1, 2, 3, 4, 5, 6, 7, 8, 9, 10, 11, 12, 13, 14, 15))
#define PG8_MMA(ai, bj, At, Bt) do { __builtin_amdgcn_s_setprio(1); if constexpr (F8) { const i32x8 b80_ = PG8_F8FRAG(Bt[0]), b81_ = PG8_F8FRAG(Bt[1]); _Pragma("unroll") for (int m = 0; m < 4; ++m) { const i32x8 a8_ = PG8_F8FRAG(At[m]); \
        asm volatile("v_mfma_scale_f32_16x16x128_f8f6f4 %0, %1, %2, %0, %3, %3 op_sel_hi:[0,0,0]" : "+v"(acc[ai][bj][m][0]) : "v"(b80_), "v"(a8_), "v"(f8scl)); \
        asm volatile("v_mfma_scale_f32_16x16x128_f8f6f4 %0, %1, %2, %0, %3, %3 op_sel_hi:[0,0,0]" : "+v"(acc[ai][bj][m][1]) : "v"(b81_), "v"(a8_), "v"(f8scl)); } } else { \
        _Pragma("unroll") for (int m = 0; m < 4; ++m) _Pragma("unroll") for (int n = 0; n < 2; ++n) _Pragma("unroll") for (int k = 0; k < 2; ++k) \
        acc[ai][bj][m][n] = __builtin_amdgcn_mfma_f32_16x16x32_bf16(Bt[n][k], At[m][k], acc[ai][bj][m][n], 0, 0, 0); } __builtin_amdgcn_s_setprio(0); } while (0)
#define PG8_WAIT_V(n) asm volatile("s_waitcnt vmcnt(" #n ")" ::: "memory")
#define PG8_WAIT_L(n) asm volatile("s_waitcnt lgkmcnt(" #n ")" ::: "memory")
#define PG8_BAR __builtin_amdgcn_s_barrier()
#define PG8_SCHED __builtin_amdgcn_sched_barrier(0)
    Unit cur, nxt; int ui = 0;
    if (!S.next(0, cur)) return;
    f32x4 acc[2][2][4][2];
#pragma unroll
    for (int a = 0; a < 2; ++a)
#pragma unroll
        for (int b = 0; b < 2; ++b)
#pragma unroll
            for (int m = 0; m < 4; ++m)
#pragma unroll
                for (int n = 0; n < 2; ++n) acc[a][b][m][n] = (f32x4){0.f, 0.f, 0.f, 0.f};
    bf16x8 At[4][2], B0[2][2], B1[2][2];
    const char* cA = (const char*)g.A + (GATHER ? (size_t)0 : (size_t)cur.pm * tstep); const char* cB = (const char*)g.Bt + (size_t)cur.pn * tstep;
    if constexpr (GATHER) { PG8_LOADTK(tkc, 0); }
    S.a_ready(cur);
    if constexpr (SP2) {
        PG8_STAGE(PG8_SB(0, 0), cB, voffB); PG8_STAGE(PG8_SB(0, 1), cB + hstep, voffB); PG8_STAGE_A(PG8_SA(0, 0), cA, 0, tkc); PG8_STAGE_A(PG8_SA(0, 1), cA, 1, tkc);
        if (wr == 1) PG8_BAR;
        PG8_WAIT_V(2); PG8_BAR;
        PG8_STAGE(PG8_SB(1, 0), cB + kstep, voffB); PG8_STAGE_A(PG8_SA(1, 0), cA + kstep, 0, tkc); PG8_STAGE(PG8_SB(1, 1), cB + hstep + kstep, voffB);
        PG8_WAIT_V(6); PG8_BAR;
    } else {
        PG8_STAGE(PG8_SB(0, 0), cB, voffB); PG8_STAGE_A(PG8_SA(0, 0), cA, 0, tkc); PG8_STAGE(PG8_SB(0, 1), cB + hstep, voffB); PG8_STAGE_A(PG8_SA(0, 1), cA, 1, tkc);
        if (wr == 1) PG8_BAR;
        PG8_WAIT_V(4); PG8_BAR;
        PG8_STAGE(PG8_SB(1, 0), cB + kstep, voffB); PG8_STAGE_A(PG8_SA(1, 0), cA + kstep, 0, tkc); PG8_STAGE(PG8_SB(1, 1), cB + hstep + kstep, voffB);
        PG8_WAIT_V(6); PG8_BAR;
    }
    for (;;) {
        const bool has_next = S.next(ui + 1, nxt);
        const char* nA = has_next ? (const char*)g.A + (GATHER ? (size_t)0 : (size_t)nxt.pm * tstep) : cA;
 const char* nB = has_next ? (const char*)g.Bt + (size_t)nxt.pn * tstep : cB;
        for (int t = 0; t < nt; t += 2) {
            const bool last = (t == nt - 2);
            const char* a1 = cA + (size_t)(t + 1) * kstep;
            const char* a2 = last ? nA : cA + (size_t)(t + 2) * kstep; const char* b2 = last ? nB : cB + (size_t)(t + 2) * kstep;
            const char* a3 = a2 + kstep; const char* b3 = b2 + kstep;
            unsigned tk2[2]; tk2[0] = tkc[0]; tk2[1] = tkc[1]; (void)tk2;
            if constexpr (GATHER) { if (last && has_next) { PG8_LOADTK(tk2, ui + 1); } }
            if (last && has_next) S.a_ready(nxt);
            if constexpr (SP2) {
            PG8_LDB(B0, 0, 0); PG8_LDB(B1, 0, 1); PG8_SCHED; PG8_LDA(At, 0, 0); PG8_STAGE_A(PG8_SA(1, 1), a1, 1, tkc);
            PG8_WAIT_V(8); PG8_WAIT_L(0); PG8_BAR; PG8_MMA(0, 0, At, B0); PG8_MMA(0, 1, At, B1); PG8_BAR; PG8_SCHED;
            PG8_LDA(At, 0, 1); PG8_STAGE(PG8_SB(0, 0), b2, voffB); PG8_STAGE(PG8_SB(0, 1), b2 + hstep, voffB); PG8_STAGE_A(PG8_SA(0, 0), a2, 0, tk2);
            PG8_WAIT_V(8); PG8_WAIT_L(0); PG8_BAR; PG8_MMA(1, 0, At, B0); PG8_MMA(1, 1, At, B1); PG8_BAR; PG8_SCHED;
            PG8_LDB(B0, 1, 0); PG8_LDB(B1, 1, 1); PG8_SCHED; PG8_LDA(At, 1, 0); PG8_STAGE_A(PG8_SA(0, 1), a2, 1, tk2);
            PG8_WAIT_V(8); PG8_WAIT_L(0); PG8_BAR; PG8_MMA(0, 0, At, B0); PG8_MMA(0, 1, At, B1); PG8_BAR; PG8_SCHED;
            PG8_LDA(At, 1, 1); PG8_STAGE(PG8_SB(1, 0), b3, voffB); PG8_STAGE(PG8_SB(1, 1), b3 + hstep, voffB); PG8_STAGE_A(PG8_SA(1, 0), a3, 0, tk2);
            PG8_WAIT_V(8); PG8_WAIT_L(0); PG8_BAR; PG8_MMA(1, 0, At, B0); PG8_MMA(1, 1, At, B1); PG8_BAR; PG8_SCHED;
            } else {
            PG8_LDB(B0, 0, 0); PG8_SCHED; PG8_LDA(At, 0, 0); PG8_STAGE_A(PG8_SA(1, 1), a1, 1, tkc);
            PG8_WAIT_L(8); PG8_BAR; PG8_WAIT_L(0); PG8_MMA(0, 0, At, B0); PG8_BAR; PG8_SCHED;
            PG8_LDB(B1, 0, 1); PG8_STAGE(PG8_SB(0, 0), b2, voffB);
            PG8_BAR; PG8_WAIT_L(0); PG8_MMA(0, 1, At, B1); PG8_BAR;
            PG8_LDA(At, 0, 1); PG8_STAGE_A(PG8_SA(0, 0), a2, 0, tk2);
            PG8_BAR; PG8_WAIT_L(0); PG8_MMA(1, 0, At, B0); PG8_BAR; PG8_SCHED;
            PG8_STAGE(PG8_SB(0, 1), b2 + hstep, voffB);
            PG8_WAIT_V(6); PG8_BAR; PG8_MMA(1, 1, At, B1); PG8_BAR;
            PG8_LDB(B0, 1, 0); PG8_SCHED; PG8_LDA(At, 1, 0); PG8_STAGE_A(PG8_SA(0, 1), a2, 1, tk2);
            PG8_WAIT_L(8); PG8_BAR; PG8_WAIT_L(0); PG8_MMA(0, 0, At, B0); PG8_BAR; PG8_SCHED;
            PG8_LDB(B1, 1, 1); PG8_STAGE(PG8_SB(1, 0), b3, voffB);
            PG8_BAR; PG8_WAIT_L(0); PG8_MMA(0, 1, At, B1); PG8_BAR;
            PG8_LDA(At, 1, 1); PG8_STAGE_A(PG8_SA(1, 0), a3, 0, tk2);
            PG8_BAR; PG8_WAIT_L(0); PG8_MMA(1, 0, At, B0); PG8_BAR; PG8_SCHED;
            PG8_STAGE(PG8_SB(1, 1), b3 + hstep, voffB);
            PG8_WAIT_V(6); PG8_BAR; PG8_MMA(1, 1, At, B1); PG8_BAR;
            }
        }
        if constexpr (ALIGN_EPI) { if (wr == 0) PG8_BAR; }
        if constexpr (F8) asm volatile("s_nop 15\n\ts_nop 15" ::: "memory");
        if constexpr (!Epi::AFTER_DRAIN) { E(acc, cur, wr, wc, fr, fq);
#if defined(MK_EPI_REP) && MK_EPI_REP
            E(acc, cur, wr, wc, fr, fq);
#endif
            S.done(cur); }
        if (!has_next) break;
#pragma unroll
        for (int a = 0; a < 2; ++a)
#pragma unroll
            for (int b = 0; b < 2; ++b)
#pragma unroll
                for (int m = 0; m < 4; ++m)
#pragma unroll
                    for (int n = 0; n < 2; ++n) acc[a][b][m][n] = (f32x4){0.f, 0.f, 0.f, 0.f};
        cur = nxt; cA = nA; cB = nB; ++ui; if constexpr (GATHER) { PG8_LOADTK(tkc, ui); }
        if constexpr (ALIGN_EPI) { if (wr == 1) PG8_BAR; }
    }
    PG8_WAIT_V(0);
    if constexpr (!ALIGN_EPI) { if (wr == 0) PG8_BAR; }
    PG8_BAR;
    if constexpr (Epi::AFTER_DRAIN) { E.fused(acc, cur, wr, wc, fr, fq, lds, wid, lane); S.done(cur); }
#undef PG8_SA
#undef PG8_SB
#undef PG8_STAGE
#undef PG8_STAGE_A
#undef PG8_LOADTK
#undef PG8_LDA
#undef PG8_LDB
#undef PG8_MMA
#undef PG8_F8FRAG
#undef PG8_WAIT_V
#undef PG8_WAIT_L
#undef PG8_BAR
#undef PG8_SCHED
}
}
namespace pg8 {
struct EpiF32 {
    static constexpr bool PERM = false, AFTER_DRAIN = false;
    float* O; int ldc;
    __device__ __forceinline__ void operator()(const f32x4 (&acc)[2][2][4][2], const Unit& u, int wr, int wc, int fr_, int fq_) const {
        int t_ = threadIdx.x; asm volatile("" : "+v"(t_)); const int fr = t_ & 15, fq = (t_ & 63) >> 4; (void)fr_; (void)fq_;
        const int row0 = u.pm * BM + wr * 64 + fr, col0 = u.pn * BM + wc * 32 + 4 * fq;
#pragma unroll
        for (int ai = 0; ai < 2; ++ai)
#pragma unroll
            for (int m = 0; m < 4; ++m) { float* rowp = O + (size_t)(row0 + ai * HALF + m * 16) * ldc + col0;
#pragma unroll
                for (int bj = 0; bj < 2; ++bj)
#pragma unroll
                    for (int n = 0; n < 2; ++n) *(f32x4*)(rowp + bj * HALF + n * 16) = acc[ai][bj][m][n]; }
    }
};
struct EpiResF32 {
    static constexpr bool PERM = false, AFTER_DRAIN = false;
    const float* base; float* out; int ldc; float alpha;
    __device__ __forceinline__ void operator()(const f32x4 (&acc)[2][2][4][2], const Unit& u, int wr, int wc, int fr_, int fq_) const {
        int t_ = threadIdx.x; asm volatile("" : "+v"(t_)); const int fr = t_ & 15, fq = (t_ & 63) >> 4; (void)fr_; (void)fq_;
        const int row0 = u.pm * BM + wr * 64 + fr, col0 = u.pn * BM + wc * 32 + 4 * fq;
#pragma unroll
        for (int ai = 0; ai < 2; ++ai)
#pragma unroll
            for (int m = 0; m < 4; ++m) { const size_t off = (size_t)(row0 + ai * HALF + m * 16) * ldc + col0;
                f32x4 bs[2][2];
#pragma unroll
                for (int bj = 0; bj < 2; ++bj)
#pragma unroll
                    for (int n = 0; n < 2; ++n) bs[bj][n] = *(const f32x4*)(base + off + bj * HALF + n * 16);
#pragma unroll
                for (int bj = 0; bj < 2; ++bj)
#pragma unroll
                    for (int n = 0; n < 2; ++n) *(f32x4*)(out + off + bj * HALF + n * 16) = bs[bj][n] * alpha + acc[ai][bj][m][n]; }
    }
};
struct EpiDsaNorm {
    static constexpr bool PERM = false, AFTER_DRAIN = false;
    bf16_t* cqn; bf16_t* ckv; bf16_t* kidx; float* widx; const float* gq; const float* gkv; const float* gki; const float* bki; unsigned* cmaxw; PG8_LAS float* scr; float rms_eps, ln_eps;
    __device__ __forceinline__ void operator()(const f32x4 (&acc)[2][2][4][2], const Unit& u, int wr, int wc, int fr_, int fq_) const {
        int t_ = threadIdx.x; asm volatile("" : "+v"(t_)); const int fr = t_ & 15, fq = (t_ & 63) >> 4; (void)fr_; (void)fq_;
#define EDN_RED4(v_) do { v_ += __shfl_xor(v_, 16); v_ += __shfl_xor(v_, 32); } while (0)
#define EDN_BAR() asm volatile("s_waitcnt lgkmcnt(0)\n\ts_barrier" ::: "memory")
#define EDN_PK(v_) ({ u32x2e w_; w_.x = cvt_pk_bf16((v_)[0], (v_)[1]); w_.y = cvt_pk_bf16((v_)[2], (v_)[3]); w_; })
        typedef unsigned u32x2e __attribute__((ext_vector_type(2)));
        if (u.pn == 0) {
#pragma unroll
            for (int ai = 0; ai < 2; ++ai)
#pragma unroll
                for (int m = 0; m < 4; ++m) { float s = 0.f;
#pragma unroll
                    for (int bj = 0; bj < 2; ++bj)
#pragma unroll
                        for (int n = 0; n < 2; ++n) { const f32x4 x = acc[ai][bj][m][n]; s += (x[0] * x[0] + x[1] * x[1]) + (x[2] * x[2] + x[3] * x[3]); }
                    EDN_RED4(s); if (fq == 0) scr[(ai * HALF + wr * 64 + m * 16 + fr) * 4 + wc] = s; }
            EDN_BAR();
#pragma unroll
            for (int ai = 0; ai < 2; ++ai)
#pragma unroll
                for (int m = 0; m < 4; ++m) { const int rl = ai * HALF + wr * 64 + m * 16 + fr; const f32x4 p4 = *(const PG8_LAS f32x4*)(scr + rl * 4);
                    const float rq = 1.0f / sqrtf(((p4[0] + p4[1]) + (p4[2] + p4[3])) * (1.0f / 256.0f) + rms_eps); bf16_t* rowp = cqn + (size_t)(u.pm * BM + rl) * 256;
#pragma unroll
                    for (int bj = 0; bj < 2; ++bj)
#pragma unroll
                        for (int n = 0; n < 2; ++n) { const int col = bj * HALF + wc * 32 + n * 16 + 4 * fq; const f32x4 v = acc[ai][bj][m][n] * rq * *(const f32x4*)(gq + col); *(u32x2e*)(rowp + col) = EDN_PK(v); } }
        } else {
            float cmx = 0.f;
#pragma unroll
            for (int ai = 0; ai < 2; ++ai)
#pragma unroll
                for (int m = 0; m < 4; ++m) { const int rl = ai * HALF + wr * 64 + m * 16 + fr; float s1 = 0.f, s4 = 0.f, s2 = 0.f, s3 = 0.f;
#pragma unroll
                    for (int n = 0; n < 2; ++n) { const f32x4 x = acc[ai][0][m][n]; const f32x4 xg = x * *(const f32x4*)(gkv + wc * 32 + n * 16 + 4 * fq);
                        s1 += (x[0] * x[0] + x[1] * x[1]) + (x[2] * x[2] + x[3] * x[3]); s4 += (xg[0] * xg[0] + xg[1] * xg[1]) + (xg[2] * xg[2] + xg[3] * xg[3]);
                        const f32x4 y = acc[ai][1][m][n]; s2 += (y[0] + y[1]) + (y[2] + y[3]); s3 += (y[0] * y[0] + y[1] * y[1]) + (y[2] * y[2] + y[3] * y[3]); }
                    EDN_RED4(s1); EDN_RED4(s4); EDN_RED4(s2); EDN_RED4(s3);
                    if (fq == 0) { scr[rl * 4 + wc] = s1; scr[1024 + rl * 4 + wc] = s4; if (wc < 2) { scr[2048 + rl * 2 + wc] = s2; scr[2560 + rl * 2 + wc] = s3; } } }
            EDN_BAR();
#pragma unroll
            for (int ai = 0; ai < 2; ++ai)
#pragma unroll
                for (int m = 0; m < 4; ++m) { const int rl = ai * HALF + wr * 64 + m * 16 + fr; const size_t grow = (size_t)(u.pm * BM + rl);
                    const f32x4 p1 = *(const PG8_LAS f32x4*)(scr + rl * 4), p4 = *(const PG8_LAS f32x4*)(scr + 1024 + rl * 4);
                    const float rkv = 1.0f / sqrtf(((p1[0] + p1[1]) + (p1[2] + p1[3])) * (1.0f / 128.0f) + rms_eps);
                    cmx = fmaxf(cmx, ((p4[0] + p4[1]) + (p4[2] + p4[3])) * rkv * rkv);
#pragma unroll
                    for (int n = 0; n < 2; ++n) { const int col = wc * 32 + n * 16 + 4 * fq; const f32x4 v = acc[ai][0][m][n] * rkv * *(const f32x4*)(gkv + col); { int w8 = __builtin_amdgcn_cvt_pk_fp8_f32(v[0], v[1], 0, false); w8 = __builtin_amdgcn_cvt_pk_fp8_f32(v[2], v[3], w8, true); *(unsigned*)((unsigned char*)ckv + grow * 128 + col) = (unsigned)w8; } }
                    if (wc < 2) { const float sm = scr[2048 + rl * 2] + scr[2048 + rl * 2 + 1], sq = scr[2560 + rl * 2] + scr[2560 + rl * 2 + 1];
                        const float mean = sm * (1.0f / 64.0f); const float var = fmaxf(sq * (1.0f / 64.0f) - mean * mean, 0.f); const float rstd = 1.0f / sqrtf(var + ln_eps);
#pragma unroll
                        for (int n = 0; n < 2; ++n) { const int col = wc * 32 + n * 16 + 4 * fq; const f32x4 v = (acc[ai][1][m][n] - mean) * rstd * *(const f32x4*)(gki + col) + *(const f32x4*)(bki + col); *(u32x2e*)(kidx + grow * 64 + col) = EDN_PK(v); } }
                    if (wc == 2 && fq < 2) *(f32x4*)(widx + grow * 8 + 4 * fq) = acc[ai][1][m][0] * 0.04419417382415922f; }
            if (wc == 0 && fq == 0) __hip_atomic_fetch_max(cmaxw, __builtin_bit_cast(unsigned, sqrtf(cmx)), __ATOMIC_RELAXED, __HIP_MEMORY_SCOPE_AGENT);
        }
        EDN_BAR();
#undef EDN_RED4
#undef EDN_BAR
#undef EDN_PK
    }
};
struct EpiCq {
    static constexpr bool PERM = true, AFTER_DRAIN = false;
    bf16_t* qlat; bf16_t* qidx;
    __device__ __forceinline__ void operator()(const f32x4 (&acc)[2][2][4][2], const Unit& u, int wr, int wc, int fr_, int fq_) const {
        int t_ = threadIdx.x; asm volatile("" : "+v"(t_)); const int fr = t_ & 15, fq = (t_ & 63) >> 4; (void)fr_; (void)fq_;
        const int row0 = u.pm * BM + wr * 64 + fr; int colt = u.pn * BM; bf16_t* base = qlat; int ldc = 2048;
        if (colt >= 2048) { base = qidx; ldc = 512; colt -= 2048; }
        const int col0 = colt + wc * 32 + 8 * fq;
#pragma unroll
        for (int ai = 0; ai < 2; ++ai)
#pragma unroll
            for (int m = 0; m < 4; ++m) { bf16_t* rowp = base + (size_t)(row0 + ai * HALF + m * 16) * ldc + col0;
#pragma unroll
                for (int bj = 0; bj < 2; ++bj) { const f32x4 v0 = acc[ai][bj][m][0], v1 = acc[ai][bj][m][1];
                    u32x4 w; w.x = cvt_pk_bf16(v0[0], v0[1]); w.y = cvt_pk_bf16(v0[2], v0[3]); w.z = cvt_pk_bf16(v1[0], v1[1]); w.w = cvt_pk_bf16(v1[2], v1[3]);
                    *(u32x4*)(rowp + bj * HALF) = w; } }
    }
};
struct EpiSwiglu {
    static constexpr bool PERM = true, AFTER_DRAIN = false;
    bf16_t* H; const float* bgu;
    __device__ __forceinline__ void operator()(const f32x4 (&acc)[2][2][4][2], const Unit& u, int wr, int wc, int fr_, int fq_) const {
        int t_ = threadIdx.x; asm volatile("" : "+v"(t_)); const int fr = t_ & 15, fq = (t_ & 63) >> 4; (void)fr_; (void)fq_;
        const int e = u.pn >> 3, pnl = u.pn & 7;
        const int row0 = u.pm * BM + wr * 64 + fr, col0 = pnl * 128 + wc * 32 + 8 * fq;
        const float* bg = bgu + (size_t)e * 2048 + col0; const float* bu = bg + 1024;
        f32x4 bgv[2], buv[2];
#pragma unroll
        for (int n = 0; n < 2; ++n) { bgv[n] = *(const f32x4*)(bg + 4 * n); buv[n] = *(const f32x4*)(bu + 4 * n); }
#pragma unroll
        for (int ai = 0; ai < 2; ++ai)
#pragma unroll
            for (int m = 0; m < 4; ++m) { bf16_t* rowp = H + (size_t)(row0 + ai * HALF + m * 16) * 1024 + col0;
                float h[8];
#pragma unroll
                for (int n = 0; n < 2; ++n) { const f32x4 g4 = acc[ai][0][m][n] + bgv[n], u4 = acc[ai][1][m][n] + buv[n];
#pragma unroll
                    for (int i = 0; i < 4; ++i) { const float g = fminf(g4[i], 7.0f); const float up = fminf(fmaxf(u4[i], -7.0f), 7.0f);
                        const float sg = __builtin_amdgcn_rcpf(1.0f + __builtin_amdgcn_exp2f(g * (-1.702f * 1.4426950408889634f)));
                        h[4 * n + i] = (up + 1.0f) * (g * sg); } }
                u32x4 w; w.x = cvt_pk_bf16(h[0], h[1]); w.y = cvt_pk_bf16(h[2], h[3]); w.z = cvt_pk_bf16(h[4], h[5]); w.w = cvt_pk_bf16(h[6], h[7]);
                *(u32x4*)rowp = w; }
    }
};
__device__ __forceinline__ unsigned cvt4_fp8(float a, float b, float c, float d) { int w = 0; w = __builtin_amdgcn_cvt_pk_fp8_f32(a, b, w, false); w = __builtin_amdgcn_cvt_pk_fp8_f32(c, d, w, true); return (unsigned)w; }
struct EpiSwiglu8 {
    static constexpr bool PERM = true, AFTER_DRAIN = false;
    unsigned char* H; const float* bgu; float inv, hs;
    __device__ __forceinline__ void operator()(const f32x4 (&acc)[2][2][4][2], const Unit& u, int wr, int wc, int fr_, int fq_) const {
        int t_ = threadIdx.x; asm volatile("" : "+v"(t_)); const int fr = t_ & 15, fq = (t_ & 63) >> 4; (void)fr_; (void)fq_;
        const int e = u.pn >> 3, pnl = u.pn & 7;
        const int row0 = u.pm * BM + wr * 64 + fr, col0 = pnl * 128 + wc * 32 + 8 * fq;
        const float* bg = bgu + (size_t)e * 2048 + col0; const float* bu = bg + 1024;
        typedef float f32x2e __attribute__((ext_vector_type(2)));
        constexpr float KS = -1.702f * 1.4426950408889634f;
        f32x2e bgk[2][2], buq[2][2];
#pragma unroll
        for (int n = 0; n < 2; ++n) { const f32x4 g4 = *(const f32x4*)(bg + 4 * n) * KS; const f32x4 u4 = *(const f32x4*)(bu + 4 * n);
            bgk[n][0] = (f32x2e){g4[0], g4[1]}; bgk[n][1] = (f32x2e){g4[2], g4[3]}; buq[n][0] = (f32x2e){u4[0], u4[1]}; buq[n][1] = (f32x2e){u4[2], u4[3]}; }
        const float ik = inv * KS, hk = hs / KS; const f32x2e ik2 = {ik, ik}, inv2 = {inv, inv}, hk2 = {hk, hk}, one2 = {1.0f, 1.0f};
#pragma unroll
        for (int ai = 0; ai < 2; ++ai)
#pragma unroll
            for (int m = 0; m < 4; ++m) { unsigned char* rowp = H + (size_t)(row0 + ai * HALF + m * 16) * 1024 + col0;
                f32x2e h[4];
#pragma unroll
                for (int n = 0; n < 2; ++n)
#pragma unroll
                    for (int q = 0; q < 2; ++q) { const f32x4 ag = acc[ai][0][m][n], au = acc[ai][1][m][n];
                        f32x2e gk = __builtin_elementwise_fma((f32x2e){ag[2 * q], ag[2 * q + 1]}, ik2, bgk[n][q]);
                        f32x2e uq = __builtin_elementwise_fma((f32x2e){au[2 * q], au[2 * q + 1]}, inv2, buq[n][q]);
                        gk.x = fmaxf(gk.x, 7.0f * KS); gk.y = fmaxf(gk.y, 7.0f * KS);
                        uq.x = __builtin_amdgcn_fmed3f(uq.x, -7.0f, 7.0f); uq.y = __builtin_amdgcn_fmed3f(uq.y, -7.0f, 7.0f);
                        const f32x2e d2 = (f32x2e){__builtin_amdgcn_exp2f(gk.x), __builtin_amdgcn_exp2f(gk.y)} + one2;
                        const f32x2e r2 = {__builtin_amdgcn_rcpf(d2.x), __builtin_amdgcn_rcpf(d2.y)};
                        h[2 * n + q] = (gk * r2) * __builtin_elementwise_fma(uq, hk2, hk2); }
                typedef unsigned u32x2e __attribute__((ext_vector_type(2)));
                u32x2e w; w.x = cvt4_fp8(h[0].x, h[0].y, h[1].x, h[1].y); w.y = cvt4_fp8(h[2].x, h[2].y, h[3].x, h[3].y);
                *(u32x2e*)rowp = w; }
    }
};
struct EpiDown8 {
    static constexpr bool PERM = true, AFTER_DRAIN = false;
    unsigned char* O; const float* bias; float inv, ys;
    __device__ __forceinline__ void operator()(const f32x4 (&acc)[2][2][4][2], const Unit& u, int wr, int wc, int fr_, int fq_) const {
        int t_ = threadIdx.x; asm volatile("" : "+v"(t_)); const int fr = t_ & 15, fq = (t_ & 63) >> 4; (void)fr_; (void)fq_;
        const int e = u.pn >> 2, pnl = u.pn & 3;
        const int row0 = u.pm * BM + wr * 64 + fr, col0 = pnl * BM + wc * 32 + 8 * fq;
        f32x4 bv[2][2];
#pragma unroll
        for (int bj = 0; bj < 2; ++bj)
#pragma unroll
            for (int n = 0; n < 2; ++n) bv[bj][n] = *(const f32x4*)(bias + (size_t)e * 1024 + col0 + bj * HALF + 4 * n) * ys;
        const float sc = inv * ys;
#pragma unroll
        for (int ai = 0; ai < 2; ++ai)
#pragma unroll
            for (int m = 0; m < 4; ++m) { unsigned char* rowp = O + (size_t)(row0 + ai * HALF + m * 16) * 1024 + col0;
#pragma unroll
                for (int bj = 0; bj < 2; ++bj) { const f32x4 v0 = acc[ai][bj][m][0] * sc + bv[bj][0], v1 = acc[ai][bj][m][1] * sc + bv[bj][1];
                    typedef unsigned u32x2e __attribute__((ext_vector_type(2)));
                    u32x2e w; w.x = cvt4_fp8(v0[0], v0[1], v0[2], v0[3]); w.y = cvt4_fp8(v1[0], v1[1], v1[2], v1[3]);
                    *(u32x2e*)(rowp + bj * HALF) = w; } }
    }
};
struct EpiQkv8 {
    static constexpr bool PERM = true, AFTER_DRAIN = false;
    bf16_t* O; size_t split_stride; float inv, scale0;
    __device__ __forceinline__ void operator()(const f32x4 (&acc)[2][2][4][2], const Unit& u, int wr, int wc, int fr_, int fq_) const {
        int t_ = threadIdx.x; asm volatile("" : "+v"(t_)); const int fr = t_ & 15, fq = (t_ & 63) >> 4; (void)fr_; (void)fq_;
        const int row0 = u.pm * BM + wr * 64 + fr; const int t = (u.pn * BM) >> 10; const int colt = u.pn * BM - (t << 10);
        bf16_t* base = O + (size_t)t * split_stride; const float sc = inv * (t == 0 ? scale0 : 1.f);
        const int col0 = colt + wc * 32 + 8 * fq;
#pragma unroll
        for (int ai = 0; ai < 2; ++ai)
#pragma unroll
            for (int m = 0; m < 4; ++m) { bf16_t* rowp = base + (size_t)(row0 + ai * HALF + m * 16) * 1024 + col0;
#pragma unroll
                for (int bj = 0; bj < 2; ++bj) { const f32x4 v0 = acc[ai][bj][m][0] * sc, v1 = acc[ai][bj][m][1] * sc;
                    u32x4 w; w.x = cvt_pk_bf16(v0[0], v0[1]); w.y = cvt_pk_bf16(v0[2], v0[3]); w.z = cvt_pk_bf16(v1[0], v1[1]); w.w = cvt_pk_bf16(v1[2], v1[3]);
                    *(u32x4*)(rowp + bj * HALF) = w; } }
    }
};
struct EpiBf16s {
    static constexpr bool PERM = true, AFTER_DRAIN = false;
    bf16_t* O; int ldc; float inv;
    __device__ __forceinline__ void operator()(const f32x4 (&acc)[2][2][4][2], const Unit& u, int wr, int wc, int fr_, int fq_) const {
        int t_ = threadIdx.x; asm volatile("" : "+v"(t_)); const int fr = t_ & 15, fq = (t_ & 63) >> 4; (void)fr_; (void)fq_;
        const int row0 = u.pm * BM + wr * 64 + fr, col0 = u.pn * BM + wc * 32 + 8 * fq;
#pragma unroll
        for (int ai = 0; ai < 2; ++ai)
#pragma unroll
            for (int m = 0; m < 4; ++m) { bf16_t* rowp = O + (size_t)(row0 + ai * HALF + m * 16) * ldc + col0;
#pragma unroll
                for (int bj = 0; bj < 2; ++bj) { const f32x4 v0 = acc[ai][bj][m][0] * inv, v1 = acc[ai][bj][m][1] * inv;
                    u32x4 w; w.x = cvt_pk_bf16(v0[0], v0[1]); w.y = cvt_pk_bf16(v0[2], v0[3]); w.z = cvt_pk_bf16(v1[0], v1[1]); w.w = cvt_pk_bf16(v1[2], v1[3]);
                    *(u32x4*)(rowp + bj * HALF) = w; } }
    }
};
struct EpiF8s {
    static constexpr bool PERM = true, AFTER_DRAIN = false;
    unsigned char* O; float sc;
    __device__ __forceinline__ void operator()(const f32x4 (&acc)[2][2][4][2], const Unit& u, int wr, int wc, int fr_, int fq_) const {
        int t_ = threadIdx.x; asm volatile("" : "+v"(t_)); const int fr = t_ & 15, fq = (t_ & 63) >> 4; (void)fr_; (void)fq_;
        const int row0 = u.pm * BM + wr * 64 + fr, col0 = u.pn * BM + wc * 32 + 8 * fq;
#pragma unroll
        for (int ai = 0; ai < 2; ++ai)
#pragma unroll
            for (int m = 0; m < 4; ++m) { unsigned char* rowp = O + (size_t)(row0 + ai * HALF + m * 16) * 1024 + col0;
#pragma unroll
                for (int bj = 0; bj < 2; ++bj) { const f32x4 v0 = acc[ai][bj][m][0] * sc, v1 = acc[ai][bj][m][1] * sc;
                    typedef unsigned u32x2e __attribute__((ext_vector_type(2)));
                    u32x2e w; w.x = cvt4_fp8(v0[0], v0[1], v0[2], v0[3]); w.y = cvt4_fp8(v1[0], v1[1], v1[2], v1[3]);
                    *(u32x2e*)(rowp + bj * HALF) = w; } }
    }
};
struct EpiResF32s {
    static constexpr bool PERM = false, AFTER_DRAIN = false;
    const float* base; float* out; int ldc; float alpha, inv;
    __device__ __forceinline__ void operator()(const f32x4 (&acc)[2][2][4][2], const Unit& u, int wr, int wc, int fr_, int fq_) const {
        int t_ = threadIdx.x; asm volatile("" : "+v"(t_)); const int fr = t_ & 15, fq = (t_ & 63) >> 4; (void)fr_; (void)fq_;
        const int row0 = u.pm * BM + wr * 64 + fr, col0 = u.pn * BM + wc * 32 + 4 * fq;
#pragma unroll
        for (int ai = 0; ai < 2; ++ai)
#pragma unroll
            for (int m = 0; m < 4; ++m) { const size_t off = (size_t)(row0 + ai * HALF + m * 16) * ldc + col0;
                f32x4 bs[2][2];
#pragma unroll
                for (int bj = 0; bj < 2; ++bj)
#pragma unroll
                    for (int n = 0; n < 2; ++n) bs[bj][n] = *(const f32x4*)(base + off + bj * HALF + n * 16);
#pragma unroll
                for (int bj = 0; bj < 2; ++bj)
#pragma unroll
                    for (int n = 0; n < 2; ++n) *(f32x4*)(out + off + bj * HALF + n * 16) = bs[bj][n] * alpha + acc[ai][bj][m][n] * inv; }
    }
};
struct MoeOrder {
    int nT, nNl, G, c; const PG8_LAS int* tile_e;
    __device__ __forceinline__ bool next(int i, Unit& u) const {
        const int nwg = nT * nNl; const long L = (long)i * G + c; if (L >= nwg) return false;
        const int q = nwg / NXCD, r = nwg % NXCD, xcd = (int)(L % NXCD), off = (int)(L / NXCD);
        const int wgid = (xcd < r ? xcd * (q + 1) : r * (q + 1) + (xcd - r) * q) + off;
        const int pm = wgid / nNl, j = wgid % nNl;
        u.pm = pm; u.pn = tile_e[pm] * nNl + j; return true;
    }
    __device__ __forceinline__ void a_ready(const Unit&) const {}
    __device__ __forceinline__ void done(const Unit&) const {}
};
}
#ifndef PG8_SP2
#define PG8_SP2 true
#endif
#ifndef PG8_ALIGN
#define PG8_ALIGN true
#endif
#include <hip/hip_bf16.h>
#include <cmath>
namespace attn_body {
using bf16=__hip_bfloat16;
using bf16x8=__attribute__((ext_vector_type(8)))short;
using s16x4=__attribute__((ext_vector_type(4)))short;
using f32x16=__attribute__((ext_vector_type(16)))float;
using u32x4=__attribute__((ext_vector_type(4)))unsigned;
constexpr int BATCH=8,NHEAD=16,SEQ=4096,D=64,DM=NHEAD*D,XD=16;
constexpr int NW=8,QBLK=32,QB=QBLK*NW,KVBLK=64,NQB=SEQ/QB;
constexpr int ATTN_PITCH=DM, ATTN_UNIT_ROWS=QB;
__device__ __forceinline__ int crow(int r,int hi){return (r&3)+8*(r>>2)+4*hi;}
#define SBAR() __builtin_amdgcn_sched_barrier(0)
__device__ __forceinline__ void cmask(f32x16&p0,f32x16&p1,int jb,int qrel,int hi){
  const float NEG=-INFINITY; int kb=64*jb+4*hi;
  #pragma unroll
  for(int r=0;r<16;++r){int kv=kb+(r&3)+8*(r>>2); if(kv>qrel)p0[r]=NEG; if(kv+32>qrel)p1[r]=NEG;}
}

constexpr int NSLOT=3, SLOTB=10240;
constexpr int LDS_K=0, LDS_V=NSLOT*SLOTB, LDS_WS=2*NSLOT*SLOTB, LDS_OST=LDS_WS+NW*64*4, LDS_BYTES=LDS_OST+NW*4096;
constexpr float C2=0.125f*1.4426950408889634f;
__device__ __forceinline__ void glds16(const void*gsrc,unsigned lds_dst){unsigned keep;
  asm volatile("s_mov_b32 %0, m0\n\ts_mov_b32 m0, %2\n\ts_nop 0\n\tglobal_load_lds_dwordx4 %1, off\n\ts_mov_b32 m0, %0":"=&s"(keep):"v"(gsrc),"s"(lds_dst):"memory");}
__device__ __forceinline__ float max3f(float a,float b,float c){float r;asm("v_max3_f32 %0, %1, %2, %3":"=v"(r):"v"(a),"v"(b),"v"(c));return r;}
__device__ __forceinline__ float max2f(float a,float b){float r;asm("v_max_f32_e32 %0, %1, %2":"=v"(r):"v"(a),"v"(b));return r;}
__device__ __forceinline__ float fadd_s(float a,float b){float r;asm("v_add_f32_e32 %0, %1, %2":"=v"(r):"v"(a),"v"(b));return r;}
__device__ __forceinline__ float fsub_s(float a,float b){float r;asm("v_sub_f32_e32 %0, %1, %2":"=v"(r):"v"(a),"v"(b));return r;}
typedef float f32x2_t __attribute__((ext_vector_type(2))); typedef __bf16 bf16x2_t __attribute__((ext_vector_type(2)));
__device__ __forceinline__ unsigned cvtpk_s(float lo,float hi){f32x2_t v={lo,hi};bf16x2_t b=__builtin_convertvector(v,bf16x2_t);return __builtin_bit_cast(unsigned,b);}
#define WAIT_BAR(N) asm volatile("s_waitcnt vmcnt(" #N ") lgkmcnt(0)\n\ts_barrier":::"memory")

__device__ __forceinline__ void qkt(f32x16&p0,f32x16&p1,const char*Kslot,const bf16x8*qr,int r32,int hi){
  const f32x16 zz=f32x16{};
  const char*kb=Kslot+hi*1024+r32*16;
  #pragma unroll
  for(int d0=0;d0<5;++d0){
    const bf16x8 b0=*reinterpret_cast<const bf16x8*>(kb+d0*2048);
    const bf16x8 b1=*reinterpret_cast<const bf16x8*>(kb+d0*2048+512);
    if(d0==0){p0=__builtin_amdgcn_mfma_f32_32x32x16_bf16(b0,qr[0],zz,0,0,0);p1=__builtin_amdgcn_mfma_f32_32x32x16_bf16(b1,qr[0],zz,0,0,0);}
    else{p0=__builtin_amdgcn_mfma_f32_32x32x16_bf16(b0,qr[d0],p0,0,0,0);p1=__builtin_amdgcn_mfma_f32_32x32x16_bf16(b1,qr[d0],p1,0,0,0);}}
}
typedef __attribute__((address_space(3))) const char* lds_cptr;
typedef short v4i16_t __attribute__((ext_vector_type(4)));
__device__ __forceinline__ void kload8(bf16x8*kf,lds_cptr kp){
  kf[0]=*(const __attribute__((address_space(3))) bf16x8*)(kp);      kf[1]=*(const __attribute__((address_space(3))) bf16x8*)(kp+512);
  kf[2]=*(const __attribute__((address_space(3))) bf16x8*)(kp+2048); kf[3]=*(const __attribute__((address_space(3))) bf16x8*)(kp+2560);
  kf[4]=*(const __attribute__((address_space(3))) bf16x8*)(kp+4096); kf[5]=*(const __attribute__((address_space(3))) bf16x8*)(kp+4608);
  kf[6]=*(const __attribute__((address_space(3))) bf16x8*)(kp+6144); kf[7]=*(const __attribute__((address_space(3))) bf16x8*)(kp+6656);
  kf[8]=*(const __attribute__((address_space(3))) bf16x8*)(kp+8192); kf[9]=*(const __attribute__((address_space(3))) bf16x8*)(kp+8704);
}
__device__ __forceinline__ void kload2(bf16x8*kf,lds_cptr kp,int j){ kf[2*j]=*(const __attribute__((address_space(3))) bf16x8*)(kp+j*2048); kf[2*j+1]=*(const __attribute__((address_space(3))) bf16x8*)(kp+j*2048+512); }
__device__ __forceinline__ s16x4 vtr(lds_cptr p){ return __builtin_bit_cast(s16x4,__builtin_amdgcn_ds_read_tr16_b64_v4i16((__attribute__((address_space(3))) v4i16_t*)p)); }
__device__ __forceinline__ float rowmax(const f32x16&p0,const f32x16&p1){
  float a=max3f(p0[0],p0[1],p1[0]),b=max3f(p0[2],p0[3],p1[1]);a=max3f(a,p1[2],p1[3]);
  #pragma unroll
  for(int r=4;r<16;r+=4){a=max3f(a,p0[r],p0[r+1]);b=max3f(b,p0[r+2],p0[r+3]);a=max3f(a,p1[r],p1[r+1]);b=max3f(b,p1[r+2],p1[r+3]);}
  const float m=max2f(a,b);
  auto rr=__builtin_amdgcn_permlane32_swap(__float_as_uint(m),__float_as_uint(m),false,false);
  return max2f(__uint_as_float(rr[0]),__uint_as_float(rr[1]));
}
__device__ __forceinline__ void pv(f32x16*o,int vb,bf16x8 pa0,bf16x8 pa1,bf16x8 pa2,bf16x8 pa3){
  #pragma unroll
  for(int d0=0;d0<2;++d0){s16x4 lo[4],hi[4];
    #pragma unroll
    for(int ks=0;ks<4;++ks){
      asm volatile("ds_read_b64_tr_b16 %0,%1 offset:%c2":"=&v"(lo[ks]):"v"(vb),"i"(d0*4096+ks*1024):"memory");
      asm volatile("ds_read_b64_tr_b16 %0,%1 offset:%c2":"=&v"(hi[ks]):"v"(vb),"i"(d0*4096+ks*1024+512):"memory");}
    asm volatile("s_waitcnt lgkmcnt(0)":::"memory");SBAR();
    #define PK(k) (bf16x8){lo[k][0],lo[k][1],lo[k][2],lo[k][3],hi[k][0],hi[k][1],hi[k][2],hi[k][3]}
    o[d0]=__builtin_amdgcn_mfma_f32_32x32x16_bf16(pa0,PK(0),o[d0],0,0,0);
    o[d0]=__builtin_amdgcn_mfma_f32_32x32x16_bf16(pa1,PK(1),o[d0],0,0,0);
    o[d0]=__builtin_amdgcn_mfma_f32_32x32x16_bf16(pa2,PK(2),o[d0],0,0,0);
    o[d0]=__builtin_amdgcn_mfma_f32_32x32x16_bf16(pa3,PK(3),o[d0],0,0,0);
    #undef PK
  }
}

#ifndef ATTN_STORE16
#define ATTN_STORE16(p,v) (*(u32x4*)(p)=(v))
#endif
__device__ __forceinline__ void set_m(bf16x8&q4,float mneg,int hi){
  const unsigned p1=cvtpk_s(mneg,0.f)&0xffffu; const float f1=__uint_as_float(p1<<16); const float r1=mneg-f1;
  const unsigned p2=cvtpk_s(r1,0.f)&0xffffu;   const float f2=__uint_as_float(p2<<16); const float r2=r1-f2;
  const unsigned p3=cvtpk_s(r2,0.f)&0xffffu;
  u32x4 w=__builtin_bit_cast(u32x4,q4); w[3]=hi?w[3]:(p1|(p2<<16)); w[0]=hi?p3:w[0]; q4=__builtin_bit_cast(bf16x8,w);
}
template<int THRL,bool GUARD> __device__ __forceinline__ void attn_unit(int b,int h,int qb,const bf16*Q,const bf16*__restrict__ K,const bf16*__restrict__ V,bf16*O,const bf16*__restrict__ QX,const bf16*__restrict__ KX,const float*__restrict__ DG,char*shm,int ts,unsigned*qctr,unsigned*tkslot){
  int tid_o=threadIdx.x; asm volatile("":"+v"(tid_o)); const int tid=tid_o,lane=tid&63,r32=lane&31,hi=lane>>5; const int wid=__builtin_amdgcn_readfirstlane(tid>>6);
  const long rowbase=(long)b*SEQ; const int q0=qb*QB;
  const bf16*Qw=Q+(rowbase+q0+wid*QBLK)*DM+h*D;
  const bf16*Kh=K+(rowbase+(long)ts*KVBLK)*DM+h*D,*Vh=V+(rowbase+(long)ts*KVBLK)*DM+h*D;
  const unsigned lds0=(unsigned)(uintptr_t)shm;
  float*wsf=(float*)(shm+LDS_WS)+wid*64;
  const bf16*ksrc=Kh+(long)lane*DM+wid*8;
  const bf16*vsrc=Vh+(long)(16*(wid&3)+(lane>>2))*DM+(wid>>2)*32+(lane&3)*8;
  const bf16*kxsrc=KX+((rowbase+(long)ts*KVBLK+lane)*NHEAD+h)*XD+(wid&1)*8;
  const unsigned kdst=lds0+LDS_K+wid*1024, vdst=lds0+LDS_V+wid*1024, kxdst=lds0+LDS_K+8192+(wid&1)*1024;
  #define DMA_K(t,slot) do{ glds16(ksrc+(long)(t)*KVBLK*DM,(unsigned)__builtin_amdgcn_readfirstlane(kdst+(slot))); glds16(kxsrc+(long)(t)*KVBLK*NHEAD*XD,(unsigned)__builtin_amdgcn_readfirstlane(kxdst+(slot))); }while(0)
  #define DMA_V(t,slot) glds16(vsrc+(long)(t)*KVBLK*DM,(unsigned)__builtin_amdgcn_readfirstlane(vdst+(slot)))
  const int vb0=(int)(lds0+LDS_V)+((lane>>4)&1)*32+(lane&3)*8+(4*hi+((lane&15)>>2))*64;
  const char*Kbase=shm+LDS_K; bf16x8 kf[10];
  const lds_cptr shm3=(lds_cptr)shm; const lds_cptr kp0=shm3+LDS_K+hi*1024+r32*16; const lds_cptr vp0=shm3+LDS_V+((lane>>4)&1)*32+(lane&3)*8+(4*hi+((lane&15)>>2))*64;
  const int NT=(q0+QB)/KVBLK-ts;
  DMA_K(0,0);DMA_V(0,0);DMA_K(1,SLOTB);
  bf16x8 qr[5];
  #pragma unroll
  for(int d0=0;d0<4;++d0)qr[d0]=*reinterpret_cast<const bf16x8*>(&Qw[(long)r32*DM+d0*16+hi*8]);
  qr[4]=*reinterpret_cast<const bf16x8*>(&QX[((rowbase+q0+wid*QBLK+r32)*NHEAD+h)*XD+hi*8]);
  float mhat=DG[(rowbase+q0+wid*QBLK+r32)*NHEAD+h]; set_m(qr[4],-mhat,hi); asm volatile("":"+v"(qr[4]));
  float l_reg=0.f;f32x16 o[2];o[0]=f32x16{};o[1]=f32x16{};const f32x16 zero16=f32x16{};
  const int qrel=wid*QBLK+r32;
  #define CMASK(P0,P1,t) do{int jb_=(t)-(NT-4); if(jb_>=0)cmask(P0,P1,jb_,qrel,hi);}while(0)
  bool resc=false;
  #define START(P0,P1) do{ resc=false; \
    if constexpr(GUARD){ const float rm=rowmax(P0,P1); if(__any(rm>(float)THRL)){ const float dl=__builtin_fmaxf(rm,0.f); mhat+=dl; \
      _Pragma("unroll") for(int r=0;r<16;++r){P0[r]-=dl;P1[r]-=dl;} set_m(qr[4],-mhat,hi); asm volatile("":"+v"(qr[4])); } } \
    _Pragma("unroll") for(int r=0;r<16;++r)P0[r]=__builtin_amdgcn_exp2f(P0[r]); }while(0)
  #define RESC() do{ if(resc){ asm volatile("s_waitcnt lgkmcnt(0)":::"memory"); \
      _Pragma("unroll") for(int d_=0;d_<2;++d_) _Pragma("unroll") for(int r=0;r<16;++r)o[d_][r]*=wsf[crow(r,hi)]; } }while(0)
  f32x16 pA0,pA1,pB0,pB1;
  int sl_prev=0,sl_cur=0,sl_next=SLOTB;
  #define ROT() do{sl_prev=sl_cur;sl_cur=sl_next;sl_next=(sl_next==(NSLOT-1)*SLOTB)?0:sl_next+SLOTB;}while(0)
  DMA_K(2,2*SLOTB);
  WAIT_BAR(3);
  qkt(pA0,pA1,Kbase,qr,r32,hi);asm volatile("s_nop 15\n\ts_nop 7":"+v"(pA0),"+v"(pA1));CMASK(pA0,pA1,0);
  START(pA0,pA1);
  _Pragma("unroll") for(int r=0;r<16;++r)pA1[r]=__builtin_amdgcn_exp2f(pA1[r]);
  WAIT_BAR(0);
  DMA_K(3,0);DMA_V(1,SLOTB);
  ROT();
  kload8(kf,kp0+sl_cur);
  WAIT_BAR(3);
  s16x4 vlo[8],vhi[8]; u32x4 pw0,pw1,pw2,pw3;
  #define PKW(P,B) cvtpk_s(P[B],P[B+1])
  #define PAF(k) __builtin_bit_cast(bf16x8,pw##k)
  #define VFR(i) (bf16x8){vlo[i][0],vlo[i][1],vlo[i][2],vlo[i][3],vhi[i][0],vhi[i][1],vhi[i][2],vhi[i][3]}
  #define PIN(x) asm volatile("":"+v"(x))
  #define MX3(a,b,c) __builtin_fmaxf(__builtin_fmaxf((a),(b)),(c))
  #define GAPA(MF,A0,A1,A2,A3,W0,W1,PW) do{ MF; sacc+=A0; sacc+=A1; sacc+=A2; sacc+=A3; PIN(sacc); W0; W1; PIN(PW); SBAR(); }while(0)
  #define EX(v) __builtin_amdgcn_exp2f(v)
  #define GAPB(MF,X,B) do{ MF; X[B]=EX(X[B]); X[B+1]=EX(X[B+1]); X[B+2]=EX(X[B+2]); X[B+3]=EX(X[B+3]); PIN(X); SBAR(); }while(0)
  #define VRD(i) do{ vlo[i]=vtr(vp_+(((i)>>2)*4096+((i)&3)*1024)); vhi[i]=vtr(vp_+(((i)>>2)*4096+((i)&3)*1024+512)); }while(0)
  #define KRD(G,j) do{ if(G){ kload2(kf,kp0+sl_next,j); SBAR(); } }while(0)
  #define STEP(C0,C1,P0,P1,t,GK,GV,GL) do{ SBAR(); \
    const lds_cptr vp_=vp0+sl_prev; \
    VRD(0); SBAR(); float sacc=(P0[0]+P0[1]); \
    GAPA(C0=__builtin_amdgcn_mfma_f32_32x32x16_bf16(kf[0],qr[0],zero16,0,0,0), P0[2],P0[3],P0[4],P0[5],     pw0[0]=PKW(P0,0), pw0[1]=PKW(P0,2), pw0); \
    VRD(4); SBAR(); GAPA(C1=__builtin_amdgcn_mfma_f32_32x32x16_bf16(kf[1],qr[0],zero16,0,0,0), P0[6],P0[7],P0[8],P0[9],     pw0[2]=PKW(P0,4), pw0[3]=PKW(P0,6), pw0); \
    VRD(1); SBAR(); GAPA(C0=__builtin_amdgcn_mfma_f32_32x32x16_bf16(kf[2],qr[1],C0,0,0,0),   P0[10],P0[11],P0[12],P0[13], pw1[0]=PKW(P0,8), pw1[1]=PKW(P0,10), pw1); \
    VRD(5); SBAR(); GAPA(C1=__builtin_amdgcn_mfma_f32_32x32x16_bf16(kf[3],qr[1],C1,0,0,0),   P0[14],P0[15],P1[0],P1[1],   pw1[2]=PKW(P0,12),pw1[3]=PKW(P0,14), pw1); \
    VRD(2); SBAR(); GAPA(C0=__builtin_amdgcn_mfma_f32_32x32x16_bf16(kf[4],qr[2],C0,0,0,0),   P1[2],P1[3],P1[4],P1[5],     pw2[0]=PKW(P1,0), pw2[1]=PKW(P1,2), pw2); \
    VRD(6); SBAR(); GAPA(C1=__builtin_amdgcn_mfma_f32_32x32x16_bf16(kf[5],qr[2],C1,0,0,0),   P1[6],P1[7],P1[8],P1[9],     pw2[2]=PKW(P1,4), pw2[3]=PKW(P1,6), pw2); \
    VRD(3); SBAR(); GAPA(C0=__builtin_amdgcn_mfma_f32_32x32x16_bf16(kf[6],qr[3],C0,0,0,0),   P1[10],P1[11],P1[12],P1[13], pw3[0]=PKW(P1,8), pw3[1]=PKW(P1,10), pw3); \
    VRD(7); SBAR(); GAPA(C1=__builtin_amdgcn_mfma_f32_32x32x16_bf16(kf[7],qr[3],C1,0,0,0),   P1[14],P1[15],0.f,0.f,       pw3[2]=PKW(P1,12),pw3[3]=PKW(P1,14), pw3); \
    C0=__builtin_amdgcn_mfma_f32_32x32x16_bf16(kf[8],qr[4],C0,0,0,0); C1=__builtin_amdgcn_mfma_f32_32x32x16_bf16(kf[9],qr[4],C1,0,0,0); SBAR(); \
    l_reg+=sacc; \
    if(GK){DMA_K((t)+3,sl_cur);} if(GV){DMA_V((t)+1,sl_next);} \
    CMASK(C0,C1,t); \
    if constexpr(!GUARD){ resc=false; } else { float a=MX3(C0[0],C0[1],C1[0]),b=MX3(C0[2],C0[3],C1[1]); a=MX3(a,C1[2],C1[3]); \
      _Pragma("unroll") for(int r=4;r<16;r+=4){a=MX3(a,C0[r],C0[r+1]);b=MX3(b,C0[r+2],C0[r+3]);a=MX3(a,C1[r],C1[r+1]);b=MX3(b,C1[r+2],C1[r+3]);} \
      float rm=__builtin_fmaxf(a,b); { auto rr=__builtin_amdgcn_permlane32_swap(__float_as_uint(rm),__float_as_uint(rm),false,false); rm=__builtin_fmaxf(__uint_as_float(rr[0]),__uint_as_float(rr[1])); } \
      resc=false; \
      if(__builtin_expect(__any(rm>(float)THRL),0)){ const float dl=__builtin_fmaxf(rm,0.f); mhat+=dl; \
        _Pragma("unroll") for(int r=0;r<16;++r){C0[r]-=dl;C1[r]-=dl;} \
        set_m(qr[4],-mhat,hi); asm volatile("":"+v"(qr[4])); \
        const float f=__builtin_amdgcn_exp2f(-dl); l_reg*=f; if(hi==0)wsf[r32]=f; resc=true; } } \
    SBAR(); \
    GAPB(o[0]=__builtin_amdgcn_mfma_f32_32x32x16_bf16(PAF(0),VFR(0),o[0],0,0,0), C0,0); \
    GAPB(o[1]=__builtin_amdgcn_mfma_f32_32x32x16_bf16(PAF(0),VFR(4),o[1],0,0,0), C0,4); \
    KRD(GL,0); GAPB(o[0]=__builtin_amdgcn_mfma_f32_32x32x16_bf16(PAF(1),VFR(1),o[0],0,0,0), C0,8); \
    KRD(GL,1); GAPB(o[1]=__builtin_amdgcn_mfma_f32_32x32x16_bf16(PAF(1),VFR(5),o[1],0,0,0), C0,12); \
    KRD(GL,2); GAPB(o[0]=__builtin_amdgcn_mfma_f32_32x32x16_bf16(PAF(2),VFR(2),o[0],0,0,0), C1,0); \
    KRD(GL,3); GAPB(o[1]=__builtin_amdgcn_mfma_f32_32x32x16_bf16(PAF(2),VFR(6),o[1],0,0,0), C1,4); \
    KRD(GL,4); GAPB(o[0]=__builtin_amdgcn_mfma_f32_32x32x16_bf16(PAF(3),VFR(3),o[0],0,0,0), C1,8); \
    GAPB(o[1]=__builtin_amdgcn_mfma_f32_32x32x16_bf16(PAF(3),VFR(7),o[1],0,0,0), C1,12); \
    }while(0)
  int t=1;
  #undef CMASK
  #define CMASK(P0,P1,t) do{}while(0)
  for(;t+5<NT;t+=2){
    STEP(pB0,pB1,pA0,pA1,t,true,true,true);     WAIT_BAR(3); RESC(); ROT();
    STEP(pA0,pA1,pB0,pB1,t+1,true,true,true);   WAIT_BAR(3); RESC(); ROT();
  }
  #undef CMASK
  #define CMASK(P0,P1,t) do{int jb_=(t)-(NT-4); if(jb_>=0)cmask(P0,P1,jb_,qrel,hi);}while(0)
  #define ENDW(tt) do{ if((tt)+3<NT){WAIT_BAR(3);} else if((tt)+2<NT){WAIT_BAR(1);} else {WAIT_BAR(0);} }while(0)
  for(;t+1<NT;t+=2){
    STEP(pB0,pB1,pA0,pA1,t,(t+3<NT),(t+1<NT),(t+1<NT));       ENDW(t);   RESC(); ROT();
    STEP(pA0,pA1,pB0,pB1,t+1,(t+4<NT),(t+2<NT),(t+2<NT));     ENDW(t+1); RESC(); ROT();
  }
  STEP(pB0,pB1,pA0,pA1,NT-1,false,false,false); RESC();
  { float sacc=pB0[0]+pB0[1]; _Pragma("unroll") for(int r=2;r<16;++r)sacc+=pB0[r]; _Pragma("unroll") for(int r=0;r<16;++r)sacc+=pB1[r]; l_reg+=sacc;
    pw0=(u32x4){PKW(pB0,0),PKW(pB0,2),PKW(pB0,4),PKW(pB0,6)};pw1=(u32x4){PKW(pB0,8),PKW(pB0,10),PKW(pB0,12),PKW(pB0,14)};pw2=(u32x4){PKW(pB1,0),PKW(pB1,2),PKW(pB1,4),PKW(pB1,6)};pw3=(u32x4){PKW(pB1,8),PKW(pB1,10),PKW(pB1,12),PKW(pB1,14)};
    SBAR(); pv(o,vb0+sl_cur,PAF(0),PAF(1),PAF(2),PAF(3)); }
  #undef PKW
  #undef PAF
  #undef VFR
  #undef PIN
  #undef MX3
  #undef GAPA
  #undef GAPB
  #undef EX
  #undef VRD
  #undef KRD
  #undef STEP
  #undef ENDW
  unsigned nxt_tk=0u; if(tid==0)nxt_tk=__hip_atomic_fetch_add(qctr,1u,__ATOMIC_RELAXED,__HIP_MEMORY_SCOPE_AGENT);
  {auto rr=__builtin_amdgcn_permlane32_swap(__float_as_uint(l_reg),__float_as_uint(l_reg),false,false);l_reg=__uint_as_float(rr[0])+__uint_as_float(rr[1]);}
  if(hi==0)wsf[32+r32]=l_reg;asm volatile("s_waitcnt lgkmcnt(0)":::"memory");
  float rli[16];
  #pragma unroll
  for(int r=0;r<16;++r)rli[r]=__builtin_amdgcn_rcpf(wsf[32+crow(r,hi)]);
  { unsigned char*stg=(unsigned char*)(shm+LDS_OST)+wid*2048;
    #pragma unroll
    for(int r=0;r<16;++r){const int orow=crow(r,hi); const float sc=rli[r]*32.0f;
      const unsigned pkd=(unsigned)__builtin_amdgcn_cvt_pk_fp8_f32(o[0][r]*sc,o[1][r]*sc,0,false);
      stg[orow*64+r32]=(unsigned char)(pkd&0xffu); stg[orow*64+32+r32]=(unsigned char)((pkd>>8)&0xffu);}
    asm volatile("s_waitcnt lgkmcnt(0)":::"memory");
    unsigned char*Ow8=(unsigned char*)O+(rowbase+q0+wid*QBLK)*DM+h*D;
    #pragma unroll
    for(int i=0;i<2;++i){const int row=i*16+(lane>>2),ch=lane&3; const u32x4 v=*(const u32x4*)(stg+row*64+ch*16); ATTN_STORE16(Ow8+(long)row*DM+ch*16,v);} }
  if(tid==0)*tkslot=nxt_tk;
  asm volatile("s_waitcnt lgkmcnt(0)\n\ts_barrier":::"memory");
  #undef DMA_K
  #undef DMA_V
  #undef CMASK
  #undef START
  #undef RESC
  #undef ROT
}
constexpr int ATTN_LDS_BYTES=LDS_BYTES;
struct AttnTensors { const bf16* Q; const bf16* K; const bf16* V; bf16* O; const bf16* QX; const bf16* KX; const float* DG; };
struct AttnUnit { int bh; int qb; };
struct StaticOrder {
  int vcu, G;
  __device__ __forceinline__ explicit StaticOrder(int grid,int block):vcu((grid%8==0)?(block%8)*(grid/8)+block/8:block),G(grid){}
  __device__ __forceinline__ bool next(int i,AttnUnit&u)const{
    if(G==256){ if(i>=8)return false; const int s=vcu&1,p=i>>1,j=i&1; u.bh=vcu>>1; u.qb=4*p+(j?3-s:s); return true; }
    const int L=i*G+vcu; if(L>=BATCH*NHEAD*NQB)return false; u.bh=L%(BATCH*NHEAD); u.qb=NQB-1-L/(BATCH*NHEAD); return true; }
  __device__ __forceinline__ void a_ready(const AttnUnit&)const{}
  __device__ __forceinline__ void done(const AttnUnit&)const{}
};
template<int THRL=8> __device__ __forceinline__ void attn_phase(char*lds,const AttnTensors&T,unsigned*qctr,const unsigned char*ts_glob){
  unsigned*tkslot=(unsigned*)(lds+LDS_BYTES); unsigned char*tstab=(unsigned char*)(lds+LDS_BYTES+64);
  { const int tid=threadIdx.x; ((unsigned*)tstab)[tid]=((const unsigned*)ts_glob)[tid];
    if(tid==0)*tkslot=__hip_atomic_fetch_add(qctr,1u,__ATOMIC_RELAXED,__HIP_MEMORY_SCOPE_AGENT); }
  __syncthreads();
  for(;;){ const unsigned u=(unsigned)__builtin_amdgcn_readfirstlane((int)*(volatile __attribute__((address_space(3))) unsigned*)tkslot); if(u>=(unsigned)(BATCH*NHEAD*NQB))break;
    const int qb=NQB-1-(int)(u>>7), bh=(int)(u&127); const int tsv=__builtin_amdgcn_readfirstlane((int)tstab[bh*NQB+qb]); const int ts=tsv&~1;
    if(tsv&1) attn_unit<THRL,true>(bh/NHEAD,bh%NHEAD,qb,T.Q,T.K,T.V,T.O,T.QX,T.KX,T.DG,lds,ts,qctr,tkslot);
    else      attn_unit<THRL,false>(bh/NHEAD,bh%NHEAD,qb,T.Q,T.K,T.V,T.O,T.QX,T.KX,T.DG,lds,ts,qctr,tkslot); }
  __syncthreads();
}
#undef SBAR
#undef WAIT_BAR
}

constexpr int NWAVES = 8;
#ifndef MK_N_LAUNCHES
#define MK_N_LAUNCHES 1
#endif
constexpr int BATCH = 8, T = 4096, D = 1024, M = BATCH * T;
constexpr int A_H = 16, A_RQ = 256, A_RKV = 128, IDX_H = 8, IDX_D = 64, A_INW = 456, TOPK = 256;
constexpr int B_INW = 3088;
constexpr int NEXP = 32, MOE_K = 4, DEXP = 1024;
constexpr int NPAIR = M * MOE_K;
constexpr int MAXSLOT = NPAIR + NEXP * 256;
constexpr float LN_EPS = 1e-5f, RMS_EPS = 1e-6f;
constexpr float DN_ALPHA = 1.41421356237309515f;
constexpr float LOG2E = 1.4426950408889634f;
constexpr int N_PHASES = 19;

constexpr size_t MiB = 1u << 20;
constexpr size_t WS_CTL = 0, CTL_ZERO_BYTES = 1 * MiB;
constexpr size_t WS_SMALL = 1 * MiB;
constexpr size_t WS_WAIN = 2 * MiB, WS_WACQ = 3 * MiB, WS_WAO = 5 * MiB, WS_WBIN = 9 * MiB, WS_WBO = 15 * MiB;
constexpr size_t WS_PAR = 18 * MiB;
constexpr int PAR_REL = 0, PAR_AGQ = 512, PAR_AGKV = 768, PAR_AGKI = 896, PAR_ABKI = 960, PAR_BF = 1024, PAR_BROUT = 1088, PAR_LN = 2048  ,
              PAR_WROUT = 16384  , PAR_WF = 81920  , PAR_BGU = 98304  , PAR_BDOWN = 229376  , PAR_END = 294912;
static_assert((size_t)PAR_END * 4 <= 2 * MiB, "parameter copies");
constexpr size_t WS_TOKE = 20 * MiB;
constexpr size_t WS_WGU = 32 * MiB, WS_WD = 288 * MiB;
constexpr size_t WS_XF = 416 * MiB, WS_XB = 544 * MiB;
constexpr size_t WS_PROJ = 608 * MiB, WS_CQN = 672 * MiB, WS_CKV = 688 * MiB, WS_KIDX = 696 * MiB, WS_WIDX = 700 * MiB, WS_BKT = 701 * MiB  , WS_SEL = 712 * MiB  ,
                 WS_QIDX = 736 * MiB, WS_QLAT = 768 * MiB, WS_OLAT = 896 * MiB;
constexpr size_t WS_Q = 608 * MiB, WS_K = 672 * MiB, WS_V = 736 * MiB, WS_LOGF = 800 * MiB, WS_QX = 802 * MiB, WS_KX = 818 * MiB, WS_O = 834 * MiB, WS_CUM2 = 898 * MiB  , WS_KMAX = 900 * MiB  , WS_TS = 901 * MiB  , WS_DG = 902 * MiB  ;
constexpr size_t WS_TOPE = 1024 * MiB, WS_TOPG = 1025 * MiB, WS_POS = 1026 * MiB, WS_SLOT = 1027 * MiB, WS_TOK = 1027 * MiB + 512 * 1024  ;
constexpr size_t WS_XG = 1028 * MiB, WS_H = 1300 * MiB, WS_Y = 1572 * MiB  , WS_XB8 = 1700 * MiB  , WS_END = 1732 * MiB;
constexpr float F8_XS = 8.f, F8_WGS = 512.f, F8_HS = 4.f, F8_WDS = 1024.f, F8_WBINS = 512.f, F8_OLS = 32.f, F8_WAOS = 1024.f, F8_YS = 32.f, F8_OS = 32.f, F8_WBOS = 1024.f, F8_HYS = 64.f;
static_assert((size_t)MAXSLOT * 1024 * 2 <= 272 * MiB, "slot buffers");
constexpr int CW_TMO = 0, CW_CODE = 1;
constexpr int CW_BAR = 4096;
constexpr int CW_CMAX = 20416;
constexpr int CW_QMAX = 20480, CW_MNEG = 22528, CW_ATTQ = 24576;
constexpr int CW_CNT = 16384;
constexpr int SM_NT = 0, SM_TILE_E = 64;
constexpr int RING_OFF = 0, RING_BYTES = 131072;
constexpr int LDS_BYTES = 147456;
constexpr int MISC_OFF = LDS_BYTES - 256;
#define GAS __attribute__((address_space(1)))
#define LAS __attribute__((address_space(3)))
typedef unsigned short bf16;
typedef unsigned v4u __attribute__((ext_vector_type(4)));
typedef float f32x4 __attribute__((ext_vector_type(4)));
typedef short bf16x8 __attribute__((ext_vector_type(8)));
typedef GAS unsigned gu32;
typedef GAS unsigned long long gu64;
#define RLX_AGENT __ATOMIC_RELAXED, __HIP_MEMORY_SCOPE_AGENT
#define LDS_WAIT() asm volatile("s_waitcnt lgkmcnt(0)" ::: "memory")
#define VM_WAIT() asm volatile("s_waitcnt vmcnt(0)" ::: "memory")
__device__ __forceinline__ unsigned long long rt() { return __builtin_amdgcn_s_memrealtime(); }
__device__ __forceinline__ unsigned f2bf(float f) { unsigned u = __builtin_bit_cast(unsigned, f); return (u + 0x7fffu + ((u >> 16) & 1u)) >> 16; }
__device__ __forceinline__ unsigned pk2(float lo, float hi) { return f2bf(lo) | (f2bf(hi) << 16); }

#define XB_TMO      128
#define XB_XCNT(j)  (256  + 64 * (j))
#define XB_XSUB(j)  (1280 + 64 * (j))
#define XB_XGEN(j)  (2304 + 64 * (j))
#define XB_TOP      3328
#define XB_TOPGEN   3392
#define XCD_BAR_WORDS 3456
#define XB_SPIN_CAP (1u << 18)

__device__ __forceinline__ unsigned xb_ld(unsigned* p)              { return __hip_atomic_load(p, __ATOMIC_RELAXED, __HIP_MEMORY_SCOPE_AGENT); }
__device__ __forceinline__ unsigned xb_add(unsigned* p, unsigned v) { return __hip_atomic_fetch_add(p, v, __ATOMIC_RELAXED, __HIP_MEMORY_SCOPE_AGENT); }
__device__ __forceinline__ unsigned xb_xcc_id() { return (unsigned)__builtin_amdgcn_s_getreg((3 << 11) | 20) & 0xFu; }
#define XB_SPIN(cond, bar) do { unsigned _sp = 0; while (cond) { __builtin_amdgcn_s_sleep(1); \
    if ((++_sp & 255u) == 0u) { if (xb_ld(&(bar)[XB_TMO])) break; if (_sp > XB_SPIN_CAP) { atomicAdd(&(bar)[XB_TMO], 1u); break; } } } } while (0)

struct XcdBarrier {
    unsigned* bar; unsigned x;
    volatile LAS unsigned* st;
};

__device__ __forceinline__ XcdBarrier xcd_barrier_post(unsigned* bar, volatile LAS unsigned* st) {
    XcdBarrier b; b.bar = bar; b.x = xb_xcc_id(); b.st = st;
    if (threadIdx.x == 0) (void)xb_add(&bar[XB_XCNT(b.x)], 1u);
    return b;
}
__device__ __forceinline__ void xcd_barrier_complete(unsigned* bar, unsigned x, unsigned& nloc, unsigned& nx) {
    const unsigned G = gridDim.x * gridDim.y * gridDim.z;
    unsigned sum, cnt, mine, sp = 0u;
    for (;;) {
        sum = 0u; cnt = 0u; mine = 0u;
#pragma unroll
        for (unsigned j = 0; j < 16; ++j) { const unsigned c = xb_ld(&bar[XB_XCNT(j)]); sum += c; cnt += (c > 0u) ? 1u : 0u; mine = (j == x) ? c : mine; }
        if (sum == G) break;
        __builtin_amdgcn_s_sleep(1);
        if ((++sp & 255u) == 0u) { if (xb_ld(&bar[XB_TMO])) break; if (sp > XB_SPIN_CAP) { atomicAdd(&bar[XB_TMO], 1u); break; } }
    }
    nloc = mine > 0u ? mine : 1u; nx = cnt > 0u ? cnt : 1u;
}

__device__ __forceinline__ void xcd_barrier(const XcdBarrier& b) {
    asm volatile("s_waitcnt vmcnt(0)" ::: "memory");
    __syncthreads();
    if (threadIdx.x == 0) {
        unsigned* bar = b.bar;
        __builtin_amdgcn_s_waitcnt(0);
        unsigned nloc = b.st[0], nx = b.st[1];
        if (nloc == 0u) { xcd_barrier_complete(bar, b.x, nloc, nx); b.st[0] = nloc; b.st[1] = nx; }
        const unsigned old = xb_add(&bar[XB_XSUB(b.x)], 1u);
        const unsigned gen = old / nloc;
        if (old + 1u == (gen + 1u) * nloc) {
            __builtin_amdgcn_fence(__ATOMIC_RELEASE, "agent");
            asm volatile("s_waitcnt vmcnt(0)" ::: "memory");
            const unsigned og = xb_add(&bar[XB_TOP], 1u);
            const unsigned tg = og / nx;
            if (og + 1u == (tg + 1u) * nx) xb_add(&bar[XB_TOPGEN], 1u);
            else XB_SPIN(xb_ld(&bar[XB_TOPGEN]) == tg, bar);
            __builtin_amdgcn_fence(__ATOMIC_ACQUIRE, "agent");
            xb_add(&bar[XB_XGEN(b.x)], 1u);
            asm volatile("s_waitcnt vmcnt(0)" ::: "memory");
        } else {
            XB_SPIN(xb_ld(&bar[XB_XGEN(b.x)]) == gen, bar);
            __builtin_amdgcn_fence(__ATOMIC_ACQUIRE, "agent");
            asm volatile("s_waitcnt vmcnt(0)" ::: "memory");
        }
    }
    __syncthreads();
}

struct Frame {
    LAS unsigned char* lds;
    volatile LAS unsigned* MISC;
    gu32* ctl;
    int vcu, G;
    unsigned char* ws;
};
__device__ __forceinline__ int opaque_tid() { int t = threadIdx.x; asm volatile("" : "+v"(t)); return t; }
#define PHASE_IDS() const int tid = opaque_tid(), lane = tid & 63, wave = __builtin_amdgcn_readfirstlane(tid >> 6); (void)lane; (void)wave
typedef float f32x2 __attribute__((ext_vector_type(2)));
typedef unsigned u32x4 __attribute__((ext_vector_type(4)));
typedef unsigned u32x2 __attribute__((ext_vector_type(2)));
__device__ __forceinline__ float wave_sum(float x) {
    float v = x;
#define WS_STEP(ctrl, rmask) v += __builtin_bit_cast(float, __builtin_amdgcn_update_dpp(0, __builtin_bit_cast(int, v), ctrl, rmask, 0xf, false))
    WS_STEP(0x111, 0xf); WS_STEP(0x112, 0xf); WS_STEP(0x114, 0xf); WS_STEP(0x118, 0xf); WS_STEP(0x142, 0xa); WS_STEP(0x143, 0xc);
#undef WS_STEP
    return __builtin_bit_cast(float, __builtin_amdgcn_readlane(__builtin_bit_cast(int, v), 63));
}
__device__ __forceinline__ unsigned cvtpk(float lo, float hi) { typedef __bf16 bf2 __attribute__((ext_vector_type(2))); f32x2 v = {lo, hi}; bf2 b = __builtin_convertvector(v, bf2); return __builtin_bit_cast(unsigned, b); }
__device__ __forceinline__ float bf2f(unsigned short h) { return __uint_as_float((unsigned)h << 16); }

struct TrItem { const float* W; int ldw, nvalid, K; unsigned char* WT; int row_off, mode, f8; float fscale; int k0, n0; };
__device__ __forceinline__ void tr_load(const TrItem& t, f32x4 (&v)[8][2], int lane, int wave) {
#pragma unroll
    for (int i = 0; i < 8; ++i)
#pragma unroll
        for (int j = 0; j < 2; ++j) { const int n = t.n0 + 4 * lane + (t.f8 ? 0 : 256 * j); const int k = t.k0 + (t.f8 ? wave * 16 + 2 * i + j : wave * 8 + i);
            v[i][j] = (n < t.nvalid) ? __builtin_nontemporal_load((const f32x4*)(t.W + (size_t)k * t.ldw + n)) : (f32x4){0.f, 0.f, 0.f, 0.f}; }
}
__device__ __forceinline__ void tr_to_lds(const TrItem& t, const f32x4 (&v)[8][2], LAS float* scr, int lane, int wave) {
#pragma unroll
    for (int i = 0; i < 8; ++i)
#pragma unroll
        for (int j = 0; j < 2; ++j) { LAS float* d = t.f8 ? scr + (wave * 16 + 2 * i + j) * 257 + 4 * lane : scr + (wave * 8 + i) * 513 + 4 * lane + 256 * j; d[0] = v[i][j].x; d[1] = v[i][j].y; d[2] = v[i][j].z; d[3] = v[i][j].w; }
}
__device__ __forceinline__ void tr_store(const TrItem& t, LAS float* scr, int tid) {
    const int c = tid & 7;
    if (t.f8) {
        const float fs = t.fscale;
#pragma unroll
        for (int j = 0; j < 4; ++j) { const int n = (tid >> 3) + 64 * j; const LAS float* s = scr + (16 * c) * 257 + n;
            const int ng = t.n0 + n; int row;
            if (t.mode == 0) row = t.row_off + ng; else { const int np = ng & 1023; row = (np >> 7) * 256 + ((ng >> 10) << 7) + (np & 127); }
            v4u o; o.x = pg8::cvt4_fp8(s[0 * 257] * fs, s[1 * 257] * fs, s[2 * 257] * fs, s[3 * 257] * fs); o.y = pg8::cvt4_fp8(s[4 * 257] * fs, s[5 * 257] * fs, s[6 * 257] * fs, s[7 * 257] * fs);
            o.z = pg8::cvt4_fp8(s[8 * 257] * fs, s[9 * 257] * fs, s[10 * 257] * fs, s[11 * 257] * fs); o.w = pg8::cvt4_fp8(s[12 * 257] * fs, s[13 * 257] * fs, s[14 * 257] * fs, s[15 * 257] * fs);
            *(GAS v4u*)(t.WT + (size_t)row * t.K + t.k0 + 16 * c) = o; }
        return; }
#pragma unroll
    for (int j = 0; j < 8; ++j) { const int n = (tid >> 3) + 64 * j; const LAS float* s = scr + (8 * c) * 513 + n;
        const int ng = t.n0 + n; int row;
        if (t.mode == 0) row = t.row_off + ng; else { const int np = ng & 1023; row = (np >> 7) * 256 + ((ng >> 10) << 7) + (np & 127); }
        v4u o; o.x = pk2(s[0 * 513], s[1 * 513]); o.y = pk2(s[2 * 513], s[3 * 513]); o.z = pk2(s[4 * 513], s[5 * 513]); o.w = pk2(s[6 * 513], s[7 * 513]);
        *(GAS v4u*)(t.WT + ((size_t)row * t.K + t.k0 + 8 * c) * 2) = o; }
}
struct P0In { const float *x, *a_w_in, *a_w_uq, *a_w_uk, *a_w_uv, *a_w_qidx, *a_w_o, *b_w_in, *b_w_o, *w_gu, *w_down;
              const float *rel, *a_g_q, *a_g_kv, *a_g_kidx, *a_b_kidx, *b_b_f, *ln_mix_g, *ln_mix_b, *ln_ffn_g, *ln_ffn_b, *w_router, *b_router, *b_gu, *b_down; };
__device__ __forceinline__ void p0_copy(float* dst, const float* src, int n, int g0, int gs) { for (int i = g0; i < n; i += gs) dst[i] = src[i]; }
__device__ __forceinline__ void p0_prologue(Frame& F, const P0In& I) {
    PHASE_IDS();
    bf16* WAIN = (bf16*)(F.ws + WS_WAIN); bf16* WACQ = (bf16*)(F.ws + WS_WACQ); bf16* WAO = (bf16*)(F.ws + WS_WAO); bf16* WBIN = (bf16*)(F.ws + WS_WBIN); bf16* WBO = (bf16*)(F.ws + WS_WBO);
    bf16* WGU = (bf16*)(F.ws + WS_WGU); bf16* WD = (bf16*)(F.ws + WS_WD); bf16* XB = (bf16*)(F.ws + WS_XB);
#ifndef MK_P0_REP
#define MK_P0_REP 0
#endif
    for (int rep0 = 0; rep0 < 1 + (MK_P0_REP & 1); ++rep0)
    for (int it = F.vcu; it < 128 + 256; it += F.G) {
        if (it < 128) {
            const int h = it >> 3, rb = it & 7; const int rq = tid & 255, rs = wave >> 2;
            float q[64];
            const GAS f32x4* qp = (const GAS f32x4*)(I.a_w_uq + ((size_t)rq * A_H + h) * 64);
#pragma unroll
            for (int i = 0; i < 16; ++i) { const f32x4 v = qp[i]; q[4 * i] = v.x; q[4 * i + 1] = v.y; q[4 * i + 2] = v.z; q[4 * i + 3] = v.w; }
            for (int j = 0; j < 8; ++j) { const int r = rb * 16 + rs * 8 + j; const float* kp = I.a_w_uk + ((size_t)r * A_H + h) * 64; float s = 0.f;
#pragma unroll
                for (int d = 0; d < 64; ++d) s += q[d] * kp[d];
                WACQ[(size_t)(h * 128 + r) * 256 + rq] = (bf16)f2bf(s * (0.125f * LOG2E)); }
        } else {
            const int i2 = it - 128, h = i2 >> 4, nc = i2 & 15; LAS float* wo = (LAS float*)F.lds; LAS float* wuv = wo + 4096;
#pragma unroll
            for (int i = 0; i < 8; ++i) { const int idx = tid + 512 * i, d = idx >> 6, n = idx & 63; wo[idx] = I.a_w_o[(size_t)(h * 64 + d) * D + nc * 64 + n]; }
#pragma unroll
            for (int i = 0; i < 16; ++i) { const int idx = tid + 512 * i, r = idx >> 6, d = idx & 63; wuv[idx] = I.a_w_uv[((size_t)r * A_H + h) * 64 + d]; }
            LDS_WAIT(); __syncthreads();
            const int nl = tid & 63, rg = wave; float acc[16];
#pragma unroll
            for (int i = 0; i < 16; ++i) acc[i] = 0.f;
#pragma unroll 8
            for (int d = 0; d < 64; ++d) { const float w = wo[d * 64 + nl];
#pragma unroll
                for (int i = 0; i < 16; ++i) acc[i] += wuv[(rg * 16 + i) * 64 + d] * w; }
#pragma unroll
            for (int i = 0; i < 16; ++i) acc[i] *= F8_WAOS;
            v4u o0; o0.x = pg8::cvt4_fp8(acc[0], acc[1], acc[2], acc[3]); o0.y = pg8::cvt4_fp8(acc[4], acc[5], acc[6], acc[7]); o0.z = pg8::cvt4_fp8(acc[8], acc[9], acc[10], acc[11]); o0.w = pg8::cvt4_fp8(acc[12], acc[13], acc[14], acc[15]);
            *(GAS v4u*)((unsigned char*)WAO + (size_t)(nc * 64 + nl) * 2048 + h * 128 + rg * 16) = o0;
            __syncthreads();
        }
    }
    __syncthreads();
    LAS float* scr = (LAS float*)(F.lds + RING_OFF);
    constexpr int I_AIN = 16 * 1, I_QIDX = 4 * 1, I_BIN = 8 * 12, I_BO = 8 * 4, I_GU1 = 8 * 8, I_D1 = 8 * 4;
    constexpr int I_GU = 64 * I_GU1, I_DN = 64 * I_D1;
    constexpr int NITEMS = I_AIN + I_QIDX + I_BIN + I_BO + I_GU + I_DN;
    auto decode = [&](int it) -> TrItem {
        TrItem t; int r = it; t.mode = 0; t.f8 = 0; t.fscale = 1.f; t.row_off = 0;
        if (r < I_AIN) { t.W = I.a_w_in; t.ldw = A_INW; t.nvalid = A_INW; t.K = 1024; t.WT = (unsigned char*)WAIN; t.k0 = 64 * r; t.n0 = 0; return t; } r -= I_AIN;
        if (r < I_QIDX) { t.W = I.a_w_qidx; t.ldw = 512; t.nvalid = 512; t.K = 256; t.WT = (unsigned char*)WACQ; t.row_off = 2048; t.k0 = 64 * r; t.n0 = 0; return t; } r -= I_QIDX;
        if (r < I_BIN) { t.W = I.b_w_in; t.ldw = B_INW; t.nvalid = 3072; t.K = 1024; t.WT = (unsigned char*)WBIN; t.f8 = 1; t.fscale = F8_WBINS; t.k0 = 128 * (r / 12); t.n0 = 256 * (r % 12); return t; } r -= I_BIN;
        if (r < I_BO) { t.W = I.b_w_o; t.ldw = 1024; t.nvalid = 1024; t.K = 1024; t.WT = (unsigned char*)WBO; t.f8 = 1; t.fscale = F8_WBOS; t.k0 = 128 * (r / 4); t.n0 = 256 * (r % 4); return t; } r -= I_BO;
        if (r < I_GU) { const int mi = r / I_GU1, rr = r % I_GU1; t.W = I.w_gu + (size_t)mi * 1024 * 2048; t.ldw = 2048; t.nvalid = 2048; t.K = 1024; t.WT = (unsigned char*)WGU + (size_t)mi * 2048 * 1024; t.mode = 1; t.f8 = 1; t.fscale = F8_WGS;
            t.k0 = 128 * (rr / 8); t.n0 = 256 * (rr % 8); return t; } r -= I_GU;
        { const int mi = r / I_D1, rr = r % I_D1; t.W = I.w_down + (size_t)mi * 1024 * 1024; t.ldw = 1024; t.nvalid = 1024; t.K = 1024; t.WT = (unsigned char*)WD + (size_t)mi * 1024 * 1024; t.f8 = 1; t.fscale = F8_WDS;
            t.k0 = 128 * (rr / 4); t.n0 = 256 * (rr % 4); return t; }
    };
    for (int rep1 = 0; rep1 < 1 + ((MK_P0_REP >> 1) & 1); ++rep1) {
        f32x4 v[8][2]; int it = F.vcu;
        if (it < NITEMS) { const TrItem t0 = decode(it); tr_load(t0, v, lane, wave); }
        for (; it < NITEMS; it += F.G) {
            const TrItem t = decode(it);
            tr_to_lds(t, v, scr, lane, wave);
            LDS_WAIT(); __syncthreads();
            if (it + F.G < NITEMS) { const TrItem tn = decode(it + F.G); tr_load(tn, v, lane, wave); }
            tr_store(t, scr, tid);
            LDS_WAIT(); __syncthreads();
        }
    }
    { float* PAR = (float*)(F.ws + WS_PAR); const int g0 = F.vcu * 512 + tid, gs = F.G * 512;
      p0_copy(PAR + PAR_REL, I.rel, 512, g0, gs); p0_copy(PAR + PAR_AGQ, I.a_g_q, 256, g0, gs); p0_copy(PAR + PAR_AGKV, I.a_g_kv, 128, g0, gs); p0_copy(PAR + PAR_AGKI, I.a_g_kidx, 64, g0, gs);
      p0_copy(PAR + PAR_ABKI, I.a_b_kidx, 64, g0, gs); p0_copy(PAR + PAR_BF, I.b_b_f, 16, g0, gs); p0_copy(PAR + PAR_BROUT, I.b_router, 64, g0, gs);
      p0_copy(PAR + PAR_LN, I.ln_mix_g, 2048, g0, gs); p0_copy(PAR + PAR_LN + 2048, I.ln_mix_b, 2048, g0, gs); p0_copy(PAR + PAR_LN + 4096, I.ln_ffn_g, 2048, g0, gs); p0_copy(PAR + PAR_LN + 6144, I.ln_ffn_b, 2048, g0, gs);
      p0_copy(PAR + PAR_WROUT, I.w_router, 65536, g0, gs); p0_copy(PAR + PAR_BGU, I.b_gu, 131072, g0, gs); p0_copy(PAR + PAR_BDOWN, I.b_down, 65536, g0, gs);
      for (int i = g0; i < 16384; i += gs) PAR[PAR_WF + i] = I.b_w_in[(size_t)(i >> 4) * B_INW + 3072 + (i & 15)]; }
    { const size_t n8 = (size_t)M * D / 8; const size_t g0 = (size_t)F.vcu * 512 + tid, gs = (size_t)F.G * 512;
      for (int rep2 = 0; rep2 < 1 + ((MK_P0_REP >> 2) & 1); ++rep2)
      for (size_t i = g0; i < n8; i += 4 * gs) { f32x4 a[4], b[4];
#pragma unroll
          for (int q = 0; q < 4; ++q) { const size_t ii = i + q * gs; if (ii < n8) { const GAS f32x4* p = (const GAS f32x4*)(I.x + ii * 8); a[q] = __builtin_nontemporal_load(p); b[q] = __builtin_nontemporal_load(p + 1); } }
#pragma unroll
          for (int q = 0; q < 4; ++q) { const size_t ii = i + q * gs; if (ii < n8) { v4u o; o.x = pk2(a[q].x, a[q].y); o.y = pk2(a[q].z, a[q].w); o.z = pk2(b[q].x, b[q].y); o.w = pk2(b[q].z, b[q].w); *(GAS v4u*)(XB + ii * 8) = o; } } } }
}

__device__ __forceinline__ void p_dsa_norms(Frame& F, const float* g_q, const float* g_kv, const float* g_kidx, const float* b_kidx) {
    PHASE_IDS();
    const float* PROJ = (const float*)(F.ws + WS_PROJ); bf16* CQN = (bf16*)(F.ws + WS_CQN); bf16* CKV = (bf16*)(F.ws + WS_CKV); bf16* KIDX = (bf16*)(F.ws + WS_KIDX); float* WIDX = (float*)(F.ws + WS_WIDX);
    const int l = lane; const int gw = F.vcu * NWAVES + wave, NGW = F.G * NWAVES;
    const f32x4 gq = *(const f32x4*)(g_q + 4 * l); const f32x2 gkv = *(const f32x2*)(g_kv + 2 * l); const float gki = g_kidx[l], bki = b_kidx[l];
    float cmx = 0.f;
    f32x4 cq_n = {0.f, 0.f, 0.f, 0.f}; f32x2 ckv_n = {0.f, 0.f}; float ki_n = 0.f, wi_n = 0.f;
    if (gw < M) { const float* p = PROJ + (size_t)gw * 512; cq_n = *(const f32x4*)(p + 4 * l); ckv_n = *(const f32x2*)(p + 256 + 2 * l); ki_n = p[384 + l]; wi_n = p[448 + (l & 7)]; }
    for (int row = gw; row < M; row += NGW) {
        const f32x4 cq = cq_n; const f32x2 ckv = ckv_n; const float ki = ki_n; const float wi = wi_n;
        if (row + NGW < M) { const float* p = PROJ + (size_t)(row + NGW) * 512; cq_n = *(const f32x4*)(p + 4 * l); ckv_n = *(const f32x2*)(p + 256 + 2 * l); ki_n = p[384 + l]; wi_n = p[448 + (l & 7)]; }
        const float rq = 1.0f / sqrtf(wave_sum(cq.x * cq.x + cq.y * cq.y + cq.z * cq.z + cq.w * cq.w) * (1.0f / 256.0f) + RMS_EPS);
        const float rkv = 1.0f / sqrtf(wave_sum(ckv.x * ckv.x + ckv.y * ckv.y) * (1.0f / 128.0f) + RMS_EPS);
        const float mean = wave_sum(ki) * (1.0f / 64.0f); const float dk = ki - mean; const float rki = 1.0f / sqrtf(wave_sum(dk * dk) * (1.0f / 64.0f) + LN_EPS);
        u32x2 oq; oq.x = cvtpk(cq.x * rq * gq.x, cq.y * rq * gq.y); oq.y = cvtpk(cq.z * rq * gq.z, cq.w * rq * gq.w);
        *(GAS u32x2*)(CQN + (size_t)row * 256 + 4 * l) = oq;
        const float c0 = ckv.x * rkv * gkv.x, c1 = ckv.y * rkv * gkv.y;
        *(GAS unsigned*)(CKV + (size_t)row * 128 + 2 * l) = cvtpk(c0, c1);
        cmx = fmaxf(cmx, wave_sum(c0 * c0 + c1 * c1));
        KIDX[(size_t)row * 64 + l] = (bf16)f2bf(dk * rki * gki + bki);
        if (l < 8) WIDX[(size_t)row * 8 + l] = wi * 0.04419417382415922f;
    }
    if (l == 0) __hip_atomic_fetch_max(F.ctl + CW_CMAX, __float_as_uint(sqrtf(cmx)), __ATOMIC_RELAXED, __HIP_MEMORY_SCOPE_AGENT);
}

__device__ __forceinline__ int t5_bucket(int n) {
    if (n < 16) return n; if (n >= 128) return 31;
    const int v = 16 + (int)(__builtin_amdgcn_logf((float)n * 0.0625f) * (16.0f / 3.0f));
    return v < 31 ? v : 31;
}
__device__ __forceinline__ unsigned fkey(float f) { const unsigned u = __float_as_uint(f); return (u & 0x80000000u) ? ~u : (u | 0x80000000u); }
__device__ __forceinline__ int popc64(unsigned long long m) { return __builtin_popcountll(m); }
__device__ __forceinline__ int mbcnt(unsigned long long m) { return (int)__builtin_amdgcn_mbcnt_hi((unsigned)(m >> 32), __builtin_amdgcn_mbcnt_lo((unsigned)m, 0u)); }
typedef float f32x16 __attribute__((ext_vector_type(16)));
typedef unsigned short u16x2 __attribute__((ext_vector_type(2)));
__device__ __forceinline__ int wave_total_i(int x) {
    int v = x;
    v += __builtin_amdgcn_update_dpp(0, v, 0x111, 0xf, 0xf, false);
    v += __builtin_amdgcn_update_dpp(0, v, 0x112, 0xf, 0xf, false);
    v += __builtin_amdgcn_update_dpp(0, v, 0x114, 0xf, 0xf, false);
    v += __builtin_amdgcn_update_dpp(0, v, 0x118, 0xf, 0xf, false);
    v += __builtin_amdgcn_update_dpp(0, v, 0x142, 0xa, 0xf, false);
    v += __builtin_amdgcn_update_dpp(0, v, 0x143, 0xc, 0xf, false);
    return __builtin_amdgcn_readlane(v, 63);
}
#ifndef MK_IDX_REP
#define MK_IDX_REP 0
#endif
#ifndef MK_CHECK_SEL
#define MK_CHECK_SEL 0
#endif
__device__ __forceinline__ void select_top256(const unsigned (&u)[64], int nj, int l, LAS unsigned short* selst, LAS unsigned* cand  ) {
    constexpr int SEL_CAP = 1024;
    unsigned pk[32];
#pragma unroll
    for (int p = 0; p < 32; ++p) pk[p] = (u[2 * p] >> 17) | ((u[2 * p + 1] >> 1) & 0xffff0000u);
    const int ngrp = (nj + 7) >> 3; const int nconsidered = ngrp * 512;
    auto count_ge = [&](unsigned c) -> int {
        const u16x2 cpk = __builtin_bit_cast(u16x2, c * 0x10001u); u16x2 acc = {0, 0};
#pragma unroll
        for (int jb = 0; jb < 8; ++jb) { if (jb < ngrp) {
#pragma unroll
            for (int q = 0; q < 4; ++q) { const u16x2 d = __builtin_bit_cast(u16x2, pk[4 * jb + q]) - cpk; acc += (d >> (unsigned short)15); } } }
        const unsigned a = __builtin_bit_cast(unsigned, acc);
        return nconsidered - wave_total_i((int)((a & 0xffffu) + (a >> 16)));
    };
    unsigned P = 0u;
    for (int bit = 14; bit >= 0; --bit) { const unsigned c = P | (1u << bit); if (count_ge(c) >= TOPK) P = c; }
    const int c_above = count_ge(P + 1u); const int need = TOPK - c_above;
    int off = 0, coff = 0;
#pragma unroll
    for (int j = 0; j < 64; ++j) { if ((j >> 3) < ngrp) {
        const unsigned k15 = u[j] >> 17; const unsigned long long m1 = __ballot(k15 > P), mc = __ballot(k15 == P);
        if (k15 > P) selst[off + mbcnt(m1)] = (unsigned short)(j * 64 + l);
        off += popc64(m1);
        if (mc != 0ull) { if (k15 == P) { const int pos = coff + mbcnt(mc); if (pos < SEL_CAP) { cand[pos] = u[j]; cand[SEL_CAP + pos] = (unsigned)(j * 64 + l); } } coff += popc64(mc); } }
        __builtin_amdgcn_sched_barrier(0); }
    LDS_WAIT(); asm volatile("" ::: "memory");
    const int ncand = coff;
    if (ncand == need && ncand <= SEL_CAP) { for (int i = l; i < ncand; i += 64) selst[c_above + i] = (unsigned short)cand[SEL_CAP + i]; }
    else if (ncand <= 256) {
        unsigned mk[4], mi[4]; int rk[4];
#pragma unroll
        for (int r = 0; r < 4; ++r) { const int i = l + 64 * r; const bool v = i < ncand; mk[r] = v ? cand[i] : 0u; mi[r] = v ? cand[SEL_CAP + i] : 0xffffffffu; rk[r] = 0; }
        for (int c2 = 0; c2 < ncand; ++c2) { const unsigned k2 = cand[c2], i2 = cand[SEL_CAP + c2];
#pragma unroll
            for (int r = 0; r < 4; ++r) rk[r] += (k2 > mk[r] || (k2 == mk[r] && i2 < mi[r])) ? 1 : 0; }
#pragma unroll
        for (int r = 0; r < 4; ++r) { if (l + 64 * r < ncand && rk[r] < need) selst[c_above + rk[r]] = (unsigned short)mi[r]; }
    } else {
        unsigned Tk = P << 17;
        for (int bit = 16; bit >= 0; --bit) { const unsigned cd = Tk | (1u << bit); int cnt = 0;
#pragma unroll
            for (int j = 0; j < 64; ++j) cnt += (u[j] >= cd) ? 1 : 0;
            if (wave_total_i(cnt) >= TOPK) Tk = cd; }
        int cg = 0;
#pragma unroll
        for (int j = 0; j < 64; ++j) cg += (u[j] > Tk && (u[j] >> 17) == P) ? 1 : 0;
        const int ngt = wave_total_i(cg); const int need2 = need - ngt; int o2 = c_above, t2 = 0;
        unsigned Tk2 = Tk, P2 = P; asm volatile("" : "+s"(Tk2), "+s"(P2));
#pragma unroll
        for (int j = 0; j < 64; ++j) { const bool isc = (u[j] >> 17) == P2; const unsigned long long m1 = __ballot(isc && u[j] > Tk2), m2 = __ballot(isc && u[j] == Tk2);
            if (isc && u[j] > Tk2) selst[o2 + mbcnt(m1)] = (unsigned short)(j * 64 + l);
            if (isc && u[j] == Tk2) { const int rk2 = t2 + mbcnt(m2); if (rk2 < need2) selst[c_above + ngt + rk2] = (unsigned short)(j * 64 + l); }
            o2 += popc64(m1); t2 += popc64(m2); __builtin_amdgcn_sched_barrier(0); }
    }
    LDS_WAIT(); asm volatile("" ::: "memory");
}
#if MK_CHECK_SEL
__device__ __forceinline__ void select_ref(const unsigned (&u)[64], int l, LAS unsigned short* selst) {
    unsigned Tk = 0u;
    for (int bit = 31; bit >= 0; --bit) { const unsigned cand = Tk | (1u << bit); int cnt = 0;
#pragma unroll
        for (int j = 0; j < 64; ++j) cnt += popc64(__ballot(u[j] >= cand));
        if (cnt >= TOPK) Tk = cand; }
    int cgt = 0;
#pragma unroll
    for (int j = 0; j < 64; ++j) cgt += popc64(__ballot(u[j] > Tk));
    const int need = TOPK - cgt; int off = 0, toff = 0;
#pragma unroll
    for (int j = 0; j < 64; ++j) { const unsigned long long m1 = __ballot(u[j] > Tk), m2 = __ballot(u[j] == Tk);
        if (u[j] > Tk) selst[off + mbcnt(m1)] = (unsigned short)(j * 64 + l);
        if (u[j] == Tk) { const int rk = toff + mbcnt(m2); if (rk < need) selst[cgt + rk] = (unsigned short)(j * 64 + l); }
        off += popc64(m1); toff += popc64(m2); }
    LDS_WAIT(); asm volatile("" ::: "memory");
}
#endif
__device__ __forceinline__ int wave_scan_i(int x) {
    int v = x;
    v += __builtin_amdgcn_update_dpp(0, v, 0x111, 0xf, 0xf, false);
    v += __builtin_amdgcn_update_dpp(0, v, 0x112, 0xf, 0xf, false);
    v += __builtin_amdgcn_update_dpp(0, v, 0x114, 0xf, 0xf, false);
    v += __builtin_amdgcn_update_dpp(0, v, 0x118, 0xf, 0xf, false);
    v += __builtin_amdgcn_update_dpp(0, v, 0x142, 0xa, 0xf, false);
    v += __builtin_amdgcn_update_dpp(0, v, 0x143, 0xc, 0xf, false);
    return v;
}
__device__ __forceinline__ int radix_pick(LAS unsigned* hist, int want, int l, int& above) {
    const u32x4 h4 = *(const LAS u32x4*)(hist + 4 * l);
    const int tot = (int)((h4.x + h4.y) + (h4.z + h4.w)); const int pre = wave_scan_i(tot); const int total = __builtin_amdgcn_readlane(pre, 63);
    const int a3 = total - pre, a2 = a3 + (int)h4.w, a1 = a2 + (int)h4.z, a0 = a1 + (int)h4.y;
    const bool c3 = a3 < want && a3 + (int)h4.w >= want, c2 = a2 < want && a2 + (int)h4.z >= want, c1 = a1 < want && a1 + (int)h4.y >= want, c0 = a0 < want && a0 + (int)h4.x >= want;
    const unsigned long long m = __ballot(c3 || c2 || c1 || c0); const int src = (int)__builtin_ctzll(m | (1ull << 63));
    const int mybin = 4 * l + (c3 ? 3 : c2 ? 2 : c1 ? 1 : 0), myab = c3 ? a3 : c2 ? a2 : c1 ? a1 : a0;
    above = __builtin_amdgcn_readlane(myab, src);
    return __builtin_amdgcn_readlane(mybin, src);
}
__device__ __forceinline__ void select_top256_radix(const unsigned (&k)[64], int nj, int l, LAS unsigned short* selst, LAS unsigned* hist) {
    const int ngrp = (nj + 7) >> 3;
    *(LAS u32x4*)(hist + 4 * l) = (u32x4){0u, 0u, 0u, 0u};
    LDS_WAIT(); asm volatile("" ::: "memory");
#pragma unroll
    for (int j = 0; j < 64; ++j) { if ((j >> 3) < ngrp) (void)__hip_atomic_fetch_add(hist + (k[j] >> 8), 1u, __ATOMIC_RELAXED, __HIP_MEMORY_SCOPE_WORKGROUP); }
    LDS_WAIT(); asm volatile("" ::: "memory");
    int above1 = 0; const int bhi = radix_pick(hist, TOPK, l, above1); const int want2 = TOPK - above1;
    LDS_WAIT(); asm volatile("" ::: "memory");
    *(LAS u32x4*)(hist + 4 * l) = (u32x4){0u, 0u, 0u, 0u};
    LDS_WAIT(); asm volatile("" ::: "memory");
#pragma unroll
    for (int j = 0; j < 64; ++j) { if ((j >> 3) < ngrp) { if ((int)(k[j] >> 8) == bhi) (void)__hip_atomic_fetch_add(hist + (k[j] & 255u), 1u, __ATOMIC_RELAXED, __HIP_MEMORY_SCOPE_WORKGROUP); } }
    LDS_WAIT(); asm volatile("" ::: "memory");
    int above2 = 0; const int blo = radix_pick(hist, want2, l, above2);
    const unsigned T16 = ((unsigned)bhi << 8) | (unsigned)blo; const int cgt = above1 + above2, need = TOPK - cgt;
    int off = 0, toff = 0;
#pragma unroll
    for (int j = 0; j < 64; ++j) { if ((j >> 3) < ngrp) {
        const unsigned long long m1 = __ballot(k[j] > T16), m2 = __ballot(k[j] == T16);
        if (k[j] > T16) selst[off + mbcnt(m1)] = (unsigned short)(j * 64 + l);
        if (m2 != 0ull) { if (k[j] == T16) { const int rk = toff + mbcnt(m2); if (rk < need) selst[cgt + rk] = (unsigned short)(j * 64 + l); } toff += popc64(m2); }
        off += popc64(m1); }
        __builtin_amdgcn_sched_barrier(0); }
    LDS_WAIT(); asm volatile("" ::: "memory");
}
__device__ __forceinline__ void p_indexer(Frame& F) {
    PHASE_IDS();
    const bf16* QIDX = (const bf16*)(F.ws + WS_QIDX); const bf16* KIDX = (const bf16*)(F.ws + WS_KIDX); const float* WIDX = (const float*)(F.ws + WS_WIDX);
    unsigned short* SEL = (unsigned short*)(F.ws + WS_SEL); unsigned char* BKT = (unsigned char*)(F.ws + WS_BKT);
    LAS unsigned short* selst = (LAS unsigned short*)(F.lds + 131072) + wave * 256;
    const int l = lane, l31 = l & 31, hi = l >> 5;
    { const int gw = F.vcu * NWAVES + wave, NGW = F.G * NWAVES;
      for (int rr = gw; rr < BATCH * 256; rr += NGW) { const int b = rr >> 8, t = rr & 255; const size_t row = (size_t)b * T + t;
          unsigned short s4[4]; unsigned bk = 0;
#pragma unroll
          for (int i = 0; i < 4; ++i) { const int k = 4 * l + i; const bool v = k <= t; s4[i] = v ? (unsigned short)k : (unsigned short)0xFFFF; bk |= (unsigned)(v ? t5_bucket(t - k) : 32) << (8 * i); }
          u32x2 o; o.x = (unsigned)s4[0] | ((unsigned)s4[1] << 16); o.y = (unsigned)s4[2] | ((unsigned)s4[3] << 16);
          *(GAS u32x2*)(SEL + row * 256 + 4 * l) = o; *(GAS unsigned*)(BKT + row * 256 + 4 * l) = bk; } }
    LAS unsigned short* S16 = (LAS unsigned short*)F.lds;
    LAS float* wtab = (LAS float*)(F.lds + 131072 + 4096);
    for (int i = 0; ; ++i) {
        const int L = i * F.G + F.vcu; const int rnd = L >> 8, pos = L & 255;
        if (rnd >= 8) break;
        const int b = pos & 7, gs = pos >> 3; const int g = 239 - 32 * rnd - ((rnd & 1) ? (31 - gs) : gs);
        if (g < 0) continue;
        const int t0 = 256 + 16 * g, nk = t0 + 16, nkt = (nk + 31) >> 5; const size_t rowb = (size_t)b * T;
        int lt_ = threadIdx.x; asm volatile("" : "+v"(lt_)); const int l = lt_ & 63, l31 = l & 31, hi = l >> 5;
        bf16x8 af[4][4];
        { const int tl = 2 * ((l31 >> 2) & 1) + (l31 >> 4), hd = (l31 & 3) + 4 * ((l31 >> 3) & 1);
#pragma unroll
          for (int mt = 0; mt < 4; ++mt) { const bf16* qp = QIDX + (rowb + t0 + mt * 4 + tl) * 512 + hd * 64 + hi * 8;
#pragma unroll
              for (int ks = 0; ks < 4; ++ks) af[mt][ks] = *(const GAS bf16x8*)(qp + ks * 16); }
          if (lt_ < 128) wtab[lt_] = WIDX[(rowb + t0) * 8 + lt_] * 0.5f;
          LDS_WAIT(); __syncthreads(); }
        for (int rep1 = 0; rep1 < 1 + (MK_IDX_REP & 1); ++rep1) {
        bf16x8 bfr[4], bn1[4], bnx[4];
        { const bf16* kp = KIDX + (rowb + wave * 32 + l31) * 64 + hi * 8;
#pragma unroll
          for (int ks = 0; ks < 4; ++ks) bfr[ks] = (wave < nkt) ? *(const GAS bf16x8*)(kp + ks * 16) : (bf16x8){0, 0, 0, 0, 0, 0, 0, 0};
          const int kt1 = wave + NWAVES; const bf16* kp1 = KIDX + (rowb + (kt1 < nkt ? kt1 : 0) * 32 + l31) * 64 + hi * 8;
#pragma unroll
          for (int ks = 0; ks < 4; ++ks) bn1[ks] = *(const GAS bf16x8*)(kp1 + ks * 16); }
        auto tile = [&](const int kt, const bf16x8 (&cur)[4], bf16x8 (&ld)[4]) {
            const int key = kt * 32 + l31; const int ktn = kt + 2 * NWAVES;
            LAS float* wtab_k = wtab; asm volatile("" : "+v"(wtab_k));
            { const bf16* kp = KIDX + (rowb + (ktn < nkt ? ktn : kt) * 32 + l31) * 64 + hi * 8;
#pragma unroll
              for (int ks = 0; ks < 4; ++ks) ld[ks] = *(const GAS bf16x8*)(kp + ks * 16); }
#pragma unroll
            for (int mt = 0; mt < 4; ++mt) { f32x16 acc = f32x16{};
#pragma unroll
                for (int ks = 0; ks < 4; ++ks) acc = __builtin_amdgcn_mfma_f32_32x32x16_bf16(af[mt][ks], cur[ks], acc, 0, 0, 0);
                float sA = 0.f, sB = 0.f;
                const LAS f32x4* wq = (const LAS f32x4*)(wtab_k + (mt * 4 + 2 * hi) * 8); const f32x4 wa0 = wq[0], wa1 = wq[1], wb0 = wq[2], wb1 = wq[3];
                const float wA[8] = {wa0.x, wa0.y, wa0.z, wa0.w, wa1.x, wa1.y, wa1.z, wa1.w}, wB[8] = {wb0.x, wb0.y, wb0.z, wb0.w, wb1.x, wb1.y, wb1.z, wb1.w};
#pragma unroll
                for (int r = 0; r < 8; ++r) { sA += wA[r] * (acc[r] + __builtin_fabsf(acc[r])); sB += wB[r] * (acc[8 + r] + __builtin_fabsf(acc[8 + r])); }
                const int tokA = mt * 4 + 2 * hi; const int tA = t0 + tokA;
                const _Float16 hA = (_Float16)((key <= tA) ? sA : -INFINITY), hB = (_Float16)((key <= tA + 1) ? sB : -INFINITY);
                S16[tokA * 4096 + key] = __builtin_bit_cast(unsigned short, hA); S16[(tokA + 1) * 4096 + key] = __builtin_bit_cast(unsigned short, hB); }
        };
        for (int kt = wave; kt < nkt; ) {
            tile(kt, bfr, bnx); kt += NWAVES; if (kt >= nkt) break;
            tile(kt, bn1, bfr); kt += NWAVES; if (kt >= nkt) break;
            tile(kt, bnx, bn1); kt += NWAVES;
        }
        }
        LDS_WAIT(); __syncthreads();
        { const int nvalid = nkt * 32; const int nj = (nvalid + 63) >> 6;
#pragma unroll
          for (int s2 = 0; s2 < 2; ++s2) {
              const int t = t0 + 2 * wave + s2; LAS unsigned short* srow = S16 + (2 * wave + s2) * 4096;
              int nvalid_ = nvalid; asm volatile("" : "+s"(nvalid_));
              unsigned u[64];
#pragma unroll
              for (int j = 0; j < 64; ++j) { const int idx = j * 64 + l; const unsigned h0 = srow[idx];
                  const unsigned k0 = (h0 & 0x8000u) ? (~h0 & 0xffffu) : (h0 | 0x8000u);
                  u[j] = (idx < nvalid_) ? k0 : 0u; }
              LDS_WAIT(); asm volatile("" ::: "memory");
              select_top256_radix(u, nj, l, selst, (LAS unsigned*)srow);
              if (MK_IDX_REP & 2) select_top256_radix(u, nj, l, selst, (LAS unsigned*)srow);
#if MK_CHECK_SEL
              { LAS unsigned* bm = (LAS unsigned*)srow + 512;
                for (int w2 = l; w2 < 128; w2 += 64) bm[w2] = 0u;
                LDS_WAIT(); asm volatile("" ::: "memory");
                unsigned short mine[4];
#pragma unroll
                for (int i2 = 0; i2 < 4; ++i2) { mine[i2] = selst[4 * l + i2]; atomicOr((unsigned*)(bm + (mine[i2] >> 5)), 1u << (mine[i2] & 31)); }
                LDS_WAIT(); asm volatile("" ::: "memory");
                unsigned u32k[64];
#pragma unroll
                for (int j = 0; j < 64; ++j) u32k[j] = u[j] << 16;
                select_ref(u32k, l, selst);
                int bad = 0;
#pragma unroll
                for (int i2 = 0; i2 < 4; ++i2) { const unsigned short r2 = selst[4 * l + i2]; bad += ((bm[r2 >> 5] >> (r2 & 31)) & 1u) ? 0 : 1; }
                int nset = 0; for (int w2 = l; w2 < 128; w2 += 64) nset += __builtin_popcount(bm[w2]);
                bad = wave_total_i(bad) + (wave_total_i(nset) != TOPK ? 1 : 0);
                if (bad && l == 0) __hip_atomic_store(F.ctl + CW_TMO, 0xBAD5E1u, __ATOMIC_RELAXED, __HIP_MEMORY_SCOPE_AGENT);
#pragma unroll
                for (int i2 = 0; i2 < 4; ++i2) selst[4 * l + i2] = mine[i2];
                LDS_WAIT(); asm volatile("" ::: "memory"); }
#endif
              int t2_ = threadIdx.x; asm volatile("" : "+v"(t2_)); const int l2 = t2_ & 63;
              const size_t row = rowb + t; unsigned short s4[4]; unsigned bk = 0;
#pragma unroll
              for (int i2 = 0; i2 < 4; ++i2) { s4[i2] = selst[4 * l2 + i2]; bk |= (unsigned)t5_bucket(t - (int)s4[i2]) << (8 * i2); }
              u32x2 o; o.x = (unsigned)s4[0] | ((unsigned)s4[1] << 16); o.y = (unsigned)s4[2] | ((unsigned)s4[3] << 16);
              *(GAS u32x2*)(SEL + row * 256 + 4 * l2) = o; *(GAS unsigned*)(BKT + row * 256 + 4 * l2) = bk;
              LDS_WAIT(); asm volatile("" ::: "memory"); } }
        LDS_WAIT(); __syncthreads();
    }
}

typedef short v4i16_t __attribute__((ext_vector_type(4)));
__device__ __forceinline__ void p_sparse_attn(Frame& F, const float* rel_table) {
    PHASE_IDS();
    const bf16* QLAT = (const bf16*)(F.ws + WS_QLAT); const unsigned char* CKV8 = (const unsigned char*)(F.ws + WS_CKV); unsigned char* OLAT = (unsigned char*)(F.ws + WS_OLAT);
    const unsigned short* SEL = (const unsigned short*)(F.ws + WS_SEL); const unsigned char* BKT = (const unsigned char*)(F.ws + WS_BKT);
    LAS unsigned char* cb = F.lds + wave * 16384;
    LAS unsigned char* sb = F.lds + 131072 + wave * 1536;
    LAS float* relt = (LAS float*)(F.lds + 131072 + 8 * 1536);
    for (int i = tid; i < 33 * 16; i += NWAVES * 64) relt[i] = (i < 512) ? rel_table[i] * LOG2E : -INFINITY;
    LDS_WAIT(); __syncthreads();
    if (tid < 16) { float m = relt[tid]; for (int b = 1; b < 32; ++b) m = fmaxf(m, relt[b * 16 + tid]); relt[33 * 16 + tid] = m; }
    LDS_WAIT(); __syncthreads();
    const int l = lane, l15 = l & 15, g = l >> 4;
    const float cmax = __uint_as_float(__hip_atomic_load(F.ctl + CW_CMAX, __ATOMIC_RELAXED, __HIP_MEMORY_SCOPE_AGENT)) * 1.15f;
    const float bmaxh = relt[33 * 16 + l15];
    const int gw = F.vcu * NWAVES + wave, NGW = F.G * NWAVES;
    const int ntok = (M - gw + NGW - 1) / NGW;
#define SA_PARK_BKT(base_, bv_) do { _Pragma("unroll") for (int i_ = 0; i_ < 4; ++i_) { const int s_ = 4 * l + i_, sl_ = s_ & 31; (base_)[(s_ & ~31) + 4 * (sl_ & 7) + (sl_ >> 3)] = (unsigned char)((bv_) >> (8 * i_)); } } while (0)
#define SA_ROW(i_) ((NGW == 2048) ? ((size_t)(gw >> 8) * T + (size_t)((gw & 255) + 256 * (i_))) : (size_t)(gw + NGW * (i_)))
    if (ntok > 0) { const size_t row = SA_ROW(0); const u32x2 sv = *(const GAS u32x2*)(SEL + row * 256 + 4 * l); const unsigned bv = *(const GAS unsigned*)(BKT + row * 256 + 4 * l);
        *(LAS u32x2*)(sb + 8 * l) = sv; SA_PARK_BKT(sb + 512, bv); }
    LDS_WAIT();
    for (int it = 0; it < ntok; ++it) {
        const size_t row = SA_ROW(it); const size_t rowb = row & ~(size_t)(T - 1);
        LAS unsigned short* selw = (LAS unsigned short*)(sb + (it & 1) * 768); LAS unsigned char* bktw = sb + (it & 1) * 768 + 512;
        u32x2 svn = {0u, 0u}; unsigned bvn = 0u;
        if (it + 1 < ntok) { const size_t rown = SA_ROW(it + 1); svn = *(const GAS u32x2*)(SEL + rown * 256 + 4 * l); bvn = *(const GAS unsigned*)(BKT + rown * 256 + 4 * l); }
        pg8::i32x8 q8; float qq = 0.f;
        { bf16x8 bq[4];
#pragma unroll
          for (int i = 0; i < 4; ++i) bq[i] = __builtin_nontemporal_load((const bf16x8*)(QLAT + row * 2048 + l15 * 128 + g * 32 + i * 8));
#pragma unroll
          for (int i = 0; i < 4; ++i) { float x[8];
#pragma unroll
              for (int e2 = 0; e2 < 8; ++e2) { x[e2] = __uint_as_float((unsigned)(unsigned short)bq[i][e2] << 16); qq += x[e2] * x[e2]; }
              int w0 = __builtin_amdgcn_cvt_pk_fp8_f32(x[0], x[1], 0, false); w0 = __builtin_amdgcn_cvt_pk_fp8_f32(x[2], x[3], w0, true);
              int w1 = __builtin_amdgcn_cvt_pk_fp8_f32(x[4], x[5], 0, false); w1 = __builtin_amdgcn_cvt_pk_fp8_f32(x[6], x[7], w1, true);
              q8[2 * i] = w0; q8[2 * i + 1] = w1; } }
        qq += __shfl_xor(qq, 16); qq += __shfl_xor(qq, 32);
        const float mh = sqrtf(qq) * cmax + bmaxh;
        const float nmh = -mh; f32x4 lsum = (f32x4){0.f, 0.f, 0.f, 0.f}; f32x4 o[8];
#pragma unroll
        for (int mt = 0; mt < 8; ++mt) o[mt] = (f32x4){0.f, 0.f, 0.f, 0.f};
#define SA_SW(r_) ((((r_) >> 1) & 3) | (((((r_) >> 2) ^ ((r_) >> 4)) & 1) << 2))
#define SA_DMA(c_) do { _Pragma("unroll") for (int q = 0; q < 4; ++q) { const int r_ = 8 * q + (l >> 3); unsigned idx = selw[32 * (c_) + 8 * (r_ & 3) + (r_ >> 2)]; idx = (idx == 0xFFFFu) ? 0u : idx; \
            const unsigned char* src = CKV8 + (rowb + idx) * 128 + (((l & 7) ^ SA_SW(r_)) * 16); \
            __builtin_amdgcn_global_load_lds((const GAS unsigned*)src, (LAS unsigned*)(cb + ((c_) & 3) * 4096 + q * 1024), 16, 0, 0); } } while (0)
        SA_DMA(0); SA_DMA(1);
        unsigned f8one = 0x7f7f7f7fu; asm volatile("" : "+v"(f8one));
        const bf16x8 ones8 = (bf16x8){0x3F80, 0x3F80, 0x3F80, 0x3F80, 0x3F80, 0x3F80, 0x3F80, 0x3F80};
        const int pvr = (l15 >> 1) < 4 ? 4 * g + (l15 >> 1) : 16 + 4 * g + ((l15 >> 1) - 4); const int pvoff = pvr * 128 + (l15 & 1) * 8, pvsw = SA_SW(pvr);
#pragma unroll
        for (int c = 0; c < 8; c += 2) {
            if (c + 2 < 8) { SA_DMA(c + 2); SA_DMA(c + 3); asm volatile("s_waitcnt vmcnt(8)" ::: "memory"); } else { asm volatile("s_waitcnt vmcnt(0)" ::: "memory"); }
            pg8::i32x8 a8[4]; float bias[4][4]; u32x2 vt[16]; unsigned bk[4];
#pragma unroll
            for (int h2 = 0; h2 < 2; ++h2) { LAS unsigned char* cbc = cb + ((c + h2) & 3) * 4096;
                bk[2 * h2] = *(const LAS unsigned*)(bktw + (c + h2) * 32 + 4 * g); bk[2 * h2 + 1] = *(const LAS unsigned*)(bktw + (c + h2) * 32 + 16 + 4 * g);
#pragma unroll
                for (int tt = 0; tt < 2; ++tt) { const int R = 16 * tt + l15; const v4u lo = *(const LAS v4u*)(cbc + R * 128 + (((2 * g) ^ SA_SW(R)) * 16)), hi = *(const LAS v4u*)(cbc + R * 128 + (((2 * g + 1) ^ SA_SW(R)) * 16));
                    a8[2 * h2 + tt] = (pg8::i32x8){(int)lo.x, (int)lo.y, (int)lo.z, (int)lo.w, (int)hi.x, (int)hi.y, (int)hi.z, (int)hi.w}; }
#pragma unroll
                for (int mt = 0; mt < 8; ++mt) { typedef int v2i_t __attribute__((ext_vector_type(2)));
                    const v2i_t t8 = __builtin_amdgcn_ds_read_tr8_b64_v2i32((LAS v2i_t*)(cbc + pvoff + ((mt ^ pvsw) * 16))); vt[8 * h2 + mt] = (u32x2){(unsigned)t8.x, (unsigned)t8.y}; } }
#pragma unroll
            for (int q = 0; q < 4; ++q)
#pragma unroll
                for (int r = 0; r < 4; ++r) bias[q][r] = relt[((bk[q] >> (8 * r)) & 0xffu) * 16 + l15];
            __builtin_amdgcn_sched_barrier(0);
            f32x4 s0 = (f32x4){nmh, nmh, nmh, nmh}, s1 = s0, s2 = s0, s3 = s0;
            asm volatile("v_mfma_scale_f32_16x16x128_f8f6f4 %0, %4, %8, %0, %9, %9 op_sel_hi:[0,0,0]\n\tv_mfma_scale_f32_16x16x128_f8f6f4 %1, %5, %8, %1, %9, %9 op_sel_hi:[0,0,0]\n\t"
                         "v_mfma_scale_f32_16x16x128_f8f6f4 %2, %6, %8, %2, %9, %9 op_sel_hi:[0,0,0]\n\tv_mfma_scale_f32_16x16x128_f8f6f4 %3, %7, %8, %3, %9, %9 op_sel_hi:[0,0,0]\n\ts_nop 15\n\ts_nop 3"
                         : "+v"(s0), "+v"(s1), "+v"(s2), "+v"(s3) : "v"(a8[0]), "v"(a8[1]), "v"(a8[2]), "v"(a8[3]), "v"(q8), "v"(f8one));
#pragma unroll
            for (int r = 0; r < 4; ++r) { s0[r] = __builtin_amdgcn_exp2f(s0[r] + bias[0][r]); s1[r] = __builtin_amdgcn_exp2f(s1[r] + bias[1][r]); s2[r] = __builtin_amdgcn_exp2f(s2[r] + bias[2][r]); s3[r] = __builtin_amdgcn_exp2f(s3[r] + bias[3][r]); }
            u32x4 pw0, pw1; pw0.x = cvtpk(s0[0], s0[1]); pw0.y = cvtpk(s0[2], s0[3]); pw0.z = cvtpk(s1[0], s1[1]); pw0.w = cvtpk(s1[2], s1[3]);
            pw1.x = cvtpk(s2[0], s2[1]); pw1.y = cvtpk(s2[2], s2[3]); pw1.z = cvtpk(s3[0], s3[1]); pw1.w = cvtpk(s3[2], s3[3]);
#pragma unroll
            for (int h2 = 0; h2 < 2; ++h2) { const bf16x8 pb = __builtin_bit_cast(bf16x8, h2 ? pw1 : pw0);
                lsum = __builtin_amdgcn_mfma_f32_16x16x32_bf16(ones8, pb, lsum, 0, 0, 0);
#pragma unroll
                for (int mt = 0; mt < 8; ++mt) { typedef __bf16 bf2_t __attribute__((ext_vector_type(2))); const u32x2 v = vt[8 * h2 + mt];
                    u32x4 aw; aw.x = __builtin_bit_cast(unsigned, (bf2_t)__builtin_amdgcn_cvt_scalef32_pk_bf16_fp8(v.x, 1.0f, false)); aw.y = __builtin_bit_cast(unsigned, (bf2_t)__builtin_amdgcn_cvt_scalef32_pk_bf16_fp8(v.x, 1.0f, true));
                    aw.z = __builtin_bit_cast(unsigned, (bf2_t)__builtin_amdgcn_cvt_scalef32_pk_bf16_fp8(v.y, 1.0f, false)); aw.w = __builtin_bit_cast(unsigned, (bf2_t)__builtin_amdgcn_cvt_scalef32_pk_bf16_fp8(v.y, 1.0f, true));
                    o[mt] = __builtin_amdgcn_mfma_f32_16x16x32_bf16(__builtin_bit_cast(bf16x8, aw), pb, o[mt], 0, 0, 0); } }
            LDS_WAIT();
        }
#undef SA_DMA
#undef SA_SW
        const float inv = F8_OLS / lsum[0];
#pragma unroll
        for (int mt = 0; mt < 8; ++mt) __builtin_nontemporal_store(pg8::cvt4_fp8(o[mt][0] * inv, o[mt][1] * inv, o[mt][2] * inv, o[mt][3] * inv), (unsigned*)(OLAT + row * 2048 + l15 * 128 + 16 * mt + 4 * g));
        { LAS unsigned char* sn = sb + ((it + 1) & 1) * 768; *(LAS u32x2*)(sn + 8 * l) = svn; SA_PARK_BKT(sn + 512, bvn); }
        LDS_WAIT();
    }
#undef SA_ROW
#undef SA_PARK_BKT
    LDS_WAIT(); __syncthreads();
}

typedef float f32x4v __attribute__((ext_vector_type(4)));
__device__ __forceinline__ void p_ln_router(Frame& F, const float* xbase, const bool base16  , const float* lg, const float* lb, const float* w_router, const float* b_router, int layer) {
    PHASE_IDS();
    const unsigned char* HB = (const unsigned char*)(F.ws + WS_Y);        bf16* XF = (bf16*)(F.ws + WS_XF); unsigned char* XB8 = (unsigned char*)(F.ws + WS_XB8);
    int* TOPE = (int*)(F.ws + WS_TOPE); float* TOPG = (float*)(F.ws + WS_TOPG); int* POS = (int*)(F.ws + WS_POS); unsigned short* TOKE = (unsigned short*)(F.ws + WS_TOKE);
    gu32* gcnt = F.ctl + CW_CNT + 64 * layer;
    LAS float* lgt = (LAS float*)F.lds;
    LAS int* hist = (LAS int*)(F.lds + 128 * 33 * 4);
    LAS int* base = hist + 32;
    const int l = lane, l15 = l & 15, g = l >> 4;
    f32x4 gv[4], bv[4];
#pragma unroll
    for (int j = 0; j < 4; ++j) { gv[j] = *(const f32x4*)(lg + 4 * l + 256 * j); bv[j] = *(const f32x4*)(lb + 4 * l + 256 * j); }
    for (int unit = F.vcu; unit < M / 128; unit += F.G) {
        const int r0 = unit * 128 + wave * 16;
        if (tid < 32) hist[tid] = 0;
        u32x4 vn[4]; unsigned hn[4];
#define LNR_LOAD(row_) do { const GAS unsigned* hp = (const GAS unsigned*)(HB + (size_t)(row_) * D) + l; \
            if (base16) { const GAS u32x2* yp = (const GAS u32x2*)((const bf16*)xbase + (size_t)(row_) * D) + l; _Pragma("unroll") for (int j = 0; j < 4; ++j) { const u32x2 t2 = yp[64 * j]; vn[j] = (u32x4){t2.x, t2.y, 0u, 0u}; hn[j] = hp[64 * j]; } } \
            else { const GAS u32x4* yp = (const GAS u32x4*)(xbase + (size_t)(row_) * D) + l; _Pragma("unroll") for (int j = 0; j < 4; ++j) { vn[j] = yp[64 * j]; hn[j] = hp[64 * j]; } } } while (0)
        LNR_LOAD(r0);
        for (int i = 0; i < 16; ++i) { const size_t row = (size_t)(r0 + i);
            f32x4 v[4]; float s = 0.f;
#pragma unroll
            for (int j = 0; j < 4; ++j) { const f32x2 h01 = __builtin_amdgcn_cvt_pk_f32_fp8((int)hn[j], false), h23 = __builtin_amdgcn_cvt_pk_f32_fp8((int)hn[j], true); const u32x4 bb = vn[j]; f32x4 xb;
                if (base16) xb = (f32x4){__uint_as_float(bb.x << 16), __uint_as_float(bb.x & 0xffff0000u), __uint_as_float(bb.y << 16), __uint_as_float(bb.y & 0xffff0000u)};
                else xb = (f32x4){__uint_as_float(bb.x), __uint_as_float(bb.y), __uint_as_float(bb.z), __uint_as_float(bb.w)};
                v[j].x = xb.x * DN_ALPHA + h01.x * (1.0f / F8_HYS); v[j].y = xb.y * DN_ALPHA + h01.y * (1.0f / F8_HYS);
                v[j].z = xb.z * DN_ALPHA + h23.x * (1.0f / F8_HYS); v[j].w = xb.w * DN_ALPHA + h23.y * (1.0f / F8_HYS);
                s += (v[j].x + v[j].y) + (v[j].z + v[j].w); }
            if (i < 15) { LNR_LOAD(row + 1); }
            const float mean = wave_sum(s) * (1.f / D); float s2 = 0.f;
#pragma unroll
            for (int j = 0; j < 4; ++j) { v[j] = v[j] - mean; s2 += (v[j].x * v[j].x + v[j].y * v[j].y) + (v[j].z * v[j].z + v[j].w * v[j].w); }
            const float rstd = 1.f / sqrtf(wave_sum(s2) * (1.f / D) + LN_EPS);
            GAS u32x2* xo = (GAS u32x2*)(XF + row * D) + l; GAS unsigned* bo = (GAS unsigned*)(XB8 + row * D) + l;
#pragma unroll
            for (int j = 0; j < 4; ++j) { const f32x4 o = v[j] * rstd * gv[j] + bv[j]; u32x2 ow; ow.x = cvtpk(o.x, o.y); ow.y = cvtpk(o.z, o.w); xo[64 * j] = ow; bo[64 * j] = pg8::cvt4_fp8(o.x * F8_XS, o.y * F8_XS, o.z * F8_XS, o.w * F8_XS); } }
#undef LNR_LOAD
        asm volatile("s_waitcnt vmcnt(0)" ::: "memory");
        f32x4 acc0 = (f32x4){0.f, 0.f, 0.f, 0.f}, acc1 = acc0;
        { const bf16* xr = XF + (size_t)(r0 + l15) * D + 4 * g;
#pragma unroll 1
          for (int k0 = 0; k0 < D; k0 += 64) {
              f32x4 a[4]; float w0[4][4], w1[4][4];
#pragma unroll
              for (int q = 0; q < 4; ++q) { const u32x2 ab = __builtin_nontemporal_load((const u32x2*)(xr + k0 + 16 * q));
                  a[q] = (f32x4){__uint_as_float(ab.x << 16), __uint_as_float(ab.x & 0xffff0000u), __uint_as_float(ab.y << 16), __uint_as_float(ab.y & 0xffff0000u)}; const float* wp = w_router + (size_t)(k0 + 16 * q + 4 * g) * NEXP + l15;
#pragma unroll
                  for (int j = 0; j < 4; ++j) { w0[q][j] = wp[j * NEXP]; w1[q][j] = wp[j * NEXP + 16]; } }
#pragma unroll
              for (int q = 0; q < 4; ++q)
#pragma unroll
                  for (int j = 0; j < 4; ++j) { acc0 = __builtin_amdgcn_mfma_f32_16x16x4f32(a[q][j], w0[q][j], acc0, 0, 0, 0); acc1 = __builtin_amdgcn_mfma_f32_16x16x4f32(a[q][j], w1[q][j], acc1, 0, 0, 0); } } }
        { const float b0 = b_router[l15], b1 = b_router[l15 + 16];
#pragma unroll
          for (int r = 0; r < 4; ++r) { lgt[(wave * 16 + 4 * g + r) * 33 + l15] = acc0[r] + b0; lgt[(wave * 16 + 4 * g + r) * 33 + l15 + 16] = acc1[r] + b1; } }
        LDS_WAIT(); __syncthreads();
        int te[4] = {0, 0, 0, 0}, lp[4] = {0, 0, 0, 0}; float tg[4] = {0.f, 0.f, 0.f, 0.f};
        if (l < 16) { const LAS float* rp = lgt + (wave * 16 + l) * 33; float tv[4] = {-INFINITY, -INFINITY, -INFINITY, -INFINITY};
            for (int e = 0; e < NEXP; ++e) { const float v = rp[e];
                if (v > tv[3]) { if (v > tv[0]) { tv[3] = tv[2]; te[3] = te[2]; tv[2] = tv[1]; te[2] = te[1]; tv[1] = tv[0]; te[1] = te[0]; tv[0] = v; te[0] = e; }
                    else if (v > tv[1]) { tv[3] = tv[2]; te[3] = te[2]; tv[2] = tv[1]; te[2] = te[1]; tv[1] = v; te[1] = e; }
                    else if (v > tv[2]) { tv[3] = tv[2]; te[3] = te[2]; tv[2] = v; te[2] = e; }
                    else { tv[3] = v; te[3] = e; } } }
            const float e1 = __expf(tv[1] - tv[0]), e2 = __expf(tv[2] - tv[0]), e3 = __expf(tv[3] - tv[0]); const float inv = 1.0f / (1.0f + e1 + e2 + e3);
            tg[0] = inv; tg[1] = e1 * inv; tg[2] = e2 * inv; tg[3] = e3 * inv;
#pragma unroll
            for (int k = 0; k < 4; ++k) lp[k] = atomicAdd((int*)(hist + te[k]), 1); }
        LDS_WAIT(); __syncthreads();
        if (tid < 32) base[tid] = (int)__hip_atomic_fetch_add(gcnt + tid, (unsigned)hist[tid], __ATOMIC_RELAXED, __HIP_MEMORY_SCOPE_AGENT);
        LDS_WAIT(); __syncthreads();
        if (l < 16) { const size_t row = (size_t)(r0 + l);
            typedef int i32x4 __attribute__((ext_vector_type(4)));
            *(GAS i32x4*)(TOPE + row * 4) = (i32x4){te[0], te[1], te[2], te[3]};
            *(GAS f32x4*)(TOPG + row * 4) = (f32x4){tg[0], tg[1], tg[2], tg[3]};
            const int p0 = base[te[0]] + lp[0], p1 = base[te[1]] + lp[1], p2 = base[te[2]] + lp[2], p3 = base[te[3]] + lp[3];
            *(GAS i32x4*)(POS + row * 4) = (i32x4){p0, p1, p2, p3};
            TOKE[(size_t)te[0] * 32768 + p0] = (unsigned short)row; TOKE[(size_t)te[1] * 32768 + p1] = (unsigned short)row; TOKE[(size_t)te[2] * 32768 + p2] = (unsigned short)row; TOKE[(size_t)te[3] * 32768 + p3] = (unsigned short)row; }
        LDS_WAIT(); __syncthreads();
    }
}

__device__ __forceinline__ int moe_tables(Frame& F, int layer, LAS int* tab) {
    gu32* gcnt = F.ctl + CW_CNT + 64 * layer;
    if (threadIdx.x < NEXP) tab[64 + threadIdx.x] = (int)__hip_atomic_load(gcnt + threadIdx.x, __ATOMIC_RELAXED, __HIP_MEMORY_SCOPE_AGENT);
    LDS_WAIT(); __syncthreads();
    if (threadIdx.x == 0) { int acc = 0; for (int e = 0; e < NEXP; ++e) { tab[e] = acc; acc += (tab[64 + e] + 255) >> 8; } tab[NEXP] = acc; }
    LDS_WAIT(); __syncthreads();
    const int nT = tab[NEXP];
    for (int pm = threadIdx.x; pm < nT; pm += NWAVES * 64) { int e = 0; for (int k = 1; k < NEXP; ++k) e += (tab[k] <= pm) ? 1 : 0;
        tab[128 + pm] = e; }
    LDS_WAIT(); __syncthreads();
    return nT;
}

__device__ __forceinline__ void p_moe_combine_ln(Frame& F, const float* lg, const float* lb, float* out_final, int layer) {
    PHASE_IDS();
    LAS int* tab = (LAS int*)F.lds; (void)moe_tables(F, layer, tab);
    bf16* XF = (bf16*)(F.ws + WS_XF); unsigned char* XB8 = (unsigned char*)(F.ws + WS_XB8); const unsigned char* Y2 = (const unsigned char*)(F.ws + WS_XG);
    const int* TOPE = (const int*)(F.ws + WS_TOPE); const int* POS = (const int*)(F.ws + WS_POS); const float* TOPG = (const float*)(F.ws + WS_TOPG);
    const int l = lane; const int gw = F.vcu * NWAVES + wave, NGW = F.G * NWAVES;
    f32x4 gv[4], bv[4];
#pragma unroll
    for (int j = 0; j < 4; ++j) { gv[j] = *(const f32x4*)(lg + 4 * l + 256 * j); bv[j] = *(const f32x4*)(lb + 4 * l + 256 * j); }
    for (int row = gw; row < M; row += NGW) {
        typedef int i32x4 __attribute__((ext_vector_type(4)));
        const i32x4 e4 = *(const GAS i32x4*)(TOPE + (size_t)row * 4), p4 = *(const GAS i32x4*)(POS + (size_t)row * 4); const f32x4 gt = *(const GAS f32x4*)(TOPG + (size_t)row * 4);
        i32x4 sl; sl[0] = 256 * tab[e4[0]] + p4[0]; sl[1] = 256 * tab[e4[1]] + p4[1]; sl[2] = 256 * tab[e4[2]] + p4[2]; sl[3] = 256 * tab[e4[3]] + p4[3];
        GAS u32x2* xp = (GAS u32x2*)(XF + (size_t)row * D) + l; f32x4 v[4];
#pragma unroll
        for (int j = 0; j < 4; ++j) { const u32x2 xb = xp[64 * j]; v[j] = (f32x4){__uint_as_float(xb.x << 16), __uint_as_float(xb.x & 0xffff0000u), __uint_as_float(xb.y << 16), __uint_as_float(xb.y & 0xffff0000u)} * DN_ALPHA; }
#pragma unroll
        for (int k = 0; k < 4; ++k) { const GAS int* yp = (const GAS int*)(Y2 + (size_t)sl[k] * D) + l; const float gk = gt[k] * (1.0f / F8_YS);
#pragma unroll
            for (int j = 0; j < 4; ++j) { const int w = yp[64 * j];
                v[j].x += gk * __builtin_amdgcn_cvt_f32_fp8(w, 0); v[j].y += gk * __builtin_amdgcn_cvt_f32_fp8(w, 1); v[j].z += gk * __builtin_amdgcn_cvt_f32_fp8(w, 2); v[j].w += gk * __builtin_amdgcn_cvt_f32_fp8(w, 3); } }
        float s = 0.f;
#pragma unroll
        for (int j = 0; j < 4; ++j) s += (v[j].x + v[j].y) + (v[j].z + v[j].w);
        const float mean = wave_sum(s) * (1.f / D); float s2 = 0.f;
#pragma unroll
        for (int j = 0; j < 4; ++j) { v[j] = v[j] - mean; s2 += (v[j].x * v[j].x + v[j].y * v[j].y) + (v[j].z * v[j].z + v[j].w * v[j].w); }
        const float rstd = 1.f / sqrtf(wave_sum(s2) * (1.f / D) + LN_EPS);
        if (out_final) { GAS f32x4* op = (GAS f32x4*)(out_final + (size_t)row * D) + l;
            const float poison = (__hip_atomic_load(F.ctl + CW_TMO, __ATOMIC_RELAXED, __HIP_MEMORY_SCOPE_AGENT) != 0u) ? __builtin_nanf("") : 0.f;
#pragma unroll
            for (int j = 0; j < 4; ++j) op[64 * j] = v[j] * rstd * gv[j] + bv[j] + poison; }
        else { GAS unsigned* bo = (GAS unsigned*)(XB8 + (size_t)row * D) + l;
#pragma unroll
            for (int j = 0; j < 4; ++j) { const f32x4 o = v[j] * rstd * gv[j] + bv[j]; u32x2 ow; ow.x = cvtpk(o.x, o.y); ow.y = cvtpk(o.z, o.w); xp[64 * j] = ow; bo[64 * j] = pg8::cvt4_fp8(o.x * F8_XS, o.y * F8_XS, o.z * F8_XS, o.w * F8_XS); } }
    }
}

__device__ __forceinline__ void p_fox_gate(Frame& F, const float* w_f, const float* b_f) {
    PHASE_IDS();
    const bf16* XF = (const bf16*)(F.ws + WS_XF); float* LOGF = (float*)(F.ws + WS_LOGF);
    const int l = lane, l15 = l & 15, g = l >> 4; const int gw = F.vcu * NWAVES + wave, NGW = F.G * NWAVES;
    const float bf = b_f[l15];
    for (int tile = gw; tile < M / 16; tile += NGW) {
        f32x4 acc = (f32x4){0.f, 0.f, 0.f, 0.f}; const bf16* xr = XF + (size_t)(tile * 16 + l15) * D + 4 * g;
#pragma unroll 1
        for (int k0 = 0; k0 < D; k0 += 64) {
            f32x4 a[4]; float w[4][4];
#pragma unroll
            for (int q = 0; q < 4; ++q) { const u32x2 ab = *(const GAS u32x2*)(xr + k0 + 16 * q);
                a[q] = (f32x4){__uint_as_float(ab.x << 16), __uint_as_float(ab.x & 0xffff0000u), __uint_as_float(ab.y << 16), __uint_as_float(ab.y & 0xffff0000u)}; const float* wp = w_f + (size_t)(k0 + 16 * q + 4 * g) * 16 + l15;
#pragma unroll
                for (int j = 0; j < 4; ++j) w[q][j] = wp[j * 16]; }
#pragma unroll
            for (int q = 0; q < 4; ++q)
#pragma unroll
                for (int j = 0; j < 4; ++j) acc = __builtin_amdgcn_mfma_f32_16x16x4f32(a[q][j], w[q][j], acc, 0, 0, 0); }
#pragma unroll
        for (int r = 0; r < 4; ++r) { const float z = acc[r] + bf; const float ls = fminf(z, 0.f) - log1pf(__expf(-fabsf(z)));
            LOGF[(size_t)(tile * 16 + 4 * g + r) * 16 + l15] = ls; }
    }
}
__device__ __forceinline__ void split3(float f, unsigned short& h, unsigned short& m, unsigned short& lo) {
    const unsigned p1 = f2bf(f); const float f1 = __uint_as_float(p1 << 16); const float r1 = f - f1;
    const unsigned p2 = f2bf(r1); const float f2 = __uint_as_float(p2 << 16); const float r2 = r1 - f2;
    h = (unsigned short)p1; m = (unsigned short)p2; lo = (unsigned short)f2bf(r2);
}
__device__ __forceinline__ void p_fox_cum(Frame& F) {
    PHASE_IDS();
    const float* LOGF = (const float*)(F.ws + WS_LOGF); bf16* QX = (bf16*)(F.ws + WS_QX); bf16* KX = (bf16*)(F.ws + WS_KX);
    const bf16* Q = (const bf16*)(F.ws + WS_Q); const bf16* K = (const bf16*)(F.ws + WS_K);
    float* CUM2 = (float*)(F.ws + WS_CUM2); float* KMAX = (float*)(F.ws + WS_KMAX); float* DG = (float*)(F.ws + WS_DG);
    LAS double* red = (LAS double*)F.lds;
    LAS double* pre = red + 512;
    LAS double* tot = pre + 16;
    LAS float* kn2 = (LAS float*)(tot + 512);
    LAS float* qn2 = kn2 + 512;
    LAS float* dgm = qn2 + 512;
    const int h = tid & 15, sub = tid >> 4;
    for (int unit = F.vcu; unit < BATCH * 32; unit += F.G) {
        const int b = unit >> 5, seg = unit & 31; const size_t rowb = (size_t)b * T;
        double s = 0.0;
        { const int nprev = seg * 128; int t = sub;
          for (; t + 7 * 32 < nprev; t += 8 * 32) { float a[8];
#pragma unroll
              for (int q = 0; q < 8; ++q) a[q] = LOGF[(rowb + t + 32 * q) * 16 + h];
              s += (((double)a[0] + (double)a[1]) + ((double)a[2] + (double)a[3])) + (((double)a[4] + (double)a[5]) + ((double)a[6] + (double)a[7])); }
          for (; t < nprev; t += 32) s += (double)LOGF[(rowb + t) * 16 + h]; }
        red[sub * 16 + h] = s;
        const int t0 = seg * 128 + sub * 4; float lf[4];
#pragma unroll
        for (int i = 0; i < 4; ++i) lf[i] = LOGF[(rowb + t0 + i) * 16 + h];
        tot[sub * 16 + h] = (double)lf[0] + (double)lf[1] + (double)lf[2] + (double)lf[3];
        { float kmx = 0.f, qmx = 0.f, dmn = INFINITY;
#pragma unroll
          for (int i = 0; i < 4; ++i) { const GAS v4u* qp = (const GAS v4u*)(Q + (rowb + t0 + i) * D + h * 64); const GAS v4u* kp = (const GAS v4u*)(K + (rowb + t0 + i) * D + h * 64);
              float qq = 0.f, kk = 0.f, qk = 0.f;
#pragma unroll
              for (int c = 0; c < 8; ++c) { const v4u a = qp[c], bb = kp[c]; const unsigned aw[4] = {a.x, a.y, a.z, a.w}, bw[4] = {bb.x, bb.y, bb.z, bb.w};
#pragma unroll
                  for (int e = 0; e < 4; ++e) { const float a0 = __uint_as_float(aw[e] << 16), a1 = __uint_as_float(aw[e] & 0xffff0000u), b0 = __uint_as_float(bw[e] << 16), b1 = __uint_as_float(bw[e] & 0xffff0000u);
                      qq += a0 * a0 + a1 * a1; kk += b0 * b0 + b1 * b1; qk += a0 * b0 + a1 * b1; } }
              kmx = fmaxf(kmx, kk); qmx = fmaxf(qmx, qq); dmn = fminf(dmn, qk); DG[(rowb + t0 + i) * 16 + h] = qk; }
          kn2[sub * 16 + h] = kmx; qn2[sub * 16 + h] = qmx; dgm[sub * 16 + h] = dmn; }
        LDS_WAIT(); __syncthreads();
        if (tid < 16) { double a = 0.0; for (int j = 0; j < 32; ++j) a += red[j * 16 + tid]; pre[tid] = a; }
        if (tid >= 64 && tid < 96) { const int hh = tid & 15, tl = (tid >> 4) & 1; float m = 0.f; for (int j = 0; j < 16; ++j) m = fmaxf(m, kn2[(tl * 16 + j) * 16 + hh]);
            KMAX[(size_t)(b * 16 + hh) * 64 + seg * 2 + tl] = sqrtf(m); }
        if (tid >= 128 && tid < 144) { const int hh = tid & 15; float m = 0.f, d = INFINITY; for (int j = 0; j < 32; ++j) { m = fmaxf(m, qn2[j * 16 + hh]); d = fminf(d, dgm[j * 16 + hh]); }
            const int qi = (b * 16 + hh) * 16 + (seg >> 1);
            __hip_atomic_fetch_max(F.ctl + CW_QMAX + qi, __float_as_uint(sqrtf(m)), __ATOMIC_RELAXED, __HIP_MEMORY_SCOPE_AGENT);
            __hip_atomic_fetch_max(F.ctl + CW_MNEG + qi, fkey(-d), __ATOMIC_RELAXED, __HIP_MEMORY_SCOPE_AGENT); }
        LDS_WAIT(); __syncthreads();
        double c = pre[h]; for (int j = 0; j < sub; ++j) c += tot[j * 16 + h];
#pragma unroll
        for (int i = 0; i < 4; ++i) { c += (double)lf[i]; const float cf = (float)(c * 1.4426950408889634);
            unsigned short ch, cm, cl; split3(cf, ch, cm, cl); unsigned short nh, nm, nl; split3(-cf, nh, nm, nl);
            const size_t o = ((rowb + t0 + i) * 16 + h) * 16;
            CUM2[(rowb + t0 + i) * 16 + h] = cf;
            const unsigned one2 = 0x3F803F80u;
            v4u q0; q0.x = one2; q0.y = 0x3F80u | ((unsigned)ch << 16); q0.z = (unsigned)cm | ((unsigned)cl << 16); q0.w = 0u;
            v4u q1; q1.x = 0u; q1.y = 0u; q1.z = 0u; q1.w = 0u;
            v4u k0; k0.x = (unsigned)nh | ((unsigned)nm << 16); k0.y = (unsigned)nl | (0x3F80u << 16); k0.z = one2; k0.w = one2;
            v4u k1; k1.x = 0x3F80u; k1.y = 0u; k1.z = 0u; k1.w = 0u;
            *(GAS v4u*)(QX + o) = q0; *(GAS v4u*)(QX + o + 8) = q1; *(GAS v4u*)(KX + o) = k0; *(GAS v4u*)(KX + o + 8) = k1; }
        LDS_WAIT(); __syncthreads();
    }
}
__device__ __forceinline__ void p_fox_ts(Frame& F) {
    PHASE_IDS();
    const float* CUM2 = (const float*)(F.ws + WS_CUM2); const float* KMAX = (const float*)(F.ws + WS_KMAX); unsigned char* TS = (unsigned char*)(F.ws + WS_TS);
    const int gw = F.vcu * NWAVES + wave, NGW = F.G * NWAVES;
    for (int u = gw; u < BATCH * 16 * 16; u += NGW) { const int bh = u >> 4, qb = u & 15, b = bh >> 4, h = bh & 15; const size_t rowb = (size_t)b * T;
        const float qmax = __uint_as_float(__hip_atomic_load(F.ctl + CW_QMAX + u, __ATOMIC_RELAXED, __HIP_MEMORY_SCOPE_AGENT));
        const unsigned kk = __hip_atomic_load(F.ctl + CW_MNEG + u, __ATOMIC_RELAXED, __HIP_MEMORY_SCOPE_AGENT); const float negmlo = __uint_as_float((kk & 0x80000000u) ? (kk & 0x7fffffffu) : ~kk);
        const float cq = CUM2[(rowb + 256 * qb) * 16 + h]; const float ck = CUM2[(rowb + 64 * lane + 63) * 16 + h]; const float km = KMAX[(size_t)bh * 64 + lane];
        const float bound = (cq - ck) + qmax * km + negmlo + 1.0f;
        const bool keep = (lane >= 4 * qb) || !(bound < -36.0f);
        const unsigned long long m = __ballot(keep); int first = __builtin_ctzll(m); if (first > 4 * qb) first = 4 * qb;
        const bool risky = (lane <= 4 * qb + 3) && !(qmax * km + negmlo < 60.0f);
        const unsigned guard = __ballot(risky) != 0ull ? 1u : 0u;
        if (lane == 0) TS[u] = (unsigned char)((first & ~1) | guard); }
}

struct Args { const float* in[25]; float* out; unsigned char* ws; int ph_lo, ph_hi, li, pad; };

#define IN(k) (lo <= (k) && (k) < hi)
#define BOTH(k) (IN(k) && IN((k) + 1))
#define GRID_BAR(k) do { if (BOTH(k)) xcd_barrier(bar); } while (0)
#ifndef MK_REP_MASK
#define MK_REP_MASK 0u
#endif
#define RUN(k, ...) do { if (IN(k)) { __VA_ARGS__ if ((MK_REP_MASK >> (k)) & 1u) { __VA_ARGS__ } } } while (0)

__device__ __forceinline__ void moe_phases(Frame& F, const XcdBarrier& bar, int lo, int hi, const int layer, const int pb, const float* base, const bool base16, float* out_final) {
    const float* PAR = (const float*)(F.ws + WS_PAR);
    const float* lnm_g = PAR + PAR_LN + layer * D; const float* lnm_b = PAR + PAR_LN + 2048 + layer * D; const float* lnf_g = PAR + PAR_LN + 4096 + layer * D; const float* lnf_b = PAR + PAR_LN + 6144 + layer * D;
    LAS int* tab = (LAS int*)(F.lds + RING_BYTES);
    RUN(pb,  p_ln_router(F, base, base16, lnm_g, lnm_b, PAR + PAR_WROUT + (size_t)layer * D * NEXP, PAR + PAR_BROUT + layer * NEXP, layer); GRID_BAR(pb); );
    RUN(pb + 1,
        const int nT = moe_tables(F, layer, tab);
        pg8::Gemm g{(const pg8::bf16_t*)(F.ws + WS_XB8), (const pg8::bf16_t*)(F.ws + WS_WGU + (size_t)layer * NEXP * 2048 * 1024), nT * 256, NEXP * 2048, 512};
        pg8::MoeOrder S{nT, 8, F.G, (int)blockIdx.x, (const LAS int*)(tab + 128)};
        LAS unsigned short* tokl = (LAS unsigned short*)(F.lds + RING_BYTES + 5120);
        { const unsigned short* TOKE = (const unsigned short*)(F.ws + WS_TOKE);
          if (threadIdx.x < 256) { unsigned short tk[17]; unsigned vm = 0u, um = 0u;
              _Pragma("unroll") for (int i = 0; i < 17; ++i) { pg8::Unit uu; uu.pm = 0; uu.pn = 0; const bool ok = S.next(i, uu); const int e = tab[128 + uu.pm], idx = (uu.pm - tab[e]) * 256 + (int)threadIdx.x; const bool v = ok && idx < tab[64 + e];
                  tk[i] = TOKE[v ? (size_t)e * 32768 + idx : (size_t)0]; vm |= (v ? 1u : 0u) << i; um |= (ok ? 1u : 0u) << i; }
              _Pragma("unroll") for (int i = 0; i < 17; ++i) { if ((um >> i) & 1u) tokl[i * 256 + threadIdx.x] = ((vm >> i) & 1u) ? tk[i] : (unsigned short)0; } }
          LDS_WAIT(); __syncthreads(); }
        pg8::EpiSwiglu8 E{(unsigned char*)(F.ws + WS_H), PAR + PAR_BGU + (size_t)layer * NEXP * 2048, 1.0f / (F8_XS * F8_WGS), F8_HS};
        pg8::gemm_phase<pg8::EpiSwiglu8, pg8::MoeOrder, PG8_ALIGN, PG8_SP2, true, true>(F.lds + RING_OFF, g, S, E, tokl);
        GRID_BAR(pb + 1);
    );
    RUN(pb + 2,
        const int nT = moe_tables(F, layer, tab);
        pg8::Gemm g{(const pg8::bf16_t*)(F.ws + WS_H), (const pg8::bf16_t*)(F.ws + WS_WD + (size_t)layer * NEXP * 1024 * 1024), nT * 256, NEXP * 1024, 512};
        pg8::MoeOrder S{nT, 4, F.G, (int)blockIdx.x, (const LAS int*)(tab + 128)};
        pg8::EpiDown8 E{(unsigned char*)(F.ws + WS_XG), PAR + PAR_BDOWN + (size_t)layer * NEXP * 1024, 1.0f / (F8_HS * F8_WDS), F8_YS};
        pg8::gemm_phase<pg8::EpiDown8, pg8::MoeOrder, PG8_ALIGN, PG8_SP2, false, true>(F.lds + RING_OFF, g, S, E);
        GRID_BAR(pb + 2);
    );
    RUN(pb + 3,  p_moe_combine_ln(F, lnf_g, lnf_b, out_final, layer); if (!out_final) GRID_BAR(pb + 3); );
}

__global__ void __launch_bounds__(NWAVES * 64, 2) mk_fwd(Args args) {
    extern __shared__ __attribute__((aligned(16))) unsigned char lds[];
    Frame F;
    F.lds = (LAS unsigned char*)lds;
    F.MISC = (volatile LAS unsigned*)(F.lds + MISC_OFF);
    F.G = gridDim.x; { const int bx = blockIdx.x; F.vcu = (F.G % 8 == 0) ? (bx % 8) * (F.G / 8) + bx / 8 : bx; }
    F.ws = args.ws; F.ctl = (gu32*)(args.ws + WS_CTL);
    if (threadIdx.x < 64) ((LAS unsigned*)(F.lds + MISC_OFF))[threadIdx.x] = 0u;
    __syncthreads();
    XcdBarrier bar; bar.bar = (unsigned*)(F.ctl + CW_BAR); bar.x = 0; bar.st = nullptr;
    if (MK_N_LAUNCHES == 1) bar = xcd_barrier_post((unsigned*)(F.ctl + CW_BAR), F.MISC + 8);
    const int lo = args.ph_lo, hi = args.ph_hi;

    RUN(0,
        P0In I{args.in[0], args.in[2], args.in[7], args.in[8], args.in[9], args.in[10], args.in[11], args.in[12], args.in[14], args.in[21], args.in[23],
               args.in[1], args.in[3], args.in[4], args.in[5], args.in[6], args.in[13], args.in[15], args.in[16], args.in[17], args.in[18], args.in[19], args.in[20], args.in[22], args.in[24]};
        p0_prologue(F, I); GRID_BAR(0);
    );
#if defined(MK_XBAR) && MK_XBAR
    if (MK_N_LAUNCHES == 1) { for (int xb_i = 0; xb_i < MK_XBAR; ++xb_i) xcd_barrier(bar); }
#endif
    RUN(1,
        pg8::Gemm g{(const pg8::bf16_t*)(F.ws + WS_XB), (const pg8::bf16_t*)(F.ws + WS_WAIN), M, 512, 1024}; pg8::StaticOrder S; S.init(M, 512, F.G, (int)blockIdx.x);
        const float* PAR = (const float*)(F.ws + WS_PAR);
        pg8::EpiDsaNorm E{(pg8::bf16_t*)(F.ws + WS_CQN), (pg8::bf16_t*)(F.ws + WS_CKV), (pg8::bf16_t*)(F.ws + WS_KIDX), (float*)(F.ws + WS_WIDX), PAR + PAR_AGQ, PAR + PAR_AGKV, PAR + PAR_AGKI, PAR + PAR_ABKI,
                          (unsigned*)(F.ctl + CW_CMAX), (LAS float*)(F.lds + RING_BYTES), RMS_EPS, LN_EPS};
        pg8::gemm_phase<pg8::EpiDsaNorm, pg8::StaticOrder, true, PG8_SP2>(F.lds + RING_OFF, g, S, E);
        GRID_BAR(1);
    );
    RUN(2,
        pg8::Gemm g{(const pg8::bf16_t*)(F.ws + WS_CQN), (const pg8::bf16_t*)(F.ws + WS_WACQ), M, 2560, 256}; pg8::StaticOrder S; S.init(M, 2560, F.G, (int)blockIdx.x);
        pg8::EpiCq E{(pg8::bf16_t*)(F.ws + WS_QLAT), (pg8::bf16_t*)(F.ws + WS_QIDX)};
        pg8::gemm_phase<pg8::EpiCq, pg8::StaticOrder, PG8_ALIGN, PG8_SP2>(F.lds + RING_OFF, g, S, E);
        GRID_BAR(2);
    );
    RUN(3,  p_indexer(F); GRID_BAR(3); );
    RUN(4,  p_sparse_attn(F, (const float*)(F.ws + WS_PAR) + PAR_REL); GRID_BAR(4); );
    RUN(5,
        pg8::Gemm g{(const pg8::bf16_t*)(F.ws + WS_OLAT), (const pg8::bf16_t*)(F.ws + WS_WAO), M, 1024, 1024}; pg8::StaticOrder S; S.init(M, 1024, F.G, (int)blockIdx.x);
        pg8::EpiF8s E{(unsigned char*)(F.ws + WS_Y), F8_HYS / (F8_OLS * F8_WAOS)};
        pg8::gemm_phase<pg8::EpiF8s, pg8::StaticOrder, PG8_ALIGN, PG8_SP2, false, true>(F.lds + RING_OFF, g, S, E);
        GRID_BAR(5);
    );
    moe_phases(F, bar, lo, hi, 0, 6, (const float*)(F.ws + WS_XB), true, nullptr);
    RUN(10,
        p_fox_gate(F, (const float*)(F.ws + WS_PAR) + PAR_WF, (const float*)(F.ws + WS_PAR) + PAR_BF);
        pg8::Gemm g{(const pg8::bf16_t*)(F.ws + WS_XB8), (const pg8::bf16_t*)(F.ws + WS_WBIN), M, 3072, 512}; pg8::StaticOrder S; S.init(M, 3072, F.G, (int)blockIdx.x);
        pg8::EpiQkv8 E{(pg8::bf16_t*)(F.ws + WS_Q), (size_t)(WS_K - WS_Q) / 2, 1.0f / (F8_XS * F8_WBINS), attn_body::C2};
        pg8::gemm_phase<pg8::EpiQkv8, pg8::StaticOrder, PG8_ALIGN, PG8_SP2, false, true>(F.lds + RING_OFF, g, S, E);
        GRID_BAR(10);
    );
    RUN(11,  p_fox_cum(F); GRID_BAR(11); );
    RUN(12,  p_fox_ts(F); GRID_BAR(12); );
    RUN(13,
        const attn_body::AttnTensors AT{(const attn_body::bf16*)(F.ws + WS_Q), (const attn_body::bf16*)(F.ws + WS_K), (const attn_body::bf16*)(F.ws + WS_V), (attn_body::bf16*)(F.ws + WS_O),
                                        (const attn_body::bf16*)(F.ws + WS_QX), (const attn_body::bf16*)(F.ws + WS_KX), (const float*)(F.ws + WS_DG)};
        attn_body::attn_phase<64>((char*)lds + RING_OFF, AT, (unsigned*)(F.ctl + CW_ATTQ), (const unsigned char*)(F.ws + WS_TS));
        GRID_BAR(13);
    );
    RUN(14,
        pg8::Gemm g{(const pg8::bf16_t*)(F.ws + WS_O), (const pg8::bf16_t*)(F.ws + WS_WBO), M, 1024, 512}; pg8::StaticOrder S; S.init(M, 1024, F.G, (int)blockIdx.x);
        pg8::EpiF8s E{(unsigned char*)(F.ws + WS_Y), F8_HYS / (F8_OS * F8_WBOS)};
        pg8::gemm_phase<pg8::EpiF8s, pg8::StaticOrder, PG8_ALIGN, PG8_SP2, false, true>(F.lds + RING_OFF, g, S, E);
        GRID_BAR(14);
    );
    moe_phases(F, bar, lo, hi, 1, 15, (const float*)(F.ws + WS_XF), true, args.out);
}
#undef IN
#undef BOTH
#undef GRID_BAR

extern "C" void kernel_launch(void* const* d_in, const int* in_sizes, int n_in, void* d_out, int out_size, void* d_ws, size_t ws_size, hipStream_t stream) {
    static int grid = 0;
    if (grid == 0) {
        if (n_in != 25 || in_sizes[0] != M * D || out_size != M * D || ws_size < WS_END) { fprintf(stderr, "kernel_launch: unexpected shapes (n_in %d, in0 %d, out %d, ws %zu); nothing launched\n", n_in, n_in > 0 ? in_sizes[0] : -1, out_size, ws_size); grid = -1; return; }
        int dev = 0, cus = 0, per_cu = 0;
        if (hipGetDevice(&dev) != hipSuccess || hipDeviceGetAttribute(&cus, hipDeviceAttributeMultiprocessorCount, dev) != hipSuccess) { grid = -1; return; }
        if (hipFuncSetAttribute((const void*)mk_fwd, hipFuncAttributeMaxDynamicSharedMemorySize, LDS_BYTES) != hipSuccess) { fprintf(stderr, "kernel_launch: hipFuncSetAttribute failed\n"); grid = -1; return; }
        if (hipOccupancyMaxActiveBlocksPerMultiprocessor(&per_cu, (const void*)mk_fwd, NWAVES * 64, LDS_BYTES) != hipSuccess || per_cu < 1) fprintf(stderr, "kernel_launch: occupancy query reports %d workgroups per CU\n", per_cu);
        (void)hipGetLastError();
        grid = cus;
    }
    if (grid < 0) return;
    if (hipMemsetAsync((char*)d_ws + WS_CTL, 0, CTL_ZERO_BYTES, stream) != hipSuccess) return;
    Args a{};
    for (int i = 0; i < 25; ++i) a.in[i] = (const float*)d_in[i];
    a.out = (float*)d_out; a.ws = (unsigned char*)d_ws;
    constexpr int NPH = 19;
    for (int li = 0; li < MK_N_LAUNCHES; ++li) {
        if (MK_N_LAUNCHES == 1) { a.ph_lo = 0; a.ph_hi = NPH; } else { a.ph_lo = li; a.ph_hi = li + 1; }
        a.li = li;
        hipLaunchKernelGGL(mk_fwd, dim3(grid), dim3(NWAVES * 64), LDS_BYTES, stream, a);
        if (MK_N_LAUNCHES != 1 && li + 1 == NPH) break;
    }
}
```

```cpp
#define MK_N_LAUNCHES 1
#define MK_REP_MASK 0u
#define MK_P0_REP 0
#define MK_CHECK_SEL 0
#define MK_IDX_REP 0
#define MK_EPI_REP 0
#define MK_XBAR 0
#define MK_SA_EXP 0
#include <hip/hip_runtime.h>
#include <cstdio>
#include <cstdint>
namespace pg8 {
#define PG8_LAS __attribute__((address_space(3)))
typedef unsigned short bf16_t;
typedef short bf16x8 __attribute__((ext_vector_type(8)));
typedef float f32x4 __attribute__((ext_vector_type(4)));
typedef unsigned u32x4 __attribute__((ext_vector_type(4)));
typedef short bf16x16 __attribute__((ext_vector_type(16)));
typedef int i32x8 __attribute__((ext_vector_type(8)));
constexpr int BM = 256, BK = 64, HALF = 128, HTB = HALF * BK * 2  , STAGE_BYTES = 8 * HTB, NXCD = 8, WGM = 8;

__host__ __device__ __forceinline__ int lds_byte(int r, int c) { const int st = (r >> 4) * 2 + (c >> 5), rr = r & 15, cc = c & 31, ob = rr * 64 + cc * 2; return st * 1024 + (ob ^ (((ob >> 9) & 1) << 5)); }
__host__ __device__ __forceinline__ void stage_rc(int b, int& R, int& C) { const int st = b / 1024, sb = b % 1024, swz = sb ^ (((sb >> 9) & 1) << 5); R = (st >> 1) * 16 + swz / 64; C = (st & 1) * 32 + (swz % 64) / 2; }
__host__ __device__ __forceinline__ int perm32(int rho) { const int n = rho >> 4, i = rho & 15; return 8 * (i >> 2) + 4 * n + (i & 3); }

struct Unit { int pm, pn; };
struct Gemm { const bf16_t* A; const bf16_t* Bt; int M, N, K; };

struct StaticOrder {
    int nM, nN, nwg, G, c;
    __host__ __device__ void init(int M, int N, int G_, int c_) { nM = M / BM; nN = N / BM; nwg = nM * nN; G = G_; c = c_; }
    __host__ __device__ bool next(int i, Unit& u) const {
        const long L = (long)i * G + c; if (L >= nwg) return false;
        int wgid = (int)L; { const int q = nwg / NXCD, r = nwg % NXCD, xcd = wgid % NXCD, off = wgid / NXCD; wgid = (xcd < r ? xcd * (q + 1) : r * (q + 1) + (xcd - r) * q) + off; }
        const int nig = WGM * nN, gid = wgid / nig, fm = gid * WGM, gsz = (nM - fm) < WGM ? (nM - fm) : WGM;
        u.pm = fm + ((wgid % nig) % gsz); u.pn = (wgid % nig) / gsz; return true;
    }
    __device__ __forceinline__ void a_ready(const Unit&) const {}
    __device__ __forceinline__ void done(const Unit&) const {}
};

__device__ __forceinline__ unsigned cvt_pk_bf16(float lo, float hi) { unsigned r; asm volatile("v_cvt_pk_bf16_f32 %0, %1, %2" : "=v"(r) : "v"(lo), "v"(hi)); return r; }
typedef float f32x2 __attribute__((ext_vector_type(2)));
__device__ __forceinline__ f32x2 gelu_pk(f32x2 v) {
    const f32x2 av = __builtin_elementwise_abs(v), d = av * 0.2316418882f + 1.0f;
    f32x2 t; t.x = __builtin_amdgcn_rcpf(d.x); t.y = __builtin_amdgcn_rcpf(d.y);
    f32x2 q = t * 0.5307027145f + (-0.7265760135f); q = q * t + 0.7107068705f; q = q * t + (-0.142248368f); q = q * t + 0.127414796f; q = q * t;
    const f32x2 s = (v * v) * (-0.72134752044f);
    f32x2 e; e.x = __builtin_amdgcn_exp2f(s.x); e.y = __builtin_amdgcn_exp2f(s.y);
    const f32x2 m = v * (q * e), r = v - m;
    f32x2 o; o.x = v.x < 0.f ? m.x : r.x; o.y = v.y < 0.f ? m.y : r.y; return o;
}

template <int ACT  > struct EpiBf16 {
    static constexpr bool PERM = true, AFTER_DRAIN = false; static_assert(ACT == 0 || ACT == 1, "EpiBf16: ACT is 0 (none) or 1 (gelu_pk)");
    bf16_t* O; int ldc; const float* bias; int split_cols; size_t split_stride; float scale0;
    __device__ __forceinline__ void operator()(const f32x4 (&acc)[2][2][4][2], const Unit& u, int wr, int wc, int fr, int fq) const {
        const int row0 = u.pm * BM + wr * 64 + fr; int colt = u.pn * BM; bf16_t* base = O;
        float sc = 1.f; if (split_cols) { const int t = colt / split_cols; base += (size_t)t * split_stride; colt -= t * split_cols; if (t == 0) sc = scale0; }
        const int col0 = colt + wc * 32 + 8 * fq, bcol0 = u.pn * BM + wc * 32 + 8 * fq;
        f32x4 bv[2][2];
#pragma unroll
        for (int bj = 0; bj < 2; ++bj)
#pragma unroll
            for (int n = 0; n < 2; ++n) bv[bj][n] = bias ? *(const f32x4*)(bias + bcol0 + bj * HALF + 4 * n) : (f32x4){0.f, 0.f, 0.f, 0.f};
#pragma unroll
        for (int ai = 0; ai < 2; ++ai)
#pragma unroll
            for (int m = 0; m < 4; ++m) { bf16_t* rowp = base + (size_t)(row0 + ai * HALF + m * 16) * ldc + col0;
#pragma unroll
                for (int bj = 0; bj < 2; ++bj) { f32x4 v0 = acc[ai][bj][m][0] + bv[bj][0], v1 = acc[ai][bj][m][1] + bv[bj][1];
                    if (ACT == 1) { f32x2 a = gelu_pk((f32x2){v0[0], v0[1]}), b = gelu_pk((f32x2){v0[2], v0[3]}), c = gelu_pk((f32x2){v1[0], v1[1]}), d = gelu_pk((f32x2){v1[2], v1[3]});
                        v0 = (f32x4){a.x, a.y, b.x, b.y}; v1 = (f32x4){c.x, c.y, d.x, d.y}; }
                    v0 = v0 * sc; v1 = v1 * sc; u32x4 w; w.x = cvt_pk_bf16(v0[0], v0[1]); w.y = cvt_pk_bf16(v0[2], v0[3]); w.z = cvt_pk_bf16(v1[0], v1[1]); w.w = cvt_pk_bf16(v1[2], v1[3]);
                    *(u32x4*)(rowp + bj * HALF) = w; } }
    }
};

struct PanelStats {
    unsigned* xbuf;
    unsigned* cnt;
    unsigned* tmo;
    int ntn; float eps;
    unsigned code;
    __device__ __forceinline__ bool run(const f32x4 (&v)[2][2][4][2], const Unit& u, int wr, int wc, int fr, int fq, PG8_LAS unsigned char* lds, int wid, int lane) const {
        typedef float f32x2v __attribute__((ext_vector_type(2)));
        PG8_LAS f32x2v* P = (PG8_LAS f32x2v*)lds;
        PG8_LAS f32x2v* S = (PG8_LAS f32x2v*)(lds + 8192);
        PG8_LAS unsigned* flag = (PG8_LAS unsigned*)(lds + 8192 + 2048);
#pragma unroll
        for (int ai = 0; ai < 2; ++ai)
#pragma unroll
            for (int m = 0; m < 4; ++m) {
                float s = 0.f;
#pragma unroll
                for (int bj = 0; bj < 2; ++bj)
#pragma unroll
                    for (int n = 0; n < 2; ++n) { const f32x4 x = v[ai][bj][m][n]; s += (x[0] + x[1]) + (x[2] + x[3]); }
                s += __shfl_xor(s, 16); s += __shfl_xor(s, 32);
                const float mw = s * (1.0f / 64.0f); float q = 0.f;
#pragma unroll
                for (int bj = 0; bj < 2; ++bj)
#pragma unroll
                    for (int n = 0; n < 2; ++n) { const f32x4 d = v[ai][bj][m][n] - mw; q += (d[0] * d[0] + d[1] * d[1]) + (d[2] * d[2] + d[3] * d[3]); }
                q += __shfl_xor(q, 16); q += __shfl_xor(q, 32);
                if (fq == 0) P[(ai * HALF + wr * 64 + m * 16 + fr) * 4 + wc] = (f32x2v){mw, q};
            }
        asm volatile("s_waitcnt lgkmcnt(0)" ::: "memory"); __builtin_amdgcn_s_barrier(); asm volatile("" ::: "memory");
#if defined(BROKEN_EXCHANGE_NO_WAIT)
#warning BROKEN CONTROL BUILD: the row-statistics exchange does not wait; results are wrong by design
        if (blockIdx.x >= 64) { const long long t0_ = clock64(); while (clock64() - t0_ < 60000) __builtin_amdgcn_s_sleep(8); }
#endif
        const int row = wid * 32 + (lane & 31);
        if (lane < 32) {
            const f32x2v a = P[row * 4 + 0], b = P[row * 4 + 1], c = P[row * 4 + 2], d = P[row * 4 + 3];
            const float mt = (a.x + b.x + c.x + d.x) * 0.25f;
            const float da = a.x - mt, db = b.x - mt, dc = c.x - mt, dd = d.x - mt;
            const float m2 = (a.y + b.y) + (c.y + d.y) + 64.0f * ((da * da + db * db) + (dc * dc + dd * dd));
            unsigned long long* slot = (unsigned long long*)xbuf + ((size_t)(u.pm * BM + row) * 4 + u.pn);
            __hip_atomic_store(slot, ((unsigned long long)__float_as_uint(m2) << 32) | __float_as_uint(mt), __ATOMIC_RELAXED, __HIP_MEMORY_SCOPE_AGENT);
        }
        asm volatile("s_waitcnt vmcnt(0)" ::: "memory");
        if (lane == 0) __hip_atomic_fetch_add(cnt + 64 * u.pm, 1u, __ATOMIC_RELAXED, __HIP_MEMORY_SCOPE_AGENT);
        if (wid == 0) {
            bool dead = false; const unsigned long long t0 = __builtin_amdgcn_s_memrealtime(); const unsigned want = 8u * (unsigned)ntn;
            for (;;) {
#if defined(BROKEN_EXCHANGE_NO_WAIT)
                break;
#endif
                if ((unsigned)__builtin_amdgcn_readfirstlane(__hip_atomic_load(cnt + 64 * u.pm, __ATOMIC_RELAXED, __HIP_MEMORY_SCOPE_AGENT)) >= want) break;
                if (__builtin_amdgcn_s_memrealtime() - t0 > 2000000ull) {
                    if (lane == 0) { unsigned expect = 0u; __hip_atomic_compare_exchange_strong(tmo + 1, &expect, code | (unsigned)(u.pm & 0xff), __ATOMIC_RELAXED, __ATOMIC_RELAXED, __HIP_MEMORY_SCOPE_AGENT);
                                     __hip_atomic_store(tmo, 1u, __ATOMIC_RELAXED, __HIP_MEMORY_SCOPE_AGENT); }
                    dead = true; break; }
                __builtin_amdgcn_s_sleep(2);
            }
            __builtin_amdgcn_fence(__ATOMIC_ACQUIRE, "agent");
            if (lane == 0) flag[0] = dead ? 1u : 0u;
        }
        asm volatile("s_waitcnt vmcnt(0) lgkmcnt(0)" ::: "memory"); __builtin_amdgcn_s_barrier(); asm volatile("" ::: "memory");
        const bool bad = flag[0] != 0u;
        if (lane < 32) {
            const unsigned long long* slot = (const unsigned long long*)xbuf + (size_t)(u.pm * BM + row) * 4; float mt[4], m2[4]; float ms = 0.f;
#pragma unroll
            for (int t = 0; t < 4; ++t) { if (t < ntn) { const unsigned long long w = __hip_atomic_load(slot + t, __ATOMIC_RELAXED, __HIP_MEMORY_SCOPE_AGENT); mt[t] = __uint_as_float((unsigned)w); m2[t] = __uint_as_float((unsigned)(w >> 32)); } else { mt[t] = 0.f; m2[t] = 0.f; } ms += mt[t]; }
            const float mean = ms / (float)ntn; float q = 0.f;
#pragma unroll
            for (int t = 0; t < 4; ++t) if (t < ntn) { const float dm = mt[t] - mean; q += m2[t] + 256.0f * dm * dm; }
            S[row] = (f32x2v){mean, 1.0f / sqrtf(q / (256.0f * (float)ntn) + eps)};
        }
        asm volatile("s_waitcnt lgkmcnt(0)" ::: "memory"); __builtin_amdgcn_s_barrier(); asm volatile("" ::: "memory");
        return bad;
    }
};
struct EpiLnRes {
    static constexpr bool PERM = false, AFTER_DRAIN = true;
    const float* base; float* out; int ldc; const float* bias; PanelStats st; unsigned poison;
    __device__ __forceinline__ void fused(f32x4 (&acc)[2][2][4][2], const Unit& u, int wr, int wc, int fr, int fq, PG8_LAS unsigned char* lds, int wid, int lane) const {
        typedef float f32x2v __attribute__((ext_vector_type(2)));
        const PG8_LAS f32x2v* S = (const PG8_LAS f32x2v*)(lds + 8192);
        const int col0 = u.pn * BM + wc * 32 + 4 * fq;
#pragma unroll
        for (int bj = 0; bj < 2; ++bj)
#pragma unroll
            for (int n = 0; n < 2; ++n) { const f32x4 bv = bias ? *(const f32x4*)(bias + col0 + bj * HALF + n * 16) : (f32x4){0.f, 0.f, 0.f, 0.f};
#pragma unroll
                for (int ai = 0; ai < 2; ++ai)
#pragma unroll
                    for (int m = 0; m < 4; ++m) acc[ai][bj][m][n] += bv; }
        f32x4 pre[4][2][2];
#pragma unroll
        for (int m = 0; m < 4; ++m) { const size_t off = (size_t)(u.pm * BM + wr * 64 + m * 16 + fr) * ldc + col0;
#pragma unroll
            for (int bj = 0; bj < 2; ++bj)
#pragma unroll
                for (int n = 0; n < 2; ++n) pre[m][bj][n] = *(const f32x4*)(base + off + bj * HALF + n * 16); }
        const bool bad = st.run(acc, u, wr, wc, fr, fq, lds, wid, lane) || poison != 0u;
        const float qnan = __builtin_nanf("");
#pragma unroll
        for (int ai = 0; ai < 2; ++ai)
#pragma unroll
            for (int m = 0; m < 4; ++m) { const int r = ai * HALF + wr * 64 + m * 16 + fr; const f32x2v sr = S[r]; const size_t off = (size_t)(u.pm * BM + r) * ldc + col0;
#pragma unroll
                for (int bj = 0; bj < 2; ++bj)
#pragma unroll
                    for (int n = 0; n < 2; ++n) { const f32x4 bs = ai == 0 ? pre[m][bj][n] : *(const f32x4*)(base + off + bj * HALF + n * 16); f32x4 o = bs + (acc[ai][bj][m][n] - sr.x) * sr.y;
                        if (bad) o = (f32x4){qnan, qnan, qnan, qnan}; *(f32x4*)(out + off + bj * HALF + n * 16) = o; }
                if (m & 1) asm volatile("" ::: "memory"); }
    }
};
struct EpiLnResLn {
    static constexpr bool PERM = false, AFTER_DRAIN = true;
    const float* base; float* out; bf16_t* xn; int ldc; const float* bias; PanelStats st1, st2; unsigned poison;
    __device__ __forceinline__ void fused(f32x4 (&acc)[2][2][4][2], const Unit& u, int wr, int wc, int fr, int fq, PG8_LAS unsigned char* lds, int wid, int lane) const {
        typedef float f32x2v __attribute__((ext_vector_type(2))); typedef unsigned u32x2v __attribute__((ext_vector_type(2)));
        const PG8_LAS f32x2v* S = (const PG8_LAS f32x2v*)(lds + 8192);
        const int col0 = u.pn * BM + wc * 32 + 4 * fq;
#pragma unroll
        for (int bj = 0; bj < 2; ++bj)
#pragma unroll
            for (int n = 0; n < 2; ++n) { const f32x4 bv = bias ? *(const f32x4*)(bias + col0 + bj * HALF + n * 16) : (f32x4){0.f, 0.f, 0.f, 0.f};
#pragma unroll
                for (int ai = 0; ai < 2; ++ai)
#pragma unroll
                    for (int m = 0; m < 4; ++m) acc[ai][bj][m][n] += bv; }
        bool bad = st1.run(acc, u, wr, wc, fr, fq, lds, wid, lane) || poison != 0u;
        const float qnan = __builtin_nanf("");
#pragma unroll
        for (int ai = 0; ai < 2; ++ai)
#pragma unroll
            for (int m = 0; m < 4; ++m) { const int r = ai * HALF + wr * 64 + m * 16 + fr; const f32x2v sr = S[r]; const size_t off = (size_t)(u.pm * BM + r) * ldc + col0;
#pragma unroll
                for (int bj = 0; bj < 2; ++bj)
#pragma unroll
                    for (int n = 0; n < 2; ++n) { const f32x4 bs = *(const f32x4*)(base + off + bj * HALF + n * 16); acc[ai][bj][m][n] = bs + (acc[ai][bj][m][n] - sr.x) * sr.y; }
                asm volatile("" : "+v"(acc[ai][0][m][0]), "+v"(acc[ai][0][m][1]), "+v"(acc[ai][1][m][0]), "+v"(acc[ai][1][m][1]));
                if (m & 1) asm volatile("" ::: "memory"); }
        const bool bad1 = bad;
        bad = st2.run(acc, u, wr, wc, fr, fq, lds, wid, lane) || bad;
#pragma unroll
        for (int ai = 0; ai < 2; ++ai)
#pragma unroll
            for (int m = 0; m < 4; ++m) { const int r = ai * HALF + wr * 64 + m * 16 + fr; const f32x2v sr = S[r]; const size_t off = (size_t)(u.pm * BM + r) * ldc + col0;
#pragma unroll
                for (int bj = 0; bj < 2; ++bj)
#pragma unroll
                    for (int n = 0; n < 2; ++n) { const f32x4 x1 = acc[ai][bj][m][n]; *(f32x4*)(out + off + bj * HALF + n * 16) = bad1 ? (f32x4){qnan, qnan, qnan, qnan} : x1;
                        const f32x4 o = (x1 - sr.x) * sr.y; u32x2v w; w.x = cvt_pk_bf16(o[0], o[1]); w.y = cvt_pk_bf16(o[2], o[3]);
                        if (bad) { w.x = 0x7fc07fc0u; w.y = 0x7fc07fc0u; } *(u32x2v*)(xn + off + bj * HALF + n * 16) = w; }
                asm volatile("" ::: "memory"); }
    }
};

template <class Epi, class Sched, bool ALIGN_EPI = false, bool SP2 = false, bool GATHER = false, bool F8 = false>
__device__ __forceinline__ void gemm_phase(PG8_LAS unsigned char* lds, const Gemm g, const Sched& S, const Epi& E, const PG8_LAS unsigned short* tokl = nullptr) {
    int tid_ = threadIdx.x; asm volatile("" : "+v"(tid_));
    const int tid = tid_, wid = __builtin_amdgcn_readfirstlane(tid >> 6), lane = tid & 63, wr = wid >> 2, wc = wid & 3, fr = lane & 15, fq = lane >> 4;
    const int K = g.K, nt = K / BK;
    unsigned voffA[2], voffB[2];
#pragma unroll
    for (int i = 0; i < 2; ++i) { int R, C; stage_rc(tid * 16 + i * 8192, R, C); const int Rb = Epi::PERM ? ((R & ~31) + perm32(R & 31)) : R;
        voffA[i] = GATHER ? (unsigned)C * 2u : (unsigned)(R * K + C) * 2u; voffB[i] = (unsigned)(Rb * K + C) * 2u; }
    const size_t rowbytes = (size_t)K * 2; unsigned tkc[2] = {0u, 0u}; (void)rowbytes;
#define PG8_LOADTK(dst, unit_i) do { int R0_, C0_, R1_, C1_; stage_rc(tid * 16, R0_, C0_); stage_rc(tid * 16 + 8192, R1_, C1_); (void)C0_; (void)C1_; \
        _Pragma("unroll") for (int h_ = 0; h_ < 2; ++h_) dst[h_] = (unsigned)tokl[(unit_i) * 256 + h_ * HALF + R0_] | ((unsigned)tokl[(unit_i) * 256 + h_ * HALF + R1_] << 16); } while (0)
#define PG8_STAGE_A(bufoff, gbase, half, TK) do { if constexpr (GATHER) { _Pragma("unroll") for (int _i = 0; _i < 2; ++_i) { const unsigned _tok = ((TK)[half] >> (16 * _i)) & 0xffffu; \
        __builtin_amdgcn_global_load_lds((const unsigned*)((const char*)(gbase) + (size_t)_tok * rowbytes + voffA[_i]), (PG8_LAS unsigned*)(lds + (bufoff) + ldsw + _i * 8192), 16, 0, 0); } } \
    else { PG8_STAGE(bufoff, (gbase) + (half) * hstep, voffA); } } while (0)
    const size_t kstep = (size_t)(BK * 2);
    const size_t hstep = (size_t)HALF * K * 2;
    const size_t tstep = 2 * hstep;
    const unsigned ldsw = (unsigned)wid * 1024u;
    const int aoff = lds_byte(wr * 64 + fr, fq * 8), boff = lds_byte(wc * 32 + fr, fq * 8);
    unsigned f8scl = 0x7f7f7f7fu; asm volatile("" : "+v"(f8scl)); (void)f8scl;
    constexpr int KFS = 1024;
#define PG8_SA(b, h) (((b) * 2 + (h)) * HTB)
#define PG8_SB(b, h) ((4 + (b) * 2 + (h)) * HTB)
#define PG8_STAGE(bufoff, gbase, voff) do { _Pragma("unroll") for (int _i = 0; _i < 2; ++_i) \
        __builtin_amdgcn_global_load_lds((const unsigned*)((const char*)(gbase) + (voff)[_i]), (PG8_LAS unsigned*)(lds + (bufoff) + ldsw + _i * 8192), 16, 0, 0); } while (0)
#define PG8_LDA(dst, b, h) do { _Pragma("unroll") for (int m = 0; m < 4; ++m) _Pragma("unroll") for (int k = 0; k < 2; ++k) dst[m][k] = *(const PG8_LAS bf16x8*)(lds + PG8_SA(b, h) + aoff + m * 2048 + k * KFS); } while (0)
#define PG8_LDB(dst, b, h) do { _Pragma("unroll") for (int n = 0; n < 2; ++n) _Pragma("unroll") for (int k = 0; k < 2; ++k) dst[n][k] = *(const PG8_LAS bf16x8*)(lds + PG8_SB(b, h) + boff + n * 2048 + k * KFS); } while (0)
#define PG8_F8FRAG(X) __builtin_bit_cast(i32x8, __builtin_shufflevector(X[0], X[1], 0, 1, 2, 3, 4, 5, 6, 7, 8, 9, 10, 11, 12, 13, 14, 15))
#define PG8_MMA(ai, bj, At, Bt) do { __builtin_amdgcn_s_setprio(1); if constexpr (F8) { const i32x8 b80_ = PG8_F8FRAG(Bt[0]), b81_ = PG8_F8FRAG(Bt[1]); _Pragma("unroll") for (int m = 0; m < 4; ++m) { const i32x8 a8_ = PG8_F8FRAG(At[m]); \
        asm volatile("v_mfma_scale_f32_16x16x128_f8f6f4 %0, %1, %2, %0, %3, %3 op_sel_hi:[0,0,0]" : "+v"(acc[ai][bj][m][0]) : "v"(b80_), "v"(a8_), "v"(f8scl)); \
        asm volatile("v_mfma_scale_f32_16x16x128_f8f6f4 %0, %1, %2, %0, %3, %3 op_sel_hi:[0,0,0]" : "+v"(acc[ai][bj][m][1]) : "v"(b81_), "v"(a8_), "v"(f8scl)); } } else { \
        _Pragma("unroll") for (int m = 0; m < 4; ++m) _Pragma("unroll") for (int n = 0; n < 2; ++n) _Pragma("unroll") for (int k = 0; k < 2; ++k) \
        acc[ai][bj][m][n] = __builtin_amdgcn_mfma_f32_16x16x32_bf16(Bt[n][k], At[m][k], acc[ai][bj][m][n], 0, 0, 0); } __builtin_amdgcn_s_setprio(0); } while (0)
#define PG8_WAIT_V(n) asm volatile("s_waitcnt vmcnt(" #n ")" ::: "memory")
#define PG8_WAIT_L(n) asm volatile("s_waitcnt lgkmcnt(" #n ")" ::: "memory")
#define PG8_BAR __builtin_amdgcn_s_barrier()
#define PG8_SCHED __builtin_amdgcn_sched_barrier(0)
    Unit cur, nxt; int ui = 0;
    if (!S.next(0, cur)) return;
    f32x4 acc[2][2][4][2];
#pragma unroll
    for (int a = 0; a < 2; ++a)
#pragma unroll
        for (int b = 0; b < 2; ++b)
#pragma unroll
            for (int m = 0; m < 4; ++m)
#pragma unroll
                for (int n = 0; n < 2; ++n) acc[a][b][m][n] = (f32x4){0.f, 0.f, 0.f, 0.f};
    bf16x8 At[4][2], B0[2][2], B1[2][2];
    const char* cA = (const char*)g.A + (GATHER ? (size_t)0 : (size_t)cur.pm * tstep); const char* cB = (const char*)g.Bt + (size_t)cur.pn * tstep;
    if constexpr (GATHER) { PG8_LOADTK(tkc, 0); }
    S.a_ready(cur);
    if constexpr (SP2) {
        PG8_STAGE(PG8_SB(0, 0), cB, voffB); PG8_STAGE(PG8_SB(0, 1), cB + hstep, voffB); PG8_STAGE_A(PG8_SA(0, 0), cA, 0, tkc); PG8_STAGE_A(PG8_SA(0, 1), cA, 1, tkc);
        if (wr == 1) PG8_BAR;
        PG8_WAIT_V(2); PG8_BAR;
        PG8_STAGE(PG8_SB(1, 0), cB + kstep, voffB); PG8_STAGE_A(PG8_SA(1, 0), cA + kstep, 0, tkc); PG8_STAGE(PG8_SB(1, 1), cB + hstep + kstep, voffB);
        PG8_WAIT_V(6); PG8_BAR;
    } else {
        PG8_STAGE(PG8_SB(0, 0), cB, voffB); PG8_STAGE_A(PG8_SA(0, 0), cA, 0, tkc); PG8_STAGE(PG8_SB(0, 1), cB + hstep, voffB); PG8_STAGE_A(PG8_SA(0, 1), cA, 1, tkc);
        if (wr == 1) PG8_BAR;
        PG8_WAIT_V(4); PG8_BAR;
        PG8_STAGE(PG8_SB(1, 0), cB + kstep, voffB); PG8_STAGE_A(PG8_SA(1, 0), cA + kstep, 0, tkc); PG8_STAGE(PG8_SB(1, 1), cB + hstep + kstep, voffB);
        PG8_WAIT_V(6); PG8_BAR;
    }
    for (;;) {
        const bool has_next = S.next(ui + 1, nxt);
        const char* nA = has_next ? (const char*)g.A + (GATHER ? (size_t)0 : (size_t)nxt.pm * tstep) : cA;
 const char* nB = has_next ? (const char*)g.Bt + (size_t)nxt.pn * tstep : cB;
        for (int t = 0; t < nt; t += 2) {
            const bool last = (t == nt - 2);
            const char* a1 = cA + (size_t)(t + 1) * kstep;
            const char* a2 = last ? nA : cA + (size_t)(t + 2) * kstep; const char* b2 = last ? nB : cB + (size_t)(t + 2) * kstep;
            const char* a3 = a2 + kstep; const char* b3 = b2 + kstep;
            unsigned tk2[2]; tk2[0] = tkc[0]; tk2[1] = tkc[1]; (void)tk2;
            if constexpr (GATHER) { if (last && has_next) { PG8_LOADTK(tk2, ui + 1); } }
            if (last && has_next) S.a_ready(nxt);
            if constexpr (SP2) {
            PG8_LDB(B0, 0, 0); PG8_LDB(B1, 0, 1); PG8_SCHED; PG8_LDA(At, 0, 0); PG8_STAGE_A(PG8_SA(1, 1), a1, 1, tkc);
            PG8_WAIT_V(8); PG8_WAIT_L(0); PG8_BAR; PG8_MMA(0, 0, At, B0); PG8_MMA(0, 1, At, B1); PG8_BAR; PG8_SCHED;
            PG8_LDA(At, 0, 1); PG8_STAGE(PG8_SB(0, 0), b2, voffB); PG8_STAGE(PG8_SB(0, 1), b2 + hstep, voffB); PG8_STAGE_A(PG8_SA(0, 0), a2, 0, tk2);
            PG8_WAIT_V(8); PG8_WAIT_L(0); PG8_BAR; PG8_MMA(1, 0, At, B0); PG8_MMA(1, 1, At, B1); PG8_BAR; PG8_SCHED;
            PG8_LDB(B0, 1, 0); PG8_LDB(B1, 1, 1); PG8_SCHED; PG8_LDA(At, 1, 0); PG8_STAGE_A(PG8_SA(0, 1), a2, 1, tk2);
            PG8_WAIT_V(8); PG8_WAIT_L(0); PG8_BAR; PG8_MMA(0, 0, At, B0); PG8_MMA(0, 1, At, B1); PG8_BAR; PG8_SCHED;
            PG8_LDA(At, 1, 1); PG8_STAGE(PG8_SB(1, 0), b3, voffB); PG8_STAGE(PG8_SB(1, 1), b3 + hstep, voffB); PG8_STAGE_A(PG8_SA(1, 0), a3, 0, tk2);
            PG8_WAIT_V(8); PG8_WAIT_L(0); PG8_BAR; PG8_MMA(1, 0, At, B0); PG8_MMA(1, 1, At, B1); PG8_BAR; PG8_SCHED;
            } else {
            PG8_LDB(B0, 0, 0); PG8_SCHED; PG8_LDA(At, 0, 0); PG8_STAGE_A(PG8_SA(1, 1), a1, 1, tkc);
            PG8_WAIT_L(8); PG8_BAR; PG8_WAIT_L(0); PG8_MMA(0, 0, At, B0); PG8_BAR; PG8_SCHED;
            PG8_LDB(B1, 0, 1); PG8_STAGE(PG8_SB(0, 0), b2, voffB);
            PG8_BAR; PG8_WAIT_L(0); PG8_MMA(0, 1, At, B1); PG8_BAR;
            PG8_LDA(At, 0, 1); PG8_STAGE_A(PG8_SA(0, 0), a2, 0, tk2);
            PG8_BAR; PG8_WAIT_L(0); PG8_MMA(1, 0, At, B0); PG8_BAR; PG8_SCHED;
            PG8_STAGE(PG8_SB(0, 1), b2 + hstep, voffB);
            PG8_WAIT_V(6); PG8_BAR; PG8_MMA(1, 1, At, B1); PG8_BAR;
            PG8_LDB(B0, 1, 0); PG8_SCHED; PG8_LDA(At, 1, 0); PG8_STAGE_A(PG8_SA(0, 1), a2, 1, tk2);
            PG8_WAIT_L(8); PG8_BAR; PG8_WAIT_L(0); PG8_MMA(0, 0, At, B0); PG8_BAR; PG8_SCHED;
            PG8_LDB(B1, 1, 1); PG8_STAGE(PG8_SB(1, 0), b3, voffB);
            PG8_BAR; PG8_WAIT_L(0); PG8_MMA(0, 1, At, B1); PG8_BAR;
            PG8_LDA(At, 1, 1); PG8_STAGE_A(PG8_SA(1, 0), a3, 0, tk2);
            PG8_BAR; PG8_WAIT_L(0); PG8_MMA(1, 0, At, B0); PG8_BAR; PG8_SCHED;
            PG8_STAGE(PG8_SB(1, 1), b3 + hstep, voffB);
            PG8_WAIT_V(6); PG8_BAR; PG8_MMA(1, 1, At, B1); PG8_BAR;
            }
        }
        if constexpr (ALIGN_EPI) { if (wr == 0) PG8_BAR; }
        if constexpr (F8) asm volatile("s_nop 15\n\ts_nop 15" ::: "memory");
        if constexpr (!Epi::AFTER_DRAIN) { E(acc, cur, wr, wc, fr, fq);
#if defined(MK_EPI_REP) && MK_EPI_REP
            E(acc, cur, wr, wc, fr, fq);
#endif
            S.done(cur); }
        if (!has_next) break;
#pragma unroll
        for (int a = 0; a < 2; ++a)
#pragma unroll
            for (int b = 0; b < 2; ++b)
#pragma unroll
                for (int m = 0; m < 4; ++m)
#pragma unroll
                    for (int n = 0; n < 2; ++n) acc[a][b][m][n] = (f32x4){0.f, 0.f, 0.f, 0.f};
        cur = nxt; cA = nA; cB = nB; ++ui; if constexpr (GATHER) { PG8_LOADTK(tkc, ui); }
        if constexpr (ALIGN_EPI) { if (wr == 1) PG8_BAR; }
    }
    PG8_WAIT_V(0);
    if constexpr (!ALIGN_EPI) { if (wr == 0) PG8_BAR; }
    PG8_BAR;
    if constexpr (Epi::AFTER_DRAIN) { E.fused(acc, cur, wr, wc, fr, fq, lds, wid, lane); S.done(cur); }
#undef PG8_SA
#undef PG8_SB
#undef PG8_STAGE
#undef PG8_STAGE_A
#undef PG8_LOADTK
#undef PG8_LDA
#undef PG8_LDB
#undef PG8_MMA
#undef PG8_F8FRAG
#undef PG8_WAIT_V
#undef PG8_WAIT_L
#undef PG8_BAR
#undef PG8_SCHED
}
}
namespace pg8 {
struct EpiF32 {
    static constexpr bool PERM = false, AFTER_DRAIN = false;
    float* O; int ldc;
    __device__ __forceinline__ void operator()(const f32x4 (&acc)[2][2][4][2], const Unit& u, int wr, int wc, int fr_, int fq_) const {
        int t_ = threadIdx.x; asm volatile("" : "+v"(t_)); const int fr = t_ & 15, fq = (t_ & 63) >> 4; (void)fr_; (void)fq_;
        const int row0 = u.pm * BM + wr * 64 + fr, col0 = u.pn * BM + wc * 32 + 4 * fq;
#pragma unroll
        for (int ai = 0; ai < 2; ++ai)
#pragma unroll
            for (int m = 0; m < 4; ++m) { float* rowp = O + (size_t)(row0 + ai * HALF + m * 16) * ldc + col0;
#pragma unroll
                for (int bj = 0; bj < 2; ++bj)
#pragma unroll
                    for (int n = 0; n < 2; ++n) *(f32x4*)(rowp + bj * HALF + n * 16) = acc[ai][bj][m][n]; }
    }
};
struct EpiResF32 {
    static constexpr bool PERM = false, AFTER_DRAIN = false;
    const float* base; float* out; int ldc; float alpha;
    __device__ __forceinline__ void operator()(const f32x4 (&acc)[2][2][4][2], const Unit& u, int wr, int wc, int fr_, int fq_) const {
        int t_ = threadIdx.x; asm volatile("" : "+v"(t_)); const int fr = t_ & 15, fq = (t_ & 63) >> 4; (void)fr_; (void)fq_;
        const int row0 = u.pm * BM + wr * 64 + fr, col0 = u.pn * BM + wc * 32 + 4 * fq;
#pragma unroll
        for (int ai = 0; ai < 2; ++ai)
#pragma unroll
            for (int m = 0; m < 4; ++m) { const size_t off = (size_t)(row0 + ai * HALF + m * 16) * ldc + col0;
                f32x4 bs[2][2];
#pragma unroll
                for (int bj = 0; bj < 2; ++bj)
#pragma unroll
                    for (int n = 0; n < 2; ++n) bs[bj][n] = *(const f32x4*)(base + off + bj * HALF + n * 16);
#pragma unroll
                for (int bj = 0; bj < 2; ++bj)
#pragma unroll
                    for (int n = 0; n < 2; ++n) *(f32x4*)(out + off + bj * HALF + n * 16) = bs[bj][n] * alpha + acc[ai][bj][m][n]; }
    }
};
struct EpiDsaNorm {
    static constexpr bool PERM = false, AFTER_DRAIN = false;
    bf16_t* cqn; bf16_t* ckv; bf16_t* kidx; float* widx; const float* gq; const float* gkv; const float* gki; const float* bki; unsigned* cmaxw; PG8_LAS float* scr; float rms_eps, ln_eps;
    __device__ __forceinline__ void operator()(const f32x4 (&acc)[2][2][4][2], const Unit& u, int wr, int wc, int fr_, int fq_) const {
        int t_ = threadIdx.x; asm volatile("" : "+v"(t_)); const int fr = t_ & 15, fq = (t_ & 63) >> 4; (void)fr_; (void)fq_;
#define EDN_RED4(v_) do { v_ += __shfl_xor(v_, 16); v_ += __shfl_xor(v_, 32); } while (0)
#define EDN_BAR() asm volatile("s_waitcnt lgkmcnt(0)\n\ts_barrier" ::: "memory")
#define EDN_PK(v_) ({ u32x2e w_; w_.x = cvt_pk_bf16((v_)[0], (v_)[1]); w_.y = cvt_pk_bf16((v_)[2], (v_)[3]); w_; })
        typedef unsigned u32x2e __attribute__((ext_vector_type(2)));
        if (u.pn == 0) {
#pragma unroll
            for (int ai = 0; ai < 2; ++ai)
#pragma unroll
                for (int m = 0; m < 4; ++m) { float s = 0.f;
#pragma unroll
                    for (int bj = 0; bj < 2; ++bj)
#pragma unroll
                        for (int n = 0; n < 2; ++n) { const f32x4 x = acc[ai][bj][m][n]; s += (x[0] * x[0] + x[1] * x[1]) + (x[2] * x[2] + x[3] * x[3]); }
                    EDN_RED4(s); if (fq == 0) scr[(ai * HALF + wr * 64 + m * 16 + fr) * 4 + wc] = s; }
            EDN_BAR();
#pragma unroll
            for (int ai = 0; ai < 2; ++ai)
#pragma unroll
                for (int m = 0; m < 4; ++m) { const int rl = ai * HALF + wr * 64 + m * 16 + fr; const f32x4 p4 = *(const PG8_LAS f32x4*)(scr + rl * 4);
                    const float rq = 1.0f / sqrtf(((p4[0] + p4[1]) + (p4[2] + p4[3])) * (1.0f / 256.0f) + rms_eps); bf16_t* rowp = cqn + (size_t)(u.pm * BM + rl) * 256;
#pragma unroll
                    for (int bj = 0; bj < 2; ++bj)
#pragma unroll
                        for (int n = 0; n < 2; ++n) { const int col = bj * HALF + wc * 32 + n * 16 + 4 * fq; const f32x4 v = acc[ai][bj][m][n] * rq * *(const f32x4*)(gq + col); *(u32x2e*)(rowp + col) = EDN_PK(v); } }
        } else {
            float cmx = 0.f;
#pragma unroll
            for (int ai = 0; ai < 2; ++ai)
#pragma unroll
                for (int m = 0; m < 4; ++m) { const int rl = ai * HALF + wr * 64 + m * 16 + fr; float s1 = 0.f, s4 = 0.f, s2 = 0.f, s3 = 0.f;
#pragma unroll
                    for (int n = 0; n < 2; ++n) { const f32x4 x = acc[ai][0][m][n]; const f32x4 xg = x * *(const f32x4*)(gkv + wc * 32 + n * 16 + 4 * fq);
                        s1 += (x[0] * x[0] + x[1] * x[1]) + (x[2] * x[2] + x[3] * x[3]); s4 += (xg[0] * xg[0] + xg[1] * xg[1]) + (xg[2] * xg[2] + xg[3] * xg[3]);
                        const f32x4 y = acc[ai][1][m][n]; s2 += (y[0] + y[1]) + (y[2] + y[3]); s3 += (y[0] * y[0] + y[1] * y[1]) + (y[2] * y[2] + y[3] * y[3]); }
                    EDN_RED4(s1); EDN_RED4(s4); EDN_RED4(s2); EDN_RED4(s3);
                    if (fq == 0) { scr[rl * 4 + wc] = s1; scr[1024 + rl * 4 + wc] = s4; if (wc < 2) { scr[2048 + rl * 2 + wc] = s2; scr[2560 + rl * 2 + wc] = s3; } } }
            EDN_BAR();
#pragma unroll
            for (int ai = 0; ai < 2; ++ai)
#pragma unroll
                for (int m = 0; m < 4; ++m) { const int rl = ai * HALF + wr * 64 + m * 16 + fr; const size_t grow = (size_t)(u.pm * BM + rl);
                    const f32x4 p1 = *(const PG8_LAS f32x4*)(scr + rl * 4), p4 = *(const PG8_LAS f32x4*)(scr + 1024 + rl * 4);
                    const float rkv = 1.0f / sqrtf(((p1[0] + p1[1]) + (p1[2] + p1[3])) * (1.0f / 128.0f) + rms_eps);
                    cmx = fmaxf(cmx, ((p4[0] + p4[1]) + (p4[2] + p4[3])) * rkv * rkv);
#pragma unroll
                    for (int n = 0; n < 2; ++n) { const int col = wc * 32 + n * 16 + 4 * fq; const f32x4 v = acc[ai][0][m][n] * rkv * *(const f32x4*)(gkv + col); { int w8 = __builtin_amdgcn_cvt_pk_fp8_f32(v[0], v[1], 0, false); w8 = __builtin_amdgcn_cvt_pk_fp8_f32(v[2], v[3], w8, true); *(unsigned*)((unsigned char*)ckv + grow * 128 + col) = (unsigned)w8; } }
                    if (wc < 2) { const float sm = scr[2048 + rl * 2] + scr[2048 + rl * 2 + 1], sq = scr[2560 + rl * 2] + scr[2560 + rl * 2 + 1];
                        const float mean = sm * (1.0f / 64.0f); const float var = fmaxf(sq * (1.0f / 64.0f) - mean * mean, 0.f); const float rstd = 1.0f / sqrtf(var + ln_eps);
#pragma unroll
                        for (int n = 0; n < 2; ++n) { const int col = wc * 32 + n * 16 + 4 * fq; const f32x4 v = (acc[ai][1][m][n] - mean) * rstd * *(const f32x4*)(gki + col) + *(const f32x4*)(bki + col); *(u32x2e*)(kidx + grow * 64 + col) = EDN_PK(v); } }
                    if (wc == 2 && fq < 2) *(f32x4*)(widx + grow * 8 + 4 * fq) = acc[ai][1][m][0] * 0.04419417382415922f; }
            if (wc == 0 && fq == 0) __hip_atomic_fetch_max(cmaxw, __builtin_bit_cast(unsigned, sqrtf(cmx)), __ATOMIC_RELAXED, __HIP_MEMORY_SCOPE_AGENT);
        }
        EDN_BAR();
#undef EDN_RED4
#undef EDN_BAR
#undef EDN_PK
    }
};
struct EpiCq {
    static constexpr bool PERM = true, AFTER_DRAIN = false;
    bf16_t* qlat; bf16_t* qidx; float qls;
    __device__ __forceinline__ void operator()(const f32x4 (&acc)[2][2][4][2], const Unit& u, int wr, int wc, int fr_, int fq_) const {
        int t_ = threadIdx.x; asm volatile("" : "+v"(t_)); const int fr = t_ & 15, fq = (t_ & 63) >> 4; (void)fr_; (void)fq_;
        const int row0 = u.pm * BM + wr * 64 + fr; int colt = u.pn * BM; const bool lat = colt < 2048;
        if (!lat) colt -= 2048;
        const int col0 = colt + wc * 32 + 8 * fq; const float sc = lat ? qls : 1.0f;
        unsigned char* base = lat ? (unsigned char*)qlat + (size_t)col0 : (unsigned char*)qidx + (size_t)col0 * 2; const size_t rstride = lat ? 2048 : 1024; const int hoff = lat ? HALF : 2 * HALF;
#pragma unroll
        for (int ai = 0; ai < 2; ++ai)
#pragma unroll
            for (int m = 0; m < 4; ++m) { unsigned char* rowp = base + (size_t)(row0 + ai * HALF + m * 16) * rstride;
#pragma unroll
                for (int bj = 0; bj < 2; ++bj) { const f32x4 v0 = acc[ai][bj][m][0] * sc, v1 = acc[ai][bj][m][1] * sc;
                    if (lat) { typedef unsigned u32x2e __attribute__((ext_vector_type(2)));
                        int a0 = __builtin_amdgcn_cvt_pk_fp8_f32(v0[0], v0[1], 0, false); a0 = __builtin_amdgcn_cvt_pk_fp8_f32(v0[2], v0[3], a0, true);
                        int a1 = __builtin_amdgcn_cvt_pk_fp8_f32(v1[0], v1[1], 0, false); a1 = __builtin_amdgcn_cvt_pk_fp8_f32(v1[2], v1[3], a1, true);
                        u32x2e w; w.x = (unsigned)a0; w.y = (unsigned)a1; *(u32x2e*)(rowp + bj * hoff) = w; }
                    else { u32x4 w; w.x = cvt_pk_bf16(v0[0], v0[1]); w.y = cvt_pk_bf16(v0[2], v0[3]); w.z = cvt_pk_bf16(v1[0], v1[1]); w.w = cvt_pk_bf16(v1[2], v1[3]); *(u32x4*)(rowp + bj * hoff) = w; } } }
    }
};
struct EpiSwiglu {
    static constexpr bool PERM = true, AFTER_DRAIN = false;
    bf16_t* H; const float* bgu;
    __device__ __forceinline__ void operator()(const f32x4 (&acc)[2][2][4][2], const Unit& u, int wr, int wc, int fr_, int fq_) const {
        int t_ = threadIdx.x; asm volatile("" : "+v"(t_)); const int fr = t_ & 15, fq = (t_ & 63) >> 4; (void)fr_; (void)fq_;
        const int e = u.pn >> 3, pnl = u.pn & 7;
        const int row0 = u.pm * BM + wr * 64 + fr, col0 = pnl * 128 + wc * 32 + 8 * fq;
        const float* bg = bgu + (size_t)e * 2048 + col0; const float* bu = bg + 1024;
        f32x4 bgv[2], buv[2];
#pragma unroll
        for (int n = 0; n < 2; ++n) { bgv[n] = *(const f32x4*)(bg + 4 * n); buv[n] = *(const f32x4*)(bu + 4 * n); }
#pragma unroll
        for (int ai = 0; ai < 2; ++ai)
#pragma unroll
            for (int m = 0; m < 4; ++m) { bf16_t* rowp = H + (size_t)(row0 + ai * HALF + m * 16) * 1024 + col0;
                float h[8];
#pragma unroll
                for (int n = 0; n < 2; ++n) { const f32x4 g4 = acc[ai][0][m][n] + bgv[n], u4 = acc[ai][1][m][n] + buv[n];
#pragma unroll
                    for (int i = 0; i < 4; ++i) { const float g = fminf(g4[i], 7.0f); const float up = fminf(fmaxf(u4[i], -7.0f), 7.0f);
                        const float sg = __builtin_amdgcn_rcpf(1.0f + __builtin_amdgcn_exp2f(g * (-1.702f * 1.4426950408889634f)));
                        h[4 * n + i] = (up + 1.0f) * (g * sg); } }
                u32x4 w; w.x = cvt_pk_bf16(h[0], h[1]); w.y = cvt_pk_bf16(h[2], h[3]); w.z = cvt_pk_bf16(h[4], h[5]); w.w = cvt_pk_bf16(h[6], h[7]);
                *(u32x4*)rowp = w; }
    }
};
__device__ __forceinline__ unsigned cvt4_fp8(float a, float b, float c, float d) { int w = 0; w = __builtin_amdgcn_cvt_pk_fp8_f32(a, b, w, false); w = __builtin_amdgcn_cvt_pk_fp8_f32(c, d, w, true); return (unsigned)w; }
struct EpiSwiglu8 {
    static constexpr bool PERM = true, AFTER_DRAIN = false;
    unsigned char* H; const float* bgu; float inv, hs;
    __device__ __forceinline__ void operator()(const f32x4 (&acc)[2][2][4][2], const Unit& u, int wr, int wc, int fr_, int fq_) const {
        int t_ = threadIdx.x; asm volatile("" : "+v"(t_)); const int fr = t_ & 15, fq = (t_ & 63) >> 4; (void)fr_; (void)fq_;
        const int e = u.pn >> 3, pnl = u.pn & 7;
        const int row0 = u.pm * BM + wr * 64 + fr, col0 = pnl * 128 + wc * 32 + 8 * fq;
        const float* bg = bgu + (size_t)e * 2048 + col0; const float* bu = bg + 1024;
        typedef float f32x2e __attribute__((ext_vector_type(2)));
        constexpr float KS = -1.702f * 1.4426950408889634f;
        f32x2e bgk[2][2], buq[2][2];
#pragma unroll
        for (int n = 0; n < 2; ++n) { const f32x4 g4 = *(const f32x4*)(bg + 4 * n) * KS; const f32x4 u4 = *(const f32x4*)(bu + 4 * n);
            bgk[n][0] = (f32x2e){g4[0], g4[1]}; bgk[n][1] = (f32x2e){g4[2], g4[3]}; buq[n][0] = (f32x2e){u4[0], u4[1]}; buq[n][1] = (f32x2e){u4[2], u4[3]}; }
        const float ik = inv * KS, hk = hs / KS; const f32x2e ik2 = {ik, ik}, inv2 = {inv, inv}, hk2 = {hk, hk}, one2 = {1.0f, 1.0f};
#pragma unroll
        for (int ai = 0; ai < 2; ++ai)
#pragma unroll
            for (int m = 0; m < 4; ++m) { unsigned char* rowp = H + (size_t)(row0 + ai * HALF + m * 16) * 1024 + col0;
                f32x2e h[4];
#pragma unroll
                for (int n = 0; n < 2; ++n)
#pragma unroll
                    for (int q = 0; q < 2; ++q) { const f32x4 ag = acc[ai][0][m][n], au = acc[ai][1][m][n];
                        f32x2e gk = __builtin_elementwise_fma((f32x2e){ag[2 * q], ag[2 * q + 1]}, ik2, bgk[n][q]);
                        f32x2e uq = __builtin_elementwise_fma((f32x2e){au[2 * q], au[2 * q + 1]}, inv2, buq[n][q]);
                        gk.x = fmaxf(gk.x, 7.0f * KS); gk.y = fmaxf(gk.y, 7.0f * KS);
                        uq.x = __builtin_amdgcn_fmed3f(uq.x, -7.0f, 7.0f); uq.y = __builtin_amdgcn_fmed3f(uq.y, -7.0f, 7.0f);
                        const f32x2e d2 = (f32x2e){__builtin_amdgcn_exp2f(gk.x), __builtin_amdgcn_exp2f(gk.y)} + one2;
                        const f32x2e r2 = {__builtin_amdgcn_rcpf(d2.x), __builtin_amdgcn_rcpf(d2.y)};
                        h[2 * n + q] = (gk * r2) * __builtin_elementwise_fma(uq, hk2, hk2); }
                typedef unsigned u32x2e __attribute__((ext_vector_type(2)));
                u32x2e w; w.x = cvt4_fp8(h[0].x, h[0].y, h[1].x, h[1].y); w.y = cvt4_fp8(h[2].x, h[2].y, h[3].x, h[3].y);
                *(u32x2e*)rowp = w; }
    }
};
struct EpiDown8 {
    static constexpr bool PERM = true, AFTER_DRAIN = false;
    unsigned char* O; const float* bias; float inv, ys;
    __device__ __forceinline__ void operator()(const f32x4 (&acc)[2][2][4][2], const Unit& u, int wr, int wc, int fr_, int fq_) const {
        int t_ = threadIdx.x; asm volatile("" : "+v"(t_)); const int fr = t_ & 15, fq = (t_ & 63) >> 4; (void)fr_; (void)fq_;
        const int e = u.pn >> 2, pnl = u.pn & 3;
        const int row0 = u.pm * BM + wr * 64 + fr, col0 = pnl * BM + wc * 32 + 8 * fq;
        f32x4 bv[2][2];
#pragma unroll
        for (int bj = 0; bj < 2; ++bj)
#pragma unroll
            for (int n = 0; n < 2; ++n) bv[bj][n] = *(const f32x4*)(bias + (size_t)e * 1024 + col0 + bj * HALF + 4 * n) * ys;
        const float sc = inv * ys;
#pragma unroll
        for (int ai = 0; ai < 2; ++ai)
#pragma unroll
            for (int m = 0; m < 4; ++m) { unsigned char* rowp = O + (size_t)(row0 + ai * HALF + m * 16) * 1024 + col0;
#pragma unroll
                for (int bj = 0; bj < 2; ++bj) { const f32x4 v0 = acc[ai][bj][m][0] * sc + bv[bj][0], v1 = acc[ai][bj][m][1] * sc + bv[bj][1];
                    typedef unsigned u32x2e __attribute__((ext_vector_type(2)));
                    u32x2e w; w.x = cvt4_fp8(v0[0], v0[1], v0[2], v0[3]); w.y = cvt4_fp8(v1[0], v1[1], v1[2], v1[3]);
                    *(u32x2e*)(rowp + bj * HALF) = w; } }
    }
};
struct EpiQkv8 {
    static constexpr bool PERM = true, AFTER_DRAIN = false;
    bf16_t* O; size_t split_stride; float inv, scale0;
    __device__ __forceinline__ void operator()(const f32x4 (&acc)[2][2][4][2], const Unit& u, int wr, int wc, int fr_, int fq_) const {
        int t_ = threadIdx.x; asm volatile("" : "+v"(t_)); const int fr = t_ & 15, fq = (t_ & 63) >> 4; (void)fr_; (void)fq_;
        const int row0 = u.pm * BM + wr * 64 + fr; const int t = (u.pn * BM) >> 10; const int colt = u.pn * BM - (t << 10);
        bf16_t* base = O + (size_t)t * split_stride; const float sc = inv * (t == 0 ? scale0 : 1.f);
        const int col0 = colt + wc * 32 + 8 * fq;
#pragma unroll
        for (int ai = 0; ai < 2; ++ai)
#pragma unroll
            for (int m = 0; m < 4; ++m) { bf16_t* rowp = base + (size_t)(row0 + ai * HALF + m * 16) * 1024 + col0;
#pragma unroll
                for (int bj = 0; bj < 2; ++bj) { const f32x4 v0 = acc[ai][bj][m][0] * sc, v1 = acc[ai][bj][m][1] * sc;
                    u32x4 w; w.x = cvt_pk_bf16(v0[0], v0[1]); w.y = cvt_pk_bf16(v0[2], v0[3]); w.z = cvt_pk_bf16(v1[0], v1[1]); w.w = cvt_pk_bf16(v1[2], v1[3]);
                    *(u32x4*)(rowp + bj * HALF) = w; } }
    }
};
struct EpiBf16s {
    static constexpr bool PERM = true, AFTER_DRAIN = false;
    bf16_t* O; int ldc; float inv;
    __device__ __forceinline__ void operator()(const f32x4 (&acc)[2][2][4][2], const Unit& u, int wr, int wc, int fr_, int fq_) const {
        int t_ = threadIdx.x; asm volatile("" : "+v"(t_)); const int fr = t_ & 15, fq = (t_ & 63) >> 4; (void)fr_; (void)fq_;
        const int row0 = u.pm * BM + wr * 64 + fr, col0 = u.pn * BM + wc * 32 + 8 * fq;
#pragma unroll
        for (int ai = 0; ai < 2; ++ai)
#pragma unroll
            for (int m = 0; m < 4; ++m) { bf16_t* rowp = O + (size_t)(row0 + ai * HALF + m * 16) * ldc + col0;
#pragma unroll
                for (int bj = 0; bj < 2; ++bj) { const f32x4 v0 = acc[ai][bj][m][0] * inv, v1 = acc[ai][bj][m][1] * inv;
                    u32x4 w; w.x = cvt_pk_bf16(v0[0], v0[1]); w.y = cvt_pk_bf16(v0[2], v0[3]); w.z = cvt_pk_bf16(v1[0], v1[1]); w.w = cvt_pk_bf16(v1[2], v1[3]);
                    *(u32x4*)(rowp + bj * HALF) = w; } }
    }
};
struct EpiF8s {
    static constexpr bool PERM = true, AFTER_DRAIN = false;
    unsigned char* O; float sc;
    __device__ __forceinline__ void operator()(const f32x4 (&acc)[2][2][4][2], const Unit& u, int wr, int wc, int fr_, int fq_) const {
        int t_ = threadIdx.x; asm volatile("" : "+v"(t_)); const int fr = t_ & 15, fq = (t_ & 63) >> 4; (void)fr_; (void)fq_;
        const int row0 = u.pm * BM + wr * 64 + fr, col0 = u.pn * BM + wc * 32 + 8 * fq;
#pragma unroll
        for (int ai = 0; ai < 2; ++ai)
#pragma unroll
            for (int m = 0; m < 4; ++m) { unsigned char* rowp = O + (size_t)(row0 + ai * HALF + m * 16) * 1024 + col0;
#pragma unroll
                for (int bj = 0; bj < 2; ++bj) { const f32x4 v0 = acc[ai][bj][m][0] * sc, v1 = acc[ai][bj][m][1] * sc;
                    typedef unsigned u32x2e __attribute__((ext_vector_type(2)));
                    u32x2e w; w.x = cvt4_fp8(v0[0], v0[1], v0[2], v0[3]); w.y = cvt4_fp8(v1[0], v1[1], v1[2], v1[3]);
                    *(u32x2e*)(rowp + bj * HALF) = w; } }
    }
};
struct EpiResF32s {
    static constexpr bool PERM = false, AFTER_DRAIN = false;
    const float* base; float* out; int ldc; float alpha, inv;
    __device__ __forceinline__ void operator()(const f32x4 (&acc)[2][2][4][2], const Unit& u, int wr, int wc, int fr_, int fq_) const {
        int t_ = threadIdx.x; asm volatile("" : "+v"(t_)); const int fr = t_ & 15, fq = (t_ & 63) >> 4; (void)fr_; (void)fq_;
        const int row0 = u.pm * BM + wr * 64 + fr, col0 = u.pn * BM + wc * 32 + 4 * fq;
#pragma unroll
        for (int ai = 0; ai < 2; ++ai)
#pragma unroll
            for (int m = 0; m < 4; ++m) { const size_t off = (size_t)(row0 + ai * HALF + m * 16) * ldc + col0;
                f32x4 bs[2][2];
#pragma unroll
                for (int bj = 0; bj < 2; ++bj)
#pragma unroll
                    for (int n = 0; n < 2; ++n) bs[bj][n] = *(const f32x4*)(base + off + bj * HALF + n * 16);
#pragma unroll
                for (int bj = 0; bj < 2; ++bj)
#pragma unroll
                    for (int n = 0; n < 2; ++n) *(f32x4*)(out + off + bj * HALF + n * 16) = bs[bj][n] * alpha + acc[ai][bj][m][n] * inv; }
    }
};
struct MoeOrder {
    int nT, nNl, G, c; const PG8_LAS int* tile_e;
    __device__ __forceinline__ bool next(int i, Unit& u) const {
        const int nwg = nT * nNl; const long L = (long)i * G + c; if (L >= nwg) return false;
        const int q = nwg / NXCD, r = nwg % NXCD, xcd = (int)(L % NXCD), off = (int)(L / NXCD);
        const int wgid = (xcd < r ? xcd * (q + 1) : r * (q + 1) + (xcd - r) * q) + off;
        const int pm = wgid / nNl, j = wgid % nNl;
        u.pm = pm; u.pn = tile_e[pm] * nNl + j; return true;
    }
    __device__ __forceinline__ void a_ready(const Unit&) const {}
    __device__ __forceinline__ void done(const Unit&) const {}
};
}
#ifndef PG8_SP2
#define PG8_SP2 true
#endif
#ifndef PG8_ALIGN
#define PG8_ALIGN true
#endif
#include <hip/hip_bf16.h>
#include <cmath>
namespace attn_body {
using bf16=__hip_bfloat16;
using bf16x8=__attribute__((ext_vector_type(8)))short;
using s16x4=__attribute__((ext_vector_type(4)))short;
using f32x16=__attribute__((ext_vector_type(16)))float;
using u32x4=__attribute__((ext_vector_type(4)))unsigned;
constexpr int BATCH=8,NHEAD=16,SEQ=4096,D=64,DM=NHEAD*D,XD=16;
constexpr int NW=8,QBLK=32,QB=QBLK*NW,KVBLK=64,NQB=SEQ/QB;
constexpr int ATTN_PITCH=DM, ATTN_UNIT_ROWS=QB;
__device__ __forceinline__ int crow(int r,int hi){return (r&3)+8*(r>>2)+4*hi;}
#define SBAR() __builtin_amdgcn_sched_barrier(0)
__device__ __forceinline__ void cmask(f32x16&p0,f32x16&p1,int jb,int qrel,int hi){
  const float NEG=-INFINITY; int kb=64*jb+4*hi;
  #pragma unroll
  for(int r=0;r<16;++r){int kv=kb+(r&3)+8*(r>>2); if(kv>qrel)p0[r]=NEG; if(kv+32>qrel)p1[r]=NEG;}
}

constexpr int NSLOT=3, SLOTB=10240;
constexpr int LDS_K=0, LDS_V=NSLOT*SLOTB, LDS_WS=2*NSLOT*SLOTB, LDS_OST=LDS_WS+NW*64*4, LDS_BYTES=LDS_OST+NW*4096;
constexpr float C2=0.125f*1.4426950408889634f;
__device__ __forceinline__ void glds16(const void*gsrc,unsigned lds_dst){unsigned keep;
  asm volatile("s_mov_b32 %0, m0\n\ts_mov_b32 m0, %2\n\ts_nop 0\n\tglobal_load_lds_dwordx4 %1, off\n\ts_mov_b32 m0, %0":"=&s"(keep):"v"(gsrc),"s"(lds_dst):"memory");}
__device__ __forceinline__ float max3f(float a,float b,float c){float r;asm("v_max3_f32 %0, %1, %2, %3":"=v"(r):"v"(a),"v"(b),"v"(c));return r;}
__device__ __forceinline__ float max2f(float a,float b){float r;asm("v_max_f32_e32 %0, %1, %2":"=v"(r):"v"(a),"v"(b));return r;}
__device__ __forceinline__ float fadd_s(float a,float b){float r;asm("v_add_f32_e32 %0, %1, %2":"=v"(r):"v"(a),"v"(b));return r;}
__device__ __forceinline__ float fsub_s(float a,float b){float r;asm("v_sub_f32_e32 %0, %1, %2":"=v"(r):"v"(a),"v"(b));return r;}
typedef float f32x2_t __attribute__((ext_vector_type(2))); typedef __bf16 bf16x2_t __attribute__((ext_vector_type(2)));
__device__ __forceinline__ unsigned cvtpk_s(float lo,float hi){f32x2_t v={lo,hi};bf16x2_t b=__builtin_convertvector(v,bf16x2_t);return __builtin_bit_cast(unsigned,b);}
#define WAIT_BAR(N) asm volatile("s_waitcnt vmcnt(" #N ") lgkmcnt(0)\n\ts_barrier":::"memory")

__device__ __forceinline__ void qkt(f32x16&p0,f32x16&p1,const char*Kslot,const bf16x8*qr,int r32,int hi){
  const f32x16 zz=f32x16{};
  const char*kb=Kslot+hi*1024+r32*16;
  #pragma unroll
  for(int d0=0;d0<5;++d0){
    const bf16x8 b0=*reinterpret_cast<const bf16x8*>(kb+d0*2048);
    const bf16x8 b1=*reinterpret_cast<const bf16x8*>(kb+d0*2048+512);
    if(d0==0){p0=__builtin_amdgcn_mfma_f32_32x32x16_bf16(b0,qr[0],zz,0,0,0);p1=__builtin_amdgcn_mfma_f32_32x32x16_bf16(b1,qr[0],zz,0,0,0);}
    else{p0=__builtin_amdgcn_mfma_f32_32x32x16_bf16(b0,qr[d0],p0,0,0,0);p1=__builtin_amdgcn_mfma_f32_32x32x16_bf16(b1,qr[d0],p1,0,0,0);}}
}
typedef __attribute__((address_space(3))) const char* lds_cptr;
typedef short v4i16_t __attribute__((ext_vector_type(4)));
__device__ __forceinline__ void kload8(bf16x8*kf,lds_cptr kp){
  kf[0]=*(const __attribute__((address_space(3))) bf16x8*)(kp);      kf[1]=*(const __attribute__((address_space(3))) bf16x8*)(kp+512);
  kf[2]=*(const __attribute__((address_space(3))) bf16x8*)(kp+2048); kf[3]=*(const __attribute__((address_space(3))) bf16x8*)(kp+2560);
  kf[4]=*(const __attribute__((address_space(3))) bf16x8*)(kp+4096); kf[5]=*(const __attribute__((address_space(3))) bf16x8*)(kp+4608);
  kf[6]=*(const __attribute__((address_space(3))) bf16x8*)(kp+6144); kf[7]=*(const __attribute__((address_space(3))) bf16x8*)(kp+6656);
  kf[8]=*(const __attribute__((address_space(3))) bf16x8*)(kp+8192); kf[9]=*(const __attribute__((address_space(3))) bf16x8*)(kp+8704);
}
__device__ __forceinline__ void kload2(bf16x8*kf,lds_cptr kp,int j){ kf[2*j]=*(const __attribute__((address_space(3))) bf16x8*)(kp+j*2048); kf[2*j+1]=*(const __attribute__((address_space(3))) bf16x8*)(kp+j*2048+512); }
__device__ __forceinline__ s16x4 vtr(lds_cptr p){ return __builtin_bit_cast(s16x4,__builtin_amdgcn_ds_read_tr16_b64_v4i16((__attribute__((address_space(3))) v4i16_t*)p)); }
__device__ __forceinline__ float rowmax(const f32x16&p0,const f32x16&p1){
  float a=max3f(p0[0],p0[1],p1[0]),b=max3f(p0[2],p0[3],p1[1]);a=max3f(a,p1[2],p1[3]);
  #pragma unroll
  for(int r=4;r<16;r+=4){a=max3f(a,p0[r],p0[r+1]);b=max3f(b,p0[r+2],p0[r+3]);a=max3f(a,p1[r],p1[r+1]);b=max3f(b,p1[r+2],p1[r+3]);}
  const float m=max2f(a,b);
  auto rr=__builtin_amdgcn_permlane32_swap(__float_as_uint(m),__float_as_uint(m),false,false);
  return max2f(__uint_as_float(rr[0]),__uint_as_float(rr[1]));
}
__device__ __forceinline__ void pv(f32x16*o,int vb,bf16x8 pa0,bf16x8 pa1,bf16x8 pa2,bf16x8 pa3){
  #pragma unroll
  for(int d0=0;d0<2;++d0){s16x4 lo[4],hi[4];
    #pragma unroll
    for(int ks=0;ks<4;++ks){
      asm volatile("ds_read_b64_tr_b16 %0,%1 offset:%c2":"=&v"(lo[ks]):"v"(vb),"i"(d0*4096+ks*1024):"memory");
      asm volatile("ds_read_b64_tr_b16 %0,%1 offset:%c2":"=&v"(hi[ks]):"v"(vb),"i"(d0*4096+ks*1024+512):"memory");}
    asm volatile("s_waitcnt lgkmcnt(0)":::"memory");SBAR();
    #define PK(k) (bf16x8){lo[k][0],lo[k][1],lo[k][2],lo[k][3],hi[k][0],hi[k][1],hi[k][2],hi[k][3]}
    o[d0]=__builtin_amdgcn_mfma_f32_32x32x16_bf16(pa0,PK(0),o[d0],0,0,0);
    o[d0]=__builtin_amdgcn_mfma_f32_32x32x16_bf16(pa1,PK(1),o[d0],0,0,0);
    o[d0]=__builtin_amdgcn_mfma_f32_32x32x16_bf16(pa2,PK(2),o[d0],0,0,0);
    o[d0]=__builtin_amdgcn_mfma_f32_32x32x16_bf16(pa3,PK(3),o[d0],0,0,0);
    #undef PK
  }
}

#ifndef ATTN_STORE16
#define ATTN_STORE16(p,v) (*(u32x4*)(p)=(v))
#endif
__device__ __forceinline__ void set_m(bf16x8&q4,float mneg,int hi){
  const unsigned p1=cvtpk_s(mneg,0.f)&0xffffu; const float f1=__uint_as_float(p1<<16); const float r1=mneg-f1;
  const unsigned p2=cvtpk_s(r1,0.f)&0xffffu;   const float f2=__uint_as_float(p2<<16); const float r2=r1-f2;
  const unsigned p3=cvtpk_s(r2,0.f)&0xffffu;
  u32x4 w=__builtin_bit_cast(u32x4,q4); w[3]=hi?w[3]:(p1|(p2<<16)); w[0]=hi?p3:w[0]; q4=__builtin_bit_cast(bf16x8,w);
}
template<int THRL,bool GUARD> __device__ __forceinline__ void attn_unit(int b,int h,int qb,const bf16*Q,const bf16*__restrict__ K,const bf16*__restrict__ V,bf16*O,const bf16*__restrict__ QX,const bf16*__restrict__ KX,const float*__restrict__ DG,char*shm,int ts,unsigned*qctr,unsigned*tkslot){
  int tid_o=threadIdx.x; asm volatile("":"+v"(tid_o)); const int tid=tid_o,lane=tid&63,r32=lane&31,hi=lane>>5; const int wid=__builtin_amdgcn_readfirstlane(tid>>6);
  const long rowbase=(long)b*SEQ; const int q0=qb*QB;
  const bf16*Qw=Q+(rowbase+q0+wid*QBLK)*DM+h*D;
  const bf16*Kh=K+(rowbase+(long)ts*KVBLK)*DM+h*D,*Vh=V+(rowbase+(long)ts*KVBLK)*DM+h*D;
  const unsigned lds0=(unsigned)(uintptr_t)shm;
  float*wsf=(float*)(shm+LDS_WS)+wid*64;
  const bf16*ksrc=Kh+(long)lane*DM+wid*8;
  const bf16*vsrc=Vh+(long)(16*(wid&3)+(lane>>2))*DM+(wid>>2)*32+(lane&3)*8;
  const bf16*kxsrc=KX+((rowbase+(long)ts*KVBLK+lane)*NHEAD+h)*XD+(wid&1)*8;
  const unsigned kdst=lds0+LDS_K+wid*1024, vdst=lds0+LDS_V+wid*1024, kxdst=lds0+LDS_K+8192+(wid&1)*1024;
  #define DMA_K(t,slot) do{ glds16(ksrc+(long)(t)*KVBLK*DM,(unsigned)__builtin_amdgcn_readfirstlane(kdst+(slot))); glds16(kxsrc+(long)(t)*KVBLK*NHEAD*XD,(unsigned)__builtin_amdgcn_readfirstlane(kxdst+(slot))); }while(0)
  #define DMA_V(t,slot) glds16(vsrc+(long)(t)*KVBLK*DM,(unsigned)__builtin_amdgcn_readfirstlane(vdst+(slot)))
  const int vb0=(int)(lds0+LDS_V)+((lane>>4)&1)*32+(lane&3)*8+(4*hi+((lane&15)>>2))*64;
  const char*Kbase=shm+LDS_K; bf16x8 kf[10];
  const lds_cptr shm3=(lds_cptr)shm; const lds_cptr kp0=shm3+LDS_K+hi*1024+r32*16; const lds_cptr vp0=shm3+LDS_V+((lane>>4)&1)*32+(lane&3)*8+(4*hi+((lane&15)>>2))*64;
  const int NT=(q0+QB)/KVBLK-ts;
  DMA_K(0,0);DMA_V(0,0);DMA_K(1,SLOTB);
  bf16x8 qr[5];
  #pragma unroll
  for(int d0=0;d0<4;++d0)qr[d0]=*reinterpret_cast<const bf16x8*>(&Qw[(long)r32*DM+d0*16+hi*8]);
  qr[4]=*reinterpret_cast<const bf16x8*>(&QX[((rowbase+q0+wid*QBLK+r32)*NHEAD+h)*XD+hi*8]);
  float mhat=DG[(rowbase+q0+wid*QBLK+r32)*NHEAD+h]; set_m(qr[4],-mhat,hi); asm volatile("":"+v"(qr[4]));
  float l_reg=0.f;f32x16 o[2];o[0]=f32x16{};o[1]=f32x16{};const f32x16 zero16=f32x16{};
  const int qrel=wid*QBLK+r32;
  #define CMASK(P0,P1,t) do{int jb_=(t)-(NT-4); if(jb_>=0)cmask(P0,P1,jb_,qrel,hi);}while(0)
  bool resc=false;
  #define START(P0,P1) do{ resc=false; \
    if constexpr(GUARD){ const float rm=rowmax(P0,P1); if(__any(rm>(float)THRL)){ const float dl=__builtin_fmaxf(rm,0.f); mhat+=dl; \
      _Pragma("unroll") for(int r=0;r<16;++r){P0[r]-=dl;P1[r]-=dl;} set_m(qr[4],-mhat,hi); asm volatile("":"+v"(qr[4])); } } \
    _Pragma("unroll") for(int r=0;r<16;++r)P0[r]=__builtin_amdgcn_exp2f(P0[r]); }while(0)
  #define RESC() do{ if(resc){ asm volatile("s_waitcnt lgkmcnt(0)":::"memory"); \
      _Pragma("unroll") for(int d_=0;d_<2;++d_) _Pragma("unroll") for(int r=0;r<16;++r)o[d_][r]*=wsf[crow(r,hi)]; } }while(0)
  f32x16 pA0,pA1,pB0,pB1;
  int sl_prev=0,sl_cur=0,sl_next=SLOTB;
  #define ROT() do{sl_prev=sl_cur;sl_cur=sl_next;sl_next=(sl_next==(NSLOT-1)*SLOTB)?0:sl_next+SLOTB;}while(0)
  DMA_K(2,2*SLOTB);
  WAIT_BAR(3);
  qkt(pA0,pA1,Kbase,qr,r32,hi);asm volatile("s_nop 15\n\ts_nop 7":"+v"(pA0),"+v"(pA1));CMASK(pA0,pA1,0);
  START(pA0,pA1);
  _Pragma("unroll") for(int r=0;r<16;++r)pA1[r]=__builtin_amdgcn_exp2f(pA1[r]);
  WAIT_BAR(0);
  DMA_K(3,0);DMA_V(1,SLOTB);
  ROT();
  kload8(kf,kp0+sl_cur);
  WAIT_BAR(3);
  s16x4 vlo[8],vhi[8]; u32x4 pw0,pw1,pw2,pw3;
  #define PKW(P,B) cvtpk_s(P[B],P[B+1])
  #define PAF(k) __builtin_bit_cast(bf16x8,pw##k)
  #define VFR(i) (bf16x8){vlo[i][0],vlo[i][1],vlo[i][2],vlo[i][3],vhi[i][0],vhi[i][1],vhi[i][2],vhi[i][3]}
  #define PIN(x) asm volatile("":"+v"(x))
  #define MX3(a,b,c) __builtin_fmaxf(__builtin_fmaxf((a),(b)),(c))
  #define GAPA(MF,A0,A1,A2,A3,W0,W1,PW) do{ MF; sacc+=A0; sacc+=A1; sacc+=A2; sacc+=A3; PIN(sacc); W0; W1; PIN(PW); SBAR(); }while(0)
  #define EX(v) __builtin_amdgcn_exp2f(v)
  #define GAPB(MF,X,B) do{ MF; X[B]=EX(X[B]); X[B+1]=EX(X[B+1]); X[B+2]=EX(X[B+2]); X[B+3]=EX(X[B+3]); PIN(X); SBAR(); }while(0)
  #define VRD(i) do{ vlo[i]=vtr(vp_+(((i)>>2)*4096+((i)&3)*1024)); vhi[i]=vtr(vp_+(((i)>>2)*4096+((i)&3)*1024+512)); }while(0)
  #define KRD(G,j) do{ if(G){ kload2(kf,kp0+sl_next,j); SBAR(); } }while(0)
  #define STEP(C0,C1,P0,P1,t,GK,GV,GL) do{ SBAR(); \
    const lds_cptr vp_=vp0+sl_prev; \
    VRD(0); SBAR(); float sacc=(P0[0]+P0[1]); \
    GAPA(C0=__builtin_amdgcn_mfma_f32_32x32x16_bf16(kf[0],qr[0],zero16,0,0,0), P0[2],P0[3],P0[4],P0[5],     pw0[0]=PKW(P0,0), pw0[1]=PKW(P0,2), pw0); \
    VRD(4); SBAR(); GAPA(C1=__builtin_amdgcn_mfma_f32_32x32x16_bf16(kf[1],qr[0],zero16,0,0,0), P0[6],P0[7],P0[8],P0[9],     pw0[2]=PKW(P0,4), pw0[3]=PKW(P0,6), pw0); \
    VRD(1); SBAR(); GAPA(C0=__builtin_amdgcn_mfma_f32_32x32x16_bf16(kf[2],qr[1],C0,0,0,0),   P0[10],P0[11],P0[12],P0[13], pw1[0]=PKW(P0,8), pw1[1]=PKW(P0,10), pw1); \
    VRD(5); SBAR(); GAPA(C1=__builtin_amdgcn_mfma_f32_32x32x16_bf16(kf[3],qr[1],C1,0,0,0),   P0[14],P0[15],P1[0],P1[1],   pw1[2]=PKW(P0,12),pw1[3]=PKW(P0,14), pw1); \
    VRD(2); SBAR(); GAPA(C0=__builtin_amdgcn_mfma_f32_32x32x16_bf16(kf[4],qr[2],C0,0,0,0),   P1[2],P1[3],P1[4],P1[5],     pw2[0]=PKW(P1,0), pw2[1]=PKW(P1,2), pw2); \
    VRD(6); SBAR(); GAPA(C1=__builtin_amdgcn_mfma_f32_32x32x16_bf16(kf[5],qr[2],C1,0,0,0),   P1[6],P1[7],P1[8],P1[9],     pw2[2]=PKW(P1,4), pw2[3]=PKW(P1,6), pw2); \
    VRD(3); SBAR(); GAPA(C0=__builtin_amdgcn_mfma_f32_32x32x16_bf16(kf[6],qr[3],C0,0,0,0),   P1[10],P1[11],P1[12],P1[13], pw3[0]=PKW(P1,8), pw3[1]=PKW(P1,10), pw3); \
    VRD(7); SBAR(); GAPA(C1=__builtin_amdgcn_mfma_f32_32x32x16_bf16(kf[7],qr[3],C1,0,0,0),   P1[14],P1[15],0.f,0.f,       pw3[2]=PKW(P1,12),pw3[3]=PKW(P1,14), pw3); \
    C0=__builtin_amdgcn_mfma_f32_32x32x16_bf16(kf[8],qr[4],C0,0,0,0); C1=__builtin_amdgcn_mfma_f32_32x32x16_bf16(kf[9],qr[4],C1,0,0,0); SBAR(); \
    l_reg+=sacc; \
    if(GK){DMA_K((t)+3,sl_cur);} if(GV){DMA_V((t)+1,sl_next);} \
    CMASK(C0,C1,t); \
    if constexpr(!GUARD){ resc=false; } else { float a=MX3(C0[0],C0[1],C1[0]),b=MX3(C0[2],C0[3],C1[1]); a=MX3(a,C1[2],C1[3]); \
      _Pragma("unroll") for(int r=4;r<16;r+=4){a=MX3(a,C0[r],C0[r+1]);b=MX3(b,C0[r+2],C0[r+3]);a=MX3(a,C1[r],C1[r+1]);b=MX3(b,C1[r+2],C1[r+3]);} \
      float rm=__builtin_fmaxf(a,b); { auto rr=__builtin_amdgcn_permlane32_swap(__float_as_uint(rm),__float_as_uint(rm),false,false); rm=__builtin_fmaxf(__uint_as_float(rr[0]),__uint_as_float(rr[1])); } \
      resc=false; \
      if(__builtin_expect(__any(rm>(float)THRL),0)){ const float dl=__builtin_fmaxf(rm,0.f); mhat+=dl; \
        _Pragma("unroll") for(int r=0;r<16;++r){C0[r]-=dl;C1[r]-=dl;} \
        set_m(qr[4],-mhat,hi); asm volatile("":"+v"(qr[4])); \
        const float f=__builtin_amdgcn_exp2f(-dl); l_reg*=f; if(hi==0)wsf[r32]=f; resc=true; } } \
    SBAR(); \
    GAPB(o[0]=__builtin_amdgcn_mfma_f32_32x32x16_bf16(PAF(0),VFR(0),o[0],0,0,0), C0,0); \
    GAPB(o[1]=__builtin_amdgcn_mfma_f32_32x32x16_bf16(PAF(0),VFR(4),o[1],0,0,0), C0,4); \
    KRD(GL,0); GAPB(o[0]=__builtin_amdgcn_mfma_f32_32x32x16_bf16(PAF(1),VFR(1),o[0],0,0,0), C0,8); \
    KRD(GL,1); GAPB(o[1]=__builtin_amdgcn_mfma_f32_32x32x16_bf16(PAF(1),VFR(5),o[1],0,0,0), C0,12); \
    KRD(GL,2); GAPB(o[0]=__builtin_amdgcn_mfma_f32_32x32x16_bf16(PAF(2),VFR(2),o[0],0,0,0), C1,0); \
    KRD(GL,3); GAPB(o[1]=__builtin_amdgcn_mfma_f32_32x32x16_bf16(PAF(2),VFR(6),o[1],0,0,0), C1,4); \
    KRD(GL,4); GAPB(o[0]=__builtin_amdgcn_mfma_f32_32x32x16_bf16(PAF(3),VFR(3),o[0],0,0,0), C1,8); \
    GAPB(o[1]=__builtin_amdgcn_mfma_f32_32x32x16_bf16(PAF(3),VFR(7),o[1],0,0,0), C1,12); \
    }while(0)
  int t=1;
  #undef CMASK
  #define CMASK(P0,P1,t) do{}while(0)
  for(;t+5<NT;t+=2){
    STEP(pB0,pB1,pA0,pA1,t,true,true,true);     WAIT_BAR(3); RESC(); ROT();
    STEP(pA0,pA1,pB0,pB1,t+1,true,true,true);   WAIT_BAR(3); RESC(); ROT();
  }
  #undef CMASK
  #define CMASK(P0,P1,t) do{int jb_=(t)-(NT-4); if(jb_>=0)cmask(P0,P1,jb_,qrel,hi);}while(0)
  #define ENDW(tt) do{ if((tt)+3<NT){WAIT_BAR(3);} else if((tt)+2<NT){WAIT_BAR(1);} else {WAIT_BAR(0);} }while(0)
  for(;t+1<NT;t+=2){
    STEP(pB0,pB1,pA0,pA1,t,(t+3<NT),(t+1<NT),(t+1<NT));       ENDW(t);   RESC(); ROT();
    STEP(pA0,pA1,pB0,pB1,t+1,(t+4<NT),(t+2<NT),(t+2<NT));     ENDW(t+1); RESC(); ROT();
  }
  STEP(pB0,pB1,pA0,pA1,NT-1,false,false,false); RESC();
  { float sacc=pB0[0]+pB0[1]; _Pragma("unroll") for(int r=2;r<16;++r)sacc+=pB0[r]; _Pragma("unroll") for(int r=0;r<16;++r)sacc+=pB1[r]; l_reg+=sacc;
    pw0=(u32x4){PKW(pB0,0),PKW(pB0,2),PKW(pB0,4),PKW(pB0,6)};pw1=(u32x4){PKW(pB0,8),PKW(pB0,10),PKW(pB0,12),PKW(pB0,14)};pw2=(u32x4){PKW(pB1,0),PKW(pB1,2),PKW(pB1,4),PKW(pB1,6)};pw3=(u32x4){PKW(pB1,8),PKW(pB1,10),PKW(pB1,12),PKW(pB1,14)};
    SBAR(); pv(o,vb0+sl_cur,PAF(0),PAF(1),PAF(2),PAF(3)); }
  #undef PKW
  #undef PAF
  #undef VFR
  #undef PIN
  #undef MX3
  #undef GAPA
  #undef GAPB
  #undef EX
  #undef VRD
  #undef KRD
  #undef STEP
  #undef ENDW
  unsigned nxt_tk=0u; if(tid==0)nxt_tk=__hip_atomic_fetch_add(qctr,1u,__ATOMIC_RELAXED,__HIP_MEMORY_SCOPE_AGENT);
  {auto rr=__builtin_amdgcn_permlane32_swap(__float_as_uint(l_reg),__float_as_uint(l_reg),false,false);l_reg=__uint_as_float(rr[0])+__uint_as_float(rr[1]);}
  if(hi==0)wsf[32+r32]=l_reg;asm volatile("s_waitcnt lgkmcnt(0)":::"memory");
  float rli[16];
  #pragma unroll
  for(int r=0;r<16;++r)rli[r]=__builtin_amdgcn_rcpf(wsf[32+crow(r,hi)]);
  { unsigned char*stg=(unsigned char*)(shm+LDS_OST)+wid*2048;
    #pragma unroll
    for(int r=0;r<16;++r){const int orow=crow(r,hi); const float sc=rli[r]*32.0f;
      const unsigned pkd=(unsigned)__builtin_amdgcn_cvt_pk_fp8_f32(o[0][r]*sc,o[1][r]*sc,0,false);
      stg[orow*64+r32]=(unsigned char)(pkd&0xffu); stg[orow*64+32+r32]=(unsigned char)((pkd>>8)&0xffu);}
    asm volatile("s_waitcnt lgkmcnt(0)":::"memory");
    unsigned char*Ow8=(unsigned char*)O+(rowbase+q0+wid*QBLK)*DM+h*D;
    #pragma unroll
    for(int i=0;i<2;++i){const int row=i*16+(lane>>2),ch=lane&3; const u32x4 v=*(const u32x4*)(stg+row*64+ch*16); ATTN_STORE16(Ow8+(long)row*DM+ch*16,v);} }
  if(tid==0)*tkslot=nxt_tk;
  asm volatile("s_waitcnt lgkmcnt(0)\n\ts_barrier":::"memory");
  #undef DMA_K
  #undef DMA_V
  #undef CMASK
  #undef START
  #undef RESC
  #undef ROT
}
constexpr int ATTN_LDS_BYTES=LDS_BYTES;
struct AttnTensors { const bf16* Q; const bf16* K; const bf16* V; bf16* O; const bf16* QX; const bf16* KX; const float* DG; };
struct AttnUnit { int bh; int qb; };
struct StaticOrder {
  int vcu, G;
  __device__ __forceinline__ explicit StaticOrder(int grid,int block):vcu((grid%8==0)?(block%8)*(grid/8)+block/8:block),G(grid){}
  __device__ __forceinline__ bool next(int i,AttnUnit&u)const{
    if(G==256){ if(i>=8)return false; const int s=vcu&1,p=i>>1,j=i&1; u.bh=vcu>>1; u.qb=4*p+(j?3-s:s); return true; }
    const int L=i*G+vcu; if(L>=BATCH*NHEAD*NQB)return false; u.bh=L%(BATCH*NHEAD); u.qb=NQB-1-L/(BATCH*NHEAD); return true; }
  __device__ __forceinline__ void a_ready(const AttnUnit&)const{}
  __device__ __forceinline__ void done(const AttnUnit&)const{}
};
template<int THRL=8> __device__ __forceinline__ void attn_phase(char*lds,const AttnTensors&T,unsigned*qctr,const unsigned char*ts_glob){
  unsigned*tkslot=(unsigned*)(lds+LDS_BYTES); unsigned char*tstab=(unsigned char*)(lds+LDS_BYTES+64);
  { const int tid=threadIdx.x; ((unsigned*)tstab)[tid]=((const unsigned*)ts_glob)[tid];
    if(tid==0)*tkslot=__hip_atomic_fetch_add(qctr,1u,__ATOMIC_RELAXED,__HIP_MEMORY_SCOPE_AGENT); }
  __syncthreads();
  for(;;){ const unsigned u=(unsigned)__builtin_amdgcn_readfirstlane((int)*(volatile __attribute__((address_space(3))) unsigned*)tkslot); if(u>=(unsigned)(BATCH*NHEAD*NQB))break;
    const int qb=NQB-1-(int)(u>>7), bh=(int)(u&127); const int tsv=__builtin_amdgcn_readfirstlane((int)tstab[bh*NQB+qb]); const int ts=tsv&~1;
    if(tsv&1) attn_unit<THRL,true>(bh/NHEAD,bh%NHEAD,qb,T.Q,T.K,T.V,T.O,T.QX,T.KX,T.DG,lds,ts,qctr,tkslot);
    else      attn_unit<THRL,false>(bh/NHEAD,bh%NHEAD,qb,T.Q,T.K,T.V,T.O,T.QX,T.KX,T.DG,lds,ts,qctr,tkslot); }
  __syncthreads();
}
#undef SBAR
#undef WAIT_BAR
}

constexpr int NWAVES = 8;
#ifndef MK_N_LAUNCHES
#define MK_N_LAUNCHES 1
#endif
constexpr int BATCH = 8, T = 4096, D = 1024, M = BATCH * T;
constexpr int A_H = 16, A_RQ = 256, A_RKV = 128, IDX_H = 8, IDX_D = 64, A_INW = 456, TOPK = 256;
constexpr int B_INW = 3088;
constexpr int NEXP = 32, MOE_K = 4, DEXP = 1024;
constexpr int NPAIR = M * MOE_K;
constexpr int MAXSLOT = NPAIR + NEXP * 256;
constexpr float LN_EPS = 1e-5f, RMS_EPS = 1e-6f;
constexpr float DN_ALPHA = 1.41421356237309515f;
constexpr float LOG2E = 1.4426950408889634f;
constexpr int N_PHASES = 19;

constexpr size_t MiB = 1u << 20;
constexpr size_t WS_CTL = 0, CTL_ZERO_BYTES = 1 * MiB;
constexpr size_t WS_SMALL = 1 * MiB;
constexpr size_t WS_WAIN = 2 * MiB, WS_WACQ = 3 * MiB, WS_WAO = 5 * MiB, WS_WBIN = 9 * MiB, WS_WBO = 15 * MiB;
constexpr size_t WS_PAR = 18 * MiB;
constexpr int PAR_REL = 0, PAR_AGQ = 512, PAR_AGKV = 768, PAR_AGKI = 896, PAR_ABKI = 960, PAR_BF = 1024, PAR_BROUT = 1088, PAR_LN = 2048  ,
              PAR_WROUT = 16384  , PAR_WF = 81920  , PAR_BGU = 98304  , PAR_BDOWN = 229376  , PAR_END = 294912;
static_assert((size_t)PAR_END * 4 <= 2 * MiB, "parameter copies");
constexpr size_t WS_TOKE = 20 * MiB;
constexpr size_t WS_WGU = 32 * MiB, WS_WD = 288 * MiB;
constexpr size_t WS_XF = 416 * MiB, WS_XB = 544 * MiB;
constexpr size_t WS_PROJ = 608 * MiB, WS_CQN = 672 * MiB, WS_CKV = 688 * MiB, WS_KIDX = 696 * MiB, WS_WIDX = 700 * MiB, WS_BKT = 701 * MiB  , WS_SEL = 712 * MiB  ,
                 WS_QIDX = 736 * MiB, WS_QLAT = 768 * MiB, WS_OLAT = 896 * MiB;
constexpr size_t WS_Q = 608 * MiB, WS_K = 672 * MiB, WS_V = 736 * MiB, WS_LOGF = 800 * MiB, WS_QX = 802 * MiB, WS_KX = 818 * MiB, WS_O = 834 * MiB, WS_CUM2 = 898 * MiB  , WS_KMAX = 900 * MiB  , WS_TS = 901 * MiB  , WS_DG = 902 * MiB  ;
constexpr size_t WS_TOPE = 1024 * MiB, WS_TOPG = 1025 * MiB, WS_POS = 1026 * MiB, WS_SLOT = 1027 * MiB, WS_TOK = 1027 * MiB + 512 * 1024  ;
constexpr size_t WS_XG = 1028 * MiB, WS_H = 1300 * MiB, WS_Y = 1572 * MiB  , WS_XB8 = 1700 * MiB  , WS_END = 1732 * MiB;
constexpr float F8_XS = 8.f, F8_WGS = 512.f, F8_HS = 4.f, F8_WDS = 1024.f, F8_WBINS = 512.f, F8_OLS = 32.f, F8_WAOS = 1024.f, F8_YS = 32.f, F8_OS = 32.f, F8_WBOS = 1024.f, F8_HYS = 64.f, F8_QLS = 16.f  ;
static_assert((size_t)MAXSLOT * 1024 * 2 <= 272 * MiB, "slot buffers");
constexpr int CW_TMO = 0, CW_CODE = 1;
constexpr int CW_BAR = 4096;
constexpr int CW_CMAX = 20416;
constexpr int CW_QMAX = 20480, CW_MNEG = 22528, CW_ATTQ = 24576;
constexpr int CW_CNT = 16384;
constexpr int SM_NT = 0, SM_TILE_E = 64;
constexpr int RING_OFF = 0, RING_BYTES = 131072;
constexpr int LDS_BYTES = 147456;
constexpr int MISC_OFF = LDS_BYTES - 256;
#define GAS __attribute__((address_space(1)))
#define LAS __attribute__((address_space(3)))
typedef unsigned short bf16;
typedef unsigned v4u __attribute__((ext_vector_type(4)));
typedef float f32x4 __attribute__((ext_vector_type(4)));
typedef short bf16x8 __attribute__((ext_vector_type(8)));
typedef GAS unsigned gu32;
typedef GAS unsigned long long gu64;
#define RLX_AGENT __ATOMIC_RELAXED, __HIP_MEMORY_SCOPE_AGENT
#define LDS_WAIT() asm volatile("s_waitcnt lgkmcnt(0)" ::: "memory")
#define VM_WAIT() asm volatile("s_waitcnt vmcnt(0)" ::: "memory")
__device__ __forceinline__ unsigned long long rt() { return __builtin_amdgcn_s_memrealtime(); }
__device__ __forceinline__ unsigned f2bf(float f) { unsigned u = __builtin_bit_cast(unsigned, f); return (u + 0x7fffu + ((u >> 16) & 1u)) >> 16; }
__device__ __forceinline__ unsigned pk2(float lo, float hi) { return f2bf(lo) | (f2bf(hi) << 16); }

#define XB_TMO      128
#define XB_XCNT(j)  (256  + 64 * (j))
#define XB_XSUB(j)  (1280 + 64 * (j))
#define XB_XGEN(j)  (2304 + 64 * (j))
#define XB_TOP      3328
#define XB_TOPGEN   3392
#define XCD_BAR_WORDS 3456
#define XB_SPIN_CAP (1u << 18)

__device__ __forceinline__ unsigned xb_ld(unsigned* p)              { return __hip_atomic_load(p, __ATOMIC_RELAXED, __HIP_MEMORY_SCOPE_AGENT); }
__device__ __forceinline__ unsigned xb_add(unsigned* p, unsigned v) { return __hip_atomic_fetch_add(p, v, __ATOMIC_RELAXED, __HIP_MEMORY_SCOPE_AGENT); }
__device__ __forceinline__ unsigned xb_xcc_id() { return (unsigned)__builtin_amdgcn_s_getreg((3 << 11) | 20) & 0xFu; }
#define XB_SPIN(cond, bar) do { unsigned _sp = 0; while (cond) { __builtin_amdgcn_s_sleep(1); \
    if ((++_sp & 255u) == 0u) { if (xb_ld(&(bar)[XB_TMO])) break; if (_sp > XB_SPIN_CAP) { atomicAdd(&(bar)[XB_TMO], 1u); break; } } } } while (0)

struct XcdBarrier {
    unsigned* bar; unsigned x;
    volatile LAS unsigned* st;
};

__device__ __forceinline__ XcdBarrier xcd_barrier_post(unsigned* bar, volatile LAS unsigned* st) {
    XcdBarrier b; b.bar = bar; b.x = xb_xcc_id(); b.st = st;
    if (threadIdx.x == 0) (void)xb_add(&bar[XB_XCNT(b.x)], 1u);
    return b;
}
__device__ __forceinline__ void xcd_barrier_complete(unsigned* bar, unsigned x, unsigned& nloc, unsigned& nx) {
    const unsigned G = gridDim.x * gridDim.y * gridDim.z;
    unsigned sum, cnt, mine, sp = 0u;
    for (;;) {
        sum = 0u; cnt = 0u; mine = 0u;
#pragma unroll
        for (unsigned j = 0; j < 16; ++j) { const unsigned c = xb_ld(&bar[XB_XCNT(j)]); sum += c; cnt += (c > 0u) ? 1u : 0u; mine = (j == x) ? c : mine; }
        if (sum == G) break;
        __builtin_amdgcn_s_sleep(1);
        if ((++sp & 255u) == 0u) { if (xb_ld(&bar[XB_TMO])) break; if (sp > XB_SPIN_CAP) { atomicAdd(&bar[XB_TMO], 1u); break; } }
    }
    nloc = mine > 0u ? mine : 1u; nx = cnt > 0u ? cnt : 1u;
}

__device__ __forceinline__ void xcd_barrier(const XcdBarrier& b) {
    asm volatile("s_waitcnt vmcnt(0)" ::: "memory");
    __syncthreads();
    if (threadIdx.x == 0) {
        unsigned* bar = b.bar;
        __builtin_amdgcn_s_waitcnt(0);
        unsigned nloc = b.st[0], nx = b.st[1];
        if (nloc == 0u) { xcd_barrier_complete(bar, b.x, nloc, nx); b.st[0] = nloc; b.st[1] = nx; }
        const unsigned old = xb_add(&bar[XB_XSUB(b.x)], 1u);
        const unsigned gen = old / nloc;
        if (old + 1u == (gen + 1u) * nloc) {
            __builtin_amdgcn_fence(__ATOMIC_RELEASE, "agent");
            asm volatile("s_waitcnt vmcnt(0)" ::: "memory");
            const unsigned og = xb_add(&bar[XB_TOP], 1u);
            const unsigned tg = og / nx;
            if (og + 1u == (tg + 1u) * nx) xb_add(&bar[XB_TOPGEN], 1u);
            else XB_SPIN(xb_ld(&bar[XB_TOPGEN]) == tg, bar);
            __builtin_amdgcn_fence(__ATOMIC_ACQUIRE, "agent");
            xb_add(&bar[XB_XGEN(b.x)], 1u);
            asm volatile("s_waitcnt vmcnt(0)" ::: "memory");
        } else {
            XB_SPIN(xb_ld(&bar[XB_XGEN(b.x)]) == gen, bar);
            __builtin_amdgcn_fence(__ATOMIC_ACQUIRE, "agent");
            asm volatile("s_waitcnt vmcnt(0)" ::: "memory");
        }
    }
    __syncthreads();
}

struct Frame {
    LAS unsigned char* lds;
    volatile LAS unsigned* MISC;
    gu32* ctl;
    int vcu, G;
    unsigned char* ws;
};
__device__ __forceinline__ int opaque_tid() { int t = threadIdx.x; asm volatile("" : "+v"(t)); return t; }
#define PHASE_IDS() const int tid = opaque_tid(), lane = tid & 63, wave = __builtin_amdgcn_readfirstlane(tid >> 6); (void)lane; (void)wave
typedef float f32x2 __attribute__((ext_vector_type(2)));
typedef unsigned u32x4 __attribute__((ext_vector_type(4)));
typedef unsigned u32x2 __attribute__((ext_vector_type(2)));
__device__ __forceinline__ float wave_sum(float x) {
    float v = x;
#define WS_STEP(ctrl, rmask) v += __builtin_bit_cast(float, __builtin_amdgcn_update_dpp(0, __builtin_bit_cast(int, v), ctrl, rmask, 0xf, false))
    WS_STEP(0x111, 0xf); WS_STEP(0x112, 0xf); WS_STEP(0x114, 0xf); WS_STEP(0x118, 0xf); WS_STEP(0x142, 0xa); WS_STEP(0x143, 0xc);
#undef WS_STEP
    return __builtin_bit_cast(float, __builtin_amdgcn_readlane(__builtin_bit_cast(int, v), 63));
}
__device__ __forceinline__ unsigned cvtpk(float lo, float hi) { typedef __bf16 bf2 __attribute__((ext_vector_type(2))); f32x2 v = {lo, hi}; bf2 b = __builtin_convertvector(v, bf2); return __builtin_bit_cast(unsigned, b); }
__device__ __forceinline__ float bf2f(unsigned short h) { return __uint_as_float((unsigned)h << 16); }

struct TrItem { const float* W; int ldw, nvalid, K; unsigned char* WT; int row_off, mode, f8; float fscale; int k0, n0; };
__device__ __forceinline__ void tr_load(const TrItem& t, f32x4 (&v)[8][2], int lane, int wave) {
#pragma unroll
    for (int i = 0; i < 8; ++i)
#pragma unroll
        for (int j = 0; j < 2; ++j) { const int n = t.n0 + 4 * lane + (t.f8 ? 0 : 256 * j); const int k = t.k0 + (t.f8 ? wave * 16 + 2 * i + j : wave * 8 + i);
            v[i][j] = (n < t.nvalid) ? __builtin_nontemporal_load((const f32x4*)(t.W + (size_t)k * t.ldw + n)) : (f32x4){0.f, 0.f, 0.f, 0.f}; }
}
__device__ __forceinline__ void tr_to_lds(const TrItem& t, const f32x4 (&v)[8][2], LAS float* scr, int lane, int wave) {
#pragma unroll
    for (int i = 0; i < 8; ++i)
#pragma unroll
        for (int j = 0; j < 2; ++j) { LAS float* d = t.f8 ? scr + (wave * 16 + 2 * i + j) * 257 + 4 * lane : scr + (wave * 8 + i) * 513 + 4 * lane + 256 * j; d[0] = v[i][j].x; d[1] = v[i][j].y; d[2] = v[i][j].z; d[3] = v[i][j].w; }
}
__device__ __forceinline__ void tr_store(const TrItem& t, LAS float* scr, int tid) {
    const int c = tid & 7;
    if (t.f8) {
        const float fs = t.fscale;
#pragma unroll
        for (int j = 0; j < 4; ++j) { const int n = (tid >> 3) + 64 * j; const LAS float* s = scr + (16 * c) * 257 + n;
            const int ng = t.n0 + n; int row;
            if (t.mode == 0) row = t.row_off + ng; else { const int np = ng & 1023; row = (np >> 7) * 256 + ((ng >> 10) << 7) + (np & 127); }
            v4u o; o.x = pg8::cvt4_fp8(s[0 * 257] * fs, s[1 * 257] * fs, s[2 * 257] * fs, s[3 * 257] * fs); o.y = pg8::cvt4_fp8(s[4 * 257] * fs, s[5 * 257] * fs, s[6 * 257] * fs, s[7 * 257] * fs);
            o.z = pg8::cvt4_fp8(s[8 * 257] * fs, s[9 * 257] * fs, s[10 * 257] * fs, s[11 * 257] * fs); o.w = pg8::cvt4_fp8(s[12 * 257] * fs, s[13 * 257] * fs, s[14 * 257] * fs, s[15 * 257] * fs);
            *(GAS v4u*)(t.WT + (size_t)row * t.K + t.k0 + 16 * c) = o; }
        return; }
#pragma unroll
    for (int j = 0; j < 8; ++j) { const int n = (tid >> 3) + 64 * j; const LAS float* s = scr + (8 * c) * 513 + n;
        const int ng = t.n0 + n; int row;
        if (t.mode == 0) row = t.row_off + ng; else { const int np = ng & 1023; row = (np >> 7) * 256 + ((ng >> 10) << 7) + (np & 127); }
        v4u o; o.x = pk2(s[0 * 513], s[1 * 513]); o.y = pk2(s[2 * 513], s[3 * 513]); o.z = pk2(s[4 * 513], s[5 * 513]); o.w = pk2(s[6 * 513], s[7 * 513]);
        *(GAS v4u*)(t.WT + ((size_t)row * t.K + t.k0 + 8 * c) * 2) = o; }
}
struct P0In { const float *x, *a_w_in, *a_w_uq, *a_w_uk, *a_w_uv, *a_w_qidx, *a_w_o, *b_w_in, *b_w_o, *w_gu, *w_down;
              const float *rel, *a_g_q, *a_g_kv, *a_g_kidx, *a_b_kidx, *b_b_f, *ln_mix_g, *ln_mix_b, *ln_ffn_g, *ln_ffn_b, *w_router, *b_router, *b_gu, *b_down; };
__device__ __forceinline__ void p0_copy(float* dst, const float* src, int n, int g0, int gs) { for (int i = g0; i < n; i += gs) dst[i] = src[i]; }
__device__ __forceinline__ void p0_prologue(Frame& F, const P0In& I) {
    PHASE_IDS();
    bf16* WAIN = (bf16*)(F.ws + WS_WAIN); bf16* WACQ = (bf16*)(F.ws + WS_WACQ); bf16* WAO = (bf16*)(F.ws + WS_WAO); bf16* WBIN = (bf16*)(F.ws + WS_WBIN); bf16* WBO = (bf16*)(F.ws + WS_WBO);
    bf16* WGU = (bf16*)(F.ws + WS_WGU); bf16* WD = (bf16*)(F.ws + WS_WD); bf16* XB = (bf16*)(F.ws + WS_XB);
#ifndef MK_P0_REP
#define MK_P0_REP 0
#endif
    for (int rep0 = 0; rep0 < 1 + (MK_P0_REP & 1); ++rep0)
    for (int it = F.vcu; it < 128 + 256; it += F.G) {
        if (it < 128) {
            const int h = it >> 3, rb = it & 7; const int rq = tid & 255, rs = wave >> 2;
            float q[64];
            const GAS f32x4* qp = (const GAS f32x4*)(I.a_w_uq + ((size_t)rq * A_H + h) * 64);
#pragma unroll
            for (int i = 0; i < 16; ++i) { const f32x4 v = qp[i]; q[4 * i] = v.x; q[4 * i + 1] = v.y; q[4 * i + 2] = v.z; q[4 * i + 3] = v.w; }
            for (int j = 0; j < 8; ++j) { const int r = rb * 16 + rs * 8 + j; const float* kp = I.a_w_uk + ((size_t)r * A_H + h) * 64; float s = 0.f;
#pragma unroll
                for (int d = 0; d < 64; ++d) s += q[d] * kp[d];
                WACQ[(size_t)(h * 128 + r) * 256 + rq] = (bf16)f2bf(s * (0.125f * LOG2E)); }
        } else {
            const int i2 = it - 128, h = i2 >> 4, nc = i2 & 15; LAS float* wo = (LAS float*)F.lds; LAS float* wuv = wo + 4096;
#pragma unroll
            for (int i = 0; i < 8; ++i) { const int idx = tid + 512 * i, d = idx >> 6, n = idx & 63; wo[idx] = I.a_w_o[(size_t)(h * 64 + d) * D + nc * 64 + n]; }
#pragma unroll
            for (int i = 0; i < 16; ++i) { const int idx = tid + 512 * i, r = idx >> 6, d = idx & 63; wuv[idx] = I.a_w_uv[((size_t)r * A_H + h) * 64 + d]; }
            LDS_WAIT(); __syncthreads();
            const int nl = tid & 63, rg = wave; float acc[16];
#pragma unroll
            for (int i = 0; i < 16; ++i) acc[i] = 0.f;
#pragma unroll 8
            for (int d = 0; d < 64; ++d) { const float w = wo[d * 64 + nl];
#pragma unroll
                for (int i = 0; i < 16; ++i) acc[i] += wuv[(rg * 16 + i) * 64 + d] * w; }
#pragma unroll
            for (int i = 0; i < 16; ++i) acc[i] *= F8_WAOS;
            v4u o0; o0.x = pg8::cvt4_fp8(acc[0], acc[1], acc[2], acc[3]); o0.y = pg8::cvt4_fp8(acc[4], acc[5], acc[6], acc[7]); o0.z = pg8::cvt4_fp8(acc[8], acc[9], acc[10], acc[11]); o0.w = pg8::cvt4_fp8(acc[12], acc[13], acc[14], acc[15]);
            *(GAS v4u*)((unsigned char*)WAO + (size_t)(nc * 64 + nl) * 2048 + h * 128 + rg * 16) = o0;
            __syncthreads();
        }
    }
    __syncthreads();
    LAS float* scr = (LAS float*)(F.lds + RING_OFF);
    constexpr int I_AIN = 16 * 1, I_QIDX = 4 * 1, I_BIN = 8 * 12, I_BO = 8 * 4, I_GU1 = 8 * 8, I_D1 = 8 * 4;
    constexpr int I_GU = 64 * I_GU1, I_DN = 64 * I_D1;
    constexpr int NITEMS = I_AIN + I_QIDX + I_BIN + I_BO + I_GU + I_DN;
    auto decode = [&](int it) -> TrItem {
        TrItem t; int r = it; t.mode = 0; t.f8 = 0; t.fscale = 1.f; t.row_off = 0;
        if (r < I_AIN) { t.W = I.a_w_in; t.ldw = A_INW; t.nvalid = A_INW; t.K = 1024; t.WT = (unsigned char*)WAIN; t.k0 = 64 * r; t.n0 = 0; return t; } r -= I_AIN;
        if (r < I_QIDX) { t.W = I.a_w_qidx; t.ldw = 512; t.nvalid = 512; t.K = 256; t.WT = (unsigned char*)WACQ; t.row_off = 2048; t.k0 = 64 * r; t.n0 = 0; return t; } r -= I_QIDX;
        if (r < I_BIN) { t.W = I.b_w_in; t.ldw = B_INW; t.nvalid = 3072; t.K = 1024; t.WT = (unsigned char*)WBIN; t.f8 = 1; t.fscale = F8_WBINS; t.k0 = 128 * (r / 12); t.n0 = 256 * (r % 12); return t; } r -= I_BIN;
        if (r < I_BO) { t.W = I.b_w_o; t.ldw = 1024; t.nvalid = 1024; t.K = 1024; t.WT = (unsigned char*)WBO; t.f8 = 1; t.fscale = F8_WBOS; t.k0 = 128 * (r / 4); t.n0 = 256 * (r % 4); return t; } r -= I_BO;
        if (r < I_GU) { const int mi = r / I_GU1, rr = r % I_GU1; t.W = I.w_gu + (size_t)mi * 1024 * 2048; t.ldw = 2048; t.nvalid = 2048; t.K = 1024; t.WT = (unsigned char*)WGU + (size_t)mi * 2048 * 1024; t.mode = 1; t.f8 = 1; t.fscale = F8_WGS;
            t.k0 = 128 * (rr / 8); t.n0 = 256 * (rr % 8); return t; } r -= I_GU;
        { const int mi = r / I_D1, rr = r % I_D1; t.W = I.w_down + (size_t)mi * 1024 * 1024; t.ldw = 1024; t.nvalid = 1024; t.K = 1024; t.WT = (unsigned char*)WD + (size_t)mi * 1024 * 1024; t.f8 = 1; t.fscale = F8_WDS;
            t.k0 = 128 * (rr / 4); t.n0 = 256 * (rr % 4); return t; }
    };
    for (int rep1 = 0; rep1 < 1 + ((MK_P0_REP >> 1) & 1); ++rep1) {
        f32x4 v[8][2]; int it = F.vcu;
        if (it < NITEMS) { const TrItem t0 = decode(it); tr_load(t0, v, lane, wave); }
        for (; it < NITEMS; it += F.G) {
            const TrItem t = decode(it);
            tr_to_lds(t, v, scr, lane, wave);
            LDS_WAIT(); __syncthreads();
            if (it + F.G < NITEMS) { const TrItem tn = decode(it + F.G); tr_load(tn, v, lane, wave); }
            tr_store(t, scr, tid);
            LDS_WAIT(); __syncthreads();
        }
    }
    { float* PAR = (float*)(F.ws + WS_PAR); const int g0 = F.vcu * 512 + tid, gs = F.G * 512;
      p0_copy(PAR + PAR_REL, I.rel, 512, g0, gs); p0_copy(PAR + PAR_AGQ, I.a_g_q, 256, g0, gs); p0_copy(PAR + PAR_AGKV, I.a_g_kv, 128, g0, gs); p0_copy(PAR + PAR_AGKI, I.a_g_kidx, 64, g0, gs);
      p0_copy(PAR + PAR_ABKI, I.a_b_kidx, 64, g0, gs); p0_copy(PAR + PAR_BF, I.b_b_f, 16, g0, gs); p0_copy(PAR + PAR_BROUT, I.b_router, 64, g0, gs);
      p0_copy(PAR + PAR_LN, I.ln_mix_g, 2048, g0, gs); p0_copy(PAR + PAR_LN + 2048, I.ln_mix_b, 2048, g0, gs); p0_copy(PAR + PAR_LN + 4096, I.ln_ffn_g, 2048, g0, gs); p0_copy(PAR + PAR_LN + 6144, I.ln_ffn_b, 2048, g0, gs);
      p0_copy(PAR + PAR_WROUT, I.w_router, 65536, g0, gs); p0_copy(PAR + PAR_BGU, I.b_gu, 131072, g0, gs); p0_copy(PAR + PAR_BDOWN, I.b_down, 65536, g0, gs);
      for (int i = g0; i < 16384; i += gs) PAR[PAR_WF + i] = I.b_w_in[(size_t)(i >> 4) * B_INW + 3072 + (i & 15)]; }
    { const size_t n8 = (size_t)M * D / 8; const size_t g0 = (size_t)F.vcu * 512 + tid, gs = (size_t)F.G * 512;
      for (int rep2 = 0; rep2 < 1 + ((MK_P0_REP >> 2) & 1); ++rep2)
      for (size_t i = g0; i < n8; i += 4 * gs) { f32x4 a[4], b[4];
#pragma unroll
          for (int q = 0; q < 4; ++q) { const size_t ii = i + q * gs; if (ii < n8) { const GAS f32x4* p = (const GAS f32x4*)(I.x + ii * 8); a[q] = __builtin_nontemporal_load(p); b[q] = __builtin_nontemporal_load(p + 1); } }
#pragma unroll
          for (int q = 0; q < 4; ++q) { const size_t ii = i + q * gs; if (ii < n8) { v4u o; o.x = pk2(a[q].x, a[q].y); o.y = pk2(a[q].z, a[q].w); o.z = pk2(b[q].x, b[q].y); o.w = pk2(b[q].z, b[q].w); *(GAS v4u*)(XB + ii * 8) = o; } } } }
}

__device__ __forceinline__ void p_dsa_norms(Frame& F, const float* g_q, const float* g_kv, const float* g_kidx, const float* b_kidx) {
    PHASE_IDS();
    const float* PROJ = (const float*)(F.ws + WS_PROJ); bf16* CQN = (bf16*)(F.ws + WS_CQN); bf16* CKV = (bf16*)(F.ws + WS_CKV); bf16* KIDX = (bf16*)(F.ws + WS_KIDX); float* WIDX = (float*)(F.ws + WS_WIDX);
    const int l = lane; const int gw = F.vcu * NWAVES + wave, NGW = F.G * NWAVES;
    const f32x4 gq = *(const f32x4*)(g_q + 4 * l); const f32x2 gkv = *(const f32x2*)(g_kv + 2 * l); const float gki = g_kidx[l], bki = b_kidx[l];
    float cmx = 0.f;
    f32x4 cq_n = {0.f, 0.f, 0.f, 0.f}; f32x2 ckv_n = {0.f, 0.f}; float ki_n = 0.f, wi_n = 0.f;
    if (gw < M) { const float* p = PROJ + (size_t)gw * 512; cq_n = *(const f32x4*)(p + 4 * l); ckv_n = *(const f32x2*)(p + 256 + 2 * l); ki_n = p[384 + l]; wi_n = p[448 + (l & 7)]; }
    for (int row = gw; row < M; row += NGW) {
        const f32x4 cq = cq_n; const f32x2 ckv = ckv_n; const float ki = ki_n; const float wi = wi_n;
        if (row + NGW < M) { const float* p = PROJ + (size_t)(row + NGW) * 512; cq_n = *(const f32x4*)(p + 4 * l); ckv_n = *(const f32x2*)(p + 256 + 2 * l); ki_n = p[384 + l]; wi_n = p[448 + (l & 7)]; }
        const float rq = 1.0f / sqrtf(wave_sum(cq.x * cq.x + cq.y * cq.y + cq.z * cq.z + cq.w * cq.w) * (1.0f / 256.0f) + RMS_EPS);
        const float rkv = 1.0f / sqrtf(wave_sum(ckv.x * ckv.x + ckv.y * ckv.y) * (1.0f / 128.0f) + RMS_EPS);
        const float mean = wave_sum(ki) * (1.0f / 64.0f); const float dk = ki - mean; const float rki = 1.0f / sqrtf(wave_sum(dk * dk) * (1.0f / 64.0f) + LN_EPS);
        u32x2 oq; oq.x = cvtpk(cq.x * rq * gq.x, cq.y * rq * gq.y); oq.y = cvtpk(cq.z * rq * gq.z, cq.w * rq * gq.w);
        *(GAS u32x2*)(CQN + (size_t)row * 256 + 4 * l) = oq;
        const float c0 = ckv.x * rkv * gkv.x, c1 = ckv.y * rkv * gkv.y;
        *(GAS unsigned*)(CKV + (size_t)row * 128 + 2 * l) = cvtpk(c0, c1);
        cmx = fmaxf(cmx, wave_sum(c0 * c0 + c1 * c1));
        KIDX[(size_t)row * 64 + l] = (bf16)f2bf(dk * rki * gki + bki);
        if (l < 8) WIDX[(size_t)row * 8 + l] = wi * 0.04419417382415922f;
    }
    if (l == 0) __hip_atomic_fetch_max(F.ctl + CW_CMAX, __float_as_uint(sqrtf(cmx)), __ATOMIC_RELAXED, __HIP_MEMORY_SCOPE_AGENT);
}

__device__ __forceinline__ int t5_bucket(int n) {
    if (n < 16) return n; if (n >= 128) return 31;
    const int v = 16 + (int)(__builtin_amdgcn_logf((float)n * 0.0625f) * (16.0f / 3.0f));
    return v < 31 ? v : 31;
}
__device__ __forceinline__ unsigned fkey(float f) { const unsigned u = __float_as_uint(f); return (u & 0x80000000u) ? ~u : (u | 0x80000000u); }
__device__ __forceinline__ int popc64(unsigned long long m) { return __builtin_popcountll(m); }
__device__ __forceinline__ int mbcnt(unsigned long long m) { return (int)__builtin_amdgcn_mbcnt_hi((unsigned)(m >> 32), __builtin_amdgcn_mbcnt_lo((unsigned)m, 0u)); }
typedef float f32x16 __attribute__((ext_vector_type(16)));
typedef unsigned short u16x2 __attribute__((ext_vector_type(2)));
__device__ __forceinline__ int wave_total_i(int x) {
    int v = x;
    v += __builtin_amdgcn_update_dpp(0, v, 0x111, 0xf, 0xf, false);
    v += __builtin_amdgcn_update_dpp(0, v, 0x112, 0xf, 0xf, false);
    v += __builtin_amdgcn_update_dpp(0, v, 0x114, 0xf, 0xf, false);
    v += __builtin_amdgcn_update_dpp(0, v, 0x118, 0xf, 0xf, false);
    v += __builtin_amdgcn_update_dpp(0, v, 0x142, 0xa, 0xf, false);
    v += __builtin_amdgcn_update_dpp(0, v, 0x143, 0xc, 0xf, false);
    return __builtin_amdgcn_readlane(v, 63);
}
#ifndef MK_IDX_REP
#define MK_IDX_REP 0
#endif
#ifndef MK_CHECK_SEL
#define MK_CHECK_SEL 0
#endif
__device__ __forceinline__ void select_top256(const unsigned (&u)[64], int nj, int l, LAS unsigned short* selst, LAS unsigned* cand  ) {
    constexpr int SEL_CAP = 1024;
    unsigned pk[32];
#pragma unroll
    for (int p = 0; p < 32; ++p) pk[p] = (u[2 * p] >> 17) | ((u[2 * p + 1] >> 1) & 0xffff0000u);
    const int ngrp = (nj + 7) >> 3; const int nconsidered = ngrp * 512;
    auto count_ge = [&](unsigned c) -> int {
        const u16x2 cpk = __builtin_bit_cast(u16x2, c * 0x10001u); u16x2 acc = {0, 0};
#pragma unroll
        for (int jb = 0; jb < 8; ++jb) { if (jb < ngrp) {
#pragma unroll
            for (int q = 0; q < 4; ++q) { const u16x2 d = __builtin_bit_cast(u16x2, pk[4 * jb + q]) - cpk; acc += (d >> (unsigned short)15); } } }
        const unsigned a = __builtin_bit_cast(unsigned, acc);
        return nconsidered - wave_total_i((int)((a & 0xffffu) + (a >> 16)));
    };
    unsigned P = 0u;
    for (int bit = 14; bit >= 0; --bit) { const unsigned c = P | (1u << bit); if (count_ge(c) >= TOPK) P = c; }
    const int c_above = count_ge(P + 1u); const int need = TOPK - c_above;
    int off = 0, coff = 0;
#pragma unroll
    for (int j = 0; j < 64; ++j) { if ((j >> 3) < ngrp) {
        const unsigned k15 = u[j] >> 17; const unsigned long long m1 = __ballot(k15 > P), mc = __ballot(k15 == P);
        if (k15 > P) selst[off + mbcnt(m1)] = (unsigned short)(j * 64 + l);
        off += popc64(m1);
        if (mc != 0ull) { if (k15 == P) { const int pos = coff + mbcnt(mc); if (pos < SEL_CAP) { cand[pos] = u[j]; cand[SEL_CAP + pos] = (unsigned)(j * 64 + l); } } coff += popc64(mc); } }
        __builtin_amdgcn_sched_barrier(0); }
    LDS_WAIT(); asm volatile("" ::: "memory");
    const int ncand = coff;
    if (ncand == need && ncand <= SEL_CAP) { for (int i = l; i < ncand; i += 64) selst[c_above + i] = (unsigned short)cand[SEL_CAP + i]; }
    else if (ncand <= 256) {
        unsigned mk[4], mi[4]; int rk[4];
#pragma unroll
        for (int r = 0; r < 4; ++r) { const int i = l + 64 * r; const bool v = i < ncand; mk[r] = v ? cand[i] : 0u; mi[r] = v ? cand[SEL_CAP + i] : 0xffffffffu; rk[r] = 0; }
        for (int c2 = 0; c2 < ncand; ++c2) { const unsigned k2 = cand[c2], i2 = cand[SEL_CAP + c2];
#pragma unroll
            for (int r = 0; r < 4; ++r) rk[r] += (k2 > mk[r] || (k2 == mk[r] && i2 < mi[r])) ? 1 : 0; }
#pragma unroll
        for (int r = 0; r < 4; ++r) { if (l + 64 * r < ncand && rk[r] < need) selst[c_above + rk[r]] = (unsigned short)mi[r]; }
    } else {
        unsigned Tk = P << 17;
        for (int bit = 16; bit >= 0; --bit) { const unsigned cd = Tk | (1u << bit); int cnt = 0;
#pragma unroll
            for (int j = 0; j < 64; ++j) cnt += (u[j] >= cd) ? 1 : 0;
            if (wave_total_i(cnt) >= TOPK) Tk = cd; }
        int cg = 0;
#pragma unroll
        for (int j = 0; j < 64; ++j) cg += (u[j] > Tk && (u[j] >> 17) == P) ? 1 : 0;
        const int ngt = wave_total_i(cg); const int need2 = need - ngt; int o2 = c_above, t2 = 0;
        unsigned Tk2 = Tk, P2 = P; asm volatile("" : "+s"(Tk2), "+s"(P2));
#pragma unroll
        for (int j = 0; j < 64; ++j) { const bool isc = (u[j] >> 17) == P2; const unsigned long long m1 = __ballot(isc && u[j] > Tk2), m2 = __ballot(isc && u[j] == Tk2);
            if (isc && u[j] > Tk2) selst[o2 + mbcnt(m1)] = (unsigned short)(j * 64 + l);
            if (isc && u[j] == Tk2) { const int rk2 = t2 + mbcnt(m2); if (rk2 < need2) selst[c_above + ngt + rk2] = (unsigned short)(j * 64 + l); }
            o2 += popc64(m1); t2 += popc64(m2); __builtin_amdgcn_sched_barrier(0); }
    }
    LDS_WAIT(); asm volatile("" ::: "memory");
}
#if MK_CHECK_SEL
__device__ __forceinline__ void select_ref(const unsigned (&u)[64], int l, LAS unsigned short* selst) {
    unsigned Tk = 0u;
    for (int bit = 31; bit >= 0; --bit) { const unsigned cand = Tk | (1u << bit); int cnt = 0;
#pragma unroll
        for (int j = 0; j < 64; ++j) cnt += popc64(__ballot(u[j] >= cand));
        if (cnt >= TOPK) Tk = cand; }
    int cgt = 0;
#pragma unroll
    for (int j = 0; j < 64; ++j) cgt += popc64(__ballot(u[j] > Tk));
    const int need = TOPK - cgt; int off = 0, toff = 0;
#pragma unroll
    for (int j = 0; j < 64; ++j) { const unsigned long long m1 = __ballot(u[j] > Tk), m2 = __ballot(u[j] == Tk);
        if (u[j] > Tk) selst[off + mbcnt(m1)] = (unsigned short)(j * 64 + l);
        if (u[j] == Tk) { const int rk = toff + mbcnt(m2); if (rk < need) selst[cgt + rk] = (unsigned short)(j * 64 + l); }
        off += popc64(m1); toff += popc64(m2); }
    LDS_WAIT(); asm volatile("" ::: "memory");
}
#endif
__device__ __forceinline__ int wave_scan_i(int x) {
    int v = x;
    v += __builtin_amdgcn_update_dpp(0, v, 0x111, 0xf, 0xf, false);
    v += __builtin_amdgcn_update_dpp(0, v, 0x112, 0xf, 0xf, false);
    v += __builtin_amdgcn_update_dpp(0, v, 0x114, 0xf, 0xf, false);
    v += __builtin_amdgcn_update_dpp(0, v, 0x118, 0xf, 0xf, false);
    v += __builtin_amdgcn_update_dpp(0, v, 0x142, 0xa, 0xf, false);
    v += __builtin_amdgcn_update_dpp(0, v, 0x143, 0xc, 0xf, false);
    return v;
}
__device__ __forceinline__ int radix_pick(LAS unsigned* hist, int want, int l, int& above) {
    const u32x4 h4 = *(const LAS u32x4*)(hist + 4 * l);
    const int tot = (int)((h4.x + h4.y) + (h4.z + h4.w)); const int pre = wave_scan_i(tot); const int total = __builtin_amdgcn_readlane(pre, 63);
    const int a3 = total - pre, a2 = a3 + (int)h4.w, a1 = a2 + (int)h4.z, a0 = a1 + (int)h4.y;
    const bool c3 = a3 < want && a3 + (int)h4.w >= want, c2 = a2 < want && a2 + (int)h4.z >= want, c1 = a1 < want && a1 + (int)h4.y >= want, c0 = a0 < want && a0 + (int)h4.x >= want;
    const unsigned long long m = __ballot(c3 || c2 || c1 || c0); const int src = (int)__builtin_ctzll(m | (1ull << 63));
    const int mybin = 4 * l + (c3 ? 3 : c2 ? 2 : c1 ? 1 : 0), myab = c3 ? a3 : c2 ? a2 : c1 ? a1 : a0;
    above = __builtin_amdgcn_readlane(myab, src);
    return __builtin_amdgcn_readlane(mybin, src);
}
__device__ __forceinline__ void select_top256_radix(const unsigned (&k)[64], int nj, int l, LAS unsigned short* selst, LAS unsigned* hist) {
    const int ngrp = (nj + 7) >> 3;
    *(LAS u32x4*)(hist + 4 * l) = (u32x4){0u, 0u, 0u, 0u};
    LDS_WAIT(); asm volatile("" ::: "memory");
#pragma unroll
    for (int j = 0; j < 64; ++j) { if ((j >> 3) < ngrp) (void)__hip_atomic_fetch_add(hist + (k[j] >> 8), 1u, __ATOMIC_RELAXED, __HIP_MEMORY_SCOPE_WORKGROUP); }
    LDS_WAIT(); asm volatile("" ::: "memory");
    int above1 = 0; const int bhi = radix_pick(hist, TOPK, l, above1); const int want2 = TOPK - above1;
    LDS_WAIT(); asm volatile("" ::: "memory");
    *(LAS u32x4*)(hist + 4 * l) = (u32x4){0u, 0u, 0u, 0u};
    LDS_WAIT(); asm volatile("" ::: "memory");
#pragma unroll
    for (int j = 0; j < 64; ++j) { if ((j >> 3) < ngrp) { if ((int)(k[j] >> 8) == bhi) (void)__hip_atomic_fetch_add(hist + (k[j] & 255u), 1u, __ATOMIC_RELAXED, __HIP_MEMORY_SCOPE_WORKGROUP); } }
    LDS_WAIT(); asm volatile("" ::: "memory");
    int above2 = 0; const int blo = radix_pick(hist, want2, l, above2);
    const unsigned T16 = ((unsigned)bhi << 8) | (unsigned)blo; const int cgt = above1 + above2, need = TOPK - cgt;
    int off = 0, toff = 0;
#pragma unroll
    for (int j = 0; j < 64; ++j) { if ((j >> 3) < ngrp) {
        const unsigned long long m1 = __ballot(k[j] > T16), m2 = __ballot(k[j] == T16);
        if (k[j] > T16) selst[off + mbcnt(m1)] = (unsigned short)(j * 64 + l);
        if (m2 != 0ull) { if (k[j] == T16) { const int rk = toff + mbcnt(m2); if (rk < need) selst[cgt + rk] = (unsigned short)(j * 64 + l); } toff += popc64(m2); }
        off += popc64(m1); }
        __builtin_amdgcn_sched_barrier(0); }
    LDS_WAIT(); asm volatile("" ::: "memory");
}
__device__ __forceinline__ void p_indexer(Frame& F) {
    PHASE_IDS();
    const bf16* QIDX = (const bf16*)(F.ws + WS_QIDX); const bf16* KIDX = (const bf16*)(F.ws + WS_KIDX); const float* WIDX = (const float*)(F.ws + WS_WIDX);
    unsigned short* SEL = (unsigned short*)(F.ws + WS_SEL); unsigned char* BKT = (unsigned char*)(F.ws + WS_BKT);
    LAS unsigned short* selst = (LAS unsigned short*)(F.lds + 131072) + wave * 256;
    const int l = lane, l31 = l & 31, hi = l >> 5;
    { const int gw = F.vcu * NWAVES + wave, NGW = F.G * NWAVES;
      for (int rr = gw; rr < BATCH * 256; rr += NGW) { const int b = rr >> 8, t = rr & 255; const size_t row = (size_t)b * T + t;
          unsigned short s4[4]; unsigned bk = 0;
#pragma unroll
          for (int i = 0; i < 4; ++i) { const int k = 4 * l + i; const bool v = k <= t; s4[i] = v ? (unsigned short)k : (unsigned short)0xFFFF; bk |= (unsigned)(v ? t5_bucket(t - k) : 32) << (8 * i); }
          u32x2 o; o.x = (unsigned)s4[0] | ((unsigned)s4[1] << 16); o.y = (unsigned)s4[2] | ((unsigned)s4[3] << 16);
          *(GAS u32x2*)(SEL + row * 256 + 4 * l) = o; *(GAS unsigned*)(BKT + row * 256 + 4 * l) = bk; } }
    LAS unsigned short* S16 = (LAS unsigned short*)F.lds;
    LAS float* wtab = (LAS float*)(F.lds + 131072 + 4096);
    for (int i = 0; ; ++i) {
        const int L = i * F.G + F.vcu; const int rnd = L >> 8, pos = L & 255;
        if (rnd >= 8) break;
        const int b = pos & 7, gs = pos >> 3; const int g = 239 - 32 * rnd - ((rnd & 1) ? (31 - gs) : gs);
        if (g < 0) continue;
        const int t0 = 256 + 16 * g, nk = t0 + 16, nkt = (nk + 31) >> 5; const size_t rowb = (size_t)b * T;
        int lt_ = threadIdx.x; asm volatile("" : "+v"(lt_)); const int l = lt_ & 63, l31 = l & 31, hi = l >> 5;
        bf16x8 af[4][4];
        { const int tl = 2 * ((l31 >> 2) & 1) + (l31 >> 4), hd = (l31 & 3) + 4 * ((l31 >> 3) & 1);
#pragma unroll
          for (int mt = 0; mt < 4; ++mt) { const bf16* qp = QIDX + (rowb + t0 + mt * 4 + tl) * 512 + hd * 64 + hi * 8;
#pragma unroll
              for (int ks = 0; ks < 4; ++ks) af[mt][ks] = *(const GAS bf16x8*)(qp + ks * 16); }
          if (lt_ < 128) wtab[lt_] = WIDX[(rowb + t0) * 8 + lt_] * 0.5f;
          LDS_WAIT(); __syncthreads(); }
        for (int rep1 = 0; rep1 < 1 + (MK_IDX_REP & 1); ++rep1) {
        bf16x8 bfr[4], bn1[4], bnx[4];
        { const bf16* kp = KIDX + (rowb + wave * 32 + l31) * 64 + hi * 8;
#pragma unroll
          for (int ks = 0; ks < 4; ++ks) bfr[ks] = (wave < nkt) ? *(const GAS bf16x8*)(kp + ks * 16) : (bf16x8){0, 0, 0, 0, 0, 0, 0, 0};
          const int kt1 = wave + NWAVES; const bf16* kp1 = KIDX + (rowb + (kt1 < nkt ? kt1 : 0) * 32 + l31) * 64 + hi * 8;
#pragma unroll
          for (int ks = 0; ks < 4; ++ks) bn1[ks] = *(const GAS bf16x8*)(kp1 + ks * 16); }
        auto tile = [&](const int kt, const bf16x8 (&cur)[4], bf16x8 (&ld)[4]) {
            const int key = kt * 32 + l31; const int ktn = kt + 2 * NWAVES;
            LAS float* wtab_k = wtab; asm volatile("" : "+v"(wtab_k));
            { const bf16* kp = KIDX + (rowb + (ktn < nkt ? ktn : kt) * 32 + l31) * 64 + hi * 8;
#pragma unroll
              for (int ks = 0; ks < 4; ++ks) ld[ks] = *(const GAS bf16x8*)(kp + ks * 16); }
#pragma unroll
            for (int mt = 0; mt < 4; ++mt) { f32x16 acc = f32x16{};
#pragma unroll
                for (int ks = 0; ks < 4; ++ks) acc = __builtin_amdgcn_mfma_f32_32x32x16_bf16(af[mt][ks], cur[ks], acc, 0, 0, 0);
                float sA = 0.f, sB = 0.f;
                const LAS f32x4* wq = (const LAS f32x4*)(wtab_k + (mt * 4 + 2 * hi) * 8); const f32x4 wa0 = wq[0], wa1 = wq[1], wb0 = wq[2], wb1 = wq[3];
                const float wA[8] = {wa0.x, wa0.y, wa0.z, wa0.w, wa1.x, wa1.y, wa1.z, wa1.w}, wB[8] = {wb0.x, wb0.y, wb0.z, wb0.w, wb1.x, wb1.y, wb1.z, wb1.w};
#pragma unroll
                for (int r = 0; r < 8; ++r) { sA += wA[r] * (acc[r] + __builtin_fabsf(acc[r])); sB += wB[r] * (acc[8 + r] + __builtin_fabsf(acc[8 + r])); }
                const int tokA = mt * 4 + 2 * hi; const int tA = t0 + tokA;
                const _Float16 hA = (_Float16)((key <= tA) ? sA : -INFINITY), hB = (_Float16)((key <= tA + 1) ? sB : -INFINITY);
                S16[tokA * 4096 + key] = __builtin_bit_cast(unsigned short, hA); S16[(tokA + 1) * 4096 + key] = __builtin_bit_cast(unsigned short, hB); }
        };
        for (int kt = wave; kt < nkt; ) {
            tile(kt, bfr, bnx); kt += NWAVES; if (kt >= nkt) break;
            tile(kt, bn1, bfr); kt += NWAVES; if (kt >= nkt) break;
            tile(kt, bnx, bn1); kt += NWAVES;
        }
        }
        LDS_WAIT(); __syncthreads();
        { const int nvalid = nkt * 32; const int nj = (nvalid + 63) >> 6;
#pragma unroll
          for (int s2 = 0; s2 < 2; ++s2) {
              const int t = t0 + 2 * wave + s2; LAS unsigned short* srow = S16 + (2 * wave + s2) * 4096;
              int nvalid_ = nvalid; asm volatile("" : "+s"(nvalid_));
              unsigned u[64];
#pragma unroll
              for (int j = 0; j < 64; ++j) { const int idx = j * 64 + l; const unsigned h0 = srow[idx];
                  const unsigned k0 = (h0 & 0x8000u) ? (~h0 & 0xffffu) : (h0 | 0x8000u);
                  u[j] = (idx < nvalid_) ? k0 : 0u; }
              LDS_WAIT(); asm volatile("" ::: "memory");
              select_top256_radix(u, nj, l, selst, (LAS unsigned*)srow);
              if (MK_IDX_REP & 2) select_top256_radix(u, nj, l, selst, (LAS unsigned*)srow);
#if MK_CHECK_SEL
              { LAS unsigned* bm = (LAS unsigned*)srow + 512;
                for (int w2 = l; w2 < 128; w2 += 64) bm[w2] = 0u;
                LDS_WAIT(); asm volatile("" ::: "memory");
                unsigned short mine[4];
#pragma unroll
                for (int i2 = 0; i2 < 4; ++i2) { mine[i2] = selst[4 * l + i2]; atomicOr((unsigned*)(bm + (mine[i2] >> 5)), 1u << (mine[i2] & 31)); }
                LDS_WAIT(); asm volatile("" ::: "memory");
                unsigned u32k[64];
#pragma unroll
                for (int j = 0; j < 64; ++j) u32k[j] = u[j] << 16;
                select_ref(u32k, l, selst);
                int bad = 0;
#pragma unroll
                for (int i2 = 0; i2 < 4; ++i2) { const unsigned short r2 = selst[4 * l + i2]; bad += ((bm[r2 >> 5] >> (r2 & 31)) & 1u) ? 0 : 1; }
                int nset = 0; for (int w2 = l; w2 < 128; w2 += 64) nset += __builtin_popcount(bm[w2]);
                bad = wave_total_i(bad) + (wave_total_i(nset) != TOPK ? 1 : 0);
                if (bad && l == 0) __hip_atomic_store(F.ctl + CW_TMO, 0xBAD5E1u, __ATOMIC_RELAXED, __HIP_MEMORY_SCOPE_AGENT);
#pragma unroll
                for (int i2 = 0; i2 < 4; ++i2) selst[4 * l + i2] = mine[i2];
                LDS_WAIT(); asm volatile("" ::: "memory"); }
#endif
              int t2_ = threadIdx.x; asm volatile("" : "+v"(t2_)); const int l2 = t2_ & 63;
              const size_t row = rowb + t; unsigned short s4[4]; unsigned bk = 0;
#pragma unroll
              for (int i2 = 0; i2 < 4; ++i2) { s4[i2] = selst[4 * l2 + i2]; bk |= (unsigned)t5_bucket(t - (int)s4[i2]) << (8 * i2); }
              u32x2 o; o.x = (unsigned)s4[0] | ((unsigned)s4[1] << 16); o.y = (unsigned)s4[2] | ((unsigned)s4[3] << 16);
              *(GAS u32x2*)(SEL + row * 256 + 4 * l2) = o; *(GAS unsigned*)(BKT + row * 256 + 4 * l2) = bk;
              LDS_WAIT(); asm volatile("" ::: "memory"); } }
        LDS_WAIT(); __syncthreads();
    }
}

typedef short v4i16_t __attribute__((ext_vector_type(4)));
__device__ __forceinline__ void p_sparse_attn(Frame& F, const float* rel_table) {
    PHASE_IDS();
    const unsigned char* QLAT8 = (const unsigned char*)(F.ws + WS_QLAT);        const unsigned char* CKV8 = (const unsigned char*)(F.ws + WS_CKV); unsigned char* OLAT = (unsigned char*)(F.ws + WS_OLAT);
    const unsigned short* SEL = (const unsigned short*)(F.ws + WS_SEL); const unsigned char* BKT = (const unsigned char*)(F.ws + WS_BKT);
    LAS unsigned char* cb = F.lds + wave * 16384;
    LAS unsigned char* sb = F.lds + 131072 + wave * 1536;
    LAS float* relt = (LAS float*)(F.lds + 131072 + 8 * 1536);
    for (int i = tid; i < 33 * 16; i += NWAVES * 64) relt[i] = (i < 512) ? rel_table[i] * LOG2E : -INFINITY;
    LDS_WAIT(); __syncthreads();
    if (tid < 16) { float m = relt[tid]; for (int b = 1; b < 32; ++b) m = fmaxf(m, relt[b * 16 + tid]); relt[33 * 16 + tid] = m; }
    LDS_WAIT(); __syncthreads();
    const int l = lane, l15 = l & 15, g = l >> 4;
    const float cmax = __uint_as_float(__hip_atomic_load(F.ctl + CW_CMAX, __ATOMIC_RELAXED, __HIP_MEMORY_SCOPE_AGENT)) * 1.15f;
    const float bmaxh = relt[33 * 16 + l15];
    const int gw = F.vcu * NWAVES + wave, NGW = F.G * NWAVES;
    const int ntok = (M - gw + NGW - 1) / NGW;
#define SA_PARK_BKT(base_, bv_) do { _Pragma("unroll") for (int i_ = 0; i_ < 4; ++i_) { const int s_ = 4 * l + i_, sl_ = s_ & 31; (base_)[(s_ & ~31) + 4 * (sl_ & 7) + (sl_ >> 3)] = (unsigned char)((bv_) >> (8 * i_)); } } while (0)
#define SA_ROW(i_) ((NGW == 2048) ? ((size_t)(gw >> 8) * T + (size_t)((gw & 255) + 256 * (i_))) : (size_t)(gw + NGW * (i_)))
    if (ntok > 0) { const size_t row = SA_ROW(0); const u32x2 sv = *(const GAS u32x2*)(SEL + row * 256 + 4 * l); const unsigned bv = *(const GAS unsigned*)(BKT + row * 256 + 4 * l);
        *(LAS u32x2*)(sb + 8 * l) = sv; SA_PARK_BKT(sb + 512, bv); }
    LDS_WAIT();
    for (int it = 0; it < ntok; ++it) {
        const size_t row = SA_ROW(it); const size_t rowb = row & ~(size_t)(T - 1);
        LAS unsigned short* selw = (LAS unsigned short*)(sb + (it & 1) * 768); LAS unsigned char* bktw = sb + (it & 1) * 768 + 512;
        u32x2 svn = {0u, 0u}; unsigned bvn = 0u;
        if (it + 1 < ntok) { const size_t rown = SA_ROW(it + 1); svn = *(const GAS u32x2*)(SEL + rown * 256 + 4 * l); bvn = *(const GAS unsigned*)(BKT + rown * 256 + 4 * l); }
        pg8::i32x8 q8; float qq = 0.f;
        { const v4u qa = __builtin_nontemporal_load((const v4u*)(QLAT8 + row * 2048 + l15 * 128 + g * 32)), qb = __builtin_nontemporal_load((const v4u*)(QLAT8 + row * 2048 + l15 * 128 + g * 32 + 16));
          q8 = (pg8::i32x8){(int)qa.x, (int)qa.y, (int)qa.z, (int)qa.w, (int)qb.x, (int)qb.y, (int)qb.z, (int)qb.w};
#pragma unroll
          for (int d = 0; d < 8; ++d) { const f32x2 a = __builtin_amdgcn_cvt_pk_f32_fp8(q8[d], false), b = __builtin_amdgcn_cvt_pk_f32_fp8(q8[d], true); qq += (a.x * a.x + a.y * a.y) + (b.x * b.x + b.y * b.y); }
          qq *= 1.0f / (F8_QLS * F8_QLS); }
        qq += __shfl_xor(qq, 16); qq += __shfl_xor(qq, 32);
        const float mh = sqrtf(qq) * cmax + bmaxh;
        const float nmh = -mh; f32x4 lsum = (f32x4){0.f, 0.f, 0.f, 0.f}; f32x4 o[8];
#pragma unroll
        for (int mt = 0; mt < 8; ++mt) o[mt] = (f32x4){0.f, 0.f, 0.f, 0.f};
#define SA_SW(r_) ((((r_) >> 1) & 3) | (((((r_) >> 2) ^ ((r_) >> 4)) & 1) << 2))
#define SA_DMA(c_) do { _Pragma("unroll") for (int q = 0; q < 4; ++q) { const int r_ = 8 * q + (l >> 3); unsigned idx = selw[32 * (c_) + 8 * (r_ & 3) + (r_ >> 2)]; idx = (idx == 0xFFFFu) ? 0u : idx; \
            const unsigned char* src = CKV8 + (rowb + idx) * 128 + (((l & 7) ^ SA_SW(r_)) * 16); \
            __builtin_amdgcn_global_load_lds((const GAS unsigned*)src, (LAS unsigned*)(cb + ((c_) & 3) * 4096 + q * 1024), 16, 0, 0); } } while (0)
        SA_DMA(0); SA_DMA(1);
        unsigned f8one = 0x7f7f7f7fu, f8qs = 0x7b7b7b7bu; asm volatile("" : "+v"(f8one), "+v"(f8qs));
        const bf16x8 ones8 = (bf16x8){0x3F80, 0x3F80, 0x3F80, 0x3F80, 0x3F80, 0x3F80, 0x3F80, 0x3F80};
        const int pvr = (l15 >> 1) < 4 ? 4 * g + (l15 >> 1) : 16 + 4 * g + ((l15 >> 1) - 4); const int pvoff = pvr * 128 + (l15 & 1) * 8, pvsw = SA_SW(pvr);
#pragma unroll
        for (int c = 0; c < 8; c += 2) {
            if (c + 2 < 8) { SA_DMA(c + 2); SA_DMA(c + 3); asm volatile("s_waitcnt vmcnt(8)" ::: "memory"); } else { asm volatile("s_waitcnt vmcnt(0)" ::: "memory"); }
            pg8::i32x8 a8[4]; float bias[4][4]; u32x2 vt[16]; unsigned bk[4];
#pragma unroll
            for (int h2 = 0; h2 < 2; ++h2) { LAS unsigned char* cbc = cb + ((c + h2) & 3) * 4096;
                bk[2 * h2] = *(const LAS unsigned*)(bktw + (c + h2) * 32 + 4 * g); bk[2 * h2 + 1] = *(const LAS unsigned*)(bktw + (c + h2) * 32 + 16 + 4 * g);
#pragma unroll
                for (int tt = 0; tt < 2; ++tt) { const int R = 16 * tt + l15; const v4u lo = *(const LAS v4u*)(cbc + R * 128 + (((2 * g) ^ SA_SW(R)) * 16)), hi = *(const LAS v4u*)(cbc + R * 128 + (((2 * g + 1) ^ SA_SW(R)) * 16));
                    a8[2 * h2 + tt] = (pg8::i32x8){(int)lo.x, (int)lo.y, (int)lo.z, (int)lo.w, (int)hi.x, (int)hi.y, (int)hi.z, (int)hi.w}; }
#pragma unroll
                for (int mt = 0; mt < 8; ++mt) { typedef int v2i_t __attribute__((ext_vector_type(2)));
                    const v2i_t t8 = __builtin_amdgcn_ds_read_tr8_b64_v2i32((LAS v2i_t*)(cbc + pvoff + ((mt ^ pvsw) * 16))); vt[8 * h2 + mt] = (u32x2){(unsigned)t8.x, (unsigned)t8.y}; } }
#pragma unroll
            for (int q = 0; q < 4; ++q)
#pragma unroll
                for (int r = 0; r < 4; ++r) bias[q][r] = relt[((bk[q] >> (8 * r)) & 0xffu) * 16 + l15];
            __builtin_amdgcn_sched_barrier(0);
            f32x4 s0 = (f32x4){nmh, nmh, nmh, nmh}, s1 = s0, s2 = s0, s3 = s0;
            asm volatile("v_mfma_scale_f32_16x16x128_f8f6f4 %0, %4, %8, %0, %9, %10 op_sel_hi:[0,0,0]\n\tv_mfma_scale_f32_16x16x128_f8f6f4 %1, %5, %8, %1, %9, %10 op_sel_hi:[0,0,0]\n\t"
                         "v_mfma_scale_f32_16x16x128_f8f6f4 %2, %6, %8, %2, %9, %10 op_sel_hi:[0,0,0]\n\tv_mfma_scale_f32_16x16x128_f8f6f4 %3, %7, %8, %3, %9, %10 op_sel_hi:[0,0,0]\n\ts_nop 15\n\ts_nop 3"
                         : "+v"(s0), "+v"(s1), "+v"(s2), "+v"(s3) : "v"(a8[0]), "v"(a8[1]), "v"(a8[2]), "v"(a8[3]), "v"(q8), "v"(f8one), "v"(f8qs));
#pragma unroll
            for (int r = 0; r < 4; ++r) { s0[r] = __builtin_amdgcn_exp2f(s0[r] + bias[0][r]); s1[r] = __builtin_amdgcn_exp2f(s1[r] + bias[1][r]); s2[r] = __builtin_amdgcn_exp2f(s2[r] + bias[2][r]); s3[r] = __builtin_amdgcn_exp2f(s3[r] + bias[3][r]); }
            u32x4 pw0, pw1; pw0.x = cvtpk(s0[0], s0[1]); pw0.y = cvtpk(s0[2], s0[3]); pw0.z = cvtpk(s1[0], s1[1]); pw0.w = cvtpk(s1[2], s1[3]);
            pw1.x = cvtpk(s2[0], s2[1]); pw1.y = cvtpk(s2[2], s2[3]); pw1.z = cvtpk(s3[0], s3[1]); pw1.w = cvtpk(s3[2], s3[3]);
#pragma unroll
            for (int h2 = 0; h2 < 2; ++h2) { const bf16x8 pb = __builtin_bit_cast(bf16x8, h2 ? pw1 : pw0);
                lsum = __builtin_amdgcn_mfma_f32_16x16x32_bf16(ones8, pb, lsum, 0, 0, 0);
#pragma unroll
                for (int mt = 0; mt < 8; ++mt) { typedef __bf16 bf2_t __attribute__((ext_vector_type(2))); const u32x2 v = vt[8 * h2 + mt];
                    u32x4 aw; aw.x = __builtin_bit_cast(unsigned, (bf2_t)__builtin_amdgcn_cvt_scalef32_pk_bf16_fp8(v.x, 1.0f, false)); aw.y = __builtin_bit_cast(unsigned, (bf2_t)__builtin_amdgcn_cvt_scalef32_pk_bf16_fp8(v.x, 1.0f, true));
                    aw.z = __builtin_bit_cast(unsigned, (bf2_t)__builtin_amdgcn_cvt_scalef32_pk_bf16_fp8(v.y, 1.0f, false)); aw.w = __builtin_bit_cast(unsigned, (bf2_t)__builtin_amdgcn_cvt_scalef32_pk_bf16_fp8(v.y, 1.0f, true));
                    o[mt] = __builtin_amdgcn_mfma_f32_16x16x32_bf16(__builtin_bit_cast(bf16x8, aw), pb, o[mt], 0, 0, 0); } }
            LDS_WAIT();
        }
#undef SA_DMA
#undef SA_SW
        const float inv = F8_OLS / lsum[0];
#pragma unroll
        for (int mt = 0; mt < 8; ++mt) __builtin_nontemporal_store(pg8::cvt4_fp8(o[mt][0] * inv, o[mt][1] * inv, o[mt][2] * inv, o[mt][3] * inv), (unsigned*)(OLAT + row * 2048 + l15 * 128 + 16 * mt + 4 * g));
        { LAS unsigned char* sn = sb + ((it + 1) & 1) * 768; *(LAS u32x2*)(sn + 8 * l) = svn; SA_PARK_BKT(sn + 512, bvn); }
        LDS_WAIT();
    }
#undef SA_ROW
#undef SA_PARK_BKT
    LDS_WAIT(); __syncthreads();
}

typedef float f32x4v __attribute__((ext_vector_type(4)));
__device__ __forceinline__ void p_ln_router(Frame& F, const float* xbase, const bool base16  , const float* lg, const float* lb, const float* w_router, const float* b_router, int layer) {
    PHASE_IDS();
    const unsigned char* HB = (const unsigned char*)(F.ws + WS_Y);        bf16* XF = (bf16*)(F.ws + WS_XF); unsigned char* XB8 = (unsigned char*)(F.ws + WS_XB8);
    int* TOPE = (int*)(F.ws + WS_TOPE); float* TOPG = (float*)(F.ws + WS_TOPG); int* POS = (int*)(F.ws + WS_POS); unsigned short* TOKE = (unsigned short*)(F.ws + WS_TOKE);
    gu32* gcnt = F.ctl + CW_CNT + 64 * layer;
    LAS float* lgt = (LAS float*)F.lds;
    LAS int* hist = (LAS int*)(F.lds + 128 * 33 * 4);
    LAS int* base = hist + 32;
    const int l = lane, l15 = l & 15, g = l >> 4;
    f32x4 gv[4], bv[4];
#pragma unroll
    for (int j = 0; j < 4; ++j) { gv[j] = *(const f32x4*)(lg + 4 * l + 256 * j); bv[j] = *(const f32x4*)(lb + 4 * l + 256 * j); }
    for (int unit = F.vcu; unit < M / 128; unit += F.G) {
        const int r0 = unit * 128 + wave * 16;
        if (tid < 32) hist[tid] = 0;
        u32x4 vn[4]; unsigned hn[4];
#define LNR_LOAD(row_) do { const GAS unsigned* hp = (const GAS unsigned*)(HB + (size_t)(row_) * D) + l; \
            if (base16) { const GAS u32x2* yp = (const GAS u32x2*)((const bf16*)xbase + (size_t)(row_) * D) + l; _Pragma("unroll") for (int j = 0; j < 4; ++j) { const u32x2 t2 = yp[64 * j]; vn[j] = (u32x4){t2.x, t2.y, 0u, 0u}; hn[j] = hp[64 * j]; } } \
            else { const GAS u32x4* yp = (const GAS u32x4*)(xbase + (size_t)(row_) * D) + l; _Pragma("unroll") for (int j = 0; j < 4; ++j) { vn[j] = yp[64 * j]; hn[j] = hp[64 * j]; } } } while (0)
        LNR_LOAD(r0);
        for (int i = 0; i < 16; ++i) { const size_t row = (size_t)(r0 + i);
            f32x4 v[4]; float s = 0.f;
#pragma unroll
            for (int j = 0; j < 4; ++j) { const f32x2 h01 = __builtin_amdgcn_cvt_pk_f32_fp8((int)hn[j], false), h23 = __builtin_amdgcn_cvt_pk_f32_fp8((int)hn[j], true); const u32x4 bb = vn[j]; f32x4 xb;
                if (base16) xb = (f32x4){__uint_as_float(bb.x << 16), __uint_as_float(bb.x & 0xffff0000u), __uint_as_float(bb.y << 16), __uint_as_float(bb.y & 0xffff0000u)};
                else xb = (f32x4){__uint_as_float(bb.x), __uint_as_float(bb.y), __uint_as_float(bb.z), __uint_as_float(bb.w)};
                v[j].x = xb.x * DN_ALPHA + h01.x * (1.0f / F8_HYS); v[j].y = xb.y * DN_ALPHA + h01.y * (1.0f / F8_HYS);
                v[j].z = xb.z * DN_ALPHA + h23.x * (1.0f / F8_HYS); v[j].w = xb.w * DN_ALPHA + h23.y * (1.0f / F8_HYS);
                s += (v[j].x + v[j].y) + (v[j].z + v[j].w); }
            if (i < 15) { LNR_LOAD(row + 1); }
            const float mean = wave_sum(s) * (1.f / D); float s2 = 0.f;
#pragma unroll
            for (int j = 0; j < 4; ++j) { v[j] = v[j] - mean; s2 += (v[j].x * v[j].x + v[j].y * v[j].y) + (v[j].z * v[j].z + v[j].w * v[j].w); }
            const float rstd = 1.f / sqrtf(wave_sum(s2) * (1.f / D) + LN_EPS);
            GAS u32x2* xo = (GAS u32x2*)(XF + row * D) + l; GAS unsigned* bo = (GAS unsigned*)(XB8 + row * D) + l;
#pragma unroll
            for (int j = 0; j < 4; ++j) { const f32x4 o = v[j] * rstd * gv[j] + bv[j]; u32x2 ow; ow.x = cvtpk(o.x, o.y); ow.y = cvtpk(o.z, o.w); xo[64 * j] = ow; bo[64 * j] = pg8::cvt4_fp8(o.x * F8_XS, o.y * F8_XS, o.z * F8_XS, o.w * F8_XS); } }
#undef LNR_LOAD
        asm volatile("s_waitcnt vmcnt(0)" ::: "memory");
        f32x4 acc0 = (f32x4){0.f, 0.f, 0.f, 0.f}, acc1 = acc0;
        { const bf16* xr = XF + (size_t)(r0 + l15) * D + 4 * g;
#pragma unroll 1
          for (int k0 = 0; k0 < D; k0 += 64) {
              f32x4 a[4]; float w0[4][4], w1[4][4];
#pragma unroll
              for (int q = 0; q < 4; ++q) { const u32x2 ab = __builtin_nontemporal_load((const u32x2*)(xr + k0 + 16 * q));
                  a[q] = (f32x4){__uint_as_float(ab.x << 16), __uint_as_float(ab.x & 0xffff0000u), __uint_as_float(ab.y << 16), __uint_as_float(ab.y & 0xffff0000u)}; const float* wp = w_router + (size_t)(k0 + 16 * q + 4 * g) * NEXP + l15;
#pragma unroll
                  for (int j = 0; j < 4; ++j) { w0[q][j] = wp[j * NEXP]; w1[q][j] = wp[j * NEXP + 16]; } }
#pragma unroll
              for (int q = 0; q < 4; ++q)
#pragma unroll
                  for (int j = 0; j < 4; ++j) { acc0 = __builtin_amdgcn_mfma_f32_16x16x4f32(a[q][j], w0[q][j], acc0, 0, 0, 0); acc1 = __builtin_amdgcn_mfma_f32_16x16x4f32(a[q][j], w1[q][j], acc1, 0, 0, 0); } } }
        { const float b0 = b_router[l15], b1 = b_router[l15 + 16];
#pragma unroll
          for (int r = 0; r < 4; ++r) { lgt[(wave * 16 + 4 * g + r) * 33 + l15] = acc0[r] + b0; lgt[(wave * 16 + 4 * g + r) * 33 + l15 + 16] = acc1[r] + b1; } }
        LDS_WAIT(); __syncthreads();
        int te[4] = {0, 0, 0, 0}, lp[4] = {0, 0, 0, 0}; float tg[4] = {0.f, 0.f, 0.f, 0.f};
        if (l < 16) { const LAS float* rp = lgt + (wave * 16 + l) * 33; float tv[4] = {-INFINITY, -INFINITY, -INFINITY, -INFINITY};
            for (int e = 0; e < NEXP; ++e) { const float v = rp[e];
                if (v > tv[3]) { if (v > tv[0]) { tv[3] = tv[2]; te[3] = te[2]; tv[2] = tv[1]; te[2] = te[1]; tv[1] = tv[0]; te[1] = te[0]; tv[0] = v; te[0] = e; }
                    else if (v > tv[1]) { tv[3] = tv[2]; te[3] = te[2]; tv[2] = tv[1]; te[2] = te[1]; tv[1] = v; te[1] = e; }
                    else if (v > tv[2]) { tv[3] = tv[2]; te[3] = te[2]; tv[2] = v; te[2] = e; }
                    else { tv[3] = v; te[3] = e; } } }
            const float e1 = __expf(tv[1] - tv[0]), e2 = __expf(tv[2] - tv[0]), e3 = __expf(tv[3] - tv[0]); const float inv = 1.0f / (1.0f + e1 + e2 + e3);
            tg[0] = inv; tg[1] = e1 * inv; tg[2] = e2 * inv; tg[3] = e3 * inv;
#pragma unroll
            for (int k = 0; k < 4; ++k) lp[k] = atomicAdd((int*)(hist + te[k]), 1); }
        LDS_WAIT(); __syncthreads();
        if (tid < 32) base[tid] = (int)__hip_atomic_fetch_add(gcnt + tid, (unsigned)hist[tid], __ATOMIC_RELAXED, __HIP_MEMORY_SCOPE_AGENT);
        LDS_WAIT(); __syncthreads();
        if (l < 16) { const size_t row = (size_t)(r0 + l);
            typedef int i32x4 __attribute__((ext_vector_type(4)));
            *(GAS i32x4*)(TOPE + row * 4) = (i32x4){te[0], te[1], te[2], te[3]};
            *(GAS f32x4*)(TOPG + row * 4) = (f32x4){tg[0], tg[1], tg[2], tg[3]};
            const int p0 = base[te[0]] + lp[0], p1 = base[te[1]] + lp[1], p2 = base[te[2]] + lp[2], p3 = base[te[3]] + lp[3];
            *(GAS i32x4*)(POS + row * 4) = (i32x4){p0, p1, p2, p3};
            TOKE[(size_t)te[0] * 32768 + p0] = (unsigned short)row; TOKE[(size_t)te[1] * 32768 + p1] = (unsigned short)row; TOKE[(size_t)te[2] * 32768 + p2] = (unsigned short)row; TOKE[(size_t)te[3] * 32768 + p3] = (unsigned short)row; }
        LDS_WAIT(); __syncthreads();
    }
}

__device__ __forceinline__ int moe_tables(Frame& F, int layer, LAS int* tab) {
    gu32* gcnt = F.ctl + CW_CNT + 64 * layer;
    if (threadIdx.x < NEXP) tab[64 + threadIdx.x] = (int)__hip_atomic_load(gcnt + threadIdx.x, __ATOMIC_RELAXED, __HIP_MEMORY_SCOPE_AGENT);
    LDS_WAIT(); __syncthreads();
    if (threadIdx.x == 0) { int acc = 0; for (int e = 0; e < NEXP; ++e) { tab[e] = acc; acc += (tab[64 + e] + 255) >> 8; } tab[NEXP] = acc; }
    LDS_WAIT(); __syncthreads();
    const int nT = tab[NEXP];
    for (int pm = threadIdx.x; pm < nT; pm += NWAVES * 64) { int e = 0; for (int k = 1; k < NEXP; ++k) e += (tab[k] <= pm) ? 1 : 0;
        tab[128 + pm] = e; }
    LDS_WAIT(); __syncthreads();
    return nT;
}

__device__ __forceinline__ void p_moe_combine_ln(Frame& F, const float* lg, const float* lb, float* out_final, int layer) {
    PHASE_IDS();
    LAS int* tab = (LAS int*)F.lds; (void)moe_tables(F, layer, tab);
    bf16* XF = (bf16*)(F.ws + WS_XF); unsigned char* XB8 = (unsigned char*)(F.ws + WS_XB8); const unsigned char* Y2 = (const unsigned char*)(F.ws + WS_XG);
    const int* TOPE = (const int*)(F.ws + WS_TOPE); const int* POS = (const int*)(F.ws + WS_POS); const float* TOPG = (const float*)(F.ws + WS_TOPG);
    const int l = lane; const int gw = F.vcu * NWAVES + wave, NGW = F.G * NWAVES;
    f32x4 gv[4], bv[4];
#pragma unroll
    for (int j = 0; j < 4; ++j) { gv[j] = *(const f32x4*)(lg + 4 * l + 256 * j); bv[j] = *(const f32x4*)(lb + 4 * l + 256 * j); }
    for (int row = gw; row < M; row += NGW) {
        typedef int i32x4 __attribute__((ext_vector_type(4)));
        const i32x4 e4 = *(const GAS i32x4*)(TOPE + (size_t)row * 4), p4 = *(const GAS i32x4*)(POS + (size_t)row * 4); const f32x4 gt = *(const GAS f32x4*)(TOPG + (size_t)row * 4);
        i32x4 sl; sl[0] = 256 * tab[e4[0]] + p4[0]; sl[1] = 256 * tab[e4[1]] + p4[1]; sl[2] = 256 * tab[e4[2]] + p4[2]; sl[3] = 256 * tab[e4[3]] + p4[3];
        GAS u32x2* xp = (GAS u32x2*)(XF + (size_t)row * D) + l; f32x4 v[4];
#pragma unroll
        for (int j = 0; j < 4; ++j) { const u32x2 xb = xp[64 * j]; v[j] = (f32x4){__uint_as_float(xb.x << 16), __uint_as_float(xb.x & 0xffff0000u), __uint_as_float(xb.y << 16), __uint_as_float(xb.y & 0xffff0000u)} * DN_ALPHA; }
#pragma unroll
        for (int k = 0; k < 4; ++k) { const GAS int* yp = (const GAS int*)(Y2 + (size_t)sl[k] * D) + l; const float gk = gt[k] * (1.0f / F8_YS);
#pragma unroll
            for (int j = 0; j < 4; ++j) { const int w = yp[64 * j];
                v[j].x += gk * __builtin_amdgcn_cvt_f32_fp8(w, 0); v[j].y += gk * __builtin_amdgcn_cvt_f32_fp8(w, 1); v[j].z += gk * __builtin_amdgcn_cvt_f32_fp8(w, 2); v[j].w += gk * __builtin_amdgcn_cvt_f32_fp8(w, 3); } }
        float s = 0.f;
#pragma unroll
        for (int j = 0; j < 4; ++j) s += (v[j].x + v[j].y) + (v[j].z + v[j].w);
        const float mean = wave_sum(s) * (1.f / D); float s2 = 0.f;
#pragma unroll
        for (int j = 0; j < 4; ++j) { v[j] = v[j] - mean; s2 += (v[j].x * v[j].x + v[j].y * v[j].y) + (v[j].z * v[j].z + v[j].w * v[j].w); }
        const float rstd = 1.f / sqrtf(wave_sum(s2) * (1.f / D) + LN_EPS);
        if (out_final) { GAS f32x4* op = (GAS f32x4*)(out_final + (size_t)row * D) + l;
            const float poison = (__hip_atomic_load(F.ctl + CW_TMO, __ATOMIC_RELAXED, __HIP_MEMORY_SCOPE_AGENT) != 0u) ? __builtin_nanf("") : 0.f;
#pragma unroll
            for (int j = 0; j < 4; ++j) op[64 * j] = v[j] * rstd * gv[j] + bv[j] + poison; }
        else { GAS unsigned* bo = (GAS unsigned*)(XB8 + (size_t)row * D) + l;
#pragma unroll
            for (int j = 0; j < 4; ++j) { const f32x4 o = v[j] * rstd * gv[j] + bv[j]; u32x2 ow; ow.x = cvtpk(o.x, o.y); ow.y = cvtpk(o.z, o.w); xp[64 * j] = ow; bo[64 * j] = pg8::cvt4_fp8(o.x * F8_XS, o.y * F8_XS, o.z * F8_XS, o.w * F8_XS); } }
    }
}

__device__ __forceinline__ void p_fox_gate(Frame& F, const float* w_f, const float* b_f) {
    PHASE_IDS();
    const bf16* XF = (const bf16*)(F.ws + WS_XF); float* LOGF = (float*)(F.ws + WS_LOGF);
    const int l = lane, l15 = l & 15, g = l >> 4; const int gw = F.vcu * NWAVES + wave, NGW = F.G * NWAVES;
    const float bf = b_f[l15];
    for (int tile = gw; tile < M / 16; tile += NGW) {
        f32x4 acc = (f32x4){0.f, 0.f, 0.f, 0.f}; const bf16* xr = XF + (size_t)(tile * 16 + l15) * D + 4 * g;
#pragma unroll 1
        for (int k0 = 0; k0 < D; k0 += 64) {
            f32x4 a[4]; float w[4][4];
#pragma unroll
            for (int q = 0; q < 4; ++q) { const u32x2 ab = *(const GAS u32x2*)(xr + k0 + 16 * q);
                a[q] = (f32x4){__uint_as_float(ab.x << 16), __uint_as_float(ab.x & 0xffff0000u), __uint_as_float(ab.y << 16), __uint_as_float(ab.y & 0xffff0000u)}; const float* wp = w_f + (size_t)(k0 + 16 * q + 4 * g) * 16 + l15;
#pragma unroll
                for (int j = 0; j < 4; ++j) w[q][j] = wp[j * 16]; }
#pragma unroll
            for (int q = 0; q < 4; ++q)
#pragma unroll
                for (int j = 0; j < 4; ++j) acc = __builtin_amdgcn_mfma_f32_16x16x4f32(a[q][j], w[q][j], acc, 0, 0, 0); }
#pragma unroll
        for (int r = 0; r < 4; ++r) { const float z = acc[r] + bf; const float ls = fminf(z, 0.f) - log1pf(__expf(-fabsf(z)));
            LOGF[(size_t)(tile * 16 + 4 * g + r) * 16 + l15] = ls; }
    }
}
__device__ __forceinline__ void split3(float f, unsigned short& h, unsigned short& m, unsigned short& lo) {
    const unsigned p1 = f2bf(f); const float f1 = __uint_as_float(p1 << 16); const float r1 = f - f1;
    const unsigned p2 = f2bf(r1); const float f2 = __uint_as_float(p2 << 16); const float r2 = r1 - f2;
    h = (unsigned short)p1; m = (unsigned short)p2; lo = (unsigned short)f2bf(r2);
}
__device__ __forceinline__ void p_fox_cum(Frame& F) {
    PHASE_IDS();
    const float* LOGF = (const float*)(F.ws + WS_LOGF); bf16* QX = (bf16*)(F.ws + WS_QX); bf16* KX = (bf16*)(F.ws + WS_KX);
    const bf16* Q = (const bf16*)(F.ws + WS_Q); const bf16* K = (const bf16*)(F.ws + WS_K);
    float* CUM2 = (float*)(F.ws + WS_CUM2); float* KMAX = (float*)(F.ws + WS_KMAX); float* DG = (float*)(F.ws + WS_DG);
    LAS double* red = (LAS double*)F.lds;
    LAS double* pre = red + 512;
    LAS double* tot = pre + 16;
    LAS float* kn2 = (LAS float*)(tot + 512);
    LAS float* qn2 = kn2 + 512;
    LAS float* dgm = qn2 + 512;
    const int h = tid & 15, sub = tid >> 4;
    for (int unit = F.vcu; unit < BATCH * 32; unit += F.G) {
        const int b = unit >> 5, seg = unit & 31; const size_t rowb = (size_t)b * T;
        double s = 0.0;
        { const int nprev = seg * 128; int t = sub;
          for (; t + 7 * 32 < nprev; t += 8 * 32) { float a[8];
#pragma unroll
              for (int q = 0; q < 8; ++q) a[q] = LOGF[(rowb + t + 32 * q) * 16 + h];
              s += (((double)a[0] + (double)a[1]) + ((double)a[2] + (double)a[3])) + (((double)a[4] + (double)a[5]) + ((double)a[6] + (double)a[7])); }
          for (; t < nprev; t += 32) s += (double)LOGF[(rowb + t) * 16 + h]; }
        red[sub * 16 + h] = s;
        const int t0 = seg * 128 + sub * 4; float lf[4];
#pragma unroll
        for (int i = 0; i < 4; ++i) lf[i] = LOGF[(rowb + t0 + i) * 16 + h];
        tot[sub * 16 + h] = (double)lf[0] + (double)lf[1] + (double)lf[2] + (double)lf[3];
        { float kmx = 0.f, qmx = 0.f, dmn = INFINITY;
#pragma unroll
          for (int i = 0; i < 4; ++i) { const GAS v4u* qp = (const GAS v4u*)(Q + (rowb + t0 + i) * D + h * 64); const GAS v4u* kp = (const GAS v4u*)(K + (rowb + t0 + i) * D + h * 64);
              float qq = 0.f, kk = 0.f, qk = 0.f;
#pragma unroll
              for (int c = 0; c < 8; ++c) { const v4u a = qp[c], bb = kp[c]; const unsigned aw[4] = {a.x, a.y, a.z, a.w}, bw[4] = {bb.x, bb.y, bb.z, bb.w};
#pragma unroll
                  for (int e = 0; e < 4; ++e) { const float a0 = __uint_as_float(aw[e] << 16), a1 = __uint_as_float(aw[e] & 0xffff0000u), b0 = __uint_as_float(bw[e] << 16), b1 = __uint_as_float(bw[e] & 0xffff0000u);
                      qq += a0 * a0 + a1 * a1; kk += b0 * b0 + b1 * b1; qk += a0 * b0 + a1 * b1; } }
              kmx = fmaxf(kmx, kk); qmx = fmaxf(qmx, qq); dmn = fminf(dmn, qk); DG[(rowb + t0 + i) * 16 + h] = qk; }
          kn2[sub * 16 + h] = kmx; qn2[sub * 16 + h] = qmx; dgm[sub * 16 + h] = dmn; }
        LDS_WAIT(); __syncthreads();
        if (tid < 16) { double a = 0.0; for (int j = 0; j < 32; ++j) a += red[j * 16 + tid]; pre[tid] = a; }
        if (tid >= 64 && tid < 96) { const int hh = tid & 15, tl = (tid >> 4) & 1; float m = 0.f; for (int j = 0; j < 16; ++j) m = fmaxf(m, kn2[(tl * 16 + j) * 16 + hh]);
            KMAX[(size_t)(b * 16 + hh) * 64 + seg * 2 + tl] = sqrtf(m); }
        if (tid >= 128 && tid < 144) { const int hh = tid & 15; float m = 0.f, d = INFINITY; for (int j = 0; j < 32; ++j) { m = fmaxf(m, qn2[j * 16 + hh]); d = fminf(d, dgm[j * 16 + hh]); }
            const int qi = (b * 16 + hh) * 16 + (seg >> 1);
            __hip_atomic_fetch_max(F.ctl + CW_QMAX + qi, __float_as_uint(sqrtf(m)), __ATOMIC_RELAXED, __HIP_MEMORY_SCOPE_AGENT);
            __hip_atomic_fetch_max(F.ctl + CW_MNEG + qi, fkey(-d), __ATOMIC_RELAXED, __HIP_MEMORY_SCOPE_AGENT); }
        LDS_WAIT(); __syncthreads();
        double c = pre[h]; for (int j = 0; j < sub; ++j) c += tot[j * 16 + h];
#pragma unroll
        for (int i = 0; i < 4; ++i) { c += (double)lf[i]; const float cf = (float)(c * 1.4426950408889634);
            unsigned short ch, cm, cl; split3(cf, ch, cm, cl); unsigned short nh, nm, nl; split3(-cf, nh, nm, nl);
            const size_t o = ((rowb + t0 + i) * 16 + h) * 16;
            CUM2[(rowb + t0 + i) * 16 + h] = cf;
            const unsigned one2 = 0x3F803F80u;
            v4u q0; q0.x = one2; q0.y = 0x3F80u | ((unsigned)ch << 16); q0.z = (unsigned)cm | ((unsigned)cl << 16); q0.w = 0u;
            v4u q1; q1.x = 0u; q1.y = 0u; q1.z = 0u; q1.w = 0u;
            v4u k0; k0.x = (unsigned)nh | ((unsigned)nm << 16); k0.y = (unsigned)nl | (0x3F80u << 16); k0.z = one2; k0.w = one2;
            v4u k1; k1.x = 0x3F80u; k1.y = 0u; k1.z = 0u; k1.w = 0u;
            *(GAS v4u*)(QX + o) = q0; *(GAS v4u*)(QX + o + 8) = q1; *(GAS v4u*)(KX + o) = k0; *(GAS v4u*)(KX + o + 8) = k1; }
        LDS_WAIT(); __syncthreads();
    }
}
__device__ __forceinline__ void p_fox_ts(Frame& F) {
    PHASE_IDS();
    const float* CUM2 = (const float*)(F.ws + WS_CUM2); const float* KMAX = (const float*)(F.ws + WS_KMAX); unsigned char* TS = (unsigned char*)(F.ws + WS_TS);
    const int gw = F.vcu * NWAVES + wave, NGW = F.G * NWAVES;
    for (int u = gw; u < BATCH * 16 * 16; u += NGW) { const int bh = u >> 4, qb = u & 15, b = bh >> 4, h = bh & 15; const size_t rowb = (size_t)b * T;
        const float qmax = __uint_as_float(__hip_atomic_load(F.ctl + CW_QMAX + u, __ATOMIC_RELAXED, __HIP_MEMORY_SCOPE_AGENT));
        const unsigned kk = __hip_atomic_load(F.ctl + CW_MNEG + u, __ATOMIC_RELAXED, __HIP_MEMORY_SCOPE_AGENT); const float negmlo = __uint_as_float((kk & 0x80000000u) ? (kk & 0x7fffffffu) : ~kk);
        const float cq = CUM2[(rowb + 256 * qb) * 16 + h]; const float ck = CUM2[(rowb + 64 * lane + 63) * 16 + h]; const float km = KMAX[(size_t)bh * 64 + lane];
        const float bound = (cq - ck) + qmax * km + negmlo + 1.0f;
        const bool keep = (lane >= 4 * qb) || !(bound < -36.0f);
        const unsigned long long m = __ballot(keep); int first = __builtin_ctzll(m); if (first > 4 * qb) first = 4 * qb;
        const bool risky = (lane <= 4 * qb + 3) && !(qmax * km + negmlo < 60.0f);
        const unsigned guard = __ballot(risky) != 0ull ? 1u : 0u;
        if (lane == 0) TS[u] = (unsigned char)((first & ~1) | guard); }
}

struct Args { const float* in[25]; float* out; unsigned char* ws; int ph_lo, ph_hi, li, pad; };

#define IN(k) (lo <= (k) && (k) < hi)
#define BOTH(k) (IN(k) && IN((k) + 1))
#define GRID_BAR(k) do { if (BOTH(k)) xcd_barrier(bar); } while (0)
#ifndef MK_REP_MASK
#define MK_REP_MASK 0u
#endif
#define RUN(k, ...) do { if (IN(k)) { __VA_ARGS__ if ((MK_REP_MASK >> (k)) & 1u) { __VA_ARGS__ } } } while (0)

__device__ __forceinline__ void moe_phases(Frame& F, const XcdBarrier& bar, int lo, int hi, const int layer, const int pb, const float* base, const bool base16, float* out_final) {
    const float* PAR = (const float*)(F.ws + WS_PAR);
    const float* lnm_g = PAR + PAR_LN + layer * D; const float* lnm_b = PAR + PAR_LN + 2048 + layer * D; const float* lnf_g = PAR + PAR_LN + 4096 + layer * D; const float* lnf_b = PAR + PAR_LN + 6144 + layer * D;
    LAS int* tab = (LAS int*)(F.lds + RING_BYTES);
    RUN(pb,  p_ln_router(F, base, base16, lnm_g, lnm_b, PAR + PAR_WROUT + (size_t)layer * D * NEXP, PAR + PAR_BROUT + layer * NEXP, layer); GRID_BAR(pb); );
    RUN(pb + 1,
        const int nT = moe_tables(F, layer, tab);
        pg8::Gemm g{(const pg8::bf16_t*)(F.ws + WS_XB8), (const pg8::bf16_t*)(F.ws + WS_WGU + (size_t)layer * NEXP * 2048 * 1024), nT * 256, NEXP * 2048, 512};
        pg8::MoeOrder S{nT, 8, F.G, (int)blockIdx.x, (const LAS int*)(tab + 128)};
        LAS unsigned short* tokl = (LAS unsigned short*)(F.lds + RING_BYTES + 5120);
        { const unsigned short* TOKE = (const unsigned short*)(F.ws + WS_TOKE);
          if (threadIdx.x < 256) { unsigned short tk[17]; unsigned vm = 0u, um = 0u;
              _Pragma("unroll") for (int i = 0; i < 17; ++i) { pg8::Unit uu; uu.pm = 0; uu.pn = 0; const bool ok = S.next(i, uu); const int e = tab[128 + uu.pm], idx = (uu.pm - tab[e]) * 256 + (int)threadIdx.x; const bool v = ok && idx < tab[64 + e];
                  tk[i] = TOKE[v ? (size_t)e * 32768 + idx : (size_t)0]; vm |= (v ? 1u : 0u) << i; um |= (ok ? 1u : 0u) << i; }
              _Pragma("unroll") for (int i = 0; i < 17; ++i) { if ((um >> i) & 1u) tokl[i * 256 + threadIdx.x] = ((vm >> i) & 1u) ? tk[i] : (unsigned short)0; } }
          LDS_WAIT(); __syncthreads(); }
        pg8::EpiSwiglu8 E{(unsigned char*)(F.ws + WS_H), PAR + PAR_BGU + (size_t)layer * NEXP * 2048, 1.0f / (F8_XS * F8_WGS), F8_HS};
        pg8::gemm_phase<pg8::EpiSwiglu8, pg8::MoeOrder, PG8_ALIGN, PG8_SP2, true, true>(F.lds + RING_OFF, g, S, E, tokl);
        GRID_BAR(pb + 1);
    );
    RUN(pb + 2,
        const int nT = moe_tables(F, layer, tab);
        pg8::Gemm g{(const pg8::bf16_t*)(F.ws + WS_H), (const pg8::bf16_t*)(F.ws + WS_WD + (size_t)layer * NEXP * 1024 * 1024), nT * 256, NEXP * 1024, 512};
        pg8::MoeOrder S{nT, 4, F.G, (int)blockIdx.x, (const LAS int*)(tab + 128)};
        pg8::EpiDown8 E{(unsigned char*)(F.ws + WS_XG), PAR + PAR_BDOWN + (size_t)layer * NEXP * 1024, 1.0f / (F8_HS * F8_WDS), F8_YS};
        pg8::gemm_phase<pg8::EpiDown8, pg8::MoeOrder, PG8_ALIGN, PG8_SP2, false, true>(F.lds + RING_OFF, g, S, E);
        GRID_BAR(pb + 2);
    );
    RUN(pb + 3,  p_moe_combine_ln(F, lnf_g, lnf_b, out_final, layer); if (!out_final) GRID_BAR(pb + 3); );
}

__global__ void __launch_bounds__(NWAVES * 64, 2) mk_fwd(Args args) {
    extern __shared__ __attribute__((aligned(16))) unsigned char lds[];
    Frame F;
    F.lds = (LAS unsigned char*)lds;
    F.MISC = (volatile LAS unsigned*)(F.lds + MISC_OFF);
    F.G = gridDim.x; { const int bx = blockIdx.x; F.vcu = (F.G % 8 == 0) ? (bx % 8) * (F.G / 8) + bx / 8 : bx; }
    F.ws = args.ws; F.ctl = (gu32*)(args.ws + WS_CTL);
    if (threadIdx.x < 64) ((LAS unsigned*)(F.lds + MISC_OFF))[threadIdx.x] = 0u;
    __syncthreads();
    XcdBarrier bar; bar.bar = (unsigned*)(F.ctl + CW_BAR); bar.x = 0; bar.st = nullptr;
    if (MK_N_LAUNCHES == 1) bar = xcd_barrier_post((unsigned*)(F.ctl + CW_BAR), F.MISC + 8);
    const int lo = args.ph_lo, hi = args.ph_hi;

    RUN(0,
        P0In I{args.in[0], args.in[2], args.in[7], args.in[8], args.in[9], args.in[10], args.in[11], args.in[12], args.in[14], args.in[21], args.in[23],
               args.in[1], args.in[3], args.in[4], args.in[5], args.in[6], args.in[13], args.in[15], args.in[16], args.in[17], args.in[18], args.in[19], args.in[20], args.in[22], args.in[24]};
        p0_prologue(F, I); GRID_BAR(0);
    );
#if defined(MK_XBAR) && MK_XBAR
    if (MK_N_LAUNCHES == 1) { for (int xb_i = 0; xb_i < MK_XBAR; ++xb_i) xcd_barrier(bar); }
#endif
    RUN(1,
        pg8::Gemm g{(const pg8::bf16_t*)(F.ws + WS_XB), (const pg8::bf16_t*)(F.ws + WS_WAIN), M, 512, 1024}; pg8::StaticOrder S; S.init(M, 512, F.G, (int)blockIdx.x);
        const float* PAR = (const float*)(F.ws + WS_PAR);
        pg8::EpiDsaNorm E{(pg8::bf16_t*)(F.ws + WS_CQN), (pg8::bf16_t*)(F.ws + WS_CKV), (pg8::bf16_t*)(F.ws + WS_KIDX), (float*)(F.ws + WS_WIDX), PAR + PAR_AGQ, PAR + PAR_AGKV, PAR + PAR_AGKI, PAR + PAR_ABKI,
                          (unsigned*)(F.ctl + CW_CMAX), (LAS float*)(F.lds + RING_BYTES), RMS_EPS, LN_EPS};
        pg8::gemm_phase<pg8::EpiDsaNorm, pg8::StaticOrder, true, PG8_SP2>(F.lds + RING_OFF, g, S, E);
        GRID_BAR(1);
    );
    RUN(2,
        pg8::Gemm g{(const pg8::bf16_t*)(F.ws + WS_CQN), (const pg8::bf16_t*)(F.ws + WS_WACQ), M, 2560, 256}; pg8::StaticOrder S; S.init(M, 2560, F.G, (int)blockIdx.x);
        pg8::EpiCq E{(pg8::bf16_t*)(F.ws + WS_QLAT), (pg8::bf16_t*)(F.ws + WS_QIDX), F8_QLS};
        pg8::gemm_phase<pg8::EpiCq, pg8::StaticOrder, PG8_ALIGN, PG8_SP2>(F.lds + RING_OFF, g, S, E);
        GRID_BAR(2);
    );
    RUN(3,  p_indexer(F); GRID_BAR(3); );
    RUN(4,  p_sparse_attn(F, (const float*)(F.ws + WS_PAR) + PAR_REL); GRID_BAR(4); );
    RUN(5,
        pg8::Gemm g{(const pg8::bf16_t*)(F.ws + WS_OLAT), (const pg8::bf16_t*)(F.ws + WS_WAO), M, 1024, 1024}; pg8::StaticOrder S; S.init(M, 1024, F.G, (int)blockIdx.x);
        pg8::EpiF8s E{(unsigned char*)(F.ws + WS_Y), F8_HYS / (F8_OLS * F8_WAOS)};
        pg8::gemm_phase<pg8::EpiF8s, pg8::StaticOrder, PG8_ALIGN, PG8_SP2, false, true>(F.lds + RING_OFF, g, S, E);
        GRID_BAR(5);
    );
    moe_phases(F, bar, lo, hi, 0, 6, (const float*)(F.ws + WS_XB), true, nullptr);
    RUN(10,
        p_fox_gate(F, (const float*)(F.ws + WS_PAR) + PAR_WF, (const float*)(F.ws + WS_PAR) + PAR_BF);
        pg8::Gemm g{(const pg8::bf16_t*)(F.ws + WS_XB8), (const pg8::bf16_t*)(F.ws + WS_WBIN), M, 3072, 512}; pg8::StaticOrder S; S.init(M, 3072, F.G, (int)blockIdx.x);
        pg8::EpiQkv8 E{(pg8::bf16_t*)(F.ws + WS_Q), (size_t)(WS_K - WS_Q) / 2, 1.0f / (F8_XS * F8_WBINS), attn_body::C2};
        pg8::gemm_phase<pg8::EpiQkv8, pg8::StaticOrder, PG8_ALIGN, PG8_SP2, false, true>(F.lds + RING_OFF, g, S, E);
        GRID_BAR(10);
    );
    RUN(11,  p_fox_cum(F); GRID_BAR(11); );
    RUN(12,  p_fox_ts(F); GRID_BAR(12); );
    RUN(13,
        const attn_body::AttnTensors AT{(const attn_body::bf16*)(F.ws + WS_Q), (const attn_body::bf16*)(F.ws + WS_K), (const attn_body::bf16*)(F.ws + WS_V), (attn_body::bf16*)(F.ws + WS_O),
                                        (const attn_body::bf16*)(F.ws + WS_QX), (const attn_body::bf16*)(F.ws + WS_KX), (const float*)(F.ws + WS_DG)};
        attn_body::attn_phase<64>((char*)lds + RING_OFF, AT, (unsigned*)(F.ctl + CW_ATTQ), (const unsigned char*)(F.ws + WS_TS));
        GRID_BAR(13);
    );
    RUN(14,
        pg8::Gemm g{(const pg8::bf16_t*)(F.ws + WS_O), (const pg8::bf16_t*)(F.ws + WS_WBO), M, 1024, 512}; pg8::StaticOrder S; S.init(M, 1024, F.G, (int)blockIdx.x);
        pg8::EpiF8s E{(unsigned char*)(F.ws + WS_Y), F8_HYS / (F8_OS * F8_WBOS)};
        pg8::gemm_phase<pg8::EpiF8s, pg8::StaticOrder, PG8_ALIGN, PG8_SP2, false, true>(F.lds + RING_OFF, g, S, E);
        GRID_BAR(14);
    );
    moe_phases(F, bar, lo, hi, 1, 15, (const float*)(F.ws + WS_XF), true, args.out);
}
#undef IN
#undef BOTH
#undef GRID_BAR

extern "C" void kernel_launch(void* const* d_in, const int* in_sizes, int n_in, void* d_out, int out_size, void* d_ws, size_t ws_size, hipStream_t stream) {
    static int grid = 0;
    if (grid == 0) {
        if (n_in != 25 || in_sizes[0] != M * D || out_size != M * D || ws_size < WS_END) { fprintf(stderr, "kernel_launch: unexpected shapes (n_in %d, in0 %d, out %d, ws %zu); nothing launched\n", n_in, n_in > 0 ? in_sizes[0] : -1, out_size, ws_size); grid = -1; return; }
        int dev = 0, cus = 0, per_cu = 0;
        if (hipGetDevice(&dev) != hipSuccess || hipDeviceGetAttribute(&cus, hipDeviceAttributeMultiprocessorCount, dev) != hipSuccess) { grid = -1; return; }
        if (hipFuncSetAttribute((const void*)mk_fwd, hipFuncAttributeMaxDynamicSharedMemorySize, LDS_BYTES) != hipSuccess) { fprintf(stderr, "kernel_launch: hipFuncSetAttribute failed\n"); grid = -1; return; }
        if (hipOccupancyMaxActiveBlocksPerMultiprocessor(&per_cu, (const void*)mk_fwd, NWAVES * 64, LDS_BYTES) != hipSuccess || per_cu < 1) fprintf(stderr, "kernel_launch: occupancy query reports %d workgroups per CU\n", per_cu);
        (void)hipGetLastError();
        grid = cus;
    }
    if (grid < 0) return;
    if (hipMemsetAsync((char*)d_ws + WS_CTL, 0, CTL_ZERO_BYTES, stream) != hipSuccess) return;
    Args a{};
    for (int i = 0; i < 25; ++i) a.in[i] = (const float*)d_in[i];
    a.out = (float*)d_out; a.ws = (unsigned char*)d_ws;
    constexpr int NPH = 19;
    for (int li = 0; li < MK_N_LAUNCHES; ++li) {
        if (MK_N_LAUNCHES == 1) { a.ph_lo = 0; a.ph_hi = NPH; } else { a.ph_lo = li; a.ph_hi = li + 1; }
        a.li = li;
        hipLaunchKernelGGL(mk_fwd, dim3(grid), dim3(NWAVES * 64), LDS_BYTES, stream, a);
        if (MK_N_LAUNCHES != 1 && li + 1 == NPH) break;
    }
}
```

```cpp
#define MK_N_LAUNCHES 1
#define MK_REP_MASK 0u
#define MK_P0_REP 0
#define MK_CHECK_SEL 0
#define MK_IDX_REP 0
#define MK_EPI_REP 0
#define MK_XBAR 0
#define MK_SA_EXP 0
#include <hip/hip_runtime.h>
#include <cstdio>
#include <cstdint>
namespace pg8 {
#define PG8_LAS __attribute__((address_space(3)))
typedef unsigned short bf16_t;
typedef short bf16x8 __attribute__((ext_vector_type(8)));
typedef float f32x4 __attribute__((ext_vector_type(4)));
typedef unsigned u32x4 __attribute__((ext_vector_type(4)));
typedef short bf16x16 __attribute__((ext_vector_type(16)));
typedef int i32x8 __attribute__((ext_vector_type(8)));
constexpr int BM = 256, BK = 64, HALF = 128, HTB = HALF * BK * 2  , STAGE_BYTES = 8 * HTB, NXCD = 8, WGM = 8;

__host__ __device__ __forceinline__ int lds_byte(int r, int c) { const int st = (r >> 4) * 2 + (c >> 5), rr = r & 15, cc = c & 31, ob = rr * 64 + cc * 2; return st * 1024 + (ob ^ (((ob >> 9) & 1) << 5)); }
__host__ __device__ __forceinline__ void stage_rc(int b, int& R, int& C) { const int st = b / 1024, sb = b % 1024, swz = sb ^ (((sb >> 9) & 1) << 5); R = (st >> 1) * 16 + swz / 64; C = (st & 1) * 32 + (swz % 64) / 2; }
__host__ __device__ __forceinline__ int perm32(int rho) { const int n = rho >> 4, i = rho & 15; return 8 * (i >> 2) + 4 * n + (i & 3); }

struct Unit { int pm, pn; };
struct Gemm { const bf16_t* A; const bf16_t* Bt; int M, N, K; };

struct StaticOrder {
    int nM, nN, nwg, G, c;
    __host__ __device__ void init(int M, int N, int G_, int c_) { nM = M / BM; nN = N / BM; nwg = nM * nN; G = G_; c = c_; }
    __host__ __device__ bool next(int i, Unit& u) const {
        const long L = (long)i * G + c; if (L >= nwg) return false;
        int wgid = (int)L; { const int q = nwg / NXCD, r = nwg % NXCD, xcd = wgid % NXCD, off = wgid / NXCD; wgid = (xcd < r ? xcd * (q + 1) : r * (q + 1) + (xcd - r) * q) + off; }
        const int nig = WGM * nN, gid = wgid / nig, fm = gid * WGM, gsz = (nM - fm) < WGM ? (nM - fm) : WGM;
        u.pm = fm + ((wgid % nig) % gsz); u.pn = (wgid % nig) / gsz; return true;
    }
    __device__ __forceinline__ void a_ready(const Unit&) const {}
    __device__ __forceinline__ void done(const Unit&) const {}
};

__device__ __forceinline__ unsigned cvt_pk_bf16(float lo, float hi) { unsigned r; asm volatile("v_cvt_pk_bf16_f32 %0, %1, %2" : "=v"(r) : "v"(lo), "v"(hi)); return r; }
typedef float f32x2 __attribute__((ext_vector_type(2)));
__device__ __forceinline__ f32x2 gelu_pk(f32x2 v) {
    const f32x2 av = __builtin_elementwise_abs(v), d = av * 0.2316418882f + 1.0f;
    f32x2 t; t.x = __builtin_amdgcn_rcpf(d.x); t.y = __builtin_amdgcn_rcpf(d.y);
    f32x2 q = t * 0.5307027145f + (-0.7265760135f); q = q * t + 0.7107068705f; q = q * t + (-0.142248368f); q = q * t + 0.127414796f; q = q * t;
    const f32x2 s = (v * v) * (-0.72134752044f);
    f32x2 e; e.x = __builtin_amdgcn_exp2f(s.x); e.y = __builtin_amdgcn_exp2f(s.y);
    const f32x2 m = v * (q * e), r = v - m;
    f32x2 o; o.x = v.x < 0.f ? m.x : r.x; o.y = v.y < 0.f ? m.y : r.y; return o;
}

template <int ACT  > struct EpiBf16 {
    static constexpr bool PERM = true, AFTER_DRAIN = false; static_assert(ACT == 0 || ACT == 1, "EpiBf16: ACT is 0 (none) or 1 (gelu_pk)");
    bf16_t* O; int ldc; const float* bias; int split_cols; size_t split_stride; float scale0;
    __device__ __forceinline__ void operator()(const f32x4 (&acc)[2][2][4][2], const Unit& u, int wr, int wc, int fr, int fq) const {
        const int row0 = u.pm * BM + wr * 64 + fr; int colt = u.pn * BM; bf16_t* base = O;
        float sc = 1.f; if (split_cols) { const int t = colt / split_cols; base += (size_t)t * split_stride; colt -= t * split_cols; if (t == 0) sc = scale0; }
        const int col0 = colt + wc * 32 + 8 * fq, bcol0 = u.pn * BM + wc * 32 + 8 * fq;
        f32x4 bv[2][2];
#pragma unroll
        for (int bj = 0; bj < 2; ++bj)
#pragma unroll
            for (int n = 0; n < 2; ++n) bv[bj][n] = bias ? *(const f32x4*)(bias + bcol0 + bj * HALF + 4 * n) : (f32x4){0.f, 0.f, 0.f, 0.f};
#pragma unroll
        for (int ai = 0; ai < 2; ++ai)
#pragma unroll
            for (int m = 0; m < 4; ++m) { bf16_t* rowp = base + (size_t)(row0 + ai * HALF + m * 16) * ldc + col0;
#pragma unroll
                for (int bj = 0; bj < 2; ++bj) { f32x4 v0 = acc[ai][bj][m][0] + bv[bj][0], v1 = acc[ai][bj][m][1] + bv[bj][1];
                    if (ACT == 1) { f32x2 a = gelu_pk((f32x2){v0[0], v0[1]}), b = gelu_pk((f32x2){v0[2], v0[3]}), c = gelu_pk((f32x2){v1[0], v1[1]}), d = gelu_pk((f32x2){v1[2], v1[3]});
                        v0 = (f32x4){a.x, a.y, b.x, b.y}; v1 = (f32x4){c.x, c.y, d.x, d.y}; }
                    v0 = v0 * sc; v1 = v1 * sc; u32x4 w; w.x = cvt_pk_bf16(v0[0], v0[1]); w.y = cvt_pk_bf16(v0[2], v0[3]); w.z = cvt_pk_bf16(v1[0], v1[1]); w.w = cvt_pk_bf16(v1[2], v1[3]);
                    *(u32x4*)(rowp + bj * HALF) = w; } }
    }
};

struct PanelStats {
    unsigned* xbuf;
    unsigned* cnt;
    unsigned* tmo;
    int ntn; float eps;
    unsigned code;
    __device__ __forceinline__ bool run(const f32x4 (&v)[2][2][4][2], const Unit& u, int wr, int wc, int fr, int fq, PG8_LAS unsigned char* lds, int wid, int lane) const {
        typedef float f32x2v __attribute__((ext_vector_type(2)));
        PG8_LAS f32x2v* P = (PG8_LAS f32x2v*)lds;
        PG8_LAS f32x2v* S = (PG8_LAS f32x2v*)(lds + 8192);
        PG8_LAS unsigned* flag = (PG8_LAS unsigned*)(lds + 8192 + 2048);
#pragma unroll
        for (int ai = 0; ai < 2; ++ai)
#pragma unroll
            for (int m = 0; m < 4; ++m) {
                float s = 0.f;
#pragma unroll
                for (int bj = 0; bj < 2; ++bj)
#pragma unroll
                    for (int n = 0; n < 2; ++n) { const f32x4 x = v[ai][bj][m][n]; s += (x[0] + x[1]) + (x[2] + x[3]); }
                s += __shfl_xor(s, 16); s += __shfl_xor(s, 32);
                const float mw = s * (1.0f / 64.0f); float q = 0.f;
#pragma unroll
                for (int bj = 0; bj < 2; ++bj)
#pragma unroll
                    for (int n = 0; n < 2; ++n) { const f32x4 d = v[ai][bj][m][n] - mw; q += (d[0] * d[0] + d[1] * d[1]) + (d[2] * d[2] + d[3] * d[3]); }
                q += __shfl_xor(q, 16); q += __shfl_xor(q, 32);
                if (fq == 0) P[(ai * HALF + wr * 64 + m * 16 + fr) * 4 + wc] = (f32x2v){mw, q};
            }
        asm volatile("s_waitcnt lgkmcnt(0)" ::: "memory"); __builtin_amdgcn_s_barrier(); asm volatile("" ::: "memory");
#if defined(BROKEN_EXCHANGE_NO_WAIT)
#warning BROKEN CONTROL BUILD: the row-statistics exchange does not wait; results are wrong by design
        if (blockIdx.x >= 64) { const long long t0_ = clock64(); while (clock64() - t0_ < 60000) __builtin_amdgcn_s_sleep(8); }
#endif
        const int row = wid * 32 + (lane & 31);
        if (lane < 32) {
            const f32x2v a = P[row * 4 + 0], b = P[row * 4 + 1], c = P[row * 4 + 2], d = P[row * 4 + 3];
            const float mt = (a.x + b.x + c.x + d.x) * 0.25f;
            const float da = a.x - mt, db = b.x - mt, dc = c.x - mt, dd = d.x - mt;
            const float m2 = (a.y + b.y) + (c.y + d.y) + 64.0f * ((da * da + db * db) + (dc * dc + dd * dd));
            unsigned long long* slot = (unsigned long long*)xbuf + ((size_t)(u.pm * BM + row) * 4 + u.pn);
            __hip_atomic_store(slot, ((unsigned long long)__float_as_uint(m2) << 32) | __float_as_uint(mt), __ATOMIC_RELAXED, __HIP_MEMORY_SCOPE_AGENT);
        }
        asm volatile("s_waitcnt vmcnt(0)" ::: "memory");
        if (lane == 0) __hip_atomic_fetch_add(cnt + 64 * u.pm, 1u, __ATOMIC_RELAXED, __HIP_MEMORY_SCOPE_AGENT);
        if (wid == 0) {
            bool dead = false; const unsigned long long t0 = __builtin_amdgcn_s_memrealtime(); const unsigned want = 8u * (unsigned)ntn;
            for (;;) {
#if defined(BROKEN_EXCHANGE_NO_WAIT)
                break;
#endif
                if ((unsigned)__builtin_amdgcn_readfirstlane(__hip_atomic_load(cnt + 64 * u.pm, __ATOMIC_RELAXED, __HIP_MEMORY_SCOPE_AGENT)) >= want) break;
                if (__builtin_amdgcn_s_memrealtime() - t0 > 2000000ull) {
                    if (lane == 0) { unsigned expect = 0u; __hip_atomic_compare_exchange_strong(tmo + 1, &expect, code | (unsigned)(u.pm & 0xff), __ATOMIC_RELAXED, __ATOMIC_RELAXED, __HIP_MEMORY_SCOPE_AGENT);
                                     __hip_atomic_store(tmo, 1u, __ATOMIC_RELAXED, __HIP_MEMORY_SCOPE_AGENT); }
                    dead = true; break; }
                __builtin_amdgcn_s_sleep(2);
            }
            __builtin_amdgcn_fence(__ATOMIC_ACQUIRE, "agent");
            if (lane == 0) flag[0] = dead ? 1u : 0u;
        }
        asm volatile("s_waitcnt vmcnt(0) lgkmcnt(0)" ::: "memory"); __builtin_amdgcn_s_barrier(); asm volatile("" ::: "memory");
        const bool bad = flag[0] != 0u;
        if (lane < 32) {
            const unsigned long long* slot = (const unsigned long long*)xbuf + (size_t)(u.pm * BM + row) * 4; float mt[4], m2[4]; float ms = 0.f;
#pragma unroll
            for (int t = 0; t < 4; ++t) { if (t < ntn) { const unsigned long long w = __hip_atomic_load(slot + t, __ATOMIC_RELAXED, __HIP_MEMORY_SCOPE_AGENT); mt[t] = __uint_as_float((unsigned)w); m2[t] = __uint_as_float((unsigned)(w >> 32)); } else { mt[t] = 0.f; m2[t] = 0.f; } ms += mt[t]; }
            const float mean = ms / (float)ntn; float q = 0.f;
#pragma unroll
            for (int t = 0; t < 4; ++t) if (t < ntn) { const float dm = mt[t] - mean; q += m2[t] + 256.0f * dm * dm; }
            S[row] = (f32x2v){mean, 1.0f / sqrtf(q / (256.0f * (float)ntn) + eps)};
        }
        asm volatile("s_waitcnt lgkmcnt(0)" ::: "memory"); __builtin_amdgcn_s_barrier(); asm volatile("" ::: "memory");
        return bad;
    }
};
struct EpiLnRes {
    static constexpr bool PERM = false, AFTER_DRAIN = true;
    const float* base; float* out; int ldc; const float* bias; PanelStats st; unsigned poison;
    __device__ __forceinline__ void fused(f32x4 (&acc)[2][2][4][2], const Unit& u, int wr, int wc, int fr, int fq, PG8_LAS unsigned char* lds, int wid, int lane) const {
        typedef float f32x2v __attribute__((ext_vector_type(2)));
        const PG8_LAS f32x2v* S = (const PG8_LAS f32x2v*)(lds + 8192);
        const int col0 = u.pn * BM + wc * 32 + 4 * fq;
#pragma unroll
        for (int bj = 0; bj < 2; ++bj)
#pragma unroll
            for (int n = 0; n < 2; ++n) { const f32x4 bv = bias ? *(const f32x4*)(bias + col0 + bj * HALF + n * 16) : (f32x4){0.f, 0.f, 0.f, 0.f};
#pragma unroll
                for (int ai = 0; ai < 2; ++ai)
#pragma unroll
                    for (int m = 0; m < 4; ++m) acc[ai][bj][m][n] += bv; }
        f32x4 pre[4][2][2];
#pragma unroll
        for (int m = 0; m < 4; ++m) { const size_t off = (size_t)(u.pm * BM + wr * 64 + m * 16 + fr) * ldc + col0;
#pragma unroll
            for (int bj = 0; bj < 2; ++bj)
#pragma unroll
                for (int n = 0; n < 2; ++n) pre[m][bj][n] = *(const f32x4*)(base + off + bj * HALF + n * 16); }
        const bool bad = st.run(acc, u, wr, wc, fr, fq, lds, wid, lane) || poison != 0u;
        const float qnan = __builtin_nanf("");
#pragma unroll
        for (int ai = 0; ai < 2; ++ai)
#pragma unroll
            for (int m = 0; m < 4; ++m) { const int r = ai * HALF + wr * 64 + m * 16 + fr; const f32x2v sr = S[r]; const size_t off = (size_t)(u.pm * BM + r) * ldc + col0;
#pragma unroll
                for (int bj = 0; bj < 2; ++bj)
#pragma unroll
                    for (int n = 0; n < 2; ++n) { const f32x4 bs = ai == 0 ? pre[m][bj][n] : *(const f32x4*)(base + off + bj * HALF + n * 16); f32x4 o = bs + (acc[ai][bj][m][n] - sr.x) * sr.y;
                        if (bad) o = (f32x4){qnan, qnan, qnan, qnan}; *(f32x4*)(out + off + bj * HALF + n * 16) = o; }
                if (m & 1) asm volatile("" ::: "memory"); }
    }
};
struct EpiLnResLn {
    static constexpr bool PERM = false, AFTER_DRAIN = true;
    const float* base; float* out; bf16_t* xn; int ldc; const float* bias; PanelStats st1, st2; unsigned poison;
    __device__ __forceinline__ void fused(f32x4 (&acc)[2][2][4][2], const Unit& u, int wr, int wc, int fr, int fq, PG8_LAS unsigned char* lds, int wid, int lane) const {
        typedef float f32x2v __attribute__((ext_vector_type(2))); typedef unsigned u32x2v __attribute__((ext_vector_type(2)));
        const PG8_LAS f32x2v* S = (const PG8_LAS f32x2v*)(lds + 8192);
        const int col0 = u.pn * BM + wc * 32 + 4 * fq;
#pragma unroll
        for (int bj = 0; bj < 2; ++bj)
#pragma unroll
            for (int n = 0; n < 2; ++n) { const f32x4 bv = bias ? *(const f32x4*)(bias + col0 + bj * HALF + n * 16) : (f32x4){0.f, 0.f, 0.f, 0.f};
#pragma unroll
                for (int ai = 0; ai < 2; ++ai)
#pragma unroll
                    for (int m = 0; m < 4; ++m) acc[ai][bj][m][n] += bv; }
        bool bad = st1.run(acc, u, wr, wc, fr, fq, lds, wid, lane) || poison != 0u;
        const float qnan = __builtin_nanf("");
#pragma unroll
        for (int ai = 0; ai < 2; ++ai)
#pragma unroll
            for (int m = 0; m < 4; ++m) { const int r = ai * HALF + wr * 64 + m * 16 + fr; const f32x2v sr = S[r]; const size_t off = (size_t)(u.pm * BM + r) * ldc + col0;
#pragma unroll
                for (int bj = 0; bj < 2; ++bj)
#pragma unroll
                    for (int n = 0; n < 2; ++n) { const f32x4 bs = *(const f32x4*)(base + off + bj * HALF + n * 16); acc[ai][bj][m][n] = bs + (acc[ai][bj][m][n] - sr.x) * sr.y; }
                asm volatile("" : "+v"(acc[ai][0][m][0]), "+v"(acc[ai][0][m][1]), "+v"(acc[ai][1][m][0]), "+v"(acc[ai][1][m][1]));
                if (m & 1) asm volatile("" ::: "memory"); }
        const bool bad1 = bad;
        bad = st2.run(acc, u, wr, wc, fr, fq, lds, wid, lane) || bad;
#pragma unroll
        for (int ai = 0; ai < 2; ++ai)
#pragma unroll
            for (int m = 0; m < 4; ++m) { const int r = ai * HALF + wr * 64 + m * 16 + fr; const f32x2v sr = S[r]; const size_t off = (size_t)(u.pm * BM + r) * ldc + col0;
#pragma unroll
                for (int bj = 0; bj < 2; ++bj)
#pragma unroll
                    for (int n = 0; n < 2; ++n) { const f32x4 x1 = acc[ai][bj][m][n]; *(f32x4*)(out + off + bj * HALF + n * 16) = bad1 ? (f32x4){qnan, qnan, qnan, qnan} : x1;
                        const f32x4 o = (x1 - sr.x) * sr.y; u32x2v w; w.x = cvt_pk_bf16(o[0], o[1]); w.y = cvt_pk_bf16(o[2], o[3]);
                        if (bad) { w.x = 0x7fc07fc0u; w.y = 0x7fc07fc0u; } *(u32x2v*)(xn + off + bj * HALF + n * 16) = w; }
                asm volatile("" ::: "memory"); }
    }
};

template <class Epi, class Sched, bool ALIGN_EPI = false, bool SP2 = false, bool GATHER = false, bool F8 = false>
__device__ __forceinline__ void gemm_phase(PG8_LAS unsigned char* lds, const Gemm g, const Sched& S, const Epi& E, const PG8_LAS unsigned short* tokl = nullptr) {
    int tid_ = threadIdx.x; asm volatile("" : "+v"(tid_));
    const int tid = tid_, wid = __builtin_amdgcn_readfirstlane(tid >> 6), lane = tid & 63, wr = wid >> 2, wc = wid & 3, fr = lane & 15, fq = lane >> 4;
    const int K = g.K, nt = K / BK;
    unsigned voffA[2], voffB[2];
#pragma unroll
    for (int i = 0; i < 2; ++i) { int R, C; stage_rc(tid * 16 + i * 8192, R, C); const int Rb = Epi::PERM ? ((R & ~31) + perm32(R & 31)) : R;
        voffA[i] = GATHER ? (unsigned)C * 2u : (unsigned)(R * K + C) * 2u; voffB[i] = (unsigned)(Rb * K + C) * 2u; }
    const size_t rowbytes = (size_t)K * 2; unsigned tkc[2] = {0u, 0u}; (void)rowbytes;
#define PG8_LOADTK(dst, unit_i) do { int R0_, C0_, R1_, C1_; stage_rc(tid * 16, R0_, C0_); stage_rc(tid * 16 + 8192, R1_, C1_); (void)C0_; (void)C1_; \
        _Pragma("unroll") for (int h_ = 0; h_ < 2; ++h_) dst[h_] = (unsigned)tokl[(unit_i) * 256 + h_ * HALF + R0_] | ((unsigned)tokl[(unit_i) * 256 + h_ * HALF + R1_] << 16); } while (0)
#define PG8_STAGE_A(bufoff, gbase, half, TK) do { if constexpr (GATHER) { _Pragma("unroll") for (int _i = 0; _i < 2; ++_i) { const unsigned _tok = ((TK)[half] >> (16 * _i)) & 0xffffu; \
        __builtin_amdgcn_global_load_lds((const unsigned*)((const char*)(gbase) + (size_t)_tok * rowbytes + voffA[_i]), (PG8_LAS unsigned*)(lds + (bufoff) + ldsw + _i * 8192), 16, 0, 0); } } \
    else { PG8_STAGE(bufoff, (gbase) + (half) * hstep, voffA); } } while (0)
    const size_t kstep = (size_t)(BK * 2);
    const size_t hstep = (size_t)HALF * K * 2;
    const size_t tstep = 2 * hstep;
    const unsigned ldsw = (unsigned)wid * 1024u;
    const int aoff = lds_byte(wr * 64 + fr, fq * 8), boff = lds_byte(wc * 32 + fr, fq * 8);
    unsigned f8scl = 0x7f7f7f7fu; asm volatile("" : "+v"(f8scl)); (void)f8scl;
    constexpr int KFS = 1024;
#define PG8_SA(b, h) (((b) * 2 + (h)) * HTB)
#define PG8_SB(b, h) ((4 + (b) * 2 + (h)) * HTB)
#define PG8_STAGE(bufoff, gbase, voff) do { _Pragma("unroll") for (int _i = 0; _i < 2; ++_i) \
        __builtin_amdgcn_global_load_lds((const unsigned*)((const char*)(gbase) + (voff)[_i]), (PG8_LAS unsigned*)(lds + (bufoff) + ldsw + _i * 8192), 16, 0, 0); } while (0)
#define PG8_LDA(dst, b, h) do { _Pragma("unroll") for (int m = 0; m < 4; ++m) _Pragma("unroll") for (int k = 0; k < 2; ++k) dst[m][k] = *(const PG8_LAS bf16x8*)(lds + PG8_SA(b, h) + aoff + m * 2048 + k * KFS); } while (0)
#define PG8_LDB(dst, b, h) do { _Pragma("unroll") for (int n = 0; n < 2; ++n) _Pragma("unroll") for (int k = 0; k < 2; ++k) dst[n][k] = *(const PG8_LAS bf16x8*)(lds + PG8_SB(b, h) + boff + n * 2048 + k * KFS); } while (0)
#define PG8_F8FRAG(X) __builtin_bit_cast(i32x8, __builtin_shufflevector(X[0], X[1], 0, 1, 2, 3, 4, 5, 6, 7, 8, 9, 10, 11, 12, 13, 14, 15))
#define PG8_MMA(ai, bj, At, Bt) do { __builtin_amdgcn_s_setprio(1); if constexpr (F8) { const i32x8 b80_ = PG8_F8FRAG(Bt[0]), b81_ = PG8_F8FRAG(Bt[1]); _Pragma("unroll") for (int m = 0; m < 4; ++m) { const i32x8 a8_ = PG8_F8FRAG(At[m]); \
        asm volatile("v_mfma_scale_f32_16x16x128_f8f6f4 %0, %1, %2, %0, %3, %3 op_sel_hi:[0,0,0]" : "+v"(acc[ai][bj][m][0]) : "v"(b80_), "v"(a8_), "v"(f8scl)); \
        asm volatile("v_mfma_scale_f32_16x16x128_f8f6f4 %0, %1, %2, %0, %3, %3 op_sel_hi:[0,0,0]" : "+v"(acc[ai][bj][m][1]) : "v"(b81_), "v"(a8_), "v"(f8scl)); } } else { \
        _Pragma("unroll") for (int m = 0; m < 4; ++m) _Pragma("unroll") for (int n = 0; n < 2; ++n) _Pragma("unroll") for (int k = 0; k < 2; ++k) \
        acc[ai][bj][m][n] = __builtin_amdgcn_mfma_f32_16x16x32_bf16(Bt[n][k], At[m][k], acc[ai][bj][m][n], 0, 0, 0); } __builtin_amdgcn_s_setprio(0); } while (0)
#define PG8_WAIT_V(n) asm volatile("s_waitcnt vmcnt(" #n ")" ::: "memory")
#define PG8_WAIT_L(n) asm volatile("s_waitcnt lgkmcnt(" #n ")" ::: "memory")
#define PG8_BAR __builtin_amdgcn_s_barrier()
#define PG8_SCHED __builtin_amdgcn_sched_barrier(0)
    Unit cur, nxt; int ui = 0;
    if (!S.next(0, cur)) return;
    f32x4 acc[2][2][4][2];
#pragma unroll
    for (int a = 0; a < 2; ++a)
#pragma unroll
        for (int b = 0; b < 2; ++b)
#pragma unroll
            for (int m = 0; m < 4; ++m)
#pragma unroll
                for (int n = 0; n < 2; ++n) acc[a][b][m][n] = (f32x4){0.f, 0.f, 0.f, 0.f};
    bf16x8 At[4][2], B0[2][2], B1[2][2];
    const char* cA = (const char*)g.A + (GATHER ? (size_t)0 : (size_t)cur.pm * tstep); const char* cB = (const char*)g.Bt + (size_t)cur.pn * tstep;
    if constexpr (GATHER) { PG8_LOADTK(tkc, 0); }
    S.a_ready(cur);
    if constexpr (SP2) {
        PG8_STAGE(PG8_SB(0, 0), cB, voffB); PG8_STAGE(PG8_SB(0, 1), cB + hstep, voffB); PG8_STAGE_A(PG8_SA(0, 0), cA, 0, tkc); PG8_STAGE_A(PG8_SA(0, 1), cA, 1, tkc);
        if (wr == 1) PG8_BAR;
        PG8_WAIT_V(2); PG8_BAR;
        PG8_STAGE(PG8_SB(1, 0), cB + kstep, voffB); PG8_STAGE_A(PG8_SA(1, 0), cA + kstep, 0, tkc); PG8_STAGE(PG8_SB(1, 1), cB + hstep + kstep, voffB);
        PG8_WAIT_V(6); PG8_BAR;
    } else {
        PG8_STAGE(PG8_SB(0, 0), cB, voffB); PG8_STAGE_A(PG8_SA(0, 0), cA, 0, tkc); PG8_STAGE(PG8_SB(0, 1), cB + hstep, voffB); PG8_STAGE_A(PG8_SA(0, 1), cA, 1, tkc);
        if (wr == 1) PG8_BAR;
        PG8_WAIT_V(4); PG8_BAR;
        PG8_STAGE(PG8_SB(1, 0), cB + kstep, voffB); PG8_STAGE_A(PG8_SA(1, 0), cA + kstep, 0, tkc); PG8_STAGE(PG8_SB(1, 1), cB + hstep + kstep, voffB);
        PG8_WAIT_V(6); PG8_BAR;
    }
    for (;;) {
        const bool has_next = S.next(ui + 1, nxt);
        const char* nA = has_next ? (const char*)g.A + (GATHER ? (size_t)0 : (size_t)nxt.pm * tstep) : cA;
 const char* nB = has_next ? (const char*)g.Bt + (size_t)nxt.pn * tstep : cB;
        for (int t = 0; t < nt; t += 2) {
            const bool last = (t == nt - 2);
            const char* a1 = cA + (size_t)(t + 1) * kstep;
            const char* a2 = last ? nA : cA + (size_t)(t + 2) * kstep; const char* b2 = last ? nB : cB + (size_t)(t + 2) * kstep;
            const char* a3 = a2 + kstep; const char* b3 = b2 + kstep;
            unsigned tk2[2]; tk2[0] = tkc[0]; tk2[1] = tkc[1]; (void)tk2;
            if constexpr (GATHER) { if (last && has_next) { PG8_LOADTK(tk2, ui + 1); } }
            if (last && has_next) S.a_ready(nxt);
            if constexpr (SP2) {
            PG8_LDB(B0, 0, 0); PG8_LDB(B1, 0, 1); PG8_SCHED; PG8_LDA(At, 0, 0); PG8_STAGE_A(PG8_SA(1, 1), a1, 1, tkc);
            PG8_WAIT_V(8); PG8_WAIT_L(0); PG8_BAR; PG8_MMA(0, 0, At, B0); PG8_MMA(0, 1, At, B1); PG8_BAR; PG8_SCHED;
            PG8_LDA(At, 0, 1); PG8_STAGE(PG8_SB(0, 0), b2, voffB); PG8_STAGE(PG8_SB(0, 1), b2 + hstep, voffB); PG8_STAGE_A(PG8_SA(0, 0), a2, 0, tk2);
            PG8_WAIT_V(8); PG8_WAIT_L(0); PG8_BAR; PG8_MMA(1, 0, At, B0); PG8_MMA(1, 1, At, B1); PG8_BAR; PG8_SCHED;
            PG8_LDB(B0, 1, 0); PG8_LDB(B1, 1, 1); PG8_SCHED; PG8_LDA(At, 1, 0); PG8_STAGE_A(PG8_SA(0, 1), a2, 1, tk2);
            PG8_WAIT_V(8); PG8_WAIT_L(0); PG8_BAR; PG8_MMA(0, 0, At, B0); PG8_MMA(0, 1, At, B1); PG8_BAR; PG8_SCHED;
            PG8_LDA(At, 1, 1); PG8_STAGE(PG8_SB(1, 0), b3, voffB); PG8_STAGE(PG8_SB(1, 1), b3 + hstep, voffB); PG8_STAGE_A(PG8_SA(1, 0), a3, 0, tk2);
            PG8_WAIT_V(8); PG8_WAIT_L(0); PG8_BAR; PG8_MMA(1, 0, At, B0); PG8_MMA(1, 1, At, B1); PG8_BAR; PG8_SCHED;
            } else {
            PG8_LDB(B0, 0, 0); PG8_SCHED; PG8_LDA(At, 0, 0); PG8_STAGE_A(PG8_SA(1, 1), a1, 1, tkc);
            PG8_WAIT_L(8); PG8_BAR; PG8_WAIT_L(0); PG8_MMA(0, 0, At, B0); PG8_BAR; PG8_SCHED;
            PG8_LDB(B1, 0, 1); PG8_STAGE(PG8_SB(0, 0), b2, voffB);
            PG8_BAR; PG8_WAIT_L(0); PG8_MMA(0, 1, At, B1); PG8_BAR;
            PG8_LDA(At, 0, 1); PG8_STAGE_A(PG8_SA(0, 0), a2, 0, tk2);
            PG8_BAR; PG8_WAIT_L(0); PG8_MMA(1, 0, At, B0); PG8_BAR; PG8_SCHED;
            PG8_STAGE(PG8_SB(0, 1), b2 + hstep, voffB);
            PG8_WAIT_V(6); PG8_BAR; PG8_MMA(1, 1, At, B1); PG8_BAR;
            PG8_LDB(B0, 1, 0); PG8_SCHED; PG8_LDA(At, 1, 0); PG8_STAGE_A(PG8_SA(0, 1), a2, 1, tk2);
            PG8_WAIT_L(8); PG8_BAR; PG8_WAIT_L(0); PG8_MMA(0, 0, At, B0); PG8_BAR; PG8_SCHED;
            PG8_LDB(B1, 1, 1); PG8_STAGE(PG8_SB(1, 0), b3, voffB);
            PG8_BAR; PG8_WAIT_L(0); PG8_MMA(0, 1, At, B1); PG8_BAR;
            PG8_LDA(At, 1, 1); PG8_STAGE_A(PG8_SA(1, 0), a3, 0, tk2);
            PG8_BAR; PG8_WAIT_L(0); PG8_MMA(1, 0, At, B0); PG8_BAR; PG8_SCHED;
            PG8_STAGE(PG8_SB(1, 1), b3 + hstep, voffB);
            PG8_WAIT_V(6); PG8_BAR; PG8_MMA(1, 1, At, B1); PG8_BAR;
            }
        }
        if constexpr (ALIGN_EPI) { if (wr == 0) PG8_BAR; }
        if constexpr (F8) asm volatile("s_nop 15\n\ts_nop 15" ::: "memory");
        if constexpr (!Epi::AFTER_DRAIN) { E(acc, cur, wr, wc, fr, fq);
#if defined(MK_EPI_REP) && MK_EPI_REP
            E(acc, cur, wr, wc, fr, fq);
#endif
            S.done(cur); }
        if (!has_next) break;
#pragma unroll
        for (int a = 0; a < 2; ++a)
#pragma unroll
            for (int b = 0; b < 2; ++b)
#pragma unroll
                for (int m = 0; m < 4; ++m)
#pragma unroll
                    for (int n = 0; n < 2; ++n) acc[a][b][m][n] = (f32x4){0.f, 0.f, 0.f, 0.f};
        cur = nxt; cA = nA; cB = nB; ++ui; if constexpr (GATHER) { PG8_LOADTK(tkc, ui); }
        if constexpr (ALIGN_EPI) { if (wr == 1) PG8_BAR; }
    }
    PG8_WAIT_V(0);
    if constexpr (!ALIGN_EPI) { if (wr == 0) PG8_BAR; }
    PG8_BAR;
    if constexpr (Epi::AFTER_DRAIN) { E.fused(acc, cur, wr, wc, fr, fq, lds, wid, lane); S.done(cur); }
#undef PG8_SA
#undef PG8_SB
#undef PG8_STAGE
#undef PG8_STAGE_A
#undef PG8_LOADTK
#undef PG8_LDA
#undef PG8_LDB
#undef PG8_MMA
#undef PG8_F8FRAG
#undef PG8_WAIT_V
#undef PG8_WAIT_L
#undef PG8_BAR
#undef PG8_SCHED
}
}
namespace pg8 {
struct EpiF32 {
    static constexpr bool PERM = false, AFTER_DRAIN = false;
    float* O; int ldc;
    __device__ __forceinline__ void operator()(const f32x4 (&acc)[2][2][4][2], const Unit& u, int wr, int wc, int fr_, int fq_) const {
        int t_ = threadIdx.x; asm volatile("" : "+v"(t_)); const int fr = t_ & 15, fq = (t_ & 63) >> 4; (void)fr_; (void)fq_;
        const int row0 = u.pm * BM + wr * 64 + fr, col0 = u.pn * BM + wc * 32 + 4 * fq;
#pragma unroll
        for (int ai = 0; ai < 2; ++ai)
#pragma unroll
            for (int m = 0; m < 4; ++m) { float* rowp = O + (size_t)(row0 + ai * HALF + m * 16) * ldc + col0;
#pragma unroll
                for (int bj = 0; bj < 2; ++bj)
#pragma unroll
                    for (int n = 0; n < 2; ++n) *(f32x4*)(rowp + bj * HALF + n * 16) = acc[ai][bj][m][n]; }
    }
};
struct EpiResF32 {
    static constexpr bool PERM = false, AFTER_DRAIN = false;
    const float* base; float* out; int ldc; float alpha;
    __device__ __forceinline__ void operator()(const f32x4 (&acc)[2][2][4][2], const Unit& u, int wr, int wc, int fr_, int fq_) const {
        int t_ = threadIdx.x; asm volatile("" : "+v"(t_)); const int fr = t_ & 15, fq = (t_ & 63) >> 4; (void)fr_; (void)fq_;
        const int row0 = u.pm * BM + wr * 64 + fr, col0 = u.pn * BM + wc * 32 + 4 * fq;
#pragma unroll
        for (int ai = 0; ai < 2; ++ai)
#pragma unroll
            for (int m = 0; m < 4; ++m) { const size_t off = (size_t)(row0 + ai * HALF + m * 16) * ldc + col0;
                f32x4 bs[2][2];
#pragma unroll
                for (int bj = 0; bj < 2; ++bj)
#pragma unroll
                    for (int n = 0; n < 2; ++n) bs[bj][n] = *(const f32x4*)(base + off + bj * HALF + n * 16);
#pragma unroll
                for (int bj = 0; bj < 2; ++bj)
#pragma unroll
                    for (int n = 0; n < 2; ++n) *(f32x4*)(out + off + bj * HALF + n * 16) = bs[bj][n] * alpha + acc[ai][bj][m][n]; }
    }
};
struct EpiDsaNorm {
    static constexpr bool PERM = false, AFTER_DRAIN = false;
    bf16_t* cqn; bf16_t* ckv; bf16_t* kidx; float* widx; const float* gq; const float* gkv; const float* gki; const float* bki; unsigned* cmaxw; PG8_LAS float* scr; float rms_eps, ln_eps;
    __device__ __forceinline__ void operator()(const f32x4 (&acc)[2][2][4][2], const Unit& u, int wr, int wc, int fr_, int fq_) const {
        int t_ = threadIdx.x; asm volatile("" : "+v"(t_)); const int fr = t_ & 15, fq = (t_ & 63) >> 4; (void)fr_; (void)fq_;
#define EDN_RED4(v_) do { v_ += __shfl_xor(v_, 16); v_ += __shfl_xor(v_, 32); } while (0)
#define EDN_BAR() asm volatile("s_waitcnt lgkmcnt(0)\n\ts_barrier" ::: "memory")
#define EDN_PK(v_) ({ u32x2e w_; w_.x = cvt_pk_bf16((v_)[0], (v_)[1]); w_.y = cvt_pk_bf16((v_)[2], (v_)[3]); w_; })
        typedef unsigned u32x2e __attribute__((ext_vector_type(2)));
        if (u.pn == 0) {
#pragma unroll
            for (int ai = 0; ai < 2; ++ai)
#pragma unroll
                for (int m = 0; m < 4; ++m) { float s = 0.f;
#pragma unroll
                    for (int bj = 0; bj < 2; ++bj)
#pragma unroll
                        for (int n = 0; n < 2; ++n) { const f32x4 x = acc[ai][bj][m][n]; s += (x[0] * x[0] + x[1] * x[1]) + (x[2] * x[2] + x[3] * x[3]); }
                    EDN_RED4(s); if (fq == 0) scr[(ai * HALF + wr * 64 + m * 16 + fr) * 4 + wc] = s; }
            EDN_BAR();
#pragma unroll
            for (int ai = 0; ai < 2; ++ai)
#pragma unroll
                for (int m = 0; m < 4; ++m) { const int rl = ai * HALF + wr * 64 + m * 16 + fr; const f32x4 p4 = *(const PG8_LAS f32x4*)(scr + rl * 4);
                    const float rq = 1.0f / sqrtf(((p4[0] + p4[1]) + (p4[2] + p4[3])) * (1.0f / 256.0f) + rms_eps); bf16_t* rowp = cqn + (size_t)(u.pm * BM + rl) * 256;
#pragma unroll
                    for (int bj = 0; bj < 2; ++bj)
#pragma unroll
                        for (int n = 0; n < 2; ++n) { const int col = bj * HALF + wc * 32 + n * 16 + 4 * fq; const f32x4 v = acc[ai][bj][m][n] * rq * *(const f32x4*)(gq + col); *(u32x2e*)(rowp + col) = EDN_PK(v); } }
        } else {
            float cmx = 0.f;
#pragma unroll
            for (int ai = 0; ai < 2; ++ai)
#pragma unroll
                for (int m = 0; m < 4; ++m) { const int rl = ai * HALF + wr * 64 + m * 16 + fr; float s1 = 0.f, s4 = 0.f, s2 = 0.f, s3 = 0.f;
#pragma unroll
                    for (int n = 0; n < 2; ++n) { const f32x4 x = acc[ai][0][m][n]; const f32x4 xg = x * *(const f32x4*)(gkv + wc * 32 + n * 16 + 4 * fq);
                        s1 += (x[0] * x[0] + x[1] * x[1]) + (x[2] * x[2] + x[3] * x[3]); s4 += (xg[0] * xg[0] + xg[1] * xg[1]) + (xg[2] * xg[2] + xg[3] * xg[3]);
                        const f32x4 y = acc[ai][1][m][n]; s2 += (y[0] + y[1]) + (y[2] + y[3]); s3 += (y[0] * y[0] + y[1] * y[1]) + (y[2] * y[2] + y[3] * y[3]); }
                    EDN_RED4(s1); EDN_RED4(s4); EDN_RED4(s2); EDN_RED4(s3);
                    if (fq == 0) { scr[rl * 4 + wc] = s1; scr[1024 + rl * 4 + wc] = s4; if (wc < 2) { scr[2048 + rl * 2 + wc] = s2; scr[2560 + rl * 2 + wc] = s3; } } }
            EDN_BAR();
#pragma unroll
            for (int ai = 0; ai < 2; ++ai)
#pragma unroll
                for (int m = 0; m < 4; ++m) { const int rl = ai * HALF + wr * 64 + m * 16 + fr; const size_t grow = (size_t)(u.pm * BM + rl);
                    const f32x4 p1 = *(const PG8_LAS f32x4*)(scr + rl * 4), p4 = *(const PG8_LAS f32x4*)(scr + 1024 + rl * 4);
                    const float rkv = 1.0f / sqrtf(((p1[0] + p1[1]) + (p1[2] + p1[3])) * (1.0f / 128.0f) + rms_eps);
                    cmx = fmaxf(cmx, ((p4[0] + p4[1]) + (p4[2] + p4[3])) * rkv * rkv);
#pragma unroll
                    for (int n = 0; n < 2; ++n) { const int col = wc * 32 + n * 16 + 4 * fq; const f32x4 v = acc[ai][0][m][n] * rkv * *(const f32x4*)(gkv + col); { int w8 = __builtin_amdgcn_cvt_pk_fp8_f32(v[0], v[1], 0, false); w8 = __builtin_amdgcn_cvt_pk_fp8_f32(v[2], v[3], w8, true); *(unsigned*)((unsigned char*)ckv + grow * 128 + col) = (unsigned)w8; } }
                    if (wc < 2) { const float sm = scr[2048 + rl * 2] + scr[2048 + rl * 2 + 1], sq = scr[2560 + rl * 2] + scr[2560 + rl * 2 + 1];
                        const float mean = sm * (1.0f / 64.0f); const float var = fmaxf(sq * (1.0f / 64.0f) - mean * mean, 0.f); const float rstd = 1.0f / sqrtf(var + ln_eps);
#pragma unroll
                        for (int n = 0; n < 2; ++n) { const int col = wc * 32 + n * 16 + 4 * fq; const f32x4 v = (acc[ai][1][m][n] - mean) * rstd * *(const f32x4*)(gki + col) + *(const f32x4*)(bki + col); *(u32x2e*)(kidx + grow * 64 + col) = EDN_PK(v); } }
                    if (wc == 2 && fq < 2) *(f32x4*)(widx + grow * 8 + 4 * fq) = acc[ai][1][m][0] * 0.04419417382415922f; }
            if (wc == 0 && fq == 0) __hip_atomic_fetch_max(cmaxw, __builtin_bit_cast(unsigned, sqrtf(cmx)), __ATOMIC_RELAXED, __HIP_MEMORY_SCOPE_AGENT);
        }
        EDN_BAR();
#undef EDN_RED4
#undef EDN_BAR
#undef EDN_PK
    }
};
struct EpiCq {
    static constexpr bool PERM = true, AFTER_DRAIN = false;
    bf16_t* qlat; bf16_t* qidx; float qls;
    __device__ __forceinline__ void operator()(const f32x4 (&acc)[2][2][4][2], const Unit& u, int wr, int wc, int fr_, int fq_) const {
        int t_ = threadIdx.x; asm volatile("" : "+v"(t_)); const int fr = t_ & 15, fq = (t_ & 63) >> 4; (void)fr_; (void)fq_;
        const int row0 = u.pm * BM + wr * 64 + fr; int colt = u.pn * BM; const bool lat = colt < 2048;
        if (!lat) colt -= 2048;
        const int col0 = colt + wc * 32 + 8 * fq; const float sc = lat ? qls : 1.0f;
        unsigned char* base = lat ? (unsigned char*)qlat + (size_t)col0 : (unsigned char*)qidx + (size_t)col0 * 2; const size_t rstride = lat ? 2048 : 1024; const int hoff = lat ? HALF : 2 * HALF;
#pragma unroll
        for (int ai = 0; ai < 2; ++ai)
#pragma unroll
            for (int m = 0; m < 4; ++m) { unsigned char* rowp = base + (size_t)(row0 + ai * HALF + m * 16) * rstride;
#pragma unroll
                for (int bj = 0; bj < 2; ++bj) { const f32x4 v0 = acc[ai][bj][m][0] * sc, v1 = acc[ai][bj][m][1] * sc;
                    if (lat) { typedef unsigned u32x2e __attribute__((ext_vector_type(2)));
                        int a0 = __builtin_amdgcn_cvt_pk_fp8_f32(v0[0], v0[1], 0, false); a0 = __builtin_amdgcn_cvt_pk_fp8_f32(v0[2], v0[3], a0, true);
                        int a1 = __builtin_amdgcn_cvt_pk_fp8_f32(v1[0], v1[1], 0, false); a1 = __builtin_amdgcn_cvt_pk_fp8_f32(v1[2], v1[3], a1, true);
                        u32x2e w; w.x = (unsigned)a0; w.y = (unsigned)a1; *(u32x2e*)(rowp + bj * hoff) = w; }
                    else { u32x4 w; w.x = cvt_pk_bf16(v0[0], v0[1]); w.y = cvt_pk_bf16(v0[2], v0[3]); w.z = cvt_pk_bf16(v1[0], v1[1]); w.w = cvt_pk_bf16(v1[2], v1[3]); *(u32x4*)(rowp + bj * hoff) = w; } } }
    }
};
struct EpiSwiglu {
    static constexpr bool PERM = true, AFTER_DRAIN = false;
    bf16_t* H; const float* bgu;
    __device__ __forceinline__ void operator()(const f32x4 (&acc)[2][2][4][2], const Unit& u, int wr, int wc, int fr_, int fq_) const {
        int t_ = threadIdx.x; asm volatile("" : "+v"(t_)); const int fr = t_ & 15, fq = (t_ & 63) >> 4; (void)fr_; (void)fq_;
        const int e = u.pn >> 3, pnl = u.pn & 7;
        const int row0 = u.pm * BM + wr * 64 + fr, col0 = pnl * 128 + wc * 32 + 8 * fq;
        const float* bg = bgu + (size_t)e * 2048 + col0; const float* bu = bg + 1024;
        f32x4 bgv[2], buv[2];
#pragma unroll
        for (int n = 0; n < 2; ++n) { bgv[n] = *(const f32x4*)(bg + 4 * n); buv[n] = *(const f32x4*)(bu + 4 * n); }
#pragma unroll
        for (int ai = 0; ai < 2; ++ai)
#pragma unroll
            for (int m = 0; m < 4; ++m) { bf16_t* rowp = H + (size_t)(row0 + ai * HALF + m * 16) * 1024 + col0;
                float h[8];
#pragma unroll
                for (int n = 0; n < 2; ++n) { const f32x4 g4 = acc[ai][0][m][n] + bgv[n], u4 = acc[ai][1][m][n] + buv[n];
#pragma unroll
                    for (int i = 0; i < 4; ++i) { const float g = fminf(g4[i], 7.0f); const float up = fminf(fmaxf(u4[i], -7.0f), 7.0f);
                        const float sg = __builtin_amdgcn_rcpf(1.0f + __builtin_amdgcn_exp2f(g * (-1.702f * 1.4426950408889634f)));
                        h[4 * n + i] = (up + 1.0f) * (g * sg); } }
                u32x4 w; w.x = cvt_pk_bf16(h[0], h[1]); w.y = cvt_pk_bf16(h[2], h[3]); w.z = cvt_pk_bf16(h[4], h[5]); w.w = cvt_pk_bf16(h[6], h[7]);
                *(u32x4*)rowp = w; }
    }
};
__device__ __forceinline__ unsigned cvt4_fp8(float a, float b, float c, float d) { int w = 0; w = __builtin_amdgcn_cvt_pk_fp8_f32(a, b, w, false); w = __builtin_amdgcn_cvt_pk_fp8_f32(c, d, w, true); return (unsigned)w; }
struct EpiSwiglu8 {
    static constexpr bool PERM = true, AFTER_DRAIN = false;
    unsigned char* H; const float* bgu; float inv, hs;
    __device__ __forceinline__ void operator()(const f32x4 (&acc)[2][2][4][2], const Unit& u, int wr, int wc, int fr_, int fq_) const {
        int t_ = threadIdx.x; asm volatile("" : "+v"(t_)); const int fr = t_ & 15, fq = (t_ & 63) >> 4; (void)fr_; (void)fq_;
        const int e = u.pn >> 3, pnl = u.pn & 7;
        const int row0 = u.pm * BM + wr * 64 + fr, col0 = pnl * 128 + wc * 32 + 8 * fq;
        const float* bg = bgu + (size_t)e * 2048 + col0; const float* bu = bg + 1024;
        typedef float f32x2e __attribute__((ext_vector_type(2)));
        constexpr float KS = -1.702f * 1.4426950408889634f;
        f32x2e bgk[2][2], buq[2][2];
#pragma unroll
        for (int n = 0; n < 2; ++n) { const f32x4 g4 = *(const f32x4*)(bg + 4 * n) * KS; const f32x4 u4 = *(const f32x4*)(bu + 4 * n);
            bgk[n][0] = (f32x2e){g4[0], g4[1]}; bgk[n][1] = (f32x2e){g4[2], g4[3]}; buq[n][0] = (f32x2e){u4[0], u4[1]}; buq[n][1] = (f32x2e){u4[2], u4[3]}; }
        const float ik = inv * KS, hk = hs / KS; const f32x2e ik2 = {ik, ik}, inv2 = {inv, inv}, hk2 = {hk, hk}, one2 = {1.0f, 1.0f};
#pragma unroll
        for (int ai = 0; ai < 2; ++ai)
#pragma unroll
            for (int m = 0; m < 4; ++m) { unsigned char* rowp = H + (size_t)(row0 + ai * HALF + m * 16) * 1024 + col0;
                f32x2e h[4];
#pragma unroll
                for (int n = 0; n < 2; ++n)
#pragma unroll
                    for (int q = 0; q < 2; ++q) { const f32x4 ag = acc[ai][0][m][n], au = acc[ai][1][m][n];
                        f32x2e gk = __builtin_elementwise_fma((f32x2e){ag[2 * q], ag[2 * q + 1]}, ik2, bgk[n][q]);
                        f32x2e uq = __builtin_elementwise_fma((f32x2e){au[2 * q], au[2 * q + 1]}, inv2, buq[n][q]);
                        gk.x = fmaxf(gk.x, 7.0f * KS); gk.y = fmaxf(gk.y, 7.0f * KS);
                        uq.x = __builtin_amdgcn_fmed3f(uq.x, -7.0f, 7.0f); uq.y = __builtin_amdgcn_fmed3f(uq.y, -7.0f, 7.0f);
                        const f32x2e d2 = (f32x2e){__builtin_amdgcn_exp2f(gk.x), __builtin_amdgcn_exp2f(gk.y)} + one2;
                        const f32x2e r2 = {__builtin_amdgcn_rcpf(d2.x), __builtin_amdgcn_rcpf(d2.y)};
                        h[2 * n + q] = (gk * r2) * __builtin_elementwise_fma(uq, hk2, hk2); }
                typedef unsigned u32x2e __attribute__((ext_vector_type(2)));
                u32x2e w; w.x = cvt4_fp8(h[0].x, h[0].y, h[1].x, h[1].y); w.y = cvt4_fp8(h[2].x, h[2].y, h[3].x, h[3].y);
                *(u32x2e*)rowp = w; }
    }
};
struct EpiDown8 {
    static constexpr bool PERM = true, AFTER_DRAIN = false;
    unsigned char* O; const float* bias; float inv, ys;
    __device__ __forceinline__ void operator()(const f32x4 (&acc)[2][2][4][2], const Unit& u, int wr, int wc, int fr_, int fq_) const {
        int t_ = threadIdx.x; asm volatile("" : "+v"(t_)); const int fr = t_ & 15, fq = (t_ & 63) >> 4; (void)fr_; (void)fq_;
        const int e = u.pn >> 2, pnl = u.pn & 3;
        const int row0 = u.pm * BM + wr * 64 + fr, col0 = pnl * BM + wc * 32 + 8 * fq;
        f32x4 bv[2][2];
#pragma unroll
        for (int bj = 0; bj < 2; ++bj)
#pragma unroll
            for (int n = 0; n < 2; ++n) bv[bj][n] = *(const f32x4*)(bias + (size_t)e * 1024 + col0 + bj * HALF + 4 * n) * ys;
        const float sc = inv * ys;
#pragma unroll
        for (int ai = 0; ai < 2; ++ai)
#pragma unroll
            for (int mp = 0; mp < 2; ++mp)
#pragma unroll
                for (int bj = 0; bj < 2; ++bj) { typedef unsigned u32x2e __attribute__((ext_vector_type(2))); u32x2e w2[2];
#pragma unroll
                    for (int mi = 0; mi < 2; ++mi) { const int m = 2 * mp + mi; const f32x4 v0 = acc[ai][bj][m][0] * sc + bv[bj][0], v1 = acc[ai][bj][m][1] * sc + bv[bj][1];
                        w2[mi].x = cvt4_fp8(v0[0], v0[1], v0[2], v0[3]); w2[mi].y = cvt4_fp8(v1[0], v1[1], v1[2], v1[3]); }
                    const auto sx = __builtin_amdgcn_permlane16_swap(w2[0].x, w2[1].x, false, false); const auto sy = __builtin_amdgcn_permlane16_swap(w2[0].y, w2[1].y, false, false);
                    unsigned char* rowp = O + (size_t)(row0 + ai * HALF + (2 * mp + (fq & 1)) * 16) * 1024 + (col0 - 8 * (fq & 1)) + bj * HALF;
                    *(u32x4*)rowp = (u32x4){sx[0], sy[0], sx[1], sy[1]}; }
    }
};
struct EpiQkv8 {
    static constexpr bool PERM = true, AFTER_DRAIN = false;
    bf16_t* O; size_t split_stride; float inv, scale0;
    __device__ __forceinline__ void operator()(const f32x4 (&acc)[2][2][4][2], const Unit& u, int wr, int wc, int fr_, int fq_) const {
        int t_ = threadIdx.x; asm volatile("" : "+v"(t_)); const int fr = t_ & 15, fq = (t_ & 63) >> 4; (void)fr_; (void)fq_;
        const int row0 = u.pm * BM + wr * 64 + fr; const int t = (u.pn * BM) >> 10; const int colt = u.pn * BM - (t << 10);
        bf16_t* base = O + (size_t)t * split_stride; const float sc = inv * (t == 0 ? scale0 : 1.f);
        const int col0 = colt + wc * 32 + 8 * fq;
#pragma unroll
        for (int ai = 0; ai < 2; ++ai)
#pragma unroll
            for (int m = 0; m < 4; ++m) { bf16_t* rowp = base + (size_t)(row0 + ai * HALF + m * 16) * 1024 + col0;
#pragma unroll
                for (int bj = 0; bj < 2; ++bj) { const f32x4 v0 = acc[ai][bj][m][0] * sc, v1 = acc[ai][bj][m][1] * sc;
                    u32x4 w; w.x = cvt_pk_bf16(v0[0], v0[1]); w.y = cvt_pk_bf16(v0[2], v0[3]); w.z = cvt_pk_bf16(v1[0], v1[1]); w.w = cvt_pk_bf16(v1[2], v1[3]);
                    *(u32x4*)(rowp + bj * HALF) = w; } }
    }
};
struct EpiBf16s {
    static constexpr bool PERM = true, AFTER_DRAIN = false;
    bf16_t* O; int ldc; float inv;
    __device__ __forceinline__ void operator()(const f32x4 (&acc)[2][2][4][2], const Unit& u, int wr, int wc, int fr_, int fq_) const {
        int t_ = threadIdx.x; asm volatile("" : "+v"(t_)); const int fr = t_ & 15, fq = (t_ & 63) >> 4; (void)fr_; (void)fq_;
        const int row0 = u.pm * BM + wr * 64 + fr, col0 = u.pn * BM + wc * 32 + 8 * fq;
#pragma unroll
        for (int ai = 0; ai < 2; ++ai)
#pragma unroll
            for (int m = 0; m < 4; ++m) { bf16_t* rowp = O + (size_t)(row0 + ai * HALF + m * 16) * ldc + col0;
#pragma unroll
                for (int bj = 0; bj < 2; ++bj) { const f32x4 v0 = acc[ai][bj][m][0] * inv, v1 = acc[ai][bj][m][1] * inv;
                    u32x4 w; w.x = cvt_pk_bf16(v0[0], v0[1]); w.y = cvt_pk_bf16(v0[2], v0[3]); w.z = cvt_pk_bf16(v1[0], v1[1]); w.w = cvt_pk_bf16(v1[2], v1[3]);
                    *(u32x4*)(rowp + bj * HALF) = w; } }
    }
};
struct EpiF8s {
    static constexpr bool PERM = true, AFTER_DRAIN = false;
    unsigned char* O; float sc;
    __device__ __forceinline__ void operator()(const f32x4 (&acc)[2][2][4][2], const Unit& u, int wr, int wc, int fr_, int fq_) const {
        int t_ = threadIdx.x; asm volatile("" : "+v"(t_)); const int fr = t_ & 15, fq = (t_ & 63) >> 4; (void)fr_; (void)fq_;
        const int row0 = u.pm * BM + wr * 64 + fr, col0 = u.pn * BM + wc * 32 + 8 * fq;
#pragma unroll
        for (int ai = 0; ai < 2; ++ai)
#pragma unroll
            for (int mp = 0; mp < 2; ++mp)
#pragma unroll
                for (int bj = 0; bj < 2; ++bj) { typedef unsigned u32x2e __attribute__((ext_vector_type(2))); u32x2e w2[2];
#pragma unroll
                    for (int mi = 0; mi < 2; ++mi) { const int m = 2 * mp + mi; const f32x4 v0 = acc[ai][bj][m][0] * sc, v1 = acc[ai][bj][m][1] * sc;
                        w2[mi].x = cvt4_fp8(v0[0], v0[1], v0[2], v0[3]); w2[mi].y = cvt4_fp8(v1[0], v1[1], v1[2], v1[3]); }
                    const auto sx = __builtin_amdgcn_permlane16_swap(w2[0].x, w2[1].x, false, false); const auto sy = __builtin_amdgcn_permlane16_swap(w2[0].y, w2[1].y, false, false);
                    unsigned char* rowp = O + (size_t)(row0 + ai * HALF + (2 * mp + (fq & 1)) * 16) * 1024 + (col0 - 8 * (fq & 1)) + bj * HALF;
                    *(u32x4*)rowp = (u32x4){sx[0], sy[0], sx[1], sy[1]}; }
    }
};
struct EpiResF32s {
    static constexpr bool PERM = false, AFTER_DRAIN = false;
    const float* base; float* out; int ldc; float alpha, inv;
    __device__ __forceinline__ void operator()(const f32x4 (&acc)[2][2][4][2], const Unit& u, int wr, int wc, int fr_, int fq_) const {
        int t_ = threadIdx.x; asm volatile("" : "+v"(t_)); const int fr = t_ & 15, fq = (t_ & 63) >> 4; (void)fr_; (void)fq_;
        const int row0 = u.pm * BM + wr * 64 + fr, col0 = u.pn * BM + wc * 32 + 4 * fq;
#pragma unroll
        for (int ai = 0; ai < 2; ++ai)
#pragma unroll
            for (int m = 0; m < 4; ++m) { const size_t off = (size_t)(row0 + ai * HALF + m * 16) * ldc + col0;
                f32x4 bs[2][2];
#pragma unroll
                for (int bj = 0; bj < 2; ++bj)
#pragma unroll
                    for (int n = 0; n < 2; ++n) bs[bj][n] = *(const f32x4*)(base + off + bj * HALF + n * 16);
#pragma unroll
                for (int bj = 0; bj < 2; ++bj)
#pragma unroll
                    for (int n = 0; n < 2; ++n) *(f32x4*)(out + off + bj * HALF + n * 16) = bs[bj][n] * alpha + acc[ai][bj][m][n] * inv; }
    }
};
struct MoeOrder {
    int nT, nNl, G, c; const PG8_LAS int* tile_e;
    __device__ __forceinline__ bool next(int i, Unit& u) const {
        const int nwg = nT * nNl; const long L = (long)i * G + c; if (L >= nwg) return false;
        const int q = nwg / NXCD, r = nwg % NXCD, xcd = (int)(L % NXCD), off = (int)(L / NXCD);
        const int wgid = (xcd < r ? xcd * (q + 1) : r * (q + 1) + (xcd - r) * q) + off;
        const int pm = wgid / nNl, j = wgid % nNl;
        u.pm = pm; u.pn = tile_e[pm] * nNl + j; return true;
    }
    __device__ __forceinline__ void a_ready(const Unit&) const {}
    __device__ __forceinline__ void done(const Unit&) const {}
};
}
#ifndef PG8_SP2
#define PG8_SP2 true
#endif
#ifndef PG8_ALIGN
#define PG8_ALIGN true
#endif
#include <hip/hip_bf16.h>
#include <cmath>
namespace attn_body {
using bf16=__hip_bfloat16;
using bf16x8=__attribute__((ext_vector_type(8)))short;
using s16x4=__attribute__((ext_vector_type(4)))short;
using f32x16=__attribute__((ext_vector_type(16)))float;
using u32x4=__attribute__((ext_vector_type(4)))unsigned;
constexpr int BATCH=8,NHEAD=16,SEQ=4096,D=64,DM=NHEAD*D,XD=16;
constexpr int NW=8,QBLK=32,QB=QBLK*NW,KVBLK=64,NQB=SEQ/QB;
constexpr int ATTN_PITCH=DM, ATTN_UNIT_ROWS=QB;
__device__ __forceinline__ int crow(int r,int hi){return (r&3)+8*(r>>2)+4*hi;}
#define SBAR() __builtin_amdgcn_sched_barrier(0)
__device__ __forceinline__ void cmask(f32x16&p0,f32x16&p1,int jb,int qrel,int hi){
  const float NEG=-INFINITY; int kb=64*jb+4*hi;
  #pragma unroll
  for(int r=0;r<16;++r){int kv=kb+(r&3)+8*(r>>2); if(kv>qrel)p0[r]=NEG; if(kv+32>qrel)p1[r]=NEG;}
}

constexpr int NSLOT=3, SLOTB=10240;
constexpr int LDS_K=0, LDS_V=NSLOT*SLOTB, LDS_WS=2*NSLOT*SLOTB, LDS_OST=LDS_WS+NW*64*4, LDS_BYTES=LDS_OST+NW*4096;
constexpr float C2=0.125f*1.4426950408889634f;
__device__ __forceinline__ void glds16(const void*gsrc,unsigned lds_dst){unsigned keep;
  asm volatile("s_mov_b32 %0, m0\n\ts_mov_b32 m0, %2\n\ts_nop 0\n\tglobal_load_lds_dwordx4 %1, off\n\ts_mov_b32 m0, %0":"=&s"(keep):"v"(gsrc),"s"(lds_dst):"memory");}
__device__ __forceinline__ float max3f(float a,float b,float c){float r;asm("v_max3_f32 %0, %1, %2, %3":"=v"(r):"v"(a),"v"(b),"v"(c));return r;}
__device__ __forceinline__ float max2f(float a,float b){float r;asm("v_max_f32_e32 %0, %1, %2":"=v"(r):"v"(a),"v"(b));return r;}
__device__ __forceinline__ float fadd_s(float a,float b){float r;asm("v_add_f32_e32 %0, %1, %2":"=v"(r):"v"(a),"v"(b));return r;}
__device__ __forceinline__ float fsub_s(float a,float b){float r;asm("v_sub_f32_e32 %0, %1, %2":"=v"(r):"v"(a),"v"(b));return r;}
typedef float f32x2_t __attribute__((ext_vector_type(2))); typedef __bf16 bf16x2_t __attribute__((ext_vector_type(2)));
__device__ __forceinline__ unsigned cvtpk_s(float lo,float hi){f32x2_t v={lo,hi};bf16x2_t b=__builtin_convertvector(v,bf16x2_t);return __builtin_bit_cast(unsigned,b);}
#define WAIT_BAR(N) asm volatile("s_waitcnt vmcnt(" #N ") lgkmcnt(0)\n\ts_barrier":::"memory")

__device__ __forceinline__ void qkt(f32x16&p0,f32x16&p1,const char*Kslot,const bf16x8*qr,int r32,int hi){
  const f32x16 zz=f32x16{};
  const char*kb=Kslot+hi*1024+r32*16;
  #pragma unroll
  for(int d0=0;d0<5;++d0){
    const bf16x8 b0=*reinterpret_cast<const bf16x8*>(kb+d0*2048);
    const bf16x8 b1=*reinterpret_cast<const bf16x8*>(kb+d0*2048+512);
    if(d0==0){p0=__builtin_amdgcn_mfma_f32_32x32x16_bf16(b0,qr[0],zz,0,0,0);p1=__builtin_amdgcn_mfma_f32_32x32x16_bf16(b1,qr[0],zz,0,0,0);}
    else{p0=__builtin_amdgcn_mfma_f32_32x32x16_bf16(b0,qr[d0],p0,0,0,0);p1=__builtin_amdgcn_mfma_f32_32x32x16_bf16(b1,qr[d0],p1,0,0,0);}}
}
typedef __attribute__((address_space(3))) const char* lds_cptr;
typedef short v4i16_t __attribute__((ext_vector_type(4)));
__device__ __forceinline__ void kload8(bf16x8*kf,lds_cptr kp){
  kf[0]=*(const __attribute__((address_space(3))) bf16x8*)(kp);      kf[1]=*(const __attribute__((address_space(3))) bf16x8*)(kp+512);
  kf[2]=*(const __attribute__((address_space(3))) bf16x8*)(kp+2048); kf[3]=*(const __attribute__((address_space(3))) bf16x8*)(kp+2560);
  kf[4]=*(const __attribute__((address_space(3))) bf16x8*)(kp+4096); kf[5]=*(const __attribute__((address_space(3))) bf16x8*)(kp+4608);
  kf[6]=*(const __attribute__((address_space(3))) bf16x8*)(kp+6144); kf[7]=*(const __attribute__((address_space(3))) bf16x8*)(kp+6656);
  kf[8]=*(const __attribute__((address_space(3))) bf16x8*)(kp+8192); kf[9]=*(const __attribute__((address_space(3))) bf16x8*)(kp+8704);
}
__device__ __forceinline__ void kload2(bf16x8*kf,lds_cptr kp,int j){ kf[2*j]=*(const __attribute__((address_space(3))) bf16x8*)(kp+j*2048); kf[2*j+1]=*(const __attribute__((address_space(3))) bf16x8*)(kp+j*2048+512); }
__device__ __forceinline__ s16x4 vtr(lds_cptr p){ return __builtin_bit_cast(s16x4,__builtin_amdgcn_ds_read_tr16_b64_v4i16((__attribute__((address_space(3))) v4i16_t*)p)); }
__device__ __forceinline__ float rowmax(const f32x16&p0,const f32x16&p1){
  float a=max3f(p0[0],p0[1],p1[0]),b=max3f(p0[2],p0[3],p1[1]);a=max3f(a,p1[2],p1[3]);
  #pragma unroll
  for(int r=4;r<16;r+=4){a=max3f(a,p0[r],p0[r+1]);b=max3f(b,p0[r+2],p0[r+3]);a=max3f(a,p1[r],p1[r+1]);b=max3f(b,p1[r+2],p1[r+3]);}
  const float m=max2f(a,b);
  auto rr=__builtin_amdgcn_permlane32_swap(__float_as_uint(m),__float_as_uint(m),false,false);
  return max2f(__uint_as_float(rr[0]),__uint_as_float(rr[1]));
}
__device__ __forceinline__ void pv(f32x16*o,int vb,bf16x8 pa0,bf16x8 pa1,bf16x8 pa2,bf16x8 pa3){
  #pragma unroll
  for(int d0=0;d0<2;++d0){s16x4 lo[4],hi[4];
    #pragma unroll
    for(int ks=0;ks<4;++ks){
      asm volatile("ds_read_b64_tr_b16 %0,%1 offset:%c2":"=&v"(lo[ks]):"v"(vb),"i"(d0*4096+ks*1024):"memory");
      asm volatile("ds_read_b64_tr_b16 %0,%1 offset:%c2":"=&v"(hi[ks]):"v"(vb),"i"(d0*4096+ks*1024+512):"memory");}
    asm volatile("s_waitcnt lgkmcnt(0)":::"memory");SBAR();
    #define PK(k) (bf16x8){lo[k][0],lo[k][1],lo[k][2],lo[k][3],hi[k][0],hi[k][1],hi[k][2],hi[k][3]}
    o[d0]=__builtin_amdgcn_mfma_f32_32x32x16_bf16(pa0,PK(0),o[d0],0,0,0);
    o[d0]=__builtin_amdgcn_mfma_f32_32x32x16_bf16(pa1,PK(1),o[d0],0,0,0);
    o[d0]=__builtin_amdgcn_mfma_f32_32x32x16_bf16(pa2,PK(2),o[d0],0,0,0);
    o[d0]=__builtin_amdgcn_mfma_f32_32x32x16_bf16(pa3,PK(3),o[d0],0,0,0);
    #undef PK
  }
}

#ifndef ATTN_STORE16
#define ATTN_STORE16(p,v) (*(u32x4*)(p)=(v))
#endif
__device__ __forceinline__ void set_m(bf16x8&q4,float mneg,int hi){
  const unsigned p1=cvtpk_s(mneg,0.f)&0xffffu; const float f1=__uint_as_float(p1<<16); const float r1=mneg-f1;
  const unsigned p2=cvtpk_s(r1,0.f)&0xffffu;   const float f2=__uint_as_float(p2<<16); const float r2=r1-f2;
  const unsigned p3=cvtpk_s(r2,0.f)&0xffffu;
  u32x4 w=__builtin_bit_cast(u32x4,q4); w[3]=hi?w[3]:(p1|(p2<<16)); w[0]=hi?p3:w[0]; q4=__builtin_bit_cast(bf16x8,w);
}
template<int THRL,bool GUARD> __device__ __forceinline__ void attn_unit(int b,int h,int qb,const bf16*Q,const bf16*__restrict__ K,const bf16*__restrict__ V,bf16*O,const bf16*__restrict__ QX,const bf16*__restrict__ KX,const float*__restrict__ DG,char*shm,int ts,unsigned*qctr,unsigned*tkslot){
  int tid_o=threadIdx.x; asm volatile("":"+v"(tid_o)); const int tid=tid_o,lane=tid&63,r32=lane&31,hi=lane>>5; const int wid=__builtin_amdgcn_readfirstlane(tid>>6);
  const long rowbase=(long)b*SEQ; const int q0=qb*QB;
  const bf16*Qw=Q+(rowbase+q0+wid*QBLK)*DM+h*D;
  const bf16*Kh=K+(rowbase+(long)ts*KVBLK)*DM+h*D,*Vh=V+(rowbase+(long)ts*KVBLK)*DM+h*D;
  const unsigned lds0=(unsigned)(uintptr_t)shm;
  float*wsf=(float*)(shm+LDS_WS)+wid*64;
  const bf16*ksrc=Kh+(long)lane*DM+wid*8;
  const bf16*vsrc=Vh+(long)(16*(wid&3)+(lane>>2))*DM+(wid>>2)*32+(lane&3)*8;
  const bf16*kxsrc=KX+((rowbase+(long)ts*KVBLK+lane)*NHEAD+h)*XD+(wid&1)*8;
  const unsigned kdst=lds0+LDS_K+wid*1024, vdst=lds0+LDS_V+wid*1024, kxdst=lds0+LDS_K+8192+(wid&1)*1024;
  #define DMA_K(t,slot) do{ glds16(ksrc+(long)(t)*KVBLK*DM,(unsigned)__builtin_amdgcn_readfirstlane(kdst+(slot))); glds16(kxsrc+(long)(t)*KVBLK*NHEAD*XD,(unsigned)__builtin_amdgcn_readfirstlane(kxdst+(slot))); }while(0)
  #define DMA_V(t,slot) glds16(vsrc+(long)(t)*KVBLK*DM,(unsigned)__builtin_amdgcn_readfirstlane(vdst+(slot)))
  const int vb0=(int)(lds0+LDS_V)+((lane>>4)&1)*32+(lane&3)*8+(4*hi+((lane&15)>>2))*64;
  const char*Kbase=shm+LDS_K; bf16x8 kf[10];
  const lds_cptr shm3=(lds_cptr)shm; const lds_cptr kp0=shm3+LDS_K+hi*1024+r32*16; const lds_cptr vp0=shm3+LDS_V+((lane>>4)&1)*32+(lane&3)*8+(4*hi+((lane&15)>>2))*64;
  const int NT=(q0+QB)/KVBLK-ts;
  DMA_K(0,0);DMA_V(0,0);DMA_K(1,SLOTB);
  bf16x8 qr[5];
  #pragma unroll
  for(int d0=0;d0<4;++d0)qr[d0]=*reinterpret_cast<const bf16x8*>(&Qw[(long)r32*DM+d0*16+hi*8]);
  qr[4]=*reinterpret_cast<const bf16x8*>(&QX[((rowbase+q0+wid*QBLK+r32)*NHEAD+h)*XD+hi*8]);
  float mhat=DG[(rowbase+q0+wid*QBLK+r32)*NHEAD+h]; set_m(qr[4],-mhat,hi); asm volatile("":"+v"(qr[4]));
  float l_reg=0.f;f32x16 o[2];o[0]=f32x16{};o[1]=f32x16{};const f32x16 zero16=f32x16{};
  const int qrel=wid*QBLK+r32;
  #define CMASK(P0,P1,t) do{int jb_=(t)-(NT-4); if(jb_>=0)cmask(P0,P1,jb_,qrel,hi);}while(0)
  bool resc=false;
  #define START(P0,P1) do{ resc=false; \
    if constexpr(GUARD){ const float rm=rowmax(P0,P1); if(__any(rm>(float)THRL)){ const float dl=__builtin_fmaxf(rm,0.f); mhat+=dl; \
      _Pragma("unroll") for(int r=0;r<16;++r){P0[r]-=dl;P1[r]-=dl;} set_m(qr[4],-mhat,hi); asm volatile("":"+v"(qr[4])); } } \
    _Pragma("unroll") for(int r=0;r<16;++r)P0[r]=__builtin_amdgcn_exp2f(P0[r]); }while(0)
  #define RESC() do{ if(resc){ asm volatile("s_waitcnt lgkmcnt(0)":::"memory"); \
      _Pragma("unroll") for(int d_=0;d_<2;++d_) _Pragma("unroll") for(int r=0;r<16;++r)o[d_][r]*=wsf[crow(r,hi)]; } }while(0)
  f32x16 pA0,pA1,pB0,pB1;
  int sl_prev=0,sl_cur=0,sl_next=SLOTB;
  #define ROT() do{sl_prev=sl_cur;sl_cur=sl_next;sl_next=(sl_next==(NSLOT-1)*SLOTB)?0:sl_next+SLOTB;}while(0)
  DMA_K(2,2*SLOTB);
  WAIT_BAR(3);
  qkt(pA0,pA1,Kbase,qr,r32,hi);asm volatile("s_nop 15\n\ts_nop 7":"+v"(pA0),"+v"(pA1));CMASK(pA0,pA1,0);
  START(pA0,pA1);
  _Pragma("unroll") for(int r=0;r<16;++r)pA1[r]=__builtin_amdgcn_exp2f(pA1[r]);
  WAIT_BAR(0);
  DMA_K(3,0);DMA_V(1,SLOTB);
  ROT();
  kload8(kf,kp0+sl_cur);
  WAIT_BAR(3);
  s16x4 vlo[8],vhi[8]; u32x4 pw0,pw1,pw2,pw3;
  #define PKW(P,B) cvtpk_s(P[B],P[B+1])
  #define PAF(k) __builtin_bit_cast(bf16x8,pw##k)
  #define VFR(i) (bf16x8){vlo[i][0],vlo[i][1],vlo[i][2],vlo[i][3],vhi[i][0],vhi[i][1],vhi[i][2],vhi[i][3]}
  #define PIN(x) asm volatile("":"+v"(x))
  #define MX3(a,b,c) __builtin_fmaxf(__builtin_fmaxf((a),(b)),(c))
  #define GAPA(MF,A0,A1,A2,A3,W0,W1,PW) do{ MF; sacc+=A0; sacc+=A1; sacc+=A2; sacc+=A3; PIN(sacc); W0; W1; PIN(PW); SBAR(); }while(0)
  #define EX(v) __builtin_amdgcn_exp2f(v)
  #define GAPB(MF,X,B) do{ MF; X[B]=EX(X[B]); X[B+1]=EX(X[B+1]); X[B+2]=EX(X[B+2]); X[B+3]=EX(X[B+3]); PIN(X); SBAR(); }while(0)
  #define VRD(i) do{ vlo[i]=vtr(vp_+(((i)>>2)*4096+((i)&3)*1024)); vhi[i]=vtr(vp_+(((i)>>2)*4096+((i)&3)*1024+512)); }while(0)
  #define KRD(G,j) do{ if(G){ kload2(kf,kp0+sl_next,j); SBAR(); } }while(0)
  #define STEP(C0,C1,P0,P1,t,GK,GV,GL) do{ SBAR(); \
    const lds_cptr vp_=vp0+sl_prev; \
    VRD(0); SBAR(); float sacc=(P0[0]+P0[1]); \
    GAPA(C0=__builtin_amdgcn_mfma_f32_32x32x16_bf16(kf[0],qr[0],zero16,0,0,0), P0[2],P0[3],P0[4],P0[5],     pw0[0]=PKW(P0,0), pw0[1]=PKW(P0,2), pw0); \
    VRD(4); SBAR(); GAPA(C1=__builtin_amdgcn_mfma_f32_32x32x16_bf16(kf[1],qr[0],zero16,0,0,0), P0[6],P0[7],P0[8],P0[9],     pw0[2]=PKW(P0,4), pw0[3]=PKW(P0,6), pw0); \
    VRD(1); SBAR(); GAPA(C0=__builtin_amdgcn_mfma_f32_32x32x16_bf16(kf[2],qr[1],C0,0,0,0),   P0[10],P0[11],P0[12],P0[13], pw1[0]=PKW(P0,8), pw1[1]=PKW(P0,10), pw1); \
    VRD(5); SBAR(); GAPA(C1=__builtin_amdgcn_mfma_f32_32x32x16_bf16(kf[3],qr[1],C1,0,0,0),   P0[14],P0[15],P1[0],P1[1],   pw1[2]=PKW(P0,12),pw1[3]=PKW(P0,14), pw1); \
    VRD(2); SBAR(); GAPA(C0=__builtin_amdgcn_mfma_f32_32x32x16_bf16(kf[4],qr[2],C0,0,0,0),   P1[2],P1[3],P1[4],P1[5],     pw2[0]=PKW(P1,0), pw2[1]=PKW(P1,2), pw2); \
    VRD(6); SBAR(); GAPA(C1=__builtin_amdgcn_mfma_f32_32x32x16_bf16(kf[5],qr[2],C1,0,0,0),   P1[6],P1[7],P1[8],P1[9],     pw2[2]=PKW(P1,4), pw2[3]=PKW(P1,6), pw2); \
    VRD(3); SBAR(); GAPA(C0=__builtin_amdgcn_mfma_f32_32x32x16_bf16(kf[6],qr[3],C0,0,0,0),   P1[10],P1[11],P1[12],P1[13], pw3[0]=PKW(P1,8), pw3[1]=PKW(P1,10), pw3); \
    VRD(7); SBAR(); GAPA(C1=__builtin_amdgcn_mfma_f32_32x32x16_bf16(kf[7],qr[3],C1,0,0,0),   P1[14],P1[15],0.f,0.f,       pw3[2]=PKW(P1,12),pw3[3]=PKW(P1,14), pw3); \
    C0=__builtin_amdgcn_mfma_f32_32x32x16_bf16(kf[8],qr[4],C0,0,0,0); C1=__builtin_amdgcn_mfma_f32_32x32x16_bf16(kf[9],qr[4],C1,0,0,0); SBAR(); \
    l_reg+=sacc; \
    if(GK){DMA_K((t)+3,sl_cur);} if(GV){DMA_V((t)+1,sl_next);} \
    CMASK(C0,C1,t); \
    if constexpr(!GUARD){ resc=false; } else { float a=MX3(C0[0],C0[1],C1[0]),b=MX3(C0[2],C0[3],C1[1]); a=MX3(a,C1[2],C1[3]); \
      _Pragma("unroll") for(int r=4;r<16;r+=4){a=MX3(a,C0[r],C0[r+1]);b=MX3(b,C0[r+2],C0[r+3]);a=MX3(a,C1[r],C1[r+1]);b=MX3(b,C1[r+2],C1[r+3]);} \
      float rm=__builtin_fmaxf(a,b); { auto rr=__builtin_amdgcn_permlane32_swap(__float_as_uint(rm),__float_as_uint(rm),false,false); rm=__builtin_fmaxf(__uint_as_float(rr[0]),__uint_as_float(rr[1])); } \
      resc=false; \
      if(__builtin_expect(__any(rm>(float)THRL),0)){ const float dl=__builtin_fmaxf(rm,0.f); mhat+=dl; \
        _Pragma("unroll") for(int r=0;r<16;++r){C0[r]-=dl;C1[r]-=dl;} \
        set_m(qr[4],-mhat,hi); asm volatile("":"+v"(qr[4])); \
        const float f=__builtin_amdgcn_exp2f(-dl); l_reg*=f; if(hi==0)wsf[r32]=f; resc=true; } } \
    SBAR(); \
    GAPB(o[0]=__builtin_amdgcn_mfma_f32_32x32x16_bf16(PAF(0),VFR(0),o[0],0,0,0), C0,0); \
    GAPB(o[1]=__builtin_amdgcn_mfma_f32_32x32x16_bf16(PAF(0),VFR(4),o[1],0,0,0), C0,4); \
    KRD(GL,0); GAPB(o[0]=__builtin_amdgcn_mfma_f32_32x32x16_bf16(PAF(1),VFR(1),o[0],0,0,0), C0,8); \
    KRD(GL,1); GAPB(o[1]=__builtin_amdgcn_mfma_f32_32x32x16_bf16(PAF(1),VFR(5),o[1],0,0,0), C0,12); \
    KRD(GL,2); GAPB(o[0]=__builtin_amdgcn_mfma_f32_32x32x16_bf16(PAF(2),VFR(2),o[0],0,0,0), C1,0); \
    KRD(GL,3); GAPB(o[1]=__builtin_amdgcn_mfma_f32_32x32x16_bf16(PAF(2),VFR(6),o[1],0,0,0), C1,4); \
    KRD(GL,4); GAPB(o[0]=__builtin_amdgcn_mfma_f32_32x32x16_bf16(PAF(3),VFR(3),o[0],0,0,0), C1,8); \
    GAPB(o[1]=__builtin_amdgcn_mfma_f32_32x32x16_bf16(PAF(3),VFR(7),o[1],0,0,0), C1,12); \
    }while(0)
  int t=1;
  #undef CMASK
  #define CMASK(P0,P1,t) do{}while(0)
  for(;t+5<NT;t+=2){
    STEP(pB0,pB1,pA0,pA1,t,true,true,true);     WAIT_BAR(3); RESC(); ROT();
    STEP(pA0,pA1,pB0,pB1,t+1,true,true,true);   WAIT_BAR(3); RESC(); ROT();
  }
  #undef CMASK
  #define CMASK(P0,P1,t) do{int jb_=(t)-(NT-4); if(jb_>=0)cmask(P0,P1,jb_,qrel,hi);}while(0)
  #define ENDW(tt) do{ if((tt)+3<NT){WAIT_BAR(3);} else if((tt)+2<NT){WAIT_BAR(1);} else {WAIT_BAR(0);} }while(0)
  for(;t+1<NT;t+=2){
    STEP(pB0,pB1,pA0,pA1,t,(t+3<NT),(t+1<NT),(t+1<NT));       ENDW(t);   RESC(); ROT();
    STEP(pA0,pA1,pB0,pB1,t+1,(t+4<NT),(t+2<NT),(t+2<NT));     ENDW(t+1); RESC(); ROT();
  }
  STEP(pB0,pB1,pA0,pA1,NT-1,false,false,false); RESC();
  { float sacc=pB0[0]+pB0[1]; _Pragma("unroll") for(int r=2;r<16;++r)sacc+=pB0[r]; _Pragma("unroll") for(int r=0;r<16;++r)sacc+=pB1[r]; l_reg+=sacc;
    pw0=(u32x4){PKW(pB0,0),PKW(pB0,2),PKW(pB0,4),PKW(pB0,6)};pw1=(u32x4){PKW(pB0,8),PKW(pB0,10),PKW(pB0,12),PKW(pB0,14)};pw2=(u32x4){PKW(pB1,0),PKW(pB1,2),PKW(pB1,4),PKW(pB1,6)};pw3=(u32x4){PKW(pB1,8),PKW(pB1,10),PKW(pB1,12),PKW(pB1,14)};
    SBAR(); pv(o,vb0+sl_cur,PAF(0),PAF(1),PAF(2),PAF(3)); }
  #undef PKW
  #undef PAF
  #undef VFR
  #undef PIN
  #undef MX3
  #undef GAPA
  #undef GAPB
  #undef EX
  #undef VRD
  #undef KRD
  #undef STEP
  #undef ENDW
  unsigned nxt_tk=0u; if(tid==0)nxt_tk=__hip_atomic_fetch_add(qctr,1u,__ATOMIC_RELAXED,__HIP_MEMORY_SCOPE_AGENT);
  {auto rr=__builtin_amdgcn_permlane32_swap(__float_as_uint(l_reg),__float_as_uint(l_reg),false,false);l_reg=__uint_as_float(rr[0])+__uint_as_float(rr[1]);}
  if(hi==0)wsf[32+r32]=l_reg;asm volatile("s_waitcnt lgkmcnt(0)":::"memory");
  float rli[16];
  #pragma unroll
  for(int r=0;r<16;++r)rli[r]=__builtin_amdgcn_rcpf(wsf[32+crow(r,hi)]);
  { unsigned char*stg=(unsigned char*)(shm+LDS_OST)+wid*2048;
    #pragma unroll
    for(int r=0;r<16;++r){const int orow=crow(r,hi); const float sc=rli[r]*32.0f;
      const unsigned pkd=(unsigned)__builtin_amdgcn_cvt_pk_fp8_f32(o[0][r]*sc,o[1][r]*sc,0,false);
      stg[orow*64+r32]=(unsigned char)(pkd&0xffu); stg[orow*64+32+r32]=(unsigned char)((pkd>>8)&0xffu);}
    asm volatile("s_waitcnt lgkmcnt(0)":::"memory");
    unsigned char*Ow8=(unsigned char*)O+(rowbase+q0+wid*QBLK)*DM+h*D;
    #pragma unroll
    for(int i=0;i<2;++i){const int row=i*16+(lane>>2),ch=lane&3; const u32x4 v=*(const u32x4*)(stg+row*64+ch*16); ATTN_STORE16(Ow8+(long)row*DM+ch*16,v);} }
  if(tid==0)*tkslot=nxt_tk;
  asm volatile("s_waitcnt lgkmcnt(0)\n\ts_barrier":::"memory");
  #undef DMA_K
  #undef DMA_V
  #undef CMASK
  #undef START
  #undef RESC
  #undef ROT
}
constexpr int ATTN_LDS_BYTES=LDS_BYTES;
struct AttnTensors { const bf16* Q; const bf16* K; const bf16* V; bf16* O; const bf16* QX; const bf16* KX; const float* DG; };
struct AttnUnit { int bh; int qb; };
struct StaticOrder {
  int vcu, G;
  __device__ __forceinline__ explicit StaticOrder(int grid,int block):vcu((grid%8==0)?(block%8)*(grid/8)+block/8:block),G(grid){}
  __device__ __forceinline__ bool next(int i,AttnUnit&u)const{
    if(G==256){ if(i>=8)return false; const int s=vcu&1,p=i>>1,j=i&1; u.bh=vcu>>1; u.qb=4*p+(j?3-s:s); return true; }
    const int L=i*G+vcu; if(L>=BATCH*NHEAD*NQB)return false; u.bh=L%(BATCH*NHEAD); u.qb=NQB-1-L/(BATCH*NHEAD); return true; }
  __device__ __forceinline__ void a_ready(const AttnUnit&)const{}
  __device__ __forceinline__ void done(const AttnUnit&)const{}
};
template<int THRL=8> __device__ __forceinline__ void attn_phase(char*lds,const AttnTensors&T,unsigned*qctr,const unsigned char*ts_glob){
  unsigned*tkslot=(unsigned*)(lds+LDS_BYTES); unsigned char*tstab=(unsigned char*)(lds+LDS_BYTES+64);
  { const int tid=threadIdx.x; ((unsigned*)tstab)[tid]=((const unsigned*)ts_glob)[tid];
    if(tid==0)*tkslot=__hip_atomic_fetch_add(qctr,1u,__ATOMIC_RELAXED,__HIP_MEMORY_SCOPE_AGENT); }
  __syncthreads();
  for(;;){ const unsigned u=(unsigned)__builtin_amdgcn_readfirstlane((int)*(volatile __attribute__((address_space(3))) unsigned*)tkslot); if(u>=(unsigned)(BATCH*NHEAD*NQB))break;
    const int qb=NQB-1-(int)(u>>7), bh=(int)(u&127); const int tsv=__builtin_amdgcn_readfirstlane((int)tstab[bh*NQB+qb]); const int ts=tsv&~1;
    if(tsv&1) attn_unit<THRL,true>(bh/NHEAD,bh%NHEAD,qb,T.Q,T.K,T.V,T.O,T.QX,T.KX,T.DG,lds,ts,qctr,tkslot);
    else      attn_unit<THRL,false>(bh/NHEAD,bh%NHEAD,qb,T.Q,T.K,T.V,T.O,T.QX,T.KX,T.DG,lds,ts,qctr,tkslot); }
  __syncthreads();
}
#undef SBAR
#undef WAIT_BAR
}

constexpr int NWAVES = 8;
#ifndef MK_N_LAUNCHES
#define MK_N_LAUNCHES 1
#endif
constexpr int BATCH = 8, T = 4096, D = 1024, M = BATCH * T;
constexpr int A_H = 16, A_RQ = 256, A_RKV = 128, IDX_H = 8, IDX_D = 64, A_INW = 456, TOPK = 256;
constexpr int B_INW = 3088;
constexpr int NEXP = 32, MOE_K = 4, DEXP = 1024;
constexpr int NPAIR = M * MOE_K;
constexpr int MAXSLOT = NPAIR + NEXP * 256;
constexpr float LN_EPS = 1e-5f, RMS_EPS = 1e-6f;
constexpr float DN_ALPHA = 1.41421356237309515f;
constexpr float LOG2E = 1.4426950408889634f;
constexpr int N_PHASES = 19;

constexpr size_t MiB = 1u << 20;
constexpr size_t WS_CTL = 0, CTL_ZERO_BYTES = 128 * 1024;
constexpr size_t WS_SMALL = 1 * MiB;
constexpr size_t WS_WAIN = 2 * MiB, WS_WACQ = 3 * MiB, WS_WAO = 5 * MiB, WS_WBIN = 9 * MiB, WS_WBO = 15 * MiB;
constexpr size_t WS_PAR = 18 * MiB;
constexpr int PAR_REL = 0, PAR_AGQ = 512, PAR_AGKV = 768, PAR_AGKI = 896, PAR_ABKI = 960, PAR_BF = 1024, PAR_BROUT = 1088, PAR_LN = 2048  ,
              PAR_WROUT = 16384  , PAR_WF = 81920  , PAR_BGU = 98304  , PAR_BDOWN = 229376  , PAR_END = 294912;
static_assert((size_t)PAR_END * 4 <= 2 * MiB, "parameter copies");
constexpr size_t WS_TOKE = 20 * MiB;
constexpr size_t WS_WGU = 32 * MiB, WS_WD = 288 * MiB;
constexpr size_t WS_XF = 416 * MiB, WS_XB = 544 * MiB;
constexpr size_t WS_PROJ = 608 * MiB, WS_CQN = 672 * MiB, WS_CKV = 688 * MiB, WS_KIDX = 696 * MiB, WS_WIDX = 700 * MiB, WS_BKT = 701 * MiB  , WS_SEL = 712 * MiB  ,
                 WS_QIDX = 736 * MiB, WS_QLAT = 768 * MiB, WS_OLAT = 896 * MiB;
constexpr size_t WS_Q = 608 * MiB, WS_K = 672 * MiB, WS_V = 736 * MiB, WS_LOGF = 800 * MiB, WS_QX = 802 * MiB, WS_KX = 818 * MiB, WS_O = 834 * MiB, WS_CUM2 = 898 * MiB  , WS_KMAX = 900 * MiB  , WS_TS = 901 * MiB  , WS_DG = 902 * MiB  ;
constexpr size_t WS_TOPE = 1024 * MiB, WS_TOPG = 1025 * MiB, WS_POS = 1026 * MiB, WS_SLOT = 1027 * MiB, WS_TOK = 1027 * MiB + 512 * 1024  ;
constexpr size_t WS_XG = 1028 * MiB, WS_H = 1300 * MiB, WS_Y = 1572 * MiB  , WS_XB8 = 1700 * MiB  , WS_END = 1732 * MiB;
constexpr float F8_XS = 8.f, F8_WGS = 512.f, F8_HS = 4.f, F8_WDS = 1024.f, F8_WBINS = 512.f, F8_OLS = 32.f, F8_WAOS = 1024.f, F8_YS = 32.f, F8_OS = 32.f, F8_WBOS = 1024.f, F8_HYS = 64.f, F8_QLS = 16.f  ;
static_assert((size_t)MAXSLOT * 1024 * 2 <= 272 * MiB, "slot buffers");
constexpr int CW_TMO = 0, CW_CODE = 1;
constexpr int CW_BAR = 4096;
constexpr int CW_CMAX = 20416;
constexpr int CW_QMAX = 20480, CW_MNEG = 22528, CW_ATTQ = 24576;
constexpr int CW_CNT = 16384;
static_assert((CW_ATTQ + 64) * 4 <= (int)CTL_ZERO_BYTES && (CW_BAR + 3456) <= CW_CNT, "control words inside the zeroed block");
constexpr int SM_NT = 0, SM_TILE_E = 64;
constexpr int RING_OFF = 0, RING_BYTES = 131072;
constexpr int LDS_BYTES = 147456;
constexpr int MISC_OFF = LDS_BYTES - 256;
#define GAS __attribute__((address_space(1)))
#define LAS __attribute__((address_space(3)))
typedef unsigned short bf16;
typedef unsigned v4u __attribute__((ext_vector_type(4)));
typedef float f32x4 __attribute__((ext_vector_type(4)));
typedef short bf16x8 __attribute__((ext_vector_type(8)));
typedef GAS unsigned gu32;
typedef GAS unsigned long long gu64;
#define RLX_AGENT __ATOMIC_RELAXED, __HIP_MEMORY_SCOPE_AGENT
#define LDS_WAIT() asm volatile("s_waitcnt lgkmcnt(0)" ::: "memory")
#define VM_WAIT() asm volatile("s_waitcnt vmcnt(0)" ::: "memory")
__device__ __forceinline__ unsigned long long rt() { return __builtin_amdgcn_s_memrealtime(); }
__device__ __forceinline__ unsigned f2bf(float f) { unsigned u = __builtin_bit_cast(unsigned, f); return (u + 0x7fffu + ((u >> 16) & 1u)) >> 16; }
__device__ __forceinline__ unsigned pk2(float lo, float hi) { return f2bf(lo) | (f2bf(hi) << 16); }

#define XB_TMO      128
#define XB_XCNT(j)  (256  + 64 * (j))
#define XB_XSUB(j)  (1280 + 64 * (j))
#define XB_XGEN(j)  (2304 + 64 * (j))
#define XB_TOP      3328
#define XB_TOPGEN   3392
#define XCD_BAR_WORDS 3456
#define XB_SPIN_CAP (1u << 18)

__device__ __forceinline__ unsigned xb_ld(unsigned* p)              { return __hip_atomic_load(p, __ATOMIC_RELAXED, __HIP_MEMORY_SCOPE_AGENT); }
__device__ __forceinline__ unsigned xb_add(unsigned* p, unsigned v) { return __hip_atomic_fetch_add(p, v, __ATOMIC_RELAXED, __HIP_MEMORY_SCOPE_AGENT); }
__device__ __forceinline__ unsigned xb_xcc_id() { return (unsigned)__builtin_amdgcn_s_getreg((3 << 11) | 20) & 0xFu; }
#define XB_SPIN(cond, bar) do { unsigned _sp = 0; while (cond) { __builtin_amdgcn_s_sleep(1); \
    if ((++_sp & 255u) == 0u) { if (xb_ld(&(bar)[XB_TMO])) break; if (_sp > XB_SPIN_CAP) { atomicAdd(&(bar)[XB_TMO], 1u); break; } } } } while (0)

struct XcdBarrier {
    unsigned* bar; unsigned x;
    volatile LAS unsigned* st;
};

__device__ __forceinline__ XcdBarrier xcd_barrier_post(unsigned* bar, volatile LAS unsigned* st) {
    XcdBarrier b; b.bar = bar; b.x = xb_xcc_id(); b.st = st;
    if (threadIdx.x == 0) (void)xb_add(&bar[XB_XCNT(b.x)], 1u);
    return b;
}
__device__ __forceinline__ void xcd_barrier_complete(unsigned* bar, unsigned x, unsigned& nloc, unsigned& nx) {
    const unsigned G = gridDim.x * gridDim.y * gridDim.z;
    unsigned sum, cnt, mine, sp = 0u;
    for (;;) {
        sum = 0u; cnt = 0u; mine = 0u;
#pragma unroll
        for (unsigned j = 0; j < 16; ++j) { const unsigned c = xb_ld(&bar[XB_XCNT(j)]); sum += c; cnt += (c > 0u) ? 1u : 0u; mine = (j == x) ? c : mine; }
        if (sum == G) break;
        __builtin_amdgcn_s_sleep(1);
        if ((++sp & 255u) == 0u) { if (xb_ld(&bar[XB_TMO])) break; if (sp > XB_SPIN_CAP) { atomicAdd(&bar[XB_TMO], 1u); break; } }
    }
    nloc = mine > 0u ? mine : 1u; nx = cnt > 0u ? cnt : 1u;
}

__device__ __forceinline__ void xcd_barrier(const XcdBarrier& b) {
    asm volatile("s_waitcnt vmcnt(0)" ::: "memory");
    __syncthreads();
    if (threadIdx.x == 0) {
        unsigned* bar = b.bar;
        __builtin_amdgcn_s_waitcnt(0);
        unsigned nloc = b.st[0], nx = b.st[1];
        if (nloc == 0u) { xcd_barrier_complete(bar, b.x, nloc, nx); b.st[0] = nloc; b.st[1] = nx; }
        const unsigned old = xb_add(&bar[XB_XSUB(b.x)], 1u);
        const unsigned gen = old / nloc;
        if (old + 1u == (gen + 1u) * nloc) {
            __builtin_amdgcn_fence(__ATOMIC_RELEASE, "agent");
            asm volatile("s_waitcnt vmcnt(0)" ::: "memory");
            const unsigned og = xb_add(&bar[XB_TOP], 1u);
            const unsigned tg = og / nx;
            if (og + 1u == (tg + 1u) * nx) xb_add(&bar[XB_TOPGEN], 1u);
            else XB_SPIN(xb_ld(&bar[XB_TOPGEN]) == tg, bar);
            __builtin_amdgcn_fence(__ATOMIC_ACQUIRE, "agent");
            xb_add(&bar[XB_XGEN(b.x)], 1u);
            asm volatile("s_waitcnt vmcnt(0)" ::: "memory");
        } else {
            XB_SPIN(xb_ld(&bar[XB_XGEN(b.x)]) == gen, bar);
            __builtin_amdgcn_fence(__ATOMIC_ACQUIRE, "agent");
            asm volatile("s_waitcnt vmcnt(0)" ::: "memory");
        }
    }
    __syncthreads();
}

struct Frame {
    LAS unsigned char* lds;
    volatile LAS unsigned* MISC;
    gu32* ctl;
    int vcu, G;
    unsigned char* ws;
};
__device__ __forceinline__ int opaque_tid() { int t = threadIdx.x; asm volatile("" : "+v"(t)); return t; }
#define PHASE_IDS() const int tid = opaque_tid(), lane = tid & 63, wave = __builtin_amdgcn_readfirstlane(tid >> 6); (void)lane; (void)wave
typedef float f32x2 __attribute__((ext_vector_type(2)));
typedef unsigned u32x4 __attribute__((ext_vector_type(4)));
typedef unsigned u32x2 __attribute__((ext_vector_type(2)));
__device__ __forceinline__ float wave_sum(float x) {
    float v = x;
#define WS_STEP(ctrl, rmask) v += __builtin_bit_cast(float, __builtin_amdgcn_update_dpp(0, __builtin_bit_cast(int, v), ctrl, rmask, 0xf, false))
    WS_STEP(0x111, 0xf); WS_STEP(0x112, 0xf); WS_STEP(0x114, 0xf); WS_STEP(0x118, 0xf); WS_STEP(0x142, 0xa); WS_STEP(0x143, 0xc);
#undef WS_STEP
    return __builtin_bit_cast(float, __builtin_amdgcn_readlane(__builtin_bit_cast(int, v), 63));
}
__device__ __forceinline__ unsigned cvtpk(float lo, float hi) { typedef __bf16 bf2 __attribute__((ext_vector_type(2))); f32x2 v = {lo, hi}; bf2 b = __builtin_convertvector(v, bf2); return __builtin_bit_cast(unsigned, b); }
__device__ __forceinline__ float bf2f(unsigned short h) { return __uint_as_float((unsigned)h << 16); }

struct TrItem { const float* W; int ldw, nvalid, K; unsigned char* WT; int row_off, mode, f8; float fscale; int k0, n0; };
__device__ __forceinline__ void tr_load(const TrItem& t, f32x4 (&v)[8][2], int lane, int wave) {
#pragma unroll
    for (int i = 0; i < 8; ++i)
#pragma unroll
        for (int j = 0; j < 2; ++j) { const int n = t.n0 + 4 * lane + (t.f8 ? 0 : 256 * j); const int k = t.k0 + (t.f8 ? wave * 16 + 2 * i + j : wave * 8 + i);
            v[i][j] = (n < t.nvalid) ? __builtin_nontemporal_load((const f32x4*)(t.W + (size_t)k * t.ldw + n)) : (f32x4){0.f, 0.f, 0.f, 0.f}; }
}
__device__ __forceinline__ void tr_to_lds(const TrItem& t, const f32x4 (&v)[8][2], LAS float* scr, int lane, int wave) {
#pragma unroll
    for (int i = 0; i < 8; ++i)
#pragma unroll
        for (int j = 0; j < 2; ++j) { LAS float* d = t.f8 ? scr + (wave * 16 + 2 * i + j) * 257 + 4 * lane : scr + (wave * 8 + i) * 513 + 4 * lane + 256 * j; d[0] = v[i][j].x; d[1] = v[i][j].y; d[2] = v[i][j].z; d[3] = v[i][j].w; }
}
__device__ __forceinline__ void tr_store(const TrItem& t, LAS float* scr, int tid) {
    const int c = tid & 7;
    if (t.f8) {
        const float fs = t.fscale;
#pragma unroll
        for (int j = 0; j < 4; ++j) { const int n = (tid >> 3) + 64 * j; const LAS float* s = scr + (16 * c) * 257 + n;
            const int ng = t.n0 + n; int row;
            if (t.mode == 0) row = t.row_off + ng; else { const int np = ng & 1023; row = (np >> 7) * 256 + ((ng >> 10) << 7) + (np & 127); }
            v4u o; o.x = pg8::cvt4_fp8(s[0 * 257] * fs, s[1 * 257] * fs, s[2 * 257] * fs, s[3 * 257] * fs); o.y = pg8::cvt4_fp8(s[4 * 257] * fs, s[5 * 257] * fs, s[6 * 257] * fs, s[7 * 257] * fs);
            o.z = pg8::cvt4_fp8(s[8 * 257] * fs, s[9 * 257] * fs, s[10 * 257] * fs, s[11 * 257] * fs); o.w = pg8::cvt4_fp8(s[12 * 257] * fs, s[13 * 257] * fs, s[14 * 257] * fs, s[15 * 257] * fs);
            *(GAS v4u*)(t.WT + (size_t)row * t.K + t.k0 + 16 * c) = o; }
        return; }
#pragma unroll
    for (int j = 0; j < 8; ++j) { const int n = (tid >> 3) + 64 * j; const LAS float* s = scr + (8 * c) * 513 + n;
        const int ng = t.n0 + n; int row;
        if (t.mode == 0) row = t.row_off + ng; else { const int np = ng & 1023; row = (np >> 7) * 256 + ((ng >> 10) << 7) + (np & 127); }
        v4u o; o.x = pk2(s[0 * 513], s[1 * 513]); o.y = pk2(s[2 * 513], s[3 * 513]); o.z = pk2(s[4 * 513], s[5 * 513]); o.w = pk2(s[6 * 513], s[7 * 513]);
        *(GAS v4u*)(t.WT + ((size_t)row * t.K + t.k0 + 8 * c) * 2) = o; }
}
struct P0In { const float *x, *a_w_in, *a_w_uq, *a_w_uk, *a_w_uv, *a_w_qidx, *a_w_o, *b_w_in, *b_w_o, *w_gu, *w_down;
              const float *rel, *a_g_q, *a_g_kv, *a_g_kidx, *a_b_kidx, *b_b_f, *ln_mix_g, *ln_mix_b, *ln_ffn_g, *ln_ffn_b, *w_router, *b_router, *b_gu, *b_down; };
__device__ __forceinline__ void p0_copy(float* dst, const float* src, int n, int g0, int gs) { for (int i = g0; i < n; i += gs) dst[i] = src[i]; }
__device__ __forceinline__ void p0_prologue(Frame& F, const P0In& I) {
    PHASE_IDS();
    bf16* WAIN = (bf16*)(F.ws + WS_WAIN); bf16* WACQ = (bf16*)(F.ws + WS_WACQ); bf16* WAO = (bf16*)(F.ws + WS_WAO); bf16* WBIN = (bf16*)(F.ws + WS_WBIN); bf16* WBO = (bf16*)(F.ws + WS_WBO);
    bf16* WGU = (bf16*)(F.ws + WS_WGU); bf16* WD = (bf16*)(F.ws + WS_WD); bf16* XB = (bf16*)(F.ws + WS_XB);
#ifndef MK_P0_REP
#define MK_P0_REP 0
#endif
    for (int rep0 = 0; rep0 < 1 + (MK_P0_REP & 1); ++rep0)
    for (int it = F.vcu; it < 128 + 256; it += F.G) {
        if (it < 128) {
            const int h = it >> 3, rb = it & 7; const int rq = tid & 255, rs = wave >> 2;
            float q[64];
            const GAS f32x4* qp = (const GAS f32x4*)(I.a_w_uq + ((size_t)rq * A_H + h) * 64);
#pragma unroll
            for (int i = 0; i < 16; ++i) { const f32x4 v = qp[i]; q[4 * i] = v.x; q[4 * i + 1] = v.y; q[4 * i + 2] = v.z; q[4 * i + 3] = v.w; }
            for (int j = 0; j < 8; ++j) { const int r = rb * 16 + rs * 8 + j; const float* kp = I.a_w_uk + ((size_t)r * A_H + h) * 64; float s = 0.f;
#pragma unroll
                for (int d = 0; d < 64; ++d) s += q[d] * kp[d];
                WACQ[(size_t)(h * 128 + r) * 256 + rq] = (bf16)f2bf(s * (0.125f * LOG2E)); }
        } else {
            const int i2 = it - 128, h = i2 >> 4, nc = i2 & 15; LAS float* wo = (LAS float*)F.lds; LAS float* wuv = wo + 4096;
#pragma unroll
            for (int i = 0; i < 8; ++i) { const int idx = tid + 512 * i, d = idx >> 6, n = idx & 63; wo[idx] = I.a_w_o[(size_t)(h * 64 + d) * D + nc * 64 + n]; }
#pragma unroll
            for (int i = 0; i < 16; ++i) { const int idx = tid + 512 * i, r = idx >> 6, d = idx & 63; wuv[idx] = I.a_w_uv[((size_t)r * A_H + h) * 64 + d]; }
            LDS_WAIT(); __syncthreads();
            const int nl = tid & 63, rg = wave; float acc[16];
#pragma unroll
            for (int i = 0; i < 16; ++i) acc[i] = 0.f;
#pragma unroll 8
            for (int d = 0; d < 64; ++d) { const float w = wo[d * 64 + nl];
#pragma unroll
                for (int i = 0; i < 16; ++i) acc[i] += wuv[(rg * 16 + i) * 64 + d] * w; }
#pragma unroll
            for (int i = 0; i < 16; ++i) acc[i] *= F8_WAOS;
            v4u o0; o0.x = pg8::cvt4_fp8(acc[0], acc[1], acc[2], acc[3]); o0.y = pg8::cvt4_fp8(acc[4], acc[5], acc[6], acc[7]); o0.z = pg8::cvt4_fp8(acc[8], acc[9], acc[10], acc[11]); o0.w = pg8::cvt4_fp8(acc[12], acc[13], acc[14], acc[15]);
            *(GAS v4u*)((unsigned char*)WAO + (size_t)(nc * 64 + nl) * 2048 + h * 128 + rg * 16) = o0;
            __syncthreads();
        }
    }
    __syncthreads();
    LAS float* scr = (LAS float*)(F.lds + RING_OFF);
    constexpr int I_AIN = 16 * 1, I_QIDX = 4 * 1, I_BIN = 8 * 12, I_BO = 8 * 4, I_GU1 = 8 * 8, I_D1 = 8 * 4;
    constexpr int I_GU = 64 * I_GU1, I_DN = 64 * I_D1;
    constexpr int NITEMS = I_AIN + I_QIDX + I_BIN + I_BO + I_GU + I_DN;
    auto decode = [&](int it) -> TrItem {
        TrItem t; int r = it; t.mode = 0; t.f8 = 0; t.fscale = 1.f; t.row_off = 0;
        if (r < I_AIN) { t.W = I.a_w_in; t.ldw = A_INW; t.nvalid = A_INW; t.K = 1024; t.WT = (unsigned char*)WAIN; t.k0 = 64 * r; t.n0 = 0; return t; } r -= I_AIN;
        if (r < I_QIDX) { t.W = I.a_w_qidx; t.ldw = 512; t.nvalid = 512; t.K = 256; t.WT = (unsigned char*)WACQ; t.row_off = 2048; t.k0 = 64 * r; t.n0 = 0; return t; } r -= I_QIDX;
        if (r < I_BIN) { t.W = I.b_w_in; t.ldw = B_INW; t.nvalid = 3072; t.K = 1024; t.WT = (unsigned char*)WBIN; t.f8 = 1; t.fscale = F8_WBINS; t.k0 = 128 * (r / 12); t.n0 = 256 * (r % 12); return t; } r -= I_BIN;
        if (r < I_BO) { t.W = I.b_w_o; t.ldw = 1024; t.nvalid = 1024; t.K = 1024; t.WT = (unsigned char*)WBO; t.f8 = 1; t.fscale = F8_WBOS; t.k0 = 128 * (r / 4); t.n0 = 256 * (r % 4); return t; } r -= I_BO;
        if (r < I_GU) { const int mi = r / I_GU1, rr = r % I_GU1; t.W = I.w_gu + (size_t)mi * 1024 * 2048; t.ldw = 2048; t.nvalid = 2048; t.K = 1024; t.WT = (unsigned char*)WGU + (size_t)mi * 2048 * 1024; t.mode = 1; t.f8 = 1; t.fscale = F8_WGS;
            t.k0 = 128 * (rr / 8); t.n0 = 256 * (rr % 8); return t; } r -= I_GU;
        { const int mi = r / I_D1, rr = r % I_D1; t.W = I.w_down + (size_t)mi * 1024 * 1024; t.ldw = 1024; t.nvalid = 1024; t.K = 1024; t.WT = (unsigned char*)WD + (size_t)mi * 1024 * 1024; t.f8 = 1; t.fscale = F8_WDS;
            t.k0 = 128 * (rr / 4); t.n0 = 256 * (rr % 4); return t; }
    };
    for (int rep1 = 0; rep1 < 1 + ((MK_P0_REP >> 1) & 1); ++rep1) {
        f32x4 v[8][2]; int it = F.vcu;
        if (it < NITEMS) { const TrItem t0 = decode(it); tr_load(t0, v, lane, wave); }
        for (; it < NITEMS; it += F.G) {
            const TrItem t = decode(it);
            tr_to_lds(t, v, scr, lane, wave);
            LDS_WAIT(); __syncthreads();
            if (it + F.G < NITEMS) { const TrItem tn = decode(it + F.G); tr_load(tn, v, lane, wave); }
            tr_store(t, scr, tid);
            LDS_WAIT(); __syncthreads();
        }
    }
    { float* PAR = (float*)(F.ws + WS_PAR); const int g0 = F.vcu * 512 + tid, gs = F.G * 512;
      p0_copy(PAR + PAR_REL, I.rel, 512, g0, gs); p0_copy(PAR + PAR_AGQ, I.a_g_q, 256, g0, gs); p0_copy(PAR + PAR_AGKV, I.a_g_kv, 128, g0, gs); p0_copy(PAR + PAR_AGKI, I.a_g_kidx, 64, g0, gs);
      p0_copy(PAR + PAR_ABKI, I.a_b_kidx, 64, g0, gs); p0_copy(PAR + PAR_BF, I.b_b_f, 16, g0, gs); p0_copy(PAR + PAR_BROUT, I.b_router, 64, g0, gs);
      p0_copy(PAR + PAR_LN, I.ln_mix_g, 2048, g0, gs); p0_copy(PAR + PAR_LN + 2048, I.ln_mix_b, 2048, g0, gs); p0_copy(PAR + PAR_LN + 4096, I.ln_ffn_g, 2048, g0, gs); p0_copy(PAR + PAR_LN + 6144, I.ln_ffn_b, 2048, g0, gs);
      p0_copy(PAR + PAR_WROUT, I.w_router, 65536, g0, gs); p0_copy(PAR + PAR_BGU, I.b_gu, 131072, g0, gs); p0_copy(PAR + PAR_BDOWN, I.b_down, 65536, g0, gs);
      for (int i = g0; i < 16384; i += gs) PAR[PAR_WF + i] = I.b_w_in[(size_t)(i >> 4) * B_INW + 3072 + (i & 15)]; }
    { const size_t n8 = (size_t)M * D / 8; const size_t g0 = (size_t)F.vcu * 512 + tid, gs = (size_t)F.G * 512;
      for (int rep2 = 0; rep2 < 1 + ((MK_P0_REP >> 2) & 1); ++rep2)
      for (size_t i = g0; i < n8; i += 4 * gs) { f32x4 a[4], b[4];
#pragma unroll
          for (int q = 0; q < 4; ++q) { const size_t ii = i + q * gs; if (ii < n8) { const GAS f32x4* p = (const GAS f32x4*)(I.x + ii * 8); a[q] = __builtin_nontemporal_load(p); b[q] = __builtin_nontemporal_load(p + 1); } }
#pragma unroll
          for (int q = 0; q < 4; ++q) { const size_t ii = i + q * gs; if (ii < n8) { v4u o; o.x = pk2(a[q].x, a[q].y); o.y = pk2(a[q].z, a[q].w); o.z = pk2(b[q].x, b[q].y); o.w = pk2(b[q].z, b[q].w); *(GAS v4u*)(XB + ii * 8) = o; } } } }
}

__device__ __forceinline__ void p_dsa_norms(Frame& F, const float* g_q, const float* g_kv, const float* g_kidx, const float* b_kidx) {
    PHASE_IDS();
    const float* PROJ = (const float*)(F.ws + WS_PROJ); bf16* CQN = (bf16*)(F.ws + WS_CQN); bf16* CKV = (bf16*)(F.ws + WS_CKV); bf16* KIDX = (bf16*)(F.ws + WS_KIDX); float* WIDX = (float*)(F.ws + WS_WIDX);
    const int l = lane; const int gw = F.vcu * NWAVES + wave, NGW = F.G * NWAVES;
    const f32x4 gq = *(const f32x4*)(g_q + 4 * l); const f32x2 gkv = *(const f32x2*)(g_kv + 2 * l); const float gki = g_kidx[l], bki = b_kidx[l];
    float cmx = 0.f;
    f32x4 cq_n = {0.f, 0.f, 0.f, 0.f}; f32x2 ckv_n = {0.f, 0.f}; float ki_n = 0.f, wi_n = 0.f;
    if (gw < M) { const float* p = PROJ + (size_t)gw * 512; cq_n = *(const f32x4*)(p + 4 * l); ckv_n = *(const f32x2*)(p + 256 + 2 * l); ki_n = p[384 + l]; wi_n = p[448 + (l & 7)]; }
    for (int row = gw; row < M; row += NGW) {
        const f32x4 cq = cq_n; const f32x2 ckv = ckv_n; const float ki = ki_n; const float wi = wi_n;
        if (row + NGW < M) { const float* p = PROJ + (size_t)(row + NGW) * 512; cq_n = *(const f32x4*)(p + 4 * l); ckv_n = *(const f32x2*)(p + 256 + 2 * l); ki_n = p[384 + l]; wi_n = p[448 + (l & 7)]; }
        const float rq = 1.0f / sqrtf(wave_sum(cq.x * cq.x + cq.y * cq.y + cq.z * cq.z + cq.w * cq.w) * (1.0f / 256.0f) + RMS_EPS);
        const float rkv = 1.0f / sqrtf(wave_sum(ckv.x * ckv.x + ckv.y * ckv.y) * (1.0f / 128.0f) + RMS_EPS);
        const float mean = wave_sum(ki) * (1.0f / 64.0f); const float dk = ki - mean; const float rki = 1.0f / sqrtf(wave_sum(dk * dk) * (1.0f / 64.0f) + LN_EPS);
        u32x2 oq; oq.x = cvtpk(cq.x * rq * gq.x, cq.y * rq * gq.y); oq.y = cvtpk(cq.z * rq * gq.z, cq.w * rq * gq.w);
        *(GAS u32x2*)(CQN + (size_t)row * 256 + 4 * l) = oq;
        const float c0 = ckv.x * rkv * gkv.x, c1 = ckv.y * rkv * gkv.y;
        *(GAS unsigned*)(CKV + (size_t)row * 128 + 2 * l) = cvtpk(c0, c1);
        cmx = fmaxf(cmx, wave_sum(c0 * c0 + c1 * c1));
        KIDX[(size_t)row * 64 + l] = (bf16)f2bf(dk * rki * gki + bki);
        if (l < 8) WIDX[(size_t)row * 8 + l] = wi * 0.04419417382415922f;
    }
    if (l == 0) __hip_atomic_fetch_max(F.ctl + CW_CMAX, __float_as_uint(sqrtf(cmx)), __ATOMIC_RELAXED, __HIP_MEMORY_SCOPE_AGENT);
}

__device__ __forceinline__ int t5_bucket(int n) {
    if (n < 16) return n; if (n >= 128) return 31;
    const int v = 16 + (int)(__builtin_amdgcn_logf((float)n * 0.0625f) * (16.0f / 3.0f));
    return v < 31 ? v : 31;
}
__device__ __forceinline__ unsigned fkey(float f) { const unsigned u = __float_as_uint(f); return (u & 0x80000000u) ? ~u : (u | 0x80000000u); }
__device__ __forceinline__ int popc64(unsigned long long m) { return __builtin_popcountll(m); }
__device__ __forceinline__ int mbcnt(unsigned long long m) { return (int)__builtin_amdgcn_mbcnt_hi((unsigned)(m >> 32), __builtin_amdgcn_mbcnt_lo((unsigned)m, 0u)); }
typedef float f32x16 __attribute__((ext_vector_type(16)));
typedef unsigned short u16x2 __attribute__((ext_vector_type(2)));
__device__ __forceinline__ int wave_total_i(int x) {
    int v = x;
    v += __builtin_amdgcn_update_dpp(0, v, 0x111, 0xf, 0xf, false);
    v += __builtin_amdgcn_update_dpp(0, v, 0x112, 0xf, 0xf, false);
    v += __builtin_amdgcn_update_dpp(0, v, 0x114, 0xf, 0xf, false);
    v += __builtin_amdgcn_update_dpp(0, v, 0x118, 0xf, 0xf, false);
    v += __builtin_amdgcn_update_dpp(0, v, 0x142, 0xa, 0xf, false);
    v += __builtin_amdgcn_update_dpp(0, v, 0x143, 0xc, 0xf, false);
    return __builtin_amdgcn_readlane(v, 63);
}
#ifndef MK_IDX_REP
#define MK_IDX_REP 0
#endif
#ifndef MK_CHECK_SEL
#define MK_CHECK_SEL 0
#endif
__device__ __forceinline__ void select_top256(const unsigned (&u)[64], int nj, int l, LAS unsigned short* selst, LAS unsigned* cand  ) {
    constexpr int SEL_CAP = 1024;
    unsigned pk[32];
#pragma unroll
    for (int p = 0; p < 32; ++p) pk[p] = (u[2 * p] >> 17) | ((u[2 * p + 1] >> 1) & 0xffff0000u);
    const int ngrp = (nj + 7) >> 3; const int nconsidered = ngrp * 512;
    auto count_ge = [&](unsigned c) -> int {
        const u16x2 cpk = __builtin_bit_cast(u16x2, c * 0x10001u); u16x2 acc = {0, 0};
#pragma unroll
        for (int jb = 0; jb < 8; ++jb) { if (jb < ngrp) {
#pragma unroll
            for (int q = 0; q < 4; ++q) { const u16x2 d = __builtin_bit_cast(u16x2, pk[4 * jb + q]) - cpk; acc += (d >> (unsigned short)15); } } }
        const unsigned a = __builtin_bit_cast(unsigned, acc);
        return nconsidered - wave_total_i((int)((a & 0xffffu) + (a >> 16)));
    };
    unsigned P = 0u;
    for (int bit = 14; bit >= 0; --bit) { const unsigned c = P | (1u << bit); if (count_ge(c) >= TOPK) P = c; }
    const int c_above = count_ge(P + 1u); const int need = TOPK - c_above;
    int off = 0, coff = 0;
#pragma unroll
    for (int j = 0; j < 64; ++j) { if ((j >> 3) < ngrp) {
        const unsigned k15 = u[j] >> 17; const unsigned long long m1 = __ballot(k15 > P), mc = __ballot(k15 == P);
        if (k15 > P) selst[off + mbcnt(m1)] = (unsigned short)(j * 64 + l);
        off += popc64(m1);
        if (mc != 0ull) { if (k15 == P) { const int pos = coff + mbcnt(mc); if (pos < SEL_CAP) { cand[pos] = u[j]; cand[SEL_CAP + pos] = (unsigned)(j * 64 + l); } } coff += popc64(mc); } }
        __builtin_amdgcn_sched_barrier(0); }
    LDS_WAIT(); asm volatile("" ::: "memory");
    const int ncand = coff;
    if (ncand == need && ncand <= SEL_CAP) { for (int i = l; i < ncand; i += 64) selst[c_above + i] = (unsigned short)cand[SEL_CAP + i]; }
    else if (ncand <= 256) {
        unsigned mk[4], mi[4]; int rk[4];
#pragma unroll
        for (int r = 0; r < 4; ++r) { const int i = l + 64 * r; const bool v = i < ncand; mk[r] = v ? cand[i] : 0u; mi[r] = v ? cand[SEL_CAP + i] : 0xffffffffu; rk[r] = 0; }
        for (int c2 = 0; c2 < ncand; ++c2) { const unsigned k2 = cand[c2], i2 = cand[SEL_CAP + c2];
#pragma unroll
            for (int r = 0; r < 4; ++r) rk[r] += (k2 > mk[r] || (k2 == mk[r] && i2 < mi[r])) ? 1 : 0; }
#pragma unroll
        for (int r = 0; r < 4; ++r) { if (l + 64 * r < ncand && rk[r] < need) selst[c_above + rk[r]] = (unsigned short)mi[r]; }
    } else {
        unsigned Tk = P << 17;
        for (int bit = 16; bit >= 0; --bit) { const unsigned cd = Tk | (1u << bit); int cnt = 0;
#pragma unroll
            for (int j = 0; j < 64; ++j) cnt += (u[j] >= cd) ? 1 : 0;
            if (wave_total_i(cnt) >= TOPK) Tk = cd; }
        int cg = 0;
#pragma unroll
        for (int j = 0; j < 64; ++j) cg += (u[j] > Tk && (u[j] >> 17) == P) ? 1 : 0;
        const int ngt = wave_total_i(cg); const int need2 = need - ngt; int o2 = c_above, t2 = 0;
        unsigned Tk2 = Tk, P2 = P; asm volatile("" : "+s"(Tk2), "+s"(P2));
#pragma unroll
        for (int j = 0; j < 64; ++j) { const bool isc = (u[j] >> 17) == P2; const unsigned long long m1 = __ballot(isc && u[j] > Tk2), m2 = __ballot(isc && u[j] == Tk2);
            if (isc && u[j] > Tk2) selst[o2 + mbcnt(m1)] = (unsigned short)(j * 64 + l);
            if (isc && u[j] == Tk2) { const int rk2 = t2 + mbcnt(m2); if (rk2 < need2) selst[c_above + ngt + rk2] = (unsigned short)(j * 64 + l); }
            o2 += popc64(m1); t2 += popc64(m2); __builtin_amdgcn_sched_barrier(0); }
    }
    LDS_WAIT(); asm volatile("" ::: "memory");
}
#if MK_CHECK_SEL
__device__ __forceinline__ void select_ref(const unsigned (&u)[64], int l, LAS unsigned short* selst) {
    unsigned Tk = 0u;
    for (int bit = 31; bit >= 0; --bit) { const unsigned cand = Tk | (1u << bit); int cnt = 0;
#pragma unroll
        for (int j = 0; j < 64; ++j) cnt += popc64(__ballot(u[j] >= cand));
        if (cnt >= TOPK) Tk = cand; }
    int cgt = 0;
#pragma unroll
    for (int j = 0; j < 64; ++j) cgt += popc64(__ballot(u[j] > Tk));
    const int need = TOPK - cgt; int off = 0, toff = 0;
#pragma unroll
    for (int j = 0; j < 64; ++j) { const unsigned long long m1 = __ballot(u[j] > Tk), m2 = __ballot(u[j] == Tk);
        if (u[j] > Tk) selst[off + mbcnt(m1)] = (unsigned short)(j * 64 + l);
        if (u[j] == Tk) { const int rk = toff + mbcnt(m2); if (rk < need) selst[cgt + rk] = (unsigned short)(j * 64 + l); }
        off += popc64(m1); toff += popc64(m2); }
    LDS_WAIT(); asm volatile("" ::: "memory");
}
#endif
__device__ __forceinline__ int wave_scan_i(int x) {
    int v = x;
    v += __builtin_amdgcn_update_dpp(0, v, 0x111, 0xf, 0xf, false);
    v += __builtin_amdgcn_update_dpp(0, v, 0x112, 0xf, 0xf, false);
    v += __builtin_amdgcn_update_dpp(0, v, 0x114, 0xf, 0xf, false);
    v += __builtin_amdgcn_update_dpp(0, v, 0x118, 0xf, 0xf, false);
    v += __builtin_amdgcn_update_dpp(0, v, 0x142, 0xa, 0xf, false);
    v += __builtin_amdgcn_update_dpp(0, v, 0x143, 0xc, 0xf, false);
    return v;
}
__device__ __forceinline__ int radix_pick(LAS unsigned* hist, int want, int l, int& above) {
    const u32x4 h4 = *(const LAS u32x4*)(hist + 4 * l);
    const int tot = (int)((h4.x + h4.y) + (h4.z + h4.w)); const int pre = wave_scan_i(tot); const int total = __builtin_amdgcn_readlane(pre, 63);
    const int a3 = total - pre, a2 = a3 + (int)h4.w, a1 = a2 + (int)h4.z, a0 = a1 + (int)h4.y;
    const bool c3 = a3 < want && a3 + (int)h4.w >= want, c2 = a2 < want && a2 + (int)h4.z >= want, c1 = a1 < want && a1 + (int)h4.y >= want, c0 = a0 < want && a0 + (int)h4.x >= want;
    const unsigned long long m = __ballot(c3 || c2 || c1 || c0); const int src = (int)__builtin_ctzll(m | (1ull << 63));
    const int mybin = 4 * l + (c3 ? 3 : c2 ? 2 : c1 ? 1 : 0), myab = c3 ? a3 : c2 ? a2 : c1 ? a1 : a0;
    above = __builtin_amdgcn_readlane(myab, src);
    return __builtin_amdgcn_readlane(mybin, src);
}
__device__ __forceinline__ void select_top256_radix(const unsigned (&k)[64], int nj, int l, LAS unsigned short* selst, LAS unsigned* hist) {
    const int ngrp = (nj + 7) >> 3;
    *(LAS u32x4*)(hist + 4 * l) = (u32x4){0u, 0u, 0u, 0u};
    LDS_WAIT(); asm volatile("" ::: "memory");
#pragma unroll
    for (int j = 0; j < 64; ++j) { if ((j >> 3) < ngrp) (void)__hip_atomic_fetch_add(hist + (k[j] >> 8), 1u, __ATOMIC_RELAXED, __HIP_MEMORY_SCOPE_WORKGROUP); }
    LDS_WAIT(); asm volatile("" ::: "memory");
    int above1 = 0; const int bhi = radix_pick(hist, TOPK, l, above1); const int want2 = TOPK - above1;
    LDS_WAIT(); asm volatile("" ::: "memory");
    *(LAS u32x4*)(hist + 4 * l) = (u32x4){0u, 0u, 0u, 0u};
    LDS_WAIT(); asm volatile("" ::: "memory");
#pragma unroll
    for (int j = 0; j < 64; ++j) { if ((j >> 3) < ngrp) { if ((int)(k[j] >> 8) == bhi) (void)__hip_atomic_fetch_add(hist + (k[j] & 255u), 1u, __ATOMIC_RELAXED, __HIP_MEMORY_SCOPE_WORKGROUP); } }
    LDS_WAIT(); asm volatile("" ::: "memory");
    int above2 = 0; const int blo = radix_pick(hist, want2, l, above2);
    const unsigned T16 = ((unsigned)bhi << 8) | (unsigned)blo; const int cgt = above1 + above2, need = TOPK - cgt;
    int off = 0, toff = 0;
#pragma unroll
    for (int j = 0; j < 64; ++j) { if ((j >> 3) < ngrp) {
        const unsigned long long m1 = __ballot(k[j] > T16), m2 = __ballot(k[j] == T16);
        if (k[j] > T16) selst[off + mbcnt(m1)] = (unsigned short)(j * 64 + l);
        if (m2 != 0ull) { if (k[j] == T16) { const int rk = toff + mbcnt(m2); if (rk < need) selst[cgt + rk] = (unsigned short)(j * 64 + l); } toff += popc64(m2); }
        off += popc64(m1); }
        __builtin_amdgcn_sched_barrier(0); }
    LDS_WAIT(); asm volatile("" ::: "memory");
}
__device__ __forceinline__ void p_indexer(Frame& F) {
    PHASE_IDS();
    const bf16* QIDX = (const bf16*)(F.ws + WS_QIDX); const bf16* KIDX = (const bf16*)(F.ws + WS_KIDX); const float* WIDX = (const float*)(F.ws + WS_WIDX);
    unsigned short* SEL = (unsigned short*)(F.ws + WS_SEL); unsigned char* BKT = (unsigned char*)(F.ws + WS_BKT);
    LAS unsigned short* selst = (LAS unsigned short*)(F.lds + 131072) + wave * 256;
    const int l = lane, l31 = l & 31, hi = l >> 5;
    { const int gw = F.vcu * NWAVES + wave, NGW = F.G * NWAVES;
      for (int rr = gw; rr < BATCH * 256; rr += NGW) { const int b = rr >> 8, t = rr & 255; const size_t row = (size_t)b * T + t;
          unsigned short s4[4]; unsigned bk = 0;
#pragma unroll
          for (int i = 0; i < 4; ++i) { const int k = 4 * l + i; const bool v = k <= t; s4[i] = v ? (unsigned short)k : (unsigned short)0xFFFF; bk |= (unsigned)(v ? t5_bucket(t - k) : 32) << (8 * i); }
          u32x2 o; o.x = (unsigned)s4[0] | ((unsigned)s4[1] << 16); o.y = (unsigned)s4[2] | ((unsigned)s4[3] << 16);
          *(GAS u32x2*)(SEL + row * 256 + 4 * l) = o; *(GAS unsigned*)(BKT + row * 256 + 4 * l) = bk; } }
    LAS unsigned short* S16 = (LAS unsigned short*)F.lds;
    LAS float* wtab = (LAS float*)(F.lds + 131072 + 4096);
    for (int i = 0; ; ++i) {
        const int L = i * F.G + F.vcu; const int rnd = L >> 8, pos = L & 255;
        if (rnd >= 8) break;
        const int b = pos & 7, gs = pos >> 3; const int g = 239 - 32 * rnd - ((rnd & 1) ? (31 - gs) : gs);
        if (g < 0) continue;
        const int t0 = 256 + 16 * g, nk = t0 + 16, nkt = (nk + 31) >> 5; const size_t rowb = (size_t)b * T;
        int lt_ = threadIdx.x; asm volatile("" : "+v"(lt_)); const int l = lt_ & 63, l31 = l & 31, hi = l >> 5;
        bf16x8 af[4][4];
        { const int tl = 2 * ((l31 >> 2) & 1) + (l31 >> 4), hd = (l31 & 3) + 4 * ((l31 >> 3) & 1);
#pragma unroll
          for (int mt = 0; mt < 4; ++mt) { const bf16* qp = QIDX + (rowb + t0 + mt * 4 + tl) * 512 + hd * 64 + hi * 8;
#pragma unroll
              for (int ks = 0; ks < 4; ++ks) af[mt][ks] = *(const GAS bf16x8*)(qp + ks * 16); }
          if (lt_ < 128) wtab[lt_] = WIDX[(rowb + t0) * 8 + lt_] * 0.5f;
          LDS_WAIT(); __syncthreads(); }
        for (int rep1 = 0; rep1 < 1 + (MK_IDX_REP & 1); ++rep1) {
        bf16x8 bfr[4], bn1[4], bnx[4];
        { const bf16* kp = KIDX + (rowb + wave * 32 + l31) * 64 + hi * 8;
#pragma unroll
          for (int ks = 0; ks < 4; ++ks) bfr[ks] = (wave < nkt) ? *(const GAS bf16x8*)(kp + ks * 16) : (bf16x8){0, 0, 0, 0, 0, 0, 0, 0};
          const int kt1 = wave + NWAVES; const bf16* kp1 = KIDX + (rowb + (kt1 < nkt ? kt1 : 0) * 32 + l31) * 64 + hi * 8;
#pragma unroll
          for (int ks = 0; ks < 4; ++ks) bn1[ks] = *(const GAS bf16x8*)(kp1 + ks * 16); }
        auto tile = [&](const int kt, const bf16x8 (&cur)[4], bf16x8 (&ld)[4]) {
            const int key = kt * 32 + l31; const int ktn = kt + 2 * NWAVES;
            LAS float* wtab_k = wtab; asm volatile("" : "+v"(wtab_k));
            { const bf16* kp = KIDX + (rowb + (ktn < nkt ? ktn : kt) * 32 + l31) * 64 + hi * 8;
#pragma unroll
              for (int ks = 0; ks < 4; ++ks) ld[ks] = *(const GAS bf16x8*)(kp + ks * 16); }
#pragma unroll
            for (int mt = 0; mt < 4; ++mt) { f32x16 acc = f32x16{};
#pragma unroll
                for (int ks = 0; ks < 4; ++ks) acc = __builtin_amdgcn_mfma_f32_32x32x16_bf16(af[mt][ks], cur[ks], acc, 0, 0, 0);
                float sA = 0.f, sB = 0.f;
                const LAS f32x4* wq = (const LAS f32x4*)(wtab_k + (mt * 4 + 2 * hi) * 8); const f32x4 wa0 = wq[0], wa1 = wq[1], wb0 = wq[2], wb1 = wq[3];
                const float wA[8] = {wa0.x, wa0.y, wa0.z, wa0.w, wa1.x, wa1.y, wa1.z, wa1.w}, wB[8] = {wb0.x, wb0.y, wb0.z, wb0.w, wb1.x, wb1.y, wb1.z, wb1.w};
#pragma unroll
                for (int r = 0; r < 8; ++r) { sA += wA[r] * (acc[r] + __builtin_fabsf(acc[r])); sB += wB[r] * (acc[8 + r] + __builtin_fabsf(acc[8 + r])); }
                const int tokA = mt * 4 + 2 * hi; const int tA = t0 + tokA;
                const _Float16 hA = (_Float16)((key <= tA) ? sA : -INFINITY), hB = (_Float16)((key <= tA + 1) ? sB : -INFINITY);
                S16[tokA * 4096 + key] = __builtin_bit_cast(unsigned short, hA); S16[(tokA + 1) * 4096 + key] = __builtin_bit_cast(unsigned short, hB); }
        };
        for (int kt = wave; kt < nkt; ) {
            tile(kt, bfr, bnx); kt += NWAVES; if (kt >= nkt) break;
            tile(kt, bn1, bfr); kt += NWAVES; if (kt >= nkt) break;
            tile(kt, bnx, bn1); kt += NWAVES;
        }
        }
        LDS_WAIT(); __syncthreads();
        { const int nvalid = nkt * 32; const int nj = (nvalid + 63) >> 6;
#pragma unroll
          for (int s2 = 0; s2 < 2; ++s2) {
              const int t = t0 + 2 * wave + s2; LAS unsigned short* srow = S16 + (2 * wave + s2) * 4096;
              int nvalid_ = nvalid; asm volatile("" : "+s"(nvalid_));
              unsigned u[64];
#pragma unroll
              for (int j = 0; j < 64; ++j) { const int idx = j * 64 + l; const unsigned h0 = srow[idx];
                  const unsigned k0 = (h0 & 0x8000u) ? (~h0 & 0xffffu) : (h0 | 0x8000u);
                  u[j] = (idx < nvalid_) ? k0 : 0u; }
              LDS_WAIT(); asm volatile("" ::: "memory");
              select_top256_radix(u, nj, l, selst, (LAS unsigned*)srow);
              if (MK_IDX_REP & 2) select_top256_radix(u, nj, l, selst, (LAS unsigned*)srow);
#if MK_CHECK_SEL
              { LAS unsigned* bm = (LAS unsigned*)srow + 512;
                for (int w2 = l; w2 < 128; w2 += 64) bm[w2] = 0u;
                LDS_WAIT(); asm volatile("" ::: "memory");
                unsigned short mine[4];
#pragma unroll
                for (int i2 = 0; i2 < 4; ++i2) { mine[i2] = selst[4 * l + i2]; atomicOr((unsigned*)(bm + (mine[i2] >> 5)), 1u << (mine[i2] & 31)); }
                LDS_WAIT(); asm volatile("" ::: "memory");
                unsigned u32k[64];
#pragma unroll
                for (int j = 0; j < 64; ++j) u32k[j] = u[j] << 16;
                select_ref(u32k, l, selst);
                int bad = 0;
#pragma unroll
                for (int i2 = 0; i2 < 4; ++i2) { const unsigned short r2 = selst[4 * l + i2]; bad += ((bm[r2 >> 5] >> (r2 & 31)) & 1u) ? 0 : 1; }
                int nset = 0; for (int w2 = l; w2 < 128; w2 += 64) nset += __builtin_popcount(bm[w2]);
                bad = wave_total_i(bad) + (wave_total_i(nset) != TOPK ? 1 : 0);
                if (bad && l == 0) __hip_atomic_store(F.ctl + CW_TMO, 0xBAD5E1u, __ATOMIC_RELAXED, __HIP_MEMORY_SCOPE_AGENT);
#pragma unroll
                for (int i2 = 0; i2 < 4; ++i2) selst[4 * l + i2] = mine[i2];
                LDS_WAIT(); asm volatile("" ::: "memory"); }
#endif
              int t2_ = threadIdx.x; asm volatile("" : "+v"(t2_)); const int l2 = t2_ & 63;
              const size_t row = rowb + t; unsigned short s4[4]; unsigned bk = 0;
#pragma unroll
              for (int i2 = 0; i2 < 4; ++i2) { s4[i2] = selst[4 * l2 + i2]; bk |= (unsigned)t5_bucket(t - (int)s4[i2]) << (8 * i2); }
              u32x2 o; o.x = (unsigned)s4[0] | ((unsigned)s4[1] << 16); o.y = (unsigned)s4[2] | ((unsigned)s4[3] << 16);
              *(GAS u32x2*)(SEL + row * 256 + 4 * l2) = o; *(GAS unsigned*)(BKT + row * 256 + 4 * l2) = bk;
              LDS_WAIT(); asm volatile("" ::: "memory"); } }
        LDS_WAIT(); __syncthreads();
    }
}

typedef short v4i16_t __attribute__((ext_vector_type(4)));
__device__ __forceinline__ void p_sparse_attn(Frame& F, const float* rel_table) {
    PHASE_IDS();
    const unsigned char* QLAT8 = (const unsigned char*)(F.ws + WS_QLAT);        const unsigned char* CKV8 = (const unsigned char*)(F.ws + WS_CKV); unsigned char* OLAT = (unsigned char*)(F.ws + WS_OLAT);
    const unsigned short* SEL = (const unsigned short*)(F.ws + WS_SEL); const unsigned char* BKT = (const unsigned char*)(F.ws + WS_BKT);
    LAS unsigned char* cb = F.lds + wave * 16384;
    LAS unsigned char* sb = F.lds + 131072 + wave * 1536;
    LAS float* relt = (LAS float*)(F.lds + 131072 + 8 * 1536);
    for (int i = tid; i < 33 * 16; i += NWAVES * 64) relt[i] = (i < 512) ? rel_table[i] * LOG2E : -INFINITY;
    LDS_WAIT(); __syncthreads();
    if (tid < 16) { float m = relt[tid]; for (int b = 1; b < 32; ++b) m = fmaxf(m, relt[b * 16 + tid]); relt[33 * 16 + tid] = m; }
    LDS_WAIT(); __syncthreads();
    const int l = lane, l15 = l & 15, g = l >> 4;
    const float cmax = __uint_as_float(__hip_atomic_load(F.ctl + CW_CMAX, __ATOMIC_RELAXED, __HIP_MEMORY_SCOPE_AGENT)) * 1.15f;
    const float bmaxh = relt[33 * 16 + l15];
    const int gw = F.vcu * NWAVES + wave, NGW = F.G * NWAVES;
    const int ntok = (M - gw + NGW - 1) / NGW;
#define SA_PARK_BKT(base_, bv_) do { _Pragma("unroll") for (int i_ = 0; i_ < 4; ++i_) { const int s_ = 4 * l + i_, sl_ = s_ & 31; (base_)[(s_ & ~31) + 4 * (sl_ & 7) + (sl_ >> 3)] = (unsigned char)((bv_) >> (8 * i_)); } } while (0)
#define SA_ROW(i_) ((NGW == 2048) ? ((size_t)(gw >> 8) * T + (size_t)((gw & 255) + 256 * (i_))) : (size_t)(gw + NGW * (i_)))
    if (ntok > 0) { const size_t row = SA_ROW(0); const u32x2 sv = *(const GAS u32x2*)(SEL + row * 256 + 4 * l); const unsigned bv = *(const GAS unsigned*)(BKT + row * 256 + 4 * l);
        *(LAS u32x2*)(sb + 8 * l) = sv; SA_PARK_BKT(sb + 512, bv); }
    LDS_WAIT();
    for (int it = 0; it < ntok; ++it) {
        const size_t row = SA_ROW(it); const size_t rowb = row & ~(size_t)(T - 1);
        LAS unsigned short* selw = (LAS unsigned short*)(sb + (it & 1) * 768); LAS unsigned char* bktw = sb + (it & 1) * 768 + 512;
        u32x2 svn = {0u, 0u}; unsigned bvn = 0u;
        if (it + 1 < ntok) { const size_t rown = SA_ROW(it + 1); svn = *(const GAS u32x2*)(SEL + rown * 256 + 4 * l); bvn = *(const GAS unsigned*)(BKT + rown * 256 + 4 * l); }
        pg8::i32x8 q8; float qq = 0.f;
        { const v4u qa = __builtin_nontemporal_load((const v4u*)(QLAT8 + row * 2048 + l15 * 128 + g * 32)), qb = __builtin_nontemporal_load((const v4u*)(QLAT8 + row * 2048 + l15 * 128 + g * 32 + 16));
          q8 = (pg8::i32x8){(int)qa.x, (int)qa.y, (int)qa.z, (int)qa.w, (int)qb.x, (int)qb.y, (int)qb.z, (int)qb.w};
#pragma unroll
          for (int d = 0; d < 8; ++d) { const f32x2 a = __builtin_amdgcn_cvt_pk_f32_fp8(q8[d], false), b = __builtin_amdgcn_cvt_pk_f32_fp8(q8[d], true); qq += (a.x * a.x + a.y * a.y) + (b.x * b.x + b.y * b.y); }
          qq *= 1.0f / (F8_QLS * F8_QLS); }
        qq += __shfl_xor(qq, 16); qq += __shfl_xor(qq, 32);
        const float mh = sqrtf(qq) * cmax + bmaxh;
        const float nmh = -mh; f32x4 lsum = (f32x4){0.f, 0.f, 0.f, 0.f}; f32x4 o[8];
#pragma unroll
        for (int mt = 0; mt < 8; ++mt) o[mt] = (f32x4){0.f, 0.f, 0.f, 0.f};
#define SA_SW(r_) ((((r_) >> 1) & 3) | (((((r_) >> 2) ^ ((r_) >> 4)) & 1) << 2))
#define SA_DMA(c_) do { _Pragma("unroll") for (int q = 0; q < 4; ++q) { const int r_ = 8 * q + (l >> 3); unsigned idx = selw[32 * (c_) + 8 * (r_ & 3) + (r_ >> 2)]; idx = (idx == 0xFFFFu) ? 0u : idx; \
            const unsigned char* src = CKV8 + (rowb + idx) * 128 + (((l & 7) ^ SA_SW(r_)) * 16); \
            __builtin_amdgcn_global_load_lds((const GAS unsigned*)src, (LAS unsigned*)(cb + ((c_) & 3) * 4096 + q * 1024), 16, 0, 0); } } while (0)
        SA_DMA(0); SA_DMA(1);
        unsigned f8one = 0x7f7f7f7fu, f8qs = 0x7b7b7b7bu; asm volatile("" : "+v"(f8one), "+v"(f8qs));
        const bf16x8 ones8 = (bf16x8){0x3F80, 0x3F80, 0x3F80, 0x3F80, 0x3F80, 0x3F80, 0x3F80, 0x3F80};
        const int pvr = (l15 >> 1) < 4 ? 4 * g + (l15 >> 1) : 16 + 4 * g + ((l15 >> 1) - 4); const int pvoff = pvr * 128 + (l15 & 1) * 8, pvsw = SA_SW(pvr);
#pragma unroll
        for (int c = 0; c < 8; c += 2) {
            if (c + 2 < 8) { SA_DMA(c + 2); SA_DMA(c + 3); asm volatile("s_waitcnt vmcnt(8)" ::: "memory"); } else { asm volatile("s_waitcnt vmcnt(0)" ::: "memory"); }
            pg8::i32x8 a8[4]; float bias[4][4]; u32x2 vt[16]; unsigned bk[4];
#pragma unroll
            for (int h2 = 0; h2 < 2; ++h2) { LAS unsigned char* cbc = cb + ((c + h2) & 3) * 4096;
                bk[2 * h2] = *(const LAS unsigned*)(bktw + (c + h2) * 32 + 4 * g); bk[2 * h2 + 1] = *(const LAS unsigned*)(bktw + (c + h2) * 32 + 16 + 4 * g);
#pragma unroll
                for (int tt = 0; tt < 2; ++tt) { const int R = 16 * tt + l15; const v4u lo = *(const LAS v4u*)(cbc + R * 128 + (((2 * g) ^ SA_SW(R)) * 16)), hi = *(const LAS v4u*)(cbc + R * 128 + (((2 * g + 1) ^ SA_SW(R)) * 16));
                    a8[2 * h2 + tt] = (pg8::i32x8){(int)lo.x, (int)lo.y, (int)lo.z, (int)lo.w, (int)hi.x, (int)hi.y, (int)hi.z, (int)hi.w}; }
#pragma unroll
                for (int mt = 0; mt < 8; ++mt) { typedef int v2i_t __attribute__((ext_vector_type(2)));
                    const v2i_t t8 = __builtin_amdgcn_ds_read_tr8_b64_v2i32((LAS v2i_t*)(cbc + pvoff + ((mt ^ pvsw) * 16))); vt[8 * h2 + mt] = (u32x2){(unsigned)t8.x, (unsigned)t8.y}; } }
#pragma unroll
            for (int q = 0; q < 4; ++q)
#pragma unroll
                for (int r = 0; r < 4; ++r) bias[q][r] = relt[((bk[q] >> (8 * r)) & 0xffu) * 16 + l15];
            __builtin_amdgcn_sched_barrier(0);
            f32x4 s0 = (f32x4){nmh, nmh, nmh, nmh}, s1 = s0, s2 = s0, s3 = s0;
            asm volatile("v_mfma_scale_f32_16x16x128_f8f6f4 %0, %4, %8, %0, %9, %10 op_sel_hi:[0,0,0]\n\tv_mfma_scale_f32_16x16x128_f8f6f4 %1, %5, %8, %1, %9, %10 op_sel_hi:[0,0,0]\n\t"
                         "v_mfma_scale_f32_16x16x128_f8f6f4 %2, %6, %8, %2, %9, %10 op_sel_hi:[0,0,0]\n\tv_mfma_scale_f32_16x16x128_f8f6f4 %3, %7, %8, %3, %9, %10 op_sel_hi:[0,0,0]\n\ts_nop 15\n\ts_nop 3"
                         : "+v"(s0), "+v"(s1), "+v"(s2), "+v"(s3) : "v"(a8[0]), "v"(a8[1]), "v"(a8[2]), "v"(a8[3]), "v"(q8), "v"(f8one), "v"(f8qs));
#pragma unroll
            for (int r = 0; r < 4; ++r) { s0[r] = __builtin_amdgcn_exp2f(s0[r] + bias[0][r]); s1[r] = __builtin_amdgcn_exp2f(s1[r] + bias[1][r]); s2[r] = __builtin_amdgcn_exp2f(s2[r] + bias[2][r]); s3[r] = __builtin_amdgcn_exp2f(s3[r] + bias[3][r]); }
            u32x4 pw0, pw1; pw0.x = cvtpk(s0[0], s0[1]); pw0.y = cvtpk(s0[2], s0[3]); pw0.z = cvtpk(s1[0], s1[1]); pw0.w = cvtpk(s1[2], s1[3]);
            pw1.x = cvtpk(s2[0], s2[1]); pw1.y = cvtpk(s2[2], s2[3]); pw1.z = cvtpk(s3[0], s3[1]); pw1.w = cvtpk(s3[2], s3[3]);
#pragma unroll
            for (int h2 = 0; h2 < 2; ++h2) { const bf16x8 pb = __builtin_bit_cast(bf16x8, h2 ? pw1 : pw0);
                lsum = __builtin_amdgcn_mfma_f32_16x16x32_bf16(ones8, pb, lsum, 0, 0, 0);
#pragma unroll
                for (int mt = 0; mt < 8; ++mt) { typedef __bf16 bf2_t __attribute__((ext_vector_type(2))); const u32x2 v = vt[8 * h2 + mt];
                    u32x4 aw; aw.x = __builtin_bit_cast(unsigned, (bf2_t)__builtin_amdgcn_cvt_scalef32_pk_bf16_fp8(v.x, 1.0f, false)); aw.y = __builtin_bit_cast(unsigned, (bf2_t)__builtin_amdgcn_cvt_scalef32_pk_bf16_fp8(v.x, 1.0f, true));
                    aw.z = __builtin_bit_cast(unsigned, (bf2_t)__builtin_amdgcn_cvt_scalef32_pk_bf16_fp8(v.y, 1.0f, false)); aw.w = __builtin_bit_cast(unsigned, (bf2_t)__builtin_amdgcn_cvt_scalef32_pk_bf16_fp8(v.y, 1.0f, true));
                    o[mt] = __builtin_amdgcn_mfma_f32_16x16x32_bf16(__builtin_bit_cast(bf16x8, aw), pb, o[mt], 0, 0, 0); } }
            LDS_WAIT();
        }
#undef SA_DMA
#undef SA_SW
        const float inv = F8_OLS / lsum[0];
#pragma unroll
        for (int mt = 0; mt < 8; ++mt) __builtin_nontemporal_store(pg8::cvt4_fp8(o[mt][0] * inv, o[mt][1] * inv, o[mt][2] * inv, o[mt][3] * inv), (unsigned*)(OLAT + row * 2048 + l15 * 128 + 16 * mt + 4 * g));
        { LAS unsigned char* sn = sb + ((it + 1) & 1) * 768; *(LAS u32x2*)(sn + 8 * l) = svn; SA_PARK_BKT(sn + 512, bvn); }
        LDS_WAIT();
    }
#undef SA_ROW
#undef SA_PARK_BKT
    LDS_WAIT(); __syncthreads();
}

typedef float f32x4v __attribute__((ext_vector_type(4)));
__device__ __forceinline__ void p_ln_router(Frame& F, const float* xbase, const bool base16  , const float* lg, const float* lb, const float* w_router, const float* b_router, int layer) {
    PHASE_IDS();
    const unsigned char* HB = (const unsigned char*)(F.ws + WS_Y);        bf16* XF = (bf16*)(F.ws + WS_XF); unsigned char* XB8 = (unsigned char*)(F.ws + WS_XB8);
    int* TOPE = (int*)(F.ws + WS_TOPE); float* TOPG = (float*)(F.ws + WS_TOPG); int* POS = (int*)(F.ws + WS_POS); unsigned short* TOKE = (unsigned short*)(F.ws + WS_TOKE);
    gu32* gcnt = F.ctl + CW_CNT + 64 * layer;
    LAS float* lgt = (LAS float*)F.lds;
    LAS int* hist = (LAS int*)(F.lds + 128 * 33 * 4);
    LAS int* base = hist + 32;
    LAS bf16* wst = (LAS bf16*)(F.lds + 32768);
    const int l = lane, l15 = l & 15, g = l >> 4;
    f32x4 gv[4], bv[4];
#pragma unroll
    for (int j = 0; j < 4; ++j) { gv[j] = *(const f32x4*)(lg + 4 * l + 256 * j); bv[j] = *(const f32x4*)(lb + 4 * l + 256 * j); }
    for (int unit = F.vcu; unit < M / 128; unit += F.G) {
        const int r0 = unit * 128 + wave * 16;
        if (tid < 32) hist[tid] = 0;
        u32x4 vn[4]; unsigned hn[4];
#define LNR_LOAD(row_) do { const GAS unsigned* hp = (const GAS unsigned*)(HB + (size_t)(row_) * D) + l; \
            if (base16) { const GAS u32x2* yp = (const GAS u32x2*)((const bf16*)xbase + (size_t)(row_) * D) + l; _Pragma("unroll") for (int j = 0; j < 4; ++j) { const u32x2 t2 = yp[64 * j]; vn[j] = (u32x4){t2.x, t2.y, 0u, 0u}; hn[j] = hp[64 * j]; } } \
            else { const GAS u32x4* yp = (const GAS u32x4*)(xbase + (size_t)(row_) * D) + l; _Pragma("unroll") for (int j = 0; j < 4; ++j) { vn[j] = yp[64 * j]; hn[j] = hp[64 * j]; } } } while (0)
        f32x4 wv[8];
#define LNR_WLOAD(half_) do { _Pragma("unroll") for (int i_ = 0; i_ < 8; ++i_) wv[i_] = *(const GAS f32x4*)(w_router + (size_t)(half_) * 16384 + 4 * (tid + 512 * i_)); } while (0)
#define LNR_WSTORE() do { _Pragma("unroll") for (int i_ = 0; i_ < 8; ++i_) { const int idx_ = 4 * (tid + 512 * i_), k_ = idx_ >> 5, n_ = idx_ & 31; LAS bf16* d_ = wst + ((k_ >> 3) * 32 + n_) * 8 + (k_ & 7); \
            _Pragma("unroll") for (int e_ = 0; e_ < 4; ++e_) { const float w_ = wv[i_][e_]; const unsigned h1 = f2bf(w_); const float r1 = w_ - __uint_as_float(h1 << 16); \
                const unsigned h2 = f2bf(r1); const float r2 = r1 - __uint_as_float(h2 << 16); const unsigned h3 = f2bf(r2); \
                d_[8 * e_] = (bf16)h1; d_[16384 + 8 * e_] = (bf16)h2; d_[32768 + 8 * e_] = (bf16)h3; } } } while (0)
        LNR_WLOAD(0);
        LNR_LOAD(r0);
        for (int i = 0; i < 16; ++i) { const size_t row = (size_t)(r0 + i);
            f32x4 v[4]; float s = 0.f;
#pragma unroll
            for (int j = 0; j < 4; ++j) { const f32x2 h01 = __builtin_amdgcn_cvt_pk_f32_fp8((int)hn[j], false), h23 = __builtin_amdgcn_cvt_pk_f32_fp8((int)hn[j], true); const u32x4 bb = vn[j]; f32x4 xb;
                if (base16) xb = (f32x4){__uint_as_float(bb.x << 16), __uint_as_float(bb.x & 0xffff0000u), __uint_as_float(bb.y << 16), __uint_as_float(bb.y & 0xffff0000u)};
                else xb = (f32x4){__uint_as_float(bb.x), __uint_as_float(bb.y), __uint_as_float(bb.z), __uint_as_float(bb.w)};
                v[j].x = xb.x * DN_ALPHA + h01.x * (1.0f / F8_HYS); v[j].y = xb.y * DN_ALPHA + h01.y * (1.0f / F8_HYS);
                v[j].z = xb.z * DN_ALPHA + h23.x * (1.0f / F8_HYS); v[j].w = xb.w * DN_ALPHA + h23.y * (1.0f / F8_HYS);
                s += (v[j].x + v[j].y) + (v[j].z + v[j].w); }
            if (i < 15) { LNR_LOAD(row + 1); }
            const float mean = wave_sum(s) * (1.f / D); float s2 = 0.f;
#pragma unroll
            for (int j = 0; j < 4; ++j) { v[j] = v[j] - mean; s2 += (v[j].x * v[j].x + v[j].y * v[j].y) + (v[j].z * v[j].z + v[j].w * v[j].w); }
            const float rstd = 1.f / sqrtf(wave_sum(s2) * (1.f / D) + LN_EPS);
            GAS u32x2* xo = (GAS u32x2*)(XF + row * D) + l; GAS unsigned* bo = (GAS unsigned*)(XB8 + row * D) + l;
#pragma unroll
            for (int j = 0; j < 4; ++j) { const f32x4 o = v[j] * rstd * gv[j] + bv[j]; u32x2 ow; ow.x = cvtpk(o.x, o.y); ow.y = cvtpk(o.z, o.w); xo[64 * j] = ow; bo[64 * j] = pg8::cvt4_fp8(o.x * F8_XS, o.y * F8_XS, o.z * F8_XS, o.w * F8_XS); } }
#undef LNR_LOAD
        asm volatile("s_waitcnt vmcnt(0)" ::: "memory");
        f32x4 acc0 = (f32x4){0.f, 0.f, 0.f, 0.f}, acc1 = acc0;
        { const bf16* xr = XF + (size_t)(r0 + l15) * D + 8 * g;
#pragma unroll 1
          for (int half = 0; half < 2; ++half) {
              LNR_WSTORE(); if (half == 0) LNR_WLOAD(1);
              LDS_WAIT(); __syncthreads();
#pragma unroll 1
              for (int k0 = 0; k0 < 512; k0 += 128) {
                  bf16x8 a[4], w[4][2][3];
#pragma unroll
                  for (int q = 0; q < 4; ++q) { a[q] = __builtin_nontemporal_load((const bf16x8*)(xr + half * 512 + k0 + 32 * q));
#pragma unroll
                      for (int ct = 0; ct < 2; ++ct)
#pragma unroll
                          for (int tm = 0; tm < 3; ++tm) w[q][ct][tm] = *(const LAS bf16x8*)(wst + tm * 16384 + ((((k0 + 32 * q) >> 3) + g) * 32 + l15 + 16 * ct) * 8); }
#pragma unroll
                  for (int q = 0; q < 4; ++q)
#pragma unroll
                      for (int tm = 2; tm >= 0; --tm) { acc0 = __builtin_amdgcn_mfma_f32_16x16x32_bf16(a[q], w[q][0][tm], acc0, 0, 0, 0); acc1 = __builtin_amdgcn_mfma_f32_16x16x32_bf16(a[q], w[q][1][tm], acc1, 0, 0, 0); } }
              LDS_WAIT(); __syncthreads(); } }
#undef LNR_WLOAD
#undef LNR_WSTORE
        { const float b0 = b_router[l15], b1 = b_router[l15 + 16];
#pragma unroll
          for (int r = 0; r < 4; ++r) { lgt[(wave * 16 + 4 * g + r) * 33 + l15] = acc0[r] + b0; lgt[(wave * 16 + 4 * g + r) * 33 + l15 + 16] = acc1[r] + b1; } }
        LDS_WAIT(); __syncthreads();
        int te[4] = {0, 0, 0, 0}, lp[4] = {0, 0, 0, 0}; float tg[4] = {0.f, 0.f, 0.f, 0.f};
        if (l < 16) { const LAS float* rp = lgt + (wave * 16 + l) * 33; float tv[4] = {-INFINITY, -INFINITY, -INFINITY, -INFINITY};
            for (int e = 0; e < NEXP; ++e) { const float v = rp[e];
                if (v > tv[3]) { if (v > tv[0]) { tv[3] = tv[2]; te[3] = te[2]; tv[2] = tv[1]; te[2] = te[1]; tv[1] = tv[0]; te[1] = te[0]; tv[0] = v; te[0] = e; }
                    else if (v > tv[1]) { tv[3] = tv[2]; te[3] = te[2]; tv[2] = tv[1]; te[2] = te[1]; tv[1] = v; te[1] = e; }
                    else if (v > tv[2]) { tv[3] = tv[2]; te[3] = te[2]; tv[2] = v; te[2] = e; }
                    else { tv[3] = v; te[3] = e; } } }
            const float e1 = __expf(tv[1] - tv[0]), e2 = __expf(tv[2] - tv[0]), e3 = __expf(tv[3] - tv[0]); const float inv = 1.0f / (1.0f + e1 + e2 + e3);
            tg[0] = inv; tg[1] = e1 * inv; tg[2] = e2 * inv; tg[3] = e3 * inv;
#pragma unroll
            for (int k = 0; k < 4; ++k) lp[k] = atomicAdd((int*)(hist + te[k]), 1); }
        LDS_WAIT(); __syncthreads();
        if (tid < 32) base[tid] = (int)__hip_atomic_fetch_add(gcnt + tid, (unsigned)hist[tid], __ATOMIC_RELAXED, __HIP_MEMORY_SCOPE_AGENT);
        LDS_WAIT(); __syncthreads();
        if (l < 16) { const size_t row = (size_t)(r0 + l);
            typedef int i32x4 __attribute__((ext_vector_type(4)));
            *(GAS i32x4*)(TOPE + row * 4) = (i32x4){te[0], te[1], te[2], te[3]};
            *(GAS f32x4*)(TOPG + row * 4) = (f32x4){tg[0], tg[1], tg[2], tg[3]};
            const int p0 = base[te[0]] + lp[0], p1 = base[te[1]] + lp[1], p2 = base[te[2]] + lp[2], p3 = base[te[3]] + lp[3];
            *(GAS i32x4*)(POS + row * 4) = (i32x4){p0, p1, p2, p3};
            TOKE[(size_t)te[0] * 32768 + p0] = (unsigned short)row; TOKE[(size_t)te[1] * 32768 + p1] = (unsigned short)row; TOKE[(size_t)te[2] * 32768 + p2] = (unsigned short)row; TOKE[(size_t)te[3] * 32768 + p3] = (unsigned short)row; }
        LDS_WAIT(); __syncthreads();
    }
}

__device__ __forceinline__ int moe_tables(Frame& F, int layer, LAS int* tab) {
    gu32* gcnt = F.ctl + CW_CNT + 64 * layer;
    if (threadIdx.x < NEXP) tab[64 + threadIdx.x] = (int)__hip_atomic_load(gcnt + threadIdx.x, __ATOMIC_RELAXED, __HIP_MEMORY_SCOPE_AGENT);
    LDS_WAIT(); __syncthreads();
    if (threadIdx.x == 0) { int acc = 0; for (int e = 0; e < NEXP; ++e) { tab[e] = acc; acc += (tab[64 + e] + 255) >> 8; } tab[NEXP] = acc; }
    LDS_WAIT(); __syncthreads();
    const int nT = tab[NEXP];
    for (int pm = threadIdx.x; pm < nT; pm += NWAVES * 64) { int e = 0; for (int k = 1; k < NEXP; ++k) e += (tab[k] <= pm) ? 1 : 0;
        tab[128 + pm] = e; }
    LDS_WAIT(); __syncthreads();
    return nT;
}

__device__ __forceinline__ void p_moe_combine_ln(Frame& F, const float* lg, const float* lb, float* out_final, int layer) {
    PHASE_IDS();
    LAS int* tab = (LAS int*)F.lds; (void)moe_tables(F, layer, tab);
    bf16* XF = (bf16*)(F.ws + WS_XF); unsigned char* XB8 = (unsigned char*)(F.ws + WS_XB8); const unsigned char* Y2 = (const unsigned char*)(F.ws + WS_XG);
    const int* TOPE = (const int*)(F.ws + WS_TOPE); const int* POS = (const int*)(F.ws + WS_POS); const float* TOPG = (const float*)(F.ws + WS_TOPG);
    const int l = lane; const int gw = F.vcu * NWAVES + wave, NGW = F.G * NWAVES;
    f32x4 gv[4], bv[4];
#pragma unroll
    for (int j = 0; j < 4; ++j) { gv[j] = *(const f32x4*)(lg + 4 * l + 256 * j); bv[j] = *(const f32x4*)(lb + 4 * l + 256 * j); }
    for (int row = gw; row < M; row += NGW) {
        typedef int i32x4 __attribute__((ext_vector_type(4)));
        const i32x4 e4 = *(const GAS i32x4*)(TOPE + (size_t)row * 4), p4 = *(const GAS i32x4*)(POS + (size_t)row * 4); const f32x4 gt = *(const GAS f32x4*)(TOPG + (size_t)row * 4);
        i32x4 sl; sl[0] = 256 * tab[e4[0]] + p4[0]; sl[1] = 256 * tab[e4[1]] + p4[1]; sl[2] = 256 * tab[e4[2]] + p4[2]; sl[3] = 256 * tab[e4[3]] + p4[3];
        GAS u32x2* xp = (GAS u32x2*)(XF + (size_t)row * D) + l; f32x4 v[4];
#pragma unroll
        for (int j = 0; j < 4; ++j) { const u32x2 xb = xp[64 * j]; v[j] = (f32x4){__uint_as_float(xb.x << 16), __uint_as_float(xb.x & 0xffff0000u), __uint_as_float(xb.y << 16), __uint_as_float(xb.y & 0xffff0000u)} * DN_ALPHA; }
#pragma unroll
        for (int k = 0; k < 4; ++k) { const GAS int* yp = (const GAS int*)(Y2 + (size_t)sl[k] * D) + l; const float gk = gt[k] * (1.0f / F8_YS);
#pragma unroll
            for (int j = 0; j < 4; ++j) { const int w = yp[64 * j];
                v[j].x += gk * __builtin_amdgcn_cvt_f32_fp8(w, 0); v[j].y += gk * __builtin_amdgcn_cvt_f32_fp8(w, 1); v[j].z += gk * __builtin_amdgcn_cvt_f32_fp8(w, 2); v[j].w += gk * __builtin_amdgcn_cvt_f32_fp8(w, 3); } }
        float s = 0.f;
#pragma unroll
        for (int j = 0; j < 4; ++j) s += (v[j].x + v[j].y) + (v[j].z + v[j].w);
        const float mean = wave_sum(s) * (1.f / D); float s2 = 0.f;
#pragma unroll
        for (int j = 0; j < 4; ++j) { v[j] = v[j] - mean; s2 += (v[j].x * v[j].x + v[j].y * v[j].y) + (v[j].z * v[j].z + v[j].w * v[j].w); }
        const float rstd = 1.f / sqrtf(wave_sum(s2) * (1.f / D) + LN_EPS);
        if (out_final) { GAS f32x4* op = (GAS f32x4*)(out_final + (size_t)row * D) + l;
            const float poison = (__hip_atomic_load(F.ctl + CW_TMO, __ATOMIC_RELAXED, __HIP_MEMORY_SCOPE_AGENT) != 0u) ? __builtin_nanf("") : 0.f;
#pragma unroll
            for (int j = 0; j < 4; ++j) op[64 * j] = v[j] * rstd * gv[j] + bv[j] + poison; }
        else { GAS unsigned* bo = (GAS unsigned*)(XB8 + (size_t)row * D) + l;
#pragma unroll
            for (int j = 0; j < 4; ++j) { const f32x4 o = v[j] * rstd * gv[j] + bv[j]; u32x2 ow; ow.x = cvtpk(o.x, o.y); ow.y = cvtpk(o.z, o.w); xp[64 * j] = ow; bo[64 * j] = pg8::cvt4_fp8(o.x * F8_XS, o.y * F8_XS, o.z * F8_XS, o.w * F8_XS); } }
    }
}

__device__ __forceinline__ void p_fox_gate(Frame& F, const float* w_f, const float* b_f) {
    PHASE_IDS();
    const bf16* XF = (const bf16*)(F.ws + WS_XF); float* LOGF = (float*)(F.ws + WS_LOGF);
    const int l = lane, l15 = l & 15, g = l >> 4; const int gw = F.vcu * NWAVES + wave, NGW = F.G * NWAVES;
    const float bf = b_f[l15];
    LAS bf16* wst = (LAS bf16*)F.lds;
    { f32x4 wv[8];
#pragma unroll
      for (int i = 0; i < 8; ++i) wv[i] = *(const GAS f32x4*)(w_f + 4 * (tid + 512 * i));
#pragma unroll
      for (int i = 0; i < 8; ++i) { const int idx = 4 * (tid + 512 * i), k_ = idx >> 4, n_ = idx & 15; LAS bf16* d_ = wst + ((k_ >> 3) * 16 + n_) * 8 + (k_ & 7);
#pragma unroll
          for (int e2 = 0; e2 < 4; ++e2) { const float w_ = wv[i][e2]; const unsigned h1 = f2bf(w_); const float r1 = w_ - __uint_as_float(h1 << 16);
              const unsigned h2 = f2bf(r1); const float r2 = r1 - __uint_as_float(h2 << 16); const unsigned h3 = f2bf(r2);
              d_[8 * e2] = (bf16)h1; d_[16384 + 8 * e2] = (bf16)h2; d_[32768 + 8 * e2] = (bf16)h3; } } }
    LDS_WAIT(); __syncthreads();
    for (int tile = gw; tile < M / 16; tile += NGW) {
        f32x4 acc = (f32x4){0.f, 0.f, 0.f, 0.f}; const bf16* xr = XF + (size_t)(tile * 16 + l15) * D + 8 * g;
#pragma unroll 1
        for (int k0 = 0; k0 < D; k0 += 128) {
            bf16x8 a[4], w[4][3];
#pragma unroll
            for (int q = 0; q < 4; ++q) { a[q] = *(const GAS bf16x8*)(xr + k0 + 32 * q);
#pragma unroll
                for (int tm = 0; tm < 3; ++tm) w[q][tm] = *(const LAS bf16x8*)(wst + tm * 16384 + ((((k0 + 32 * q) >> 3) + g) * 16 + l15) * 8); }
#pragma unroll
            for (int q = 0; q < 4; ++q)
#pragma unroll
                for (int tm = 2; tm >= 0; --tm) acc = __builtin_amdgcn_mfma_f32_16x16x32_bf16(a[q], w[q][tm], acc, 0, 0, 0); }
#pragma unroll
        for (int r = 0; r < 4; ++r) { const float z = acc[r] + bf; const float ls = fminf(z, 0.f) - log1pf(__expf(-fabsf(z)));
            LOGF[(size_t)(tile * 16 + 4 * g + r) * 16 + l15] = ls; }
    }
    LDS_WAIT(); __syncthreads();
}
__device__ __forceinline__ void split3(float f, unsigned short& h, unsigned short& m, unsigned short& lo) {
    const unsigned p1 = f2bf(f); const float f1 = __uint_as_float(p1 << 16); const float r1 = f - f1;
    const unsigned p2 = f2bf(r1); const float f2 = __uint_as_float(p2 << 16); const float r2 = r1 - f2;
    h = (unsigned short)p1; m = (unsigned short)p2; lo = (unsigned short)f2bf(r2);
}
__device__ __forceinline__ void p_fox_cum(Frame& F) {
    PHASE_IDS();
    const float* LOGF = (const float*)(F.ws + WS_LOGF); bf16* QX = (bf16*)(F.ws + WS_QX); bf16* KX = (bf16*)(F.ws + WS_KX);
    const bf16* Q = (const bf16*)(F.ws + WS_Q); const bf16* K = (const bf16*)(F.ws + WS_K);
    float* CUM2 = (float*)(F.ws + WS_CUM2); float* KMAX = (float*)(F.ws + WS_KMAX); float* DG = (float*)(F.ws + WS_DG);
    LAS double* red = (LAS double*)F.lds;
    LAS double* pre = red + 512;
    LAS double* tot = pre + 16;
    LAS float* kn2 = (LAS float*)(tot + 512);
    LAS float* qn2 = kn2 + 512;
    LAS float* dgm = qn2 + 512;
    const int h = tid & 15, sub = tid >> 4;
    for (int unit = F.vcu; unit < BATCH * 32; unit += F.G) {
        const int b = unit >> 5, seg = unit & 31; const size_t rowb = (size_t)b * T;
        double s = 0.0;
        { const int nprev = seg * 128; int t = sub;
          for (; t + 7 * 32 < nprev; t += 8 * 32) { float a[8];
#pragma unroll
              for (int q = 0; q < 8; ++q) a[q] = LOGF[(rowb + t + 32 * q) * 16 + h];
              s += (((double)a[0] + (double)a[1]) + ((double)a[2] + (double)a[3])) + (((double)a[4] + (double)a[5]) + ((double)a[6] + (double)a[7])); }
          for (; t < nprev; t += 32) s += (double)LOGF[(rowb + t) * 16 + h]; }
        red[sub * 16 + h] = s;
        const int t0 = seg * 128 + sub * 4; float lf[4];
#pragma unroll
        for (int i = 0; i < 4; ++i) lf[i] = LOGF[(rowb + t0 + i) * 16 + h];
        tot[sub * 16 + h] = (double)lf[0] + (double)lf[1] + (double)lf[2] + (double)lf[3];
        { float kmx = 0.f, qmx = 0.f, dmn = INFINITY;
#pragma unroll
          for (int i = 0; i < 4; ++i) { const GAS v4u* qp = (const GAS v4u*)(Q + (rowb + t0 + i) * D + h * 64); const GAS v4u* kp = (const GAS v4u*)(K + (rowb + t0 + i) * D + h * 64);
              float qq = 0.f, kk = 0.f, qk = 0.f;
#pragma unroll
              for (int c = 0; c < 8; ++c) { const v4u a = qp[c], bb = kp[c]; const unsigned aw[4] = {a.x, a.y, a.z, a.w}, bw[4] = {bb.x, bb.y, bb.z, bb.w};
#pragma unroll
                  for (int e = 0; e < 4; ++e) { const float a0 = __uint_as_float(aw[e] << 16), a1 = __uint_as_float(aw[e] & 0xffff0000u), b0 = __uint_as_float(bw[e] << 16), b1 = __uint_as_float(bw[e] & 0xffff0000u);
                      qq += a0 * a0 + a1 * a1; kk += b0 * b0 + b1 * b1; qk += a0 * b0 + a1 * b1; } }
              kmx = fmaxf(kmx, kk); qmx = fmaxf(qmx, qq); dmn = fminf(dmn, qk); DG[(rowb + t0 + i) * 16 + h] = qk; }
          kn2[sub * 16 + h] = kmx; qn2[sub * 16 + h] = qmx; dgm[sub * 16 + h] = dmn; }
        LDS_WAIT(); __syncthreads();
        if (tid < 16) { double a = 0.0; for (int j = 0; j < 32; ++j) a += red[j * 16 + tid]; pre[tid] = a; }
        if (tid >= 64 && tid < 96) { const int hh = tid & 15, tl = (tid >> 4) & 1; float m = 0.f; for (int j = 0; j < 16; ++j) m = fmaxf(m, kn2[(tl * 16 + j) * 16 + hh]);
            KMAX[(size_t)(b * 16 + hh) * 64 + seg * 2 + tl] = sqrtf(m); }
        if (tid >= 128 && tid < 144) { const int hh = tid & 15; float m = 0.f, d = INFINITY; for (int j = 0; j < 32; ++j) { m = fmaxf(m, qn2[j * 16 + hh]); d = fminf(d, dgm[j * 16 + hh]); }
            const int qi = (b * 16 + hh) * 16 + (seg >> 1);
            __hip_atomic_fetch_max(F.ctl + CW_QMAX + qi, __float_as_uint(sqrtf(m)), __ATOMIC_RELAXED, __HIP_MEMORY_SCOPE_AGENT);
            __hip_atomic_fetch_max(F.ctl + CW_MNEG + qi, fkey(-d), __ATOMIC_RELAXED, __HIP_MEMORY_SCOPE_AGENT); }
        LDS_WAIT(); __syncthreads();
        double c = pre[h]; for (int j = 0; j < sub; ++j) c += tot[j * 16 + h];
#pragma unroll
        for (int i = 0; i < 4; ++i) { c += (double)lf[i]; const float cf = (float)(c * 1.4426950408889634);
            unsigned short ch, cm, cl; split3(cf, ch, cm, cl); unsigned short nh, nm, nl; split3(-cf, nh, nm, nl);
            const size_t o = ((rowb + t0 + i) * 16 + h) * 16;
            CUM2[(rowb + t0 + i) * 16 + h] = cf;
            const unsigned one2 = 0x3F803F80u;
            v4u q0; q0.x = one2; q0.y = 0x3F80u | ((unsigned)ch << 16); q0.z = (unsigned)cm | ((unsigned)cl << 16); q0.w = 0u;
            v4u q1; q1.x = 0u; q1.y = 0u; q1.z = 0u; q1.w = 0u;
            v4u k0; k0.x = (unsigned)nh | ((unsigned)nm << 16); k0.y = (unsigned)nl | (0x3F80u << 16); k0.z = one2; k0.w = one2;
            v4u k1; k1.x = 0x3F80u; k1.y = 0u; k1.z = 0u; k1.w = 0u;
            *(GAS v4u*)(QX + o) = q0; *(GAS v4u*)(QX + o + 8) = q1; *(GAS v4u*)(KX + o) = k0; *(GAS v4u*)(KX + o + 8) = k1; }
        LDS_WAIT(); __syncthreads();
    }
}
__device__ __forceinline__ void p_fox_ts(Frame& F) {
    PHASE_IDS();
    const float* CUM2 = (const float*)(F.ws + WS_CUM2); const float* KMAX = (const float*)(F.ws + WS_KMAX); unsigned char* TS = (unsigned char*)(F.ws + WS_TS);
    const int gw = F.vcu * NWAVES + wave, NGW = F.G * NWAVES;
    for (int u = gw; u < BATCH * 16 * 16; u += NGW) { const int bh = u >> 4, qb = u & 15, b = bh >> 4, h = bh & 15; const size_t rowb = (size_t)b * T;
        const float qmax = __uint_as_float(__hip_atomic_load(F.ctl + CW_QMAX + u, __ATOMIC_RELAXED, __HIP_MEMORY_SCOPE_AGENT));
        const unsigned kk = __hip_atomic_load(F.ctl + CW_MNEG + u, __ATOMIC_RELAXED, __HIP_MEMORY_SCOPE_AGENT); const float negmlo = __uint_as_float((kk & 0x80000000u) ? (kk & 0x7fffffffu) : ~kk);
        const float cq = CUM2[(rowb + 256 * qb) * 16 + h]; const float ck = CUM2[(rowb + 64 * lane + 63) * 16 + h]; const float km = KMAX[(size_t)bh * 64 + lane];
        const float bound = (cq - ck) + qmax * km + negmlo + 1.0f;
        const bool keep = (lane >= 4 * qb) || !(bound < -36.0f);
        const unsigned long long m = __ballot(keep); int first = __builtin_ctzll(m); if (first > 4 * qb) first = 4 * qb;
        const bool risky = (lane <= 4 * qb + 3) && !(qmax * km + negmlo < 60.0f);
        const unsigned guard = __ballot(risky) != 0ull ? 1u : 0u;
        if (lane == 0) TS[u] = (unsigned char)((first & ~1) | guard); }
}

struct Args { const float* in[25]; float* out; unsigned char* ws; int ph_lo, ph_hi, li, pad; };

#define IN(k) (lo <= (k) && (k) < hi)
#define BOTH(k) (IN(k) && IN((k) + 1))
#define GRID_BAR(k) do { if (BOTH(k)) xcd_barrier(bar); } while (0)
#ifndef MK_REP_MASK
#define MK_REP_MASK 0u
#endif
#define RUN(k, ...) do { if (IN(k)) { __VA_ARGS__ if ((MK_REP_MASK >> (k)) & 1u) { __VA_ARGS__ } } } while (0)

__device__ __forceinline__ void moe_phases(Frame& F, const XcdBarrier& bar, int lo, int hi, const int layer, const int pb, const float* base, const bool base16, float* out_final) {
    const float* PAR = (const float*)(F.ws + WS_PAR);
    const float* lnm_g = PAR + PAR_LN + layer * D; const float* lnm_b = PAR + PAR_LN + 2048 + layer * D; const float* lnf_g = PAR + PAR_LN + 4096 + layer * D; const float* lnf_b = PAR + PAR_LN + 6144 + layer * D;
    LAS int* tab = (LAS int*)(F.lds + RING_BYTES);
    RUN(pb,  p_ln_router(F, base, base16, lnm_g, lnm_b, PAR + PAR_WROUT + (size_t)layer * D * NEXP, PAR + PAR_BROUT + layer * NEXP, layer); GRID_BAR(pb); );
    RUN(pb + 1,
        const int nT = moe_tables(F, layer, tab);
        pg8::Gemm g{(const pg8::bf16_t*)(F.ws + WS_XB8), (const pg8::bf16_t*)(F.ws + WS_WGU + (size_t)layer * NEXP * 2048 * 1024), nT * 256, NEXP * 2048, 512};
        pg8::MoeOrder S{nT, 8, F.G, (int)blockIdx.x, (const LAS int*)(tab + 128)};
        LAS unsigned short* tokl = (LAS unsigned short*)(F.lds + RING_BYTES + 5120);
        { const unsigned short* TOKE = (const unsigned short*)(F.ws + WS_TOKE);
          if (threadIdx.x < 256) { unsigned short tk[17]; unsigned vm = 0u, um = 0u;
              _Pragma("unroll") for (int i = 0; i < 17; ++i) { pg8::Unit uu; uu.pm = 0; uu.pn = 0; const bool ok = S.next(i, uu); const int e = tab[128 + uu.pm], idx = (uu.pm - tab[e]) * 256 + (int)threadIdx.x; const bool v = ok && idx < tab[64 + e];
                  tk[i] = TOKE[v ? (size_t)e * 32768 + idx : (size_t)0]; vm |= (v ? 1u : 0u) << i; um |= (ok ? 1u : 0u) << i; }
              _Pragma("unroll") for (int i = 0; i < 17; ++i) { if ((um >> i) & 1u) tokl[i * 256 + threadIdx.x] = ((vm >> i) & 1u) ? tk[i] : (unsigned short)0; } }
          LDS_WAIT(); __syncthreads(); }
        pg8::EpiSwiglu8 E{(unsigned char*)(F.ws + WS_H), PAR + PAR_BGU + (size_t)layer * NEXP * 2048, 1.0f / (F8_XS * F8_WGS), F8_HS};
        pg8::gemm_phase<pg8::EpiSwiglu8, pg8::MoeOrder, PG8_ALIGN, PG8_SP2, true, true>(F.lds + RING_OFF, g, S, E, tokl);
        GRID_BAR(pb + 1);
    );
    RUN(pb + 2,
        const int nT = moe_tables(F, layer, tab);
        pg8::Gemm g{(const pg8::bf16_t*)(F.ws + WS_H), (const pg8::bf16_t*)(F.ws + WS_WD + (size_t)layer * NEXP * 1024 * 1024), nT * 256, NEXP * 1024, 512};
        pg8::MoeOrder S{nT, 4, F.G, (int)blockIdx.x, (const LAS int*)(tab + 128)};
        pg8::EpiDown8 E{(unsigned char*)(F.ws + WS_XG), PAR + PAR_BDOWN + (size_t)layer * NEXP * 1024, 1.0f / (F8_HS * F8_WDS), F8_YS};
        pg8::gemm_phase<pg8::EpiDown8, pg8::MoeOrder, PG8_ALIGN, PG8_SP2, false, true>(F.lds + RING_OFF, g, S, E);
        GRID_BAR(pb + 2);
    );
    RUN(pb + 3,  p_moe_combine_ln(F, lnf_g, lnf_b, out_final, layer); if (!out_final) GRID_BAR(pb + 3); );
}

__global__ void __launch_bounds__(NWAVES * 64, 2) mk_fwd(Args args) {
    extern __shared__ __attribute__((aligned(16))) unsigned char lds[];
    Frame F;
    F.lds = (LAS unsigned char*)lds;
    F.MISC = (volatile LAS unsigned*)(F.lds + MISC_OFF);
    F.G = gridDim.x; { const int bx = blockIdx.x; F.vcu = (F.G % 8 == 0) ? (bx % 8) * (F.G / 8) + bx / 8 : bx; }
    F.ws = args.ws; F.ctl = (gu32*)(args.ws + WS_CTL);
    if (threadIdx.x < 64) ((LAS unsigned*)(F.lds + MISC_OFF))[threadIdx.x] = 0u;
    __syncthreads();
    XcdBarrier bar; bar.bar = (unsigned*)(F.ctl + CW_BAR); bar.x = 0; bar.st = nullptr;
    if (MK_N_LAUNCHES == 1) bar = xcd_barrier_post((unsigned*)(F.ctl + CW_BAR), F.MISC + 8);
    const int lo = args.ph_lo, hi = args.ph_hi;

    RUN(0,
        P0In I{args.in[0], args.in[2], args.in[7], args.in[8], args.in[9], args.in[10], args.in[11], args.in[12], args.in[14], args.in[21], args.in[23],
               args.in[1], args.in[3], args.in[4], args.in[5], args.in[6], args.in[13], args.in[15], args.in[16], args.in[17], args.in[18], args.in[19], args.in[20], args.in[22], args.in[24]};
        p0_prologue(F, I); GRID_BAR(0);
    );
#if defined(MK_XBAR) && MK_XBAR
    if (MK_N_LAUNCHES == 1) { for (int xb_i = 0; xb_i < MK_XBAR; ++xb_i) xcd_barrier(bar); }
#endif
    RUN(1,
        pg8::Gemm g{(const pg8::bf16_t*)(F.ws + WS_XB), (const pg8::bf16_t*)(F.ws + WS_WAIN), M, 512, 1024}; pg8::StaticOrder S; S.init(M, 512, F.G, (int)blockIdx.x);
        const float* PAR = (const float*)(F.ws + WS_PAR);
        pg8::EpiDsaNorm E{(pg8::bf16_t*)(F.ws + WS_CQN), (pg8::bf16_t*)(F.ws + WS_CKV), (pg8::bf16_t*)(F.ws + WS_KIDX), (float*)(F.ws + WS_WIDX), PAR + PAR_AGQ, PAR + PAR_AGKV, PAR + PAR_AGKI, PAR + PAR_ABKI,
                          (unsigned*)(F.ctl + CW_CMAX), (LAS float*)(F.lds + RING_BYTES), RMS_EPS, LN_EPS};
        pg8::gemm_phase<pg8::EpiDsaNorm, pg8::StaticOrder, true, PG8_SP2>(F.lds + RING_OFF, g, S, E);
        GRID_BAR(1);
    );
    RUN(2,
        pg8::Gemm g{(const pg8::bf16_t*)(F.ws + WS_CQN), (const pg8::bf16_t*)(F.ws + WS_WACQ), M, 2560, 256}; pg8::StaticOrder S; S.init(M, 2560, F.G, (int)blockIdx.x);
        pg8::EpiCq E{(pg8::bf16_t*)(F.ws + WS_QLAT), (pg8::bf16_t*)(F.ws + WS_QIDX), F8_QLS};
        pg8::gemm_phase<pg8::EpiCq, pg8::StaticOrder, false, PG8_SP2>(F.lds + RING_OFF, g, S, E);
        GRID_BAR(2);
    );
    RUN(3,  p_indexer(F); GRID_BAR(3); );
    RUN(4,  p_sparse_attn(F, (const float*)(F.ws + WS_PAR) + PAR_REL); GRID_BAR(4); );
    RUN(5,
        pg8::Gemm g{(const pg8::bf16_t*)(F.ws + WS_OLAT), (const pg8::bf16_t*)(F.ws + WS_WAO), M, 1024, 1024}; pg8::StaticOrder S; S.init(M, 1024, F.G, (int)blockIdx.x);
        pg8::EpiF8s E{(unsigned char*)(F.ws + WS_Y), F8_HYS / (F8_OLS * F8_WAOS)};
        pg8::gemm_phase<pg8::EpiF8s, pg8::StaticOrder, PG8_ALIGN, PG8_SP2, false, true>(F.lds + RING_OFF, g, S, E);
        GRID_BAR(5);
    );
    moe_phases(F, bar, lo, hi, 0, 6, (const float*)(F.ws + WS_XB), true, nullptr);
    RUN(10,
        p_fox_gate(F, (const float*)(F.ws + WS_PAR) + PAR_WF, (const float*)(F.ws + WS_PAR) + PAR_BF);
        pg8::Gemm g{(const pg8::bf16_t*)(F.ws + WS_XB8), (const pg8::bf16_t*)(F.ws + WS_WBIN), M, 3072, 512}; pg8::StaticOrder S; S.init(M, 3072, F.G, (int)blockIdx.x);
        pg8::EpiQkv8 E{(pg8::bf16_t*)(F.ws + WS_Q), (size_t)(WS_K - WS_Q) / 2, 1.0f / (F8_XS * F8_WBINS), attn_body::C2};
        pg8::gemm_phase<pg8::EpiQkv8, pg8::StaticOrder, PG8_ALIGN, PG8_SP2, false, true>(F.lds + RING_OFF, g, S, E);
        GRID_BAR(10);
    );
    RUN(11,  p_fox_cum(F); GRID_BAR(11); );
    RUN(12,  p_fox_ts(F); GRID_BAR(12); );
    RUN(13,
        const attn_body::AttnTensors AT{(const attn_body::bf16*)(F.ws + WS_Q), (const attn_body::bf16*)(F.ws + WS_K), (const attn_body::bf16*)(F.ws + WS_V), (attn_body::bf16*)(F.ws + WS_O),
                                        (const attn_body::bf16*)(F.ws + WS_QX), (const attn_body::bf16*)(F.ws + WS_KX), (const float*)(F.ws + WS_DG)};
        attn_body::attn_phase<64>((char*)lds + RING_OFF, AT, (unsigned*)(F.ctl + CW_ATTQ), (const unsigned char*)(F.ws + WS_TS));
        GRID_BAR(13);
    );
    RUN(14,
        pg8::Gemm g{(const pg8::bf16_t*)(F.ws + WS_O), (const pg8::bf16_t*)(F.ws + WS_WBO), M, 1024, 512}; pg8::StaticOrder S; S.init(M, 1024, F.G, (int)blockIdx.x);
        pg8::EpiF8s E{(unsigned char*)(F.ws + WS_Y), F8_HYS / (F8_OS * F8_WBOS)};
        pg8::gemm_phase<pg8::EpiF8s, pg8::StaticOrder, PG8_ALIGN, PG8_SP2, false, true>(F.lds + RING_OFF, g, S, E);
        GRID_BAR(14);
    );
    moe_phases(F, bar, lo, hi, 1, 15, (const float*)(F.ws + WS_XF), true, args.out);
}
#undef IN
#undef BOTH
#undef GRID_BAR

extern "C" void kernel_launch(void* const* d_in, const int* in_sizes, int n_in, void* d_out, int out_size, void* d_ws, size_t ws_size, hipStream_t stream) {
    static int grid = 0;
    if (grid == 0) {
        if (n_in != 25 || in_sizes[0] != M * D || out_size != M * D || ws_size < WS_END) { fprintf(stderr, "kernel_launch: unexpected shapes (n_in %d, in0 %d, out %d, ws %zu); nothing launched\n", n_in, n_in > 0 ? in_sizes[0] : -1, out_size, ws_size); grid = -1; return; }
        int dev = 0, cus = 0, per_cu = 0;
        if (hipGetDevice(&dev) != hipSuccess || hipDeviceGetAttribute(&cus, hipDeviceAttributeMultiprocessorCount, dev) != hipSuccess) { grid = -1; return; }
        if (hipFuncSetAttribute((const void*)mk_fwd, hipFuncAttributeMaxDynamicSharedMemorySize, LDS_BYTES) != hipSuccess) { fprintf(stderr, "kernel_launch: hipFuncSetAttribute failed\n"); grid = -1; return; }
        if (hipOccupancyMaxActiveBlocksPerMultiprocessor(&per_cu, (const void*)mk_fwd, NWAVES * 64, LDS_BYTES) != hipSuccess || per_cu < 1) fprintf(stderr, "kernel_launch: occupancy query reports %d workgroups per CU\n", per_cu);
        (void)hipGetLastError();
        grid = cus;
    }
    if (grid < 0) return;
    if (hipMemsetAsync((char*)d_ws + WS_CTL, 0, CTL_ZERO_BYTES, stream) != hipSuccess) return;
    Args a{};
    for (int i = 0; i < 25; ++i) a.in[i] = (const float*)d_in[i];
    a.out = (float*)d_out; a.ws = (unsigned char*)d_ws;
    constexpr int NPH = 19;
    for (int li = 0; li < MK_N_LAUNCHES; ++li) {
        if (MK_N_LAUNCHES == 1) { a.ph_lo = 0; a.ph_hi = NPH; } else { a.ph_lo = li; a.ph_hi = li + 1; }
        a.li = li;
        hipLaunchKernelGGL(mk_fwd, dim3(grid), dim3(NWAVES * 64), LDS_BYTES, stream, a);
        if (MK_N_LAUNCHES != 1 && li + 1 == NPH) break;
    }
}
```
